# Optimizing an MI355X kernel written in HIP

```python
import math
import jax, jax.numpy as jnp
from jax import lax
import numpy as np

D_MODEL = 1024
BATCH = 4
SEQ = 4096
DEPTH = 1

MEM_LEN = 256
D_MIX = D_MODEL
D_DIFF = D_MIX // 2
D_HGRN = D_MIX // 4
D_XMEM = D_MIX // 4
H_DIFF = 4
DH_DIFF = D_DIFF // (2 * H_DIFF)
H_HGRN = 4
DK_HGRN = D_HGRN // H_HGRN
H_XMEM = 4
DH_XMEM = D_XMEM // H_XMEM
D_IN_PROJ = 3 * D_DIFF + 5 * D_HGRN + D_XMEM
Q_BLOCK = 128
HGRN_CHUNK = 16
N_EXPERTS = 32
TOP_K = 4
D_EXPERT = D_MODEL
SWIGLU_ALPHA = 1.702
SWIGLU_LIMIT = 7.0
MOE_BLOCK = 256
NORM_EPS = 1e-5

kernel_name = "hybrid_diffattn_hgrn2_memxattn_moe_encoder"


def layer_norm(t, g, b):
    t32 = t.astype(jnp.float32)
    mu = jnp.mean(t32, axis=-1, keepdims=True)
    var = jnp.mean(jnp.square(t32 - mu), axis=-1, keepdims=True)
    return ((t32 - mu) * lax.rsqrt(var + NORM_EPS) * g + b).astype(t.dtype)


def rms_norm(t):
    t32 = t.astype(jnp.float32)
    return t32 * lax.rsqrt(jnp.mean(jnp.square(t32), axis=-1, keepdims=True) + NORM_EPS)


def alibi_slopes(n_heads):
    return jnp.asarray(2.0 ** (-8.0 * np.arange(1, n_heads + 1) / n_heads), dtype=jnp.float32)


def diff_attention(q, k, v, lam):
    B, H, _, S, Dh = q.shape
    nb = S // Q_BLOCK
    scale = 1.0 / math.sqrt(Dh)
    slopes = alibi_slopes(H)
    kpos = jnp.arange(S, dtype=jnp.int32)
    qb = jnp.moveaxis(q.reshape(B, H, 2, nb, Q_BLOCK, Dh), 3, 0)

    def block(args):
        q_blk, i = args
        qpos = i * Q_BLOCK + jnp.arange(Q_BLOCK, dtype=jnp.int32)
        dist = jnp.abs(qpos[:, None] - kpos[None, :]).astype(jnp.float32)
        bias = -slopes[:, None, None] * dist
        s = jnp.einsum('bhmqd,bhmkd->bhmqk', q_blk, k).astype(jnp.float32) * scale
        p = jax.nn.softmax(s + bias[None, :, None], axis=-1)
        p = p[:, :, 0] - lam * p[:, :, 1]
        return jnp.einsum('bhqk,bhkd->bhqd', p.astype(v.dtype), v)

    out = lax.map(block, (qb, jnp.arange(nb, dtype=jnp.int32)))
    return jnp.moveaxis(out, 0, 2).reshape(B, H, S, 2 * Dh)


def hgrn2_chunkwise(q, k, logf, v):
    B, H, S, Dk = q.shape
    Dv = v.shape[-1]
    C = HGRN_CHUNK
    N = S // C
    q = q.reshape(B, H, N, C, Dk)
    k = k.reshape(B, H, N, C, Dk).astype(jnp.float32)
    v = v.reshape(B, H, N, C, Dv)
    b = jnp.cumsum(logf.reshape(B, H, N, C, Dk).astype(jnp.float32), axis=3)
    mask = jnp.tril(jnp.ones((C, C), dtype=bool))
    rel = b[:, :, :, :, None, :] - b[:, :, :, None, :, :]
    decay = jnp.exp(jnp.where(mask[:, :, None], rel, -jnp.inf))
    A = jnp.einsum('bhntd,bhnsd,bhntsd->bhnts', q.astype(jnp.float32), k, decay)
    o_intra = jnp.einsum('bhnts,bhnsv->bhntv', A, v.astype(jnp.float32))
    b_last = b[:, :, :, -1, :]
    k_to_end = k * jnp.exp(b_last[:, :, :, None, :] - b)
    U = jnp.einsum('bhncd,bhncv->bhndv', k_to_end, v.astype(jnp.float32))
    a = jnp.exp(b_last)

    def step(S_prev, inp):
        a_n, U_n = inp
        return a_n[..., None] * S_prev + U_n, S_prev

    S0 = jnp.zeros((B, H, Dk, Dv), jnp.float32)
    _, S_before = lax.scan(step, S0, (jnp.moveaxis(a, 2, 0), jnp.moveaxis(U, 2, 0)))
    S_before = jnp.moveaxis(S_before, 0, 2)
    o_inter = jnp.einsum('bhncd,bhndv->bhncv', q.astype(jnp.float32) * jnp.exp(b), S_before)
    return (o_intra + o_inter).reshape(B, H, S, Dv)


def hybrid_mixer(h, mem, w_in, lq1, lk1, lq2, lk2, diff_norm_w, lb_f, lb_b,
                 hgrn_norm_w, w_mem_kv, w_o, layer_idx):
    B, S, _ = h.shape
    sizes = [D_DIFF] * 3 + [D_HGRN] * 5 + [D_XMEM]
    points = [int(p) for p in np.cumsum(sizes)[:-1]]
    u = h @ w_in
    dq, dk, dv, hq, hf_f, hf_b, hi, hg, mq = jnp.split(u, points, axis=-1)

    q = dq.reshape(B, S, H_DIFF, 2, DH_DIFF).transpose(0, 2, 3, 1, 4)
    k = dk.reshape(B, S, H_DIFF, 2, DH_DIFF).transpose(0, 2, 3, 1, 4)
    v = dv.reshape(B, S, H_DIFF, 2 * DH_DIFF).transpose(0, 2, 1, 3)
    lam_init = 0.8 - 0.6 * math.exp(-0.3 * layer_idx)
    lam = (jnp.exp(jnp.sum(lq1.astype(jnp.float32) * lk1.astype(jnp.float32)))
           - jnp.exp(jnp.sum(lq2.astype(jnp.float32) * lk2.astype(jnp.float32))) + lam_init)
    o = diff_attention(q, k, v, lam)
    o = rms_norm(o) * diff_norm_w * (1.0 - lam_init)
    o_diff = o.transpose(0, 2, 1, 3).reshape(B, S, D_DIFF)

    heads = lambda t: t.reshape(B, S, H_HGRN, DK_HGRN).transpose(0, 2, 1, 3)
    q_h = heads(jax.nn.silu(hq))
    v_h = heads(hi)

    def gate(f_logit, lb):
        f = lb + (1.0 - lb) * jax.nn.sigmoid(f_logit.astype(jnp.float32))
        return heads(1.0 - f), heads(jnp.log(f))

    k_f, logf_f = gate(hf_f, lb_f)
    k_b, logf_b = gate(hf_b, lb_b)
    o_fwd = hgrn2_chunkwise(q_h, k_f, logf_f, v_h)
    flip = lambda t: jnp.flip(t, axis=2)
    o_bwd = flip(hgrn2_chunkwise(flip(q_h), flip(k_b), flip(logf_b), flip(v_h)))
    o = (o_fwd + o_bwd).transpose(0, 2, 1, 3)
    o = rms_norm(o) * hgrn_norm_w.reshape(H_HGRN, DK_HGRN)
    o_hgrn = o.reshape(B, S, D_HGRN) * jax.nn.sigmoid(hg.astype(jnp.float32))

    kv = mem @ w_mem_kv
    mk, mv = jnp.split(kv, 2, axis=-1)
    M = mem.shape[1]
    mk = mk.reshape(B, M, H_XMEM, DH_XMEM).transpose(0, 2, 1, 3)
    mv = mv.reshape(B, M, H_XMEM, DH_XMEM).transpose(0, 2, 1, 3)
    mqh = mq.reshape(B, S, H_XMEM, DH_XMEM).transpose(0, 2, 1, 3)
    s = jnp.einsum('bhsd,bhmd->bhsm', mqh, mk).astype(jnp.float32) / math.sqrt(DH_XMEM)
    p = jax.nn.softmax(s, axis=-1)
    o_mem = jnp.einsum('bhsm,bhmd->bshd', p.astype(mv.dtype), mv).reshape(B, S, D_XMEM)

    cat = jnp.concatenate([o_diff.astype(h.dtype), o_hgrn.astype(h.dtype), o_mem.astype(h.dtype)], axis=-1)
    return cat @ w_o


def moe_ffn(x2d, router_w, router_b, w_gu, b_gu, w_dn, b_dn):
    T, D = x2d.shape
    TK = T * TOP_K
    logits = (x2d @ router_w + router_b).astype(jnp.float32)
    top_val, top_idx = lax.top_k(logits, TOP_K)
    gates = jax.nn.softmax(top_val, axis=-1)
    flat_e = top_idx.reshape(-1).astype(jnp.int32)
    flat_tok = jnp.repeat(jnp.arange(T, dtype=jnp.int32), TOP_K)
    order = jnp.argsort(flat_e)
    sorted_e = flat_e[order]
    sorted_tok = flat_tok[order]
    sorted_gate = gates.reshape(-1)[order]
    counts = jnp.bincount(flat_e, length=N_EXPERTS).astype(jnp.int32)
    padded = (counts + MOE_BLOCK - 1) // MOE_BLOCK * MOE_BLOCK
    start = jnp.cumsum(counts) - counts
    pend = jnp.cumsum(padded)
    pstart = pend - padded
    dest = pstart[sorted_e] + jnp.arange(TK, dtype=jnp.int32) - start[sorted_e]
    n_blocks = -(-TK // MOE_BLOCK) + N_EXPERTS
    n_rows = n_blocks * MOE_BLOCK
    row_tok = jnp.zeros((n_rows,), jnp.int32).at[dest].set(sorted_tok)
    row_gate = jnp.zeros((n_rows,), jnp.float32).at[dest].set(sorted_gate)
    block_e = jnp.minimum(
        jnp.searchsorted(pend, jnp.arange(n_blocks, dtype=jnp.int32) * MOE_BLOCK, side='right'),
        N_EXPERTS - 1)
    xs = x2d[row_tok].reshape(n_blocks, MOE_BLOCK, D)

    def expert_block(args):
        xb, e = args
        hh = xb @ w_gu[e] + b_gu[e]
        glu = jnp.minimum(hh[:, 0::2], SWIGLU_LIMIT)
        lin = jnp.clip(hh[:, 1::2], -SWIGLU_LIMIT, SWIGLU_LIMIT)
        act = glu * jax.nn.sigmoid(SWIGLU_ALPHA * glu) * (lin + 1.0)
        return act @ w_dn[e] + b_dn[e]

    ys = lax.map(expert_block, (xs, block_e)).reshape(n_rows, D).astype(jnp.float32)
    out = jnp.zeros((T, D), jnp.float32).at[row_tok].add(ys * row_gate[:, None])
    return out.astype(x2d.dtype)


def setup_inputs(seed: int = 0) -> dict:
    key = jax.random.key(seed)
    ks = jax.random.split(key, 24)
    nrm = lambda k, shape, sc: jax.random.normal(k, shape, jnp.float32) * sc
    beta = (8.0 * DEPTH) ** -0.25
    L = DEPTH
    return {
        "x": nrm(ks[0], (BATCH, SEQ, D_MODEL), 1.0),
        "mem": nrm(ks[1], (BATCH, MEM_LEN, D_MODEL), 1.0),
        "w_in": nrm(ks[2], (L, D_MODEL, D_IN_PROJ), D_MODEL ** -0.5),
        "lam_q1": nrm(ks[3], (L, DH_DIFF), 0.1),
        "lam_k1": nrm(ks[4], (L, DH_DIFF), 0.1),
        "lam_q2": nrm(ks[5], (L, DH_DIFF), 0.1),
        "lam_k2": nrm(ks[6], (L, DH_DIFF), 0.1),
        "diff_norm_w": 1.0 + nrm(ks[7], (L, 2 * DH_DIFF), 0.01),
        "hgrn_lb_fwd": nrm(ks[8], (L + 1, D_HGRN), 1.0),
        "hgrn_lb_bwd": nrm(ks[9], (L + 1, D_HGRN), 1.0),
        "hgrn_norm_w": 1.0 + nrm(ks[10], (L, D_HGRN), 0.01),
        "w_mem_kv": nrm(ks[11], (L, D_MODEL, 2 * D_XMEM), D_MODEL ** -0.5),
        "w_o": nrm(ks[12], (L, D_MIX, D_MODEL), D_MIX ** -0.5 * beta),
        "ln1_g": 1.0 + nrm(ks[13], (L, D_MODEL), 0.01),
        "ln1_b": nrm(ks[14], (L, D_MODEL), 0.01),
        "router_w": nrm(ks[15], (L, D_MODEL, N_EXPERTS), D_MODEL ** -0.5),
        "router_b": nrm(ks[16], (L, N_EXPERTS), 0.01),
        "w_gate_up": nrm(ks[17], (L, N_EXPERTS, D_MODEL, 2 * D_EXPERT), D_MODEL ** -0.5),
        "b_gate_up": nrm(ks[18], (L, N_EXPERTS, 2 * D_EXPERT), 0.01),
        "w_down": nrm(ks[19], (L, N_EXPERTS, D_EXPERT, D_MODEL), D_EXPERT ** -0.5 * beta),
        "b_down": nrm(ks[20], (L, N_EXPERTS, D_MODEL), 0.01),
        "ln2_g": 1.0 + nrm(ks[21], (L, D_MODEL), 0.01),
        "ln2_b": nrm(ks[22], (L, D_MODEL), 0.01),
    }


def reference(x, mem, w_in, lam_q1, lam_k1, lam_q2, lam_k2, diff_norm_w, hgrn_lb_fwd,
              hgrn_lb_bwd, hgrn_norm_w, w_mem_kv, w_o, ln1_g, ln1_b, router_w, router_b,
              w_gate_up, b_gate_up, w_down, b_down, ln2_g, ln2_b):
    B, S, D = x.shape
    alpha = (2.0 * DEPTH) ** 0.25
    lb_fwd_all = jnp.cumsum(jax.nn.softmax(hgrn_lb_fwd.astype(jnp.float32), axis=0), axis=0)
    lb_bwd_all = jnp.cumsum(jax.nn.softmax(hgrn_lb_bwd.astype(jnp.float32), axis=0), axis=0)
    h = x
    for l in range(DEPTH):
        mix = hybrid_mixer(h, mem, w_in[l], lam_q1[l], lam_k1[l], lam_q2[l], lam_k2[l],
                           diff_norm_w[l], lb_fwd_all[l], lb_bwd_all[l], hgrn_norm_w[l],
                           w_mem_kv[l], w_o[l], l)
        h = layer_norm(alpha * h + mix, ln1_g[l], ln1_b[l])
        ffn = moe_ffn(h.reshape(B * S, D), router_w[l], router_b[l], w_gate_up[l],
                      b_gate_up[l], w_down[l], b_down[l]).reshape(B, S, D)
        h = layer_norm(alpha * h + ffn, ln2_g[l], ln2_b[l])
    return h
```

```cpp
#include <hip/hip_runtime.h>
#include <cstdio>
#include <cstdint>

constexpr int NB = 4, SEQ = 4096, DM = 1024, T = NB * SEQ, MEML = 256, NIN = 3072, NE = 32, TOPK = 4;
constexpr int TK = T * TOPK, MAXBLK = TK / 256 + NE, MAXROWS = MAXBLK * 256;
constexpr float LOG2E = 1.4426950408889634f, C2 = 0.125f * LOG2E, ALPHA = 1.189207115002721f, EPS = 1e-5f;
constexpr int U_DQ = 0, U_DK = 512, U_DV = 1024, U_HQ = 1536, U_HF = 1792, U_HI = 2304, U_HG = 2560, U_MQ = 2816;

constexpr size_t MiB = 1u << 20;
constexpr size_t WS_CTL = 0, CTL_ZERO_BYTES = 1 * MiB;
constexpr size_t WS_WIN = 2 * MiB, WS_WKV = 8 * MiB, WS_WO = 10 * MiB, WS_MEMB = 12 * MiB, WS_MKV = 14 * MiB;
constexpr size_t WS_XB = 16 * MiB, WS_U = 48 * MiB, WS_OD = 144 * MiB, WS_CAT = 176 * MiB, WS_Z1 = 208 * MiB;
constexpr size_t WS_ROUTE = 272 * MiB;
constexpr size_t WS_HU = 280 * MiB, WS_SS = 316 * MiB;
constexpr size_t WS_WGU = 336 * MiB, WS_WDN = 464 * MiB, WS_XS = 528 * MiB, WS_ACT = 672 * MiB, WS_Y = 816 * MiB;
constexpr size_t WS_ROWS = 944 * MiB;
constexpr size_t WS_OH = 948 * MiB;
constexpr size_t WS_END = 980 * MiB;
constexpr int CW_TMO = 0, CW_CODE = 1, CW_CNT = 64  , CW_BAR = 4096;

constexpr int RING_BYTES = 131072, LDSCTL_OFF = RING_BYTES, MISC_OFF = LDSCTL_OFF + 320, LDS_BYTES = 147456;
constexpr int NWAVES = 8, NTHREADS = 512;

#define GAS __attribute__((address_space(1)))
#define LAS __attribute__((address_space(3)))
typedef unsigned short bf16;
typedef unsigned v4u __attribute__((ext_vector_type(4)));
typedef unsigned v2u __attribute__((ext_vector_type(2)));
typedef float f32x4 __attribute__((ext_vector_type(4)));
typedef GAS unsigned gu32;
#define RLX_AGENT __ATOMIC_RELAXED, __HIP_MEMORY_SCOPE_AGENT
__device__ __forceinline__ unsigned f2bf(float f) { unsigned u = __builtin_bit_cast(unsigned, f); return (u + 0x7fffu + ((u >> 16) & 1u)) >> 16; }
__device__ __forceinline__ unsigned pk2(float lo, float hi) { return f2bf(lo) | (f2bf(hi) << 16); }
__device__ __forceinline__ float bf2f(unsigned v) { return __uint_as_float(v << 16); }
__device__ __forceinline__ float bflo(unsigned w) { return __uint_as_float(w << 16); }
__device__ __forceinline__ float bfhi(unsigned w) { return __uint_as_float(w & 0xffff0000u); }
__device__ __forceinline__ float wave_sum(float v) {
#pragma unroll
    for (int o = 1; o < 64; o <<= 1) v += __shfl_xor(v, o);
    return v;
}
__device__ __forceinline__ float wave_max(float v) {
#pragma unroll
    for (int o = 1; o < 64; o <<= 1) v = fmaxf(v, __shfl_xor(v, o));
    return v;
}
__device__ __forceinline__ float sigmoidf_(float x) { return 1.f / (1.f + __expf(-x)); }

#define XB_TMO      128
#define XB_XCNT(j)  (256  + 64 * (j))
#define XB_XSUB(j)  (1280 + 64 * (j))
#define XB_XGEN(j)  (2304 + 64 * (j))
#define XB_TOP      3328
#define XB_TOPGEN   3392
#define XCD_BAR_WORDS 3456
#define XB_SPIN_CAP (1u << 20)
__device__ __forceinline__ unsigned xb_ld(unsigned* p)              { return __hip_atomic_load(p, __ATOMIC_RELAXED, __HIP_MEMORY_SCOPE_AGENT); }
__device__ __forceinline__ unsigned xb_add(unsigned* p, unsigned v) { return __hip_atomic_fetch_add(p, v, __ATOMIC_RELAXED, __HIP_MEMORY_SCOPE_AGENT); }
__device__ __forceinline__ unsigned xb_xcc_id() { return (unsigned)__builtin_amdgcn_s_getreg((3 << 11) | 20) & 0xFu; }
#define XB_SPIN(cond, bar) do { unsigned _sp = 0; while (cond) { __builtin_amdgcn_s_sleep(1); \
    if ((++_sp & 255u) == 0u) { if (xb_ld(&(bar)[XB_TMO])) break; if (_sp > XB_SPIN_CAP) { atomicAdd(&(bar)[XB_TMO], 1u); break; } } } } while (0)
struct XcdBarrier { unsigned* bar; unsigned x; volatile LAS unsigned* st; };
__device__ __forceinline__ XcdBarrier xcd_barrier_post(unsigned* bar, volatile LAS unsigned* st) {
    XcdBarrier b; b.bar = bar; b.x = xb_xcc_id(); b.st = st;
    if (threadIdx.x == 0) (void)xb_add(&bar[XB_XCNT(b.x)], 1u);
    return b;
}
__device__ __forceinline__ void xcd_barrier_complete(unsigned* bar, unsigned x, unsigned& nloc, unsigned& nx) {
    const unsigned G = gridDim.x * gridDim.y * gridDim.z;
    unsigned sum, cnt, mine, sp = 0u;
    for (;;) {
        sum = 0u; cnt = 0u; mine = 0u;
#pragma unroll
        for (unsigned j = 0; j < 16; ++j) { const unsigned c = xb_ld(&bar[XB_XCNT(j)]); sum += c; cnt += (c > 0u) ? 1u : 0u; mine = (j == x) ? c : mine; }
        if (sum == G) break;
        __builtin_amdgcn_s_sleep(1);
        if ((++sp & 255u) == 0u) { if (xb_ld(&bar[XB_TMO])) break; if (sp > XB_SPIN_CAP) { atomicAdd(&bar[XB_TMO], 1u); break; } }
    }
    nloc = mine > 0u ? mine : 1u; nx = cnt > 0u ? cnt : 1u;
}
__device__ __forceinline__ void xcd_barrier(const XcdBarrier& b) {
    asm volatile("s_waitcnt vmcnt(0)" ::: "memory");
    __syncthreads();
    if (threadIdx.x == 0) {
        unsigned* bar = b.bar;
        __builtin_amdgcn_s_waitcnt(0);
        unsigned nloc = b.st[0], nx = b.st[1];
        if (nloc == 0u) { xcd_barrier_complete(bar, b.x, nloc, nx); b.st[0] = nloc; b.st[1] = nx; }
        const unsigned old = xb_add(&bar[XB_XSUB(b.x)], 1u);
        const unsigned gen = old / nloc;
        if (old + 1u == (gen + 1u) * nloc) {
            __builtin_amdgcn_fence(__ATOMIC_RELEASE, "agent");
            asm volatile("s_waitcnt vmcnt(0)" ::: "memory");
            const unsigned og = xb_add(&bar[XB_TOP], 1u);
            const unsigned tg = og / nx;
            if (og + 1u == (tg + 1u) * nx) xb_add(&bar[XB_TOPGEN], 1u);
            else XB_SPIN(xb_ld(&bar[XB_TOPGEN]) == tg, bar);
            __builtin_amdgcn_fence(__ATOMIC_ACQUIRE, "agent");
            xb_add(&bar[XB_XGEN(b.x)], 1u);
            asm volatile("s_waitcnt vmcnt(0)" ::: "memory");
        } else {
            XB_SPIN(xb_ld(&bar[XB_XGEN(b.x)]) == gen, bar);
            __builtin_amdgcn_fence(__ATOMIC_ACQUIRE, "agent");
            asm volatile("s_waitcnt vmcnt(0)" ::: "memory");
        }
    }
    __syncthreads();
}

struct Frame {
    LAS unsigned char* lds;
    volatile LAS unsigned* MISC;
    gu32* ctl;
    int tid, lane, wave, vcu, G;
    const float* in[23]; float* out; unsigned char* ws;
};
#define WSP(T_, off) ((T_*)(F.ws + (off)))

template <int MODE>
__device__ __forceinline__ void p0_transpose_item(const float* W, int K, int N, bf16* WT, LAS float* scr, int item, int lane) {
    const int nblk = N / 32, kb = item / nblk, nb = item % nblk, k0 = 64 * kb, n0 = 32 * nb;
#pragma unroll 8
    for (int i = 0; i < 32; ++i) { const int kk = 2 * i + (lane >> 5); scr[kk * 33 + (lane & 31)] = W[(size_t)(k0 + kk) * N + n0 + (lane & 31)]; }
    asm volatile("s_waitcnt lgkmcnt(0)" ::: "memory");
    const int c = lane & 7;
#pragma unroll
    for (int j = 0; j < 4; ++j) { const int n = (lane >> 3) + 8 * j; const LAS float* s = scr + (8 * c) * 33 + n;
        v4u o; o.x = pk2(s[0 * 33], s[1 * 33]); o.y = pk2(s[2 * 33], s[3 * 33]); o.z = pk2(s[4 * 33], s[5 * 33]); o.w = pk2(s[6 * 33], s[7 * 33]);
        int col = n0 + n, drow = col;
        if (MODE == 1) { const int pn = col >> 8, w = col & 255; drow = 256 * pn + 128 * (w & 1) + (w >> 1); }
        *(GAS v4u*)(WT + (size_t)drow * K + k0 + 8 * c) = o; }
    asm volatile("s_waitcnt lgkmcnt(0)" ::: "memory");
}
__device__ __forceinline__ void row_to_bf16(const float* xrow, bf16* orow, int lane) {
    const GAS f32x4* xr = (const GAS f32x4*)xrow + lane;
    GAS v2u* o8 = (GAS v2u*)orow + lane;
#pragma unroll
    for (int j = 0; j < 4; ++j) { const f32x4 v = xr[64 * j]; v2u w; w.x = pk2(v.x, v.y); w.y = pk2(v.z, v.w); o8[64 * j] = w; }
}
__device__ __forceinline__ void p0_prologue(Frame& F) {
    LAS float* scr = (LAS float*)(F.lds + F.wave * 16384);
    const int gw = F.vcu * NWAVES + F.wave, NGW = F.G * NWAVES;
    constexpr int I_IN = 16 * (NIN / 32), I_KV = 16 * (512 / 32), I_O = 16 * (1024 / 32), I_GU = 16 * (2048 / 32), I_DN = 16 * (1024 / 32);
    constexpr int NITEMS = I_IN + I_KV + I_O + NE * I_GU + NE * I_DN;
    for (int it = gw; it < NITEMS; it += NGW) {
        int r = it;
        if (r < I_IN) { p0_transpose_item<0>(F.in[2], DM, NIN, WSP(bf16, WS_WIN), scr, r, F.lane); continue; } r -= I_IN;
        if (r < I_KV) { p0_transpose_item<0>(F.in[11], DM, 512, WSP(bf16, WS_WKV), scr, r, F.lane); continue; } r -= I_KV;
        if (r < I_O) { p0_transpose_item<0>(F.in[12], DM, DM, WSP(bf16, WS_WO), scr, r, F.lane); continue; } r -= I_O;
        if (r < NE * I_GU) { const int e = r / I_GU; p0_transpose_item<1>(F.in[17] + (size_t)e * DM * 2048, DM, 2048, WSP(bf16, WS_WGU) + (size_t)e * 2048 * DM, scr, r % I_GU, F.lane); continue; } r -= NE * I_GU;
        { const int e = r / I_DN; p0_transpose_item<0>(F.in[19] + (size_t)e * DM * DM, DM, DM, WSP(bf16, WS_WDN) + (size_t)e * DM * DM, scr, r % I_DN, F.lane); }
    }
    for (int m = gw; m < T; m += NGW) row_to_bf16(F.in[0] + (size_t)m * DM, WSP(bf16, WS_XB) + (size_t)m * DM, F.lane);
    for (int m = gw; m < NB * MEML; m += NGW) row_to_bf16(F.in[1] + (size_t)m * DM, WSP(bf16, WS_MEMB) + (size_t)m * DM, F.lane);
}

__device__ __forceinline__ void ngemm_core(float (&acc)[8][4], LAS float* As, LAS float* Bs, const bf16* arow, const bf16* brow, int K) {
    const int tid = threadIdx.x, tx = tid & 31, ty = tid >> 5, sr = tid >> 2, sk = (tid & 3) * 8;
#pragma unroll
    for (int i = 0; i < 8; ++i)
#pragma unroll
        for (int j = 0; j < 4; ++j) acc[i][j] = 0.f;
    for (int k0 = 0; k0 < K; k0 += 32) {
        const v4u av = *(const GAS v4u*)(arow + k0 + sk), bv = *(const GAS v4u*)(brow + k0 + sk);
        __syncthreads();
        As[(sk + 0) * 132 + sr] = bflo(av.x); As[(sk + 1) * 132 + sr] = bfhi(av.x); As[(sk + 2) * 132 + sr] = bflo(av.y); As[(sk + 3) * 132 + sr] = bfhi(av.y);
        As[(sk + 4) * 132 + sr] = bflo(av.z); As[(sk + 5) * 132 + sr] = bfhi(av.z); As[(sk + 6) * 132 + sr] = bflo(av.w); As[(sk + 7) * 132 + sr] = bfhi(av.w);
        Bs[(sk + 0) * 132 + sr] = bflo(bv.x); Bs[(sk + 1) * 132 + sr] = bfhi(bv.x); Bs[(sk + 2) * 132 + sr] = bflo(bv.y); Bs[(sk + 3) * 132 + sr] = bfhi(bv.y);
        Bs[(sk + 4) * 132 + sr] = bflo(bv.z); Bs[(sk + 5) * 132 + sr] = bfhi(bv.z); Bs[(sk + 6) * 132 + sr] = bflo(bv.w); Bs[(sk + 7) * 132 + sr] = bfhi(bv.w);
        __syncthreads();
#pragma unroll 8
        for (int k = 0; k < 32; ++k) {
            const f32x4 a0 = *(const LAS f32x4*)&As[k * 132 + ty * 8], a1 = *(const LAS f32x4*)&As[k * 132 + ty * 8 + 4], b = *(const LAS f32x4*)&Bs[k * 132 + tx * 4];
            const float a[8] = {a0.x, a0.y, a0.z, a0.w, a1.x, a1.y, a1.z, a1.w};
#pragma unroll
            for (int i = 0; i < 8; ++i) { acc[i][0] += a[i] * b.x; acc[i][1] += a[i] * b.y; acc[i][2] += a[i] * b.z; acc[i][3] += a[i] * b.w; }
        }
    }
    __syncthreads();
}

__device__ __forceinline__ void p1_inproj(Frame& F) {
    LAS float* As = (LAS float*)F.lds; LAS float* Bs = As + 32 * 132;
    const int tid = F.tid, tx = tid & 31, ty = tid >> 5, sr = tid >> 2;
    constexpr int NT1 = (T / 128) * (NIN / 128), NT2 = (NB * MEML / 128) * (512 / 128);
    for (int u = F.vcu; u < NT1 + NT2; u += F.G) {
        float acc[8][4];
        if (u < NT1) {
            const int rt = u / (NIN / 128), ct = u % (NIN / 128);
            ngemm_core(acc, As, Bs, WSP(bf16, WS_XB) + (size_t)(rt * 128 + sr) * DM, WSP(bf16, WS_WIN) + (size_t)(ct * 128 + sr) * DM, DM);
            const float sc = (ct < 4 || ct >= 22) ? C2 : 1.f;
#pragma unroll
            for (int i = 0; i < 8; ++i) { v2u w; w.x = pk2(acc[i][0] * sc, acc[i][1] * sc); w.y = pk2(acc[i][2] * sc, acc[i][3] * sc);
                *(GAS v2u*)(WSP(bf16, WS_U) + (size_t)(rt * 128 + ty * 8 + i) * NIN + ct * 128 + tx * 4) = w; }
        } else {
            const int v = u - NT1, rt = v / 4, ct = v % 4;
            ngemm_core(acc, As, Bs, WSP(bf16, WS_MEMB) + (size_t)(rt * 128 + sr) * DM, WSP(bf16, WS_WKV) + (size_t)(ct * 128 + sr) * DM, DM);
#pragma unroll
            for (int i = 0; i < 8; ++i) { v2u w; w.x = pk2(acc[i][0], acc[i][1]); w.y = pk2(acc[i][2], acc[i][3]);
                *(GAS v2u*)(WSP(bf16, WS_MKV) + (size_t)(rt * 128 + ty * 8 + i) * 512 + ct * 128 + tx * 4) = w; }
        }
    }
}

template <int DV>
__device__ __forceinline__ void attn_naive_unit(const bf16* q, const bf16* kbase, size_t kstride, const bf16* vbase, size_t vstride, int nk, float slope2, int qpos, bf16* out, LAS float* sc, int lane) {
    float qf[64];
#pragma unroll
    for (int i = 0; i < 8; ++i) { const v4u w = *(const GAS v4u*)(q + 8 * i);
        qf[8 * i + 0] = bflo(w.x); qf[8 * i + 1] = bfhi(w.x); qf[8 * i + 2] = bflo(w.y); qf[8 * i + 3] = bfhi(w.y); qf[8 * i + 4] = bflo(w.z); qf[8 * i + 5] = bfhi(w.z); qf[8 * i + 6] = bflo(w.w); qf[8 * i + 7] = bfhi(w.w); }
    float mx = -INFINITY;
    for (int k = lane; k < nk; k += 64) {
        const bf16* kr = kbase + (size_t)k * kstride; float s = 0.f;
#pragma unroll
        for (int i = 0; i < 8; ++i) { const v4u w = *(const GAS v4u*)(kr + 8 * i);
            s += qf[8 * i + 0] * bflo(w.x) + qf[8 * i + 1] * bfhi(w.x) + qf[8 * i + 2] * bflo(w.y) + qf[8 * i + 3] * bfhi(w.y) + qf[8 * i + 4] * bflo(w.z) + qf[8 * i + 5] * bfhi(w.z) + qf[8 * i + 6] * bflo(w.w) + qf[8 * i + 7] * bfhi(w.w); }
        const int dist = qpos > k ? qpos - k : k - qpos;
        s -= slope2 * (float)dist;
        sc[k] = s; mx = fmaxf(mx, s);
    }
    mx = wave_max(mx);
    float l = 0.f;
    for (int k = lane; k < nk; k += 64) { const float p = exp2f(sc[k] - mx); sc[k] = p; l += p; }
    l = wave_sum(l);
    asm volatile("s_waitcnt lgkmcnt(0)" ::: "memory");
    const float rl = 1.f / l;
    float o[DV / 64];
#pragma unroll
    for (int j = 0; j < DV / 64; ++j) o[j] = 0.f;
    for (int k = 0; k < nk; ++k) { const float p = sc[k]; const bf16* vr = vbase + (size_t)k * vstride;
#pragma unroll
        for (int j = 0; j < DV / 64; ++j) o[j] += p * bf2f(vr[lane + 64 * j]); }
#pragma unroll
    for (int j = 0; j < DV / 64; ++j) out[lane + 64 * j] = (bf16)f2bf(o[j] * rl);
    asm volatile("s_waitcnt lgkmcnt(0)" ::: "memory");
}

__device__ __forceinline__ void p2_naive_mix(Frame& F) {
    LAS float* sc = (LAS float*)(F.lds + F.wave * 16384);
    const int gw = F.vcu * NWAVES + F.wave, NGW = F.G * NWAVES, lane = F.lane;
    const bf16* U = WSP(bf16, WS_U);
    if (gw < 32) {
        const int b = gw >> 3, h = (gw >> 1) & 3, dir = gw & 1;
        const float* lbp = dir ? F.in[9] : F.in[8];
        const float a0 = lbp[h * 64 + lane], a1 = lbp[256 + h * 64 + lane];
        const float lb = 1.f / (1.f + __expf(a1 - a0));
        float S[64];
#pragma unroll
        for (int d = 0; d < 64; ++d) S[d] = 0.f;
        float* OH = WSP(float, WS_OH);
        for (int step = 0; step < SEQ; ++step) {
            const int t = dir ? SEQ - 1 - step : step; const size_t row = (size_t)b * SEQ + t;
            const bf16* ur = U + row * NIN;
            const float hq = bf2f(ur[U_HQ + h * 64 + lane]), hf = bf2f(ur[U_HF + dir * 256 + h * 64 + lane]), vi = bf2f(ur[U_HI + h * 64 + lane]);
            const float ql = hq * sigmoidf_(hq), fl = lb + (1.f - lb) * sigmoidf_(hf);
            float o = 0.f;
#pragma unroll
            for (int d = 0; d < 64; ++d) { const float fdd = __int_as_float(__builtin_amdgcn_readlane(__float_as_int(fl), d)), qd = __int_as_float(__builtin_amdgcn_readlane(__float_as_int(ql), d));
                S[d] = fdd * S[d] + (1.f - fdd) * vi; o += qd * S[d]; }
            OH[(row * 4 + h) * 128 + dir * 64 + lane] = o;
        }
    }
    for (int u = gw; u < T * 8; u += NGW) {
        const int row = u >> 3, h = (u >> 1) & 3, m = u & 1, b = row / SEQ, qpos = row % SEQ;
        attn_naive_unit<128>(U + (size_t)row * NIN + U_DQ + h * 128 + m * 64, U + (size_t)b * SEQ * NIN + U_DK + h * 128 + m * 64, NIN, U + (size_t)b * SEQ * NIN + U_DV + h * 128, NIN, SEQ,
                             __builtin_ldexpf(LOG2E, -2 * (h + 1)), qpos, WSP(bf16, WS_OD) + (size_t)row * DM + h * 256 + m * 128, sc, lane);
    }
    const bf16* MKV = WSP(bf16, WS_MKV);
    for (int u = gw; u < T * 4; u += NGW) {
        const int row = u >> 2, h = u & 3, b = row / SEQ;
        attn_naive_unit<64>(U + (size_t)row * NIN + U_MQ + h * 64, MKV + (size_t)b * MEML * 512 + h * 64, 512, MKV + (size_t)b * MEML * 512 + 256 + h * 64, 512, MEML, 0.f, 0,
                            WSP(bf16, WS_CAT) + (size_t)row * DM + 768 + h * 64, sc, lane);
    }
}

__device__ __forceinline__ void p3_naive_combine(Frame& F) {
    const int gw = F.vcu * NWAVES + F.wave, NGW = F.G * NWAVES, lane = F.lane;
    const float sa = wave_sum(F.in[3][lane] * F.in[4][lane]), sb = wave_sum(F.in[5][lane] * F.in[6][lane]);
    const float lam = __expf(sa) - __expf(sb) + 0.2f;
    const bf16* OD = WSP(bf16, WS_OD); const float* OH = WSP(float, WS_OH); const bf16* U = WSP(bf16, WS_U); bf16* CAT = WSP(bf16, WS_CAT);
    const float dnw0 = F.in[7][lane], dnw1 = F.in[7][lane + 64];
    for (int row = gw; row < T; row += NGW) {
#pragma unroll
        for (int h = 0; h < 4; ++h) {
            const bf16* p0 = OD + (size_t)row * DM + h * 256; const bf16* p1 = p0 + 128;
            const float o0 = bf2f(p0[lane]) - lam * bf2f(p1[lane]), o1 = bf2f(p0[lane + 64]) - lam * bf2f(p1[lane + 64]);
            const float ss = wave_sum(o0 * o0 + o1 * o1), r = rsqrtf(ss * (1.f / 128.f) + EPS) * 0.8f;
            CAT[(size_t)row * DM + h * 128 + lane] = (bf16)f2bf(o0 * r * dnw0); CAT[(size_t)row * DM + h * 128 + 64 + lane] = (bf16)f2bf(o1 * r * dnw1);
        }
#pragma unroll
        for (int h = 0; h < 4; ++h) {
            const float* p = OH + ((size_t)row * 4 + h) * 128; const float o = p[lane] + p[64 + lane];
            const float ss = wave_sum(o * o), r = rsqrtf(ss * (1.f / 64.f) + EPS);
            const float g = sigmoidf_(bf2f(U[(size_t)row * NIN + U_HG + h * 64 + lane]));
            CAT[(size_t)row * DM + 512 + h * 64 + lane] = (bf16)f2bf(o * r * F.in[10][h * 64 + lane] * g);
        }
    }
}

__device__ __forceinline__ void p4_wo(Frame& F) {
    LAS float* As = (LAS float*)F.lds; LAS float* Bs = As + 32 * 132;
    const int tid = F.tid, tx = tid & 31, ty = tid >> 5, sr = tid >> 2;
    for (int u = F.vcu; u < (T / 128) * 8; u += F.G) {
        const int rt = u >> 3, ct = u & 7; float acc[8][4];
        ngemm_core(acc, As, Bs, WSP(bf16, WS_CAT) + (size_t)(rt * 128 + sr) * DM, WSP(bf16, WS_WO) + (size_t)(ct * 128 + sr) * DM, DM);
#pragma unroll
        for (int i = 0; i < 8; ++i) { const size_t off = (size_t)(rt * 128 + ty * 8 + i) * DM + ct * 128 + tx * 4; const f32x4 xv = *(const GAS f32x4*)(F.in[0] + off);
            f32x4 o; o.x = ALPHA * xv.x + acc[i][0]; o.y = ALPHA * xv.y + acc[i][1]; o.z = ALPHA * xv.z + acc[i][2]; o.w = ALPHA * xv.w + acc[i][3];
            *(GAS f32x4*)(WSP(float, WS_Z1) + off) = o; }
    }
}

__device__ __forceinline__ void ln_row(f32x4 (&v)[4], const float* g, const float* bb, int lane, float& mean, float& rstd) {
    float s = 0.f;
#pragma unroll
    for (int j = 0; j < 4; ++j) s += (v[j].x + v[j].y) + (v[j].z + v[j].w);
    mean = wave_sum(s) * (1.f / DM); float s2 = 0.f;
#pragma unroll
    for (int j = 0; j < 4; ++j) { v[j] = v[j] - mean; s2 += (v[j].x * v[j].x + v[j].y * v[j].y) + (v[j].z * v[j].z + v[j].w * v[j].w); }
    rstd = rsqrtf(wave_sum(s2) * (1.f / DM) + EPS);
#pragma unroll
    for (int j = 0; j < 4; ++j) { const f32x4 gv = *(const GAS f32x4*)(g + 4 * lane + 256 * j), bv = *(const GAS f32x4*)(bb + 4 * lane + 256 * j); v[j] = v[j] * rstd * gv + bv; }
}

__device__ __forceinline__ void p5_router(Frame& F) {
    LAS float* rw = (LAS float*)F.lds;
    for (int i = F.tid; i < DM * 8; i += NTHREADS) { const int col = i >> 3, e4 = i & 7; const int l = (col & 255) >> 2, q = 4 * (col >> 8) + (col & 3);
        const f32x4 w = *(const GAS f32x4*)(F.in[15] + (size_t)col * 32 + e4 * 4);
        *(LAS f32x4*)&rw[(q * 64 + l) * 32 + ((e4 ^ ((l >> 1) & 7)) * 4)] = w; }
    __syncthreads();
    const int gw = F.vcu * NWAVES + F.wave, NGW = F.G * NWAVES, lane = F.lane;
    int* TOPI = WSP(int, WS_ROUTE); float* TOPG = WSP(float, WS_ROUTE + 256 * 1024); int* RANK = WSP(int, WS_ROUTE + 512 * 1024); float* STATS = WSP(float, WS_ROUTE + 768 * 1024);
    const float rbias = F.in[16][lane >> 1];
    for (int row = gw; row < T; row += NGW) {
        f32x4 v[4];
#pragma unroll
        for (int j = 0; j < 4; ++j) v[j] = *(const GAS f32x4*)(WSP(float, WS_Z1) + (size_t)row * DM + 4 * lane + 256 * j);
        float mean, rstd; ln_row(v, F.in[13], F.in[14], lane, mean, rstd);
        if (lane == 0) { STATS[2 * row] = mean; STATS[2 * row + 1] = rstd; }
        float acc[32];
#pragma unroll
        for (int e = 0; e < 32; ++e) acc[e] = 0.f;
#pragma unroll
        for (int j = 0; j < 4; ++j)
#pragma unroll
            for (int c = 0; c < 4; ++c) { const float hv = v[j][c]; const int q = 4 * j + c;
#pragma unroll
                for (int e4 = 0; e4 < 8; ++e4) { const f32x4 w = *(const LAS f32x4*)&rw[(q * 64 + lane) * 32 + ((e4 ^ ((lane >> 1) & 7)) * 4)];
                    acc[4 * e4 + 0] += hv * w.x; acc[4 * e4 + 1] += hv * w.y; acc[4 * e4 + 2] += hv * w.z; acc[4 * e4 + 3] += hv * w.w; }
                asm volatile("" ::: "memory"); }
        float r16[16];
#pragma unroll
        for (int i = 0; i < 16; ++i) { const bool up = (lane & 32) != 0; const float keep = up ? acc[16 + i] : acc[i], send = up ? acc[i] : acc[16 + i]; r16[i] = keep + __shfl_xor(send, 32); }
        float r8[8];
#pragma unroll
        for (int i = 0; i < 8; ++i) { const bool up = (lane & 16) != 0; const float keep = up ? r16[8 + i] : r16[i], send = up ? r16[i] : r16[8 + i]; r8[i] = keep + __shfl_xor(send, 16); }
        float r4[4];
#pragma unroll
        for (int i = 0; i < 4; ++i) { const bool up = (lane & 8) != 0; const float keep = up ? r8[4 + i] : r8[i], send = up ? r8[i] : r8[4 + i]; r4[i] = keep + __shfl_xor(send, 8); }
        float r2[2];
#pragma unroll
        for (int i = 0; i < 2; ++i) { const bool up = (lane & 4) != 0; const float keep = up ? r4[2 + i] : r4[i], send = up ? r4[i] : r4[2 + i]; r2[i] = keep + __shfl_xor(send, 4); }
        float r1; { const bool up = (lane & 2) != 0; const float keep = up ? r2[1] : r2[0], send = up ? r2[0] : r2[1]; r1 = keep + __shfl_xor(send, 2); }
        float logit = r1 + __shfl_xor(r1, 1) + rbias;
        float tv[4]; int ti[4]; float cur = logit; const int myi = lane >> 1;
#pragma unroll
        for (int k = 0; k < 4; ++k) {
            float bv = cur; int bi = myi;
#pragma unroll
            for (int o = 1; o < 64; o <<= 1) { const float ov = __shfl_xor(bv, o); const int oi = __shfl_xor(bi, o); if (ov > bv || (ov == bv && oi < bi)) { bv = ov; bi = oi; } }
            tv[k] = bv; ti[k] = bi; if (myi == bi) cur = -INFINITY;
        }
        const float e1 = __expf(tv[1] - tv[0]), e2 = __expf(tv[2] - tv[0]), e3 = __expf(tv[3] - tv[0]); const float inv = 1.f / (1.f + e1 + e2 + e3);
        if (lane < 4) { const int e = lane == 0 ? ti[0] : lane == 1 ? ti[1] : lane == 2 ? ti[2] : ti[3]; const float g = (lane == 0 ? 1.f : lane == 1 ? e1 : lane == 2 ? e2 : e3) * inv;
            const unsigned rk = __hip_atomic_fetch_add((unsigned*)(F.ctl + CW_CNT + e), 1u, RLX_AGENT);
            TOPI[row * 4 + lane] = e; TOPG[row * 4 + lane] = g; RANK[row * 4 + lane] = (int)rk; }
    }
    __syncthreads();
}

__device__ __forceinline__ void p6_dispatch(Frame& F) {
    LAS int* pst = (LAS int*)F.lds;
    if (F.tid == 0) { int acc = 0; for (int e = 0; e < NE; ++e) { pst[e] = acc; const int c = (int)__hip_atomic_load((unsigned*)(F.ctl + CW_CNT + e), RLX_AGENT); acc += (c + 255) / 256 * 256; } pst[NE] = acc; }
    __syncthreads();
    int* ROWSLOT = WSP(int, WS_ROWS); float* ROWGATE = WSP(float, WS_ROWS + MAXROWS * 4); int* BLKE = WSP(int, WS_ROWS + 2 * MAXROWS * 4); int* BLKV = BLKE + 512; int* NBLK = BLKE + 1024;
    if (blockIdx.x == 0 && F.tid < NE) { const int e = F.tid, c = (int)__hip_atomic_load((unsigned*)(F.ctl + CW_CNT + e), RLX_AGENT); const int b0 = pst[e] / 256, nb = (pst[e + 1] - pst[e]) / 256;
        for (int i = 0; i < nb; ++i) { BLKE[b0 + i] = e; BLKV[b0 + i] = min(256, c - 256 * i); }
        if (e == 0) NBLK[0] = pst[NE] / 256; }
    const int gw = F.vcu * NWAVES + F.wave, NGW = F.G * NWAVES, lane = F.lane;
    const int* TOPI = WSP(int, WS_ROUTE); const float* TOPG = WSP(float, WS_ROUTE + 256 * 1024); const int* RANK = WSP(int, WS_ROUTE + 512 * 1024);
    for (int row = gw; row < T; row += NGW) {
        f32x4 v[4];
#pragma unroll
        for (int j = 0; j < 4; ++j) v[j] = *(const GAS f32x4*)(WSP(float, WS_Z1) + (size_t)row * DM + 4 * lane + 256 * j);
        float mean, rstd; ln_row(v, F.in[13], F.in[14], lane, mean, rstd);
        v2u w[4];
#pragma unroll
        for (int j = 0; j < 4; ++j) { w[j].x = pk2(v[j].x, v[j].y); w[j].y = pk2(v[j].z, v[j].w); }
#pragma unroll
        for (int k = 0; k < 4; ++k) { const int e = TOPI[row * 4 + k], dest = pst[e] + RANK[row * 4 + k];
            GAS v2u* o8 = (GAS v2u*)(WSP(bf16, WS_XS) + (size_t)dest * DM) + lane;
#pragma unroll
            for (int j = 0; j < 4; ++j) o8[64 * j] = w[j];
            if (lane == 0) { ROWSLOT[dest] = row * 4 + k; ROWGATE[dest] = TOPG[row * 4 + k]; } }
    }
    __syncthreads();
}

__device__ __forceinline__ void p7_gateup(Frame& F) {
    LAS float* As = (LAS float*)F.lds; LAS float* Bs = As + 32 * 132;
    const int tid = F.tid, tx = tid & 31, ty = tid >> 5, sr = tid >> 2;
    const int* BLKE = WSP(int, WS_ROWS + 2 * MAXROWS * 4); const int nblk = BLKE[1024];
    for (int u = F.vcu; u < nblk * 2 * 16; u += F.G) {
        const int blk = u >> 5, rh = (u >> 4) & 1, ft = u & 15, e = BLKE[blk];
        const int pn = ft >> 1, j0 = (ft & 1) * 64;
        const int brow = 256 * pn + (sr < 64 ? j0 + sr : 128 + j0 + (sr - 64));
        float acc[8][4];
        ngemm_core(acc, As, Bs, WSP(bf16, WS_XS) + (size_t)(blk * 256 + rh * 128 + sr) * DM, WSP(bf16, WS_WGU) + ((size_t)e * 2048 + brow) * DM, DM);
        const int f0 = 128 * pn + j0 + (tx & 15) * 4;
        const float* bg = F.in[18] + (size_t)e * 2048;
#pragma unroll
        for (int i = 0; i < 8; ++i) {
            float act[4];
#pragma unroll
            for (int j = 0; j < 4; ++j) { const float mine = acc[i][j] + bg[2 * (f0 + j) + (tx >> 4)]; const float other = __shfl_xor(mine, 16);
                const float glu = fminf(tx < 16 ? mine : other, 7.f), lin = fminf(fmaxf(tx < 16 ? other : mine, -7.f), 7.f);
                act[j] = glu * sigmoidf_(1.702f * glu) * (lin + 1.f); }
            if (tx < 16) { v2u w; w.x = pk2(act[0], act[1]); w.y = pk2(act[2], act[3]); *(GAS v2u*)(WSP(bf16, WS_ACT) + (size_t)(blk * 256 + rh * 128 + ty * 8 + i) * DM + f0) = w; }
        }
    }
}

__device__ __forceinline__ void p8_down(Frame& F) {
    LAS float* As = (LAS float*)F.lds; LAS float* Bs = As + 32 * 132;
    const int tid = F.tid, tx = tid & 31, ty = tid >> 5, sr = tid >> 2;
    const int* ROWSLOT = WSP(int, WS_ROWS); const float* ROWGATE = WSP(float, WS_ROWS + MAXROWS * 4); const int* BLKE = WSP(int, WS_ROWS + 2 * MAXROWS * 4); const int* BLKV = BLKE + 512; const int nblk = BLKE[1024];
    for (int u = F.vcu; u < nblk * 2 * 8; u += F.G) {
        const int blk = u >> 4, rh = (u >> 3) & 1, ct = u & 7, e = BLKE[blk], nv = BLKV[blk];
        float acc[8][4];
        ngemm_core(acc, As, Bs, WSP(bf16, WS_ACT) + (size_t)(blk * 256 + rh * 128 + sr) * DM, WSP(bf16, WS_WDN) + ((size_t)e * DM + ct * 128 + sr) * DM, DM);
        const f32x4 bv = *(const GAS f32x4*)(F.in[20] + (size_t)e * DM + ct * 128 + tx * 4);
#pragma unroll
        for (int i = 0; i < 8; ++i) { const int r = rh * 128 + ty * 8 + i; if (r < nv) { const int slot = ROWSLOT[blk * 256 + r]; const float g = ROWGATE[blk * 256 + r];
            v2u w; w.x = pk2((acc[i][0] + bv.x) * g, (acc[i][1] + bv.y) * g); w.y = pk2((acc[i][2] + bv.z) * g, (acc[i][3] + bv.w) * g);
            *(GAS v2u*)(WSP(bf16, WS_Y) + (size_t)slot * DM + ct * 128 + tx * 4) = w; } }
    }
}

__device__ __forceinline__ void p9_final(Frame& F) {
    const int gw = F.vcu * NWAVES + F.wave, NGW = F.G * NWAVES, lane = F.lane;
    for (int row = gw; row < T; row += NGW) {
        f32x4 v[4];
#pragma unroll
        for (int j = 0; j < 4; ++j) v[j] = *(const GAS f32x4*)(WSP(float, WS_Z1) + (size_t)row * DM + 4 * lane + 256 * j);
        float mean, rstd; ln_row(v, F.in[13], F.in[14], lane, mean, rstd);
#pragma unroll
        for (int j = 0; j < 4; ++j) v[j] = v[j] * ALPHA;
#pragma unroll
        for (int k = 0; k < 4; ++k) { const GAS v2u* y8 = (const GAS v2u*)(WSP(bf16, WS_Y) + (size_t)(row * 4 + k) * DM) + lane;
#pragma unroll
            for (int j = 0; j < 4; ++j) { const v2u w = y8[64 * j]; v[j].x += bflo(w.x); v[j].y += bfhi(w.x); v[j].z += bflo(w.y); v[j].w += bfhi(w.y); } }
        ln_row(v, F.in[21], F.in[22], lane, mean, rstd);
#pragma unroll
        for (int j = 0; j < 4; ++j) *(GAS f32x4*)(F.out + (size_t)row * DM + 4 * lane + 256 * j) = v[j];
    }
}

constexpr int NPHASE = 10;
struct Args { const float* in[23]; float* out; unsigned char* ws; int ph_lo, ph_hi; };
__global__ void __launch_bounds__(NTHREADS, 2) mega_fwd(Args args) {
    extern __shared__ __attribute__((aligned(16))) unsigned char lds[];
    Frame F;
    F.lds = (LAS unsigned char*)lds; F.MISC = (volatile LAS unsigned*)(F.lds + MISC_OFF);
    F.tid = threadIdx.x; F.lane = F.tid & 63; F.wave = __builtin_amdgcn_readfirstlane(F.tid >> 6);
    F.G = gridDim.x; { const int bx = blockIdx.x; F.vcu = (F.G % 8 == 0) ? (bx % 8) * (F.G / 8) + bx / 8 : bx; }
    F.ws = args.ws; F.ctl = (gu32*)(args.ws + WS_CTL); F.out = args.out;
#pragma unroll
    for (int i = 0; i < 23; ++i) F.in[i] = args.in[i];
    for (int u = F.tid; u < (LDS_BYTES - LDSCTL_OFF) / 4; u += NTHREADS) ((LAS unsigned*)(F.lds + LDSCTL_OFF))[u] = 0u;
    __syncthreads();
    const bool single = (args.ph_lo == 0 && args.ph_hi == NPHASE);
    XcdBarrier bar; bar.bar = (unsigned*)(F.ctl + CW_BAR); bar.x = 0; bar.st = nullptr;
    if (single) bar = xcd_barrier_post((unsigned*)(F.ctl + CW_BAR), F.MISC + 8);
    const int lo = args.ph_lo, hi = args.ph_hi;
#ifndef PH_MASK
#define PH_MASK 0x3ff
#endif
#define IN(k) (((PH_MASK >> (k)) & 1) && lo <= (k) && (k) < hi)
#define SEAM(k) do { if (IN(k) && IN((k) + 1)) xcd_barrier(bar); } while (0)
    if (IN(0)) { p0_prologue(F); } SEAM(0);
    if (IN(1)) { p1_inproj(F); } SEAM(1);
    if (IN(2)) { p2_naive_mix(F); } SEAM(2);
    if (IN(3)) { p3_naive_combine(F); } SEAM(3);
    if (IN(4)) { p4_wo(F); } SEAM(4);
    if (IN(5)) { p5_router(F); } SEAM(5);
    if (IN(6)) { p6_dispatch(F); } SEAM(6);
    if (IN(7)) { p7_gateup(F); } SEAM(7);
    if (IN(8)) { p8_down(F); } SEAM(8);
    if (IN(9)) { p9_final(F); }
#undef IN
#undef SEAM
}

#ifndef MK_MULTI
#define MK_MULTI 0
#endif
extern "C" void kernel_launch(void* const* d_in, const int* in_sizes, int n_in, void* d_out, int out_size, void* d_ws, size_t ws_size, hipStream_t stream) {
    static int grid = 0;
    if (grid == 0) {
        if (n_in != 23 || out_size != T * DM || ws_size < WS_END) { fprintf(stderr, "kernel_launch: unexpected shapes n_in %d out %d ws %zu\n", n_in, out_size, ws_size); grid = -1; return; }
        int dev = 0, cus = 0;
        if (hipGetDevice(&dev) != hipSuccess || hipDeviceGetAttribute(&cus, hipDeviceAttributeMultiprocessorCount, dev) != hipSuccess) { grid = -1; return; }
        if (hipFuncSetAttribute((const void*)mega_fwd, hipFuncAttributeMaxDynamicSharedMemorySize, LDS_BYTES) != hipSuccess) { fprintf(stderr, "kernel_launch: hipFuncSetAttribute failed\n"); grid = -1; return; }
        int per_cu = 0;
        if (hipOccupancyMaxActiveBlocksPerMultiprocessor(&per_cu, (const void*)mega_fwd, NTHREADS, LDS_BYTES) != hipSuccess || per_cu < 1) fprintf(stderr, "kernel_launch: occupancy query says %d\n", per_cu);
        (void)hipGetLastError();
        grid = cus;
    }
    if (grid < 0) return;
    (void)hipMemsetAsync((char*)d_ws + WS_CTL, 0, CTL_ZERO_BYTES, stream);
    Args a{};
    for (int i = 0; i < 23; ++i) a.in[i] = (const float*)d_in[i];
    a.out = (float*)d_out; a.ws = (unsigned char*)d_ws;
#if MK_MULTI
    for (int p = 0; p < NPHASE; ++p) { a.ph_lo = p; a.ph_hi = p + 1; hipLaunchKernelGGL(mega_fwd, dim3(grid), dim3(NTHREADS), LDS_BYTES, stream, a); }
#else
    a.ph_lo = 0; a.ph_hi = NPHASE;
    hipLaunchKernelGGL(mega_fwd, dim3(grid), dim3(NTHREADS), LDS_BYTES, stream, a);
#endif
}
```

```cpp
#include <hip/hip_runtime.h>
#include <cstdio>
#include <cstdint>

constexpr int NB = 4, SEQ = 4096, DM = 1024, T = NB * SEQ, MEML = 256, NIN = 3072, NE = 32, TOPK = 4;
constexpr int TK = T * TOPK, MAXBLK = TK / 256 + NE, MAXROWS = MAXBLK * 256;
constexpr float LOG2E = 1.4426950408889634f, C2 = 0.125f * LOG2E, ALPHA = 1.189207115002721f, EPS = 1e-5f;
constexpr int U_DQ = 0, U_DK = 512, U_DV = 1024, U_HQ = 1536, U_HF = 1792, U_HI = 2304, U_HG = 2560, U_MQ = 2816;

constexpr size_t MiB = 1u << 20;
constexpr size_t WS_CTL = 0, CTL_ZERO_BYTES = 1 * MiB;
constexpr size_t WS_WIN = 2 * MiB, WS_WKV = 8 * MiB, WS_WO = 10 * MiB, WS_MEMB = 12 * MiB, WS_MKV = 14 * MiB;
constexpr size_t WS_XB = 16 * MiB, WS_U = 48 * MiB, WS_OD = 144 * MiB, WS_CAT = 176 * MiB, WS_Z1 = 208 * MiB;
constexpr size_t WS_ROUTE = 272 * MiB;
constexpr size_t WS_HU = 280 * MiB, WS_SS = 316 * MiB;
constexpr size_t WS_WGU = 336 * MiB, WS_WDN = 464 * MiB, WS_XS = 528 * MiB, WS_ACT = 672 * MiB, WS_Y = 816 * MiB;
constexpr size_t WS_ROWS = 944 * MiB;
constexpr size_t WS_OH = 948 * MiB;
constexpr size_t WS_END = 980 * MiB;
constexpr int CW_TMO = 0, CW_CODE = 1, CW_CNT = 64  , CW_BAR = 4096;

constexpr int RING_BYTES = 131072, LDSCTL_OFF = RING_BYTES, MISC_OFF = LDSCTL_OFF + 320, LDS_BYTES = 147456;
constexpr int NWAVES = 8, NTHREADS = 512;

#define GAS __attribute__((address_space(1)))
#define LAS __attribute__((address_space(3)))
typedef unsigned short bf16;
typedef unsigned v4u __attribute__((ext_vector_type(4)));
typedef unsigned v2u __attribute__((ext_vector_type(2)));
typedef float f32x4 __attribute__((ext_vector_type(4)));
typedef GAS unsigned gu32;
#define RLX_AGENT __ATOMIC_RELAXED, __HIP_MEMORY_SCOPE_AGENT
__device__ __forceinline__ unsigned f2bf(float f) { unsigned u = __builtin_bit_cast(unsigned, f); return (u + 0x7fffu + ((u >> 16) & 1u)) >> 16; }
__device__ __forceinline__ unsigned pk2(float lo, float hi) { return f2bf(lo) | (f2bf(hi) << 16); }
__device__ __forceinline__ float bf2f(unsigned v) { return __uint_as_float(v << 16); }
__device__ __forceinline__ float bflo(unsigned w) { return __uint_as_float(w << 16); }
__device__ __forceinline__ float bfhi(unsigned w) { return __uint_as_float(w & 0xffff0000u); }
__device__ __forceinline__ float wave_sum(float v) {
#pragma unroll
    for (int o = 1; o < 64; o <<= 1) v += __shfl_xor(v, o);
    return v;
}
__device__ __forceinline__ float wave_max(float v) {
#pragma unroll
    for (int o = 1; o < 64; o <<= 1) v = fmaxf(v, __shfl_xor(v, o));
    return v;
}
__device__ __forceinline__ float sigmoidf_(float x) { return 1.f / (1.f + __expf(-x)); }

#define XB_TMO      128
#define XB_XCNT(j)  (256  + 64 * (j))
#define XB_XSUB(j)  (1280 + 64 * (j))
#define XB_XGEN(j)  (2304 + 64 * (j))
#define XB_TOP      3328
#define XB_TOPGEN   3392
#define XCD_BAR_WORDS 3456
#define XB_SPIN_CAP (1u << 20)
__device__ __forceinline__ unsigned xb_ld(unsigned* p)              { return __hip_atomic_load(p, __ATOMIC_RELAXED, __HIP_MEMORY_SCOPE_AGENT); }
__device__ __forceinline__ unsigned xb_add(unsigned* p, unsigned v) { return __hip_atomic_fetch_add(p, v, __ATOMIC_RELAXED, __HIP_MEMORY_SCOPE_AGENT); }
__device__ __forceinline__ unsigned xb_xcc_id() { return (unsigned)__builtin_amdgcn_s_getreg((3 << 11) | 20) & 0xFu; }
#define XB_SPIN(cond, bar) do { unsigned _sp = 0; while (cond) { __builtin_amdgcn_s_sleep(1); \
    if ((++_sp & 255u) == 0u) { if (xb_ld(&(bar)[XB_TMO])) break; if (_sp > XB_SPIN_CAP) { atomicAdd(&(bar)[XB_TMO], 1u); break; } } } } while (0)
struct XcdBarrier { unsigned* bar; unsigned x; volatile LAS unsigned* st; };
__device__ __forceinline__ XcdBarrier xcd_barrier_post(unsigned* bar, volatile LAS unsigned* st) {
    XcdBarrier b; b.bar = bar; b.x = xb_xcc_id(); b.st = st;
    if (threadIdx.x == 0) (void)xb_add(&bar[XB_XCNT(b.x)], 1u);
    return b;
}
__device__ __forceinline__ void xcd_barrier_complete(unsigned* bar, unsigned x, unsigned& nloc, unsigned& nx) {
    const unsigned G = gridDim.x * gridDim.y * gridDim.z;
    unsigned sum, cnt, mine, sp = 0u;
    for (;;) {
        sum = 0u; cnt = 0u; mine = 0u;
#pragma unroll
        for (unsigned j = 0; j < 16; ++j) { const unsigned c = xb_ld(&bar[XB_XCNT(j)]); sum += c; cnt += (c > 0u) ? 1u : 0u; mine = (j == x) ? c : mine; }
        if (sum == G) break;
        __builtin_amdgcn_s_sleep(1);
        if ((++sp & 255u) == 0u) { if (xb_ld(&bar[XB_TMO])) break; if (sp > XB_SPIN_CAP) { atomicAdd(&bar[XB_TMO], 1u); break; } }
    }
    nloc = mine > 0u ? mine : 1u; nx = cnt > 0u ? cnt : 1u;
}
__device__ __forceinline__ void xcd_barrier(const XcdBarrier& b) {
    asm volatile("s_waitcnt vmcnt(0)" ::: "memory");
    __syncthreads();
    if (threadIdx.x == 0) {
        unsigned* bar = b.bar;
        __builtin_amdgcn_s_waitcnt(0);
        unsigned nloc = b.st[0], nx = b.st[1];
        if (nloc == 0u) { xcd_barrier_complete(bar, b.x, nloc, nx); b.st[0] = nloc; b.st[1] = nx; }
        const unsigned old = xb_add(&bar[XB_XSUB(b.x)], 1u);
        const unsigned gen = old / nloc;
        if (old + 1u == (gen + 1u) * nloc) {
            __builtin_amdgcn_fence(__ATOMIC_RELEASE, "agent");
            asm volatile("s_waitcnt vmcnt(0)" ::: "memory");
            const unsigned og = xb_add(&bar[XB_TOP], 1u);
            const unsigned tg = og / nx;
            if (og + 1u == (tg + 1u) * nx) xb_add(&bar[XB_TOPGEN], 1u);
            else XB_SPIN(xb_ld(&bar[XB_TOPGEN]) == tg, bar);
            __builtin_amdgcn_fence(__ATOMIC_ACQUIRE, "agent");
            xb_add(&bar[XB_XGEN(b.x)], 1u);
            asm volatile("s_waitcnt vmcnt(0)" ::: "memory");
        } else {
            XB_SPIN(xb_ld(&bar[XB_XGEN(b.x)]) == gen, bar);
            __builtin_amdgcn_fence(__ATOMIC_ACQUIRE, "agent");
            asm volatile("s_waitcnt vmcnt(0)" ::: "memory");
        }
    }
    __syncthreads();
}

namespace pg8 {
#define PG8_LAS __attribute__((address_space(3)))
typedef unsigned short bf16_t;
typedef short bf16x8 __attribute__((ext_vector_type(8)));
typedef float f32x4 __attribute__((ext_vector_type(4)));
typedef unsigned u32x4 __attribute__((ext_vector_type(4)));
constexpr int BM = 256, BK = 64, HALF = 128, HTB = HALF * BK * 2  , STAGE_BYTES = 8 * HTB, NXCD = 8, WGM = 8;

__host__ __device__ __forceinline__ int lds_byte(int r, int c) { const int st = (r >> 4) * 2 + (c >> 5), rr = r & 15, cc = c & 31, ob = rr * 64 + cc * 2; return st * 1024 + (ob ^ (((ob >> 9) & 1) << 5)); }
__host__ __device__ __forceinline__ void stage_rc(int b, int& R, int& C) { const int st = b / 1024, sb = b % 1024, swz = sb ^ (((sb >> 9) & 1) << 5); R = (st >> 1) * 16 + swz / 64; C = (st & 1) * 32 + (swz % 64) / 2; }
__host__ __device__ __forceinline__ int perm32(int rho) { const int n = rho >> 4, i = rho & 15; return 8 * (i >> 2) + 4 * n + (i & 3); }

struct Unit { int pm, pn, pb, e; };
struct Gemm { const bf16_t* A; const bf16_t* Bt; int M, N, K; };

struct StaticOrder {
    int nM, nN, nwg, G, c;
    __host__ __device__ void init(int M, int N, int G_, int c_) { nM = M / BM; nN = N / BM; nwg = nM * nN; G = G_; c = c_; }
    __host__ __device__ bool next(int i, Unit& u) const {
        const long L = (long)i * G + c; if (L >= nwg) return false;
        int wgid = (int)L; { const int q = nwg / NXCD, r = nwg % NXCD, xcd = wgid % NXCD, off = wgid / NXCD; wgid = (xcd < r ? xcd * (q + 1) : r * (q + 1) + (xcd - r) * q) + off; }
        const int nig = WGM * nN, gid = wgid / nig, fm = gid * WGM, gsz = (nM - fm) < WGM ? (nM - fm) : WGM;
        u.pm = fm + ((wgid % nig) % gsz); u.pn = (wgid % nig) / gsz; u.pb = u.pn; u.e = 0; return true;
    }
    __device__ __forceinline__ void a_ready(const Unit&) const {}
    __device__ __forceinline__ void done(const Unit&) const {}
};

template <class Epi, class Sched, bool ALIGN_EPI = false, bool SP2 = false>
__device__ __forceinline__ void gemm_phase(PG8_LAS unsigned char* lds, const Gemm g, const Sched& S, const Epi& E) {
    const int tid = threadIdx.x, wid = __builtin_amdgcn_readfirstlane(tid >> 6), lane = tid & 63, wr = wid >> 2, wc = wid & 3, fr = lane & 15, fq = lane >> 4;
    const int K = g.K, nt = K / BK;
    unsigned voffA[2], voffB[2];
#pragma unroll
    for (int i = 0; i < 2; ++i) { int R, C; stage_rc(tid * 16 + i * 8192, R, C); const int Rb = Epi::PERM ? ((R & ~31) + perm32(R & 31)) : R;
        voffA[i] = (unsigned)(R * K + C) * 2u; voffB[i] = (unsigned)(Rb * K + C) * 2u; }
    const size_t kstep = (size_t)(BK * 2);
    const size_t hstep = (size_t)HALF * K * 2;
    const size_t tstep = 2 * hstep;
    const unsigned ldsw = (unsigned)wid * 1024u;
    const int aoff = lds_byte(wr * 64 + fr, fq * 8), boff = lds_byte(wc * 32 + fr, fq * 8);
#define PG8_SA(b, h) (((b) * 2 + (h)) * HTB)
#define PG8_SB(b, h) ((4 + (b) * 2 + (h)) * HTB)
#define PG8_STAGE(bufoff, gbase, voff) do { _Pragma("unroll") for (int _i = 0; _i < 2; ++_i) \
        __builtin_amdgcn_global_load_lds((const unsigned*)((const char*)(gbase) + (voff)[_i]), (PG8_LAS unsigned*)(lds + (bufoff) + ldsw + _i * 8192), 16, 0, 0); } while (0)
#define PG8_LDA(dst, b, h) do { _Pragma("unroll") for (int m = 0; m < 4; ++m) _Pragma("unroll") for (int k = 0; k < 2; ++k) dst[m][k] = *(const PG8_LAS bf16x8*)(lds + PG8_SA(b, h) + aoff + m * 2048 + k * 1024); } while (0)
#define PG8_LDB(dst, b, h) do { _Pragma("unroll") for (int n = 0; n < 2; ++n) _Pragma("unroll") for (int k = 0; k < 2; ++k) dst[n][k] = *(const PG8_LAS bf16x8*)(lds + PG8_SB(b, h) + boff + n * 2048 + k * 1024); } while (0)
#define PG8_MMA(ai, bj, At, Bt) do { __builtin_amdgcn_s_setprio(1); _Pragma("unroll") for (int m = 0; m < 4; ++m) _Pragma("unroll") for (int n = 0; n < 2; ++n) _Pragma("unroll") for (int k = 0; k < 2; ++k) \
        acc[ai][bj][m][n] = __builtin_amdgcn_mfma_f32_16x16x32_bf16(Bt[n][k], At[m][k], acc[ai][bj][m][n], 0, 0, 0); __builtin_amdgcn_s_setprio(0); } while (0)
#define PG8_WAIT_V(n) asm volatile("s_waitcnt vmcnt(" #n ")" ::: "memory")
#define PG8_WAIT_L(n) asm volatile("s_waitcnt lgkmcnt(" #n ")" ::: "memory")
#define PG8_BAR __builtin_amdgcn_s_barrier()
#define PG8_SCHED __builtin_amdgcn_sched_barrier(0)
    Unit cur, nxt; int ui = 0;
    if (!S.next(0, cur)) return;
    f32x4 acc[2][2][4][2];
#pragma unroll
    for (int a = 0; a < 2; ++a)
#pragma unroll
        for (int b = 0; b < 2; ++b)
#pragma unroll
            for (int m = 0; m < 4; ++m)
#pragma unroll
                for (int n = 0; n < 2; ++n) acc[a][b][m][n] = (f32x4){0.f, 0.f, 0.f, 0.f};
    bf16x8 At[4][2], B0[2][2], B1[2][2];
    const char* cA = (const char*)g.A + (size_t)cur.pm * tstep; const char* cB = (const char*)g.Bt + (size_t)cur.pb * tstep;
    S.a_ready(cur);
    if constexpr (SP2) {
        PG8_STAGE(PG8_SB(0, 0), cB, voffB); PG8_STAGE(PG8_SB(0, 1), cB + hstep, voffB); PG8_STAGE(PG8_SA(0, 0), cA, voffA); PG8_STAGE(PG8_SA(0, 1), cA + hstep, voffA);
        if (wr == 1) PG8_BAR;
        PG8_WAIT_V(2); PG8_BAR;
        PG8_STAGE(PG8_SB(1, 0), cB + kstep, voffB); PG8_STAGE(PG8_SA(1, 0), cA + kstep, voffA); PG8_STAGE(PG8_SB(1, 1), cB + hstep + kstep, voffB);
        PG8_WAIT_V(6); PG8_BAR;
    } else {
        PG8_STAGE(PG8_SB(0, 0), cB, voffB); PG8_STAGE(PG8_SA(0, 0), cA, voffA); PG8_STAGE(PG8_SB(0, 1), cB + hstep, voffB); PG8_STAGE(PG8_SA(0, 1), cA + hstep, voffA);
        if (wr == 1) PG8_BAR;
        PG8_WAIT_V(4); PG8_BAR;
        PG8_STAGE(PG8_SB(1, 0), cB + kstep, voffB); PG8_STAGE(PG8_SA(1, 0), cA + kstep, voffA); PG8_STAGE(PG8_SB(1, 1), cB + hstep + kstep, voffB);
        PG8_WAIT_V(6); PG8_BAR;
    }
    for (;;) {
        const bool has_next = S.next(ui + 1, nxt);
        const char* nA = has_next ? (const char*)g.A + (size_t)nxt.pm * tstep : cA; const char* nB = has_next ? (const char*)g.Bt + (size_t)nxt.pb * tstep : cB;
        for (int t = 0; t < nt; t += 2) {
            const bool last = (t == nt - 2);
            const char* a1 = cA + (size_t)(t + 1) * kstep;
            const char* a2 = last ? nA : cA + (size_t)(t + 2) * kstep; const char* b2 = last ? nB : cB + (size_t)(t + 2) * kstep;
            const char* a3 = a2 + kstep; const char* b3 = b2 + kstep;
            if (last && has_next) S.a_ready(nxt);
            if constexpr (SP2) {
            PG8_LDB(B0, 0, 0); PG8_LDB(B1, 0, 1); PG8_SCHED; PG8_LDA(At, 0, 0); PG8_STAGE(PG8_SA(1, 1), a1 + hstep, voffA);
            PG8_WAIT_V(8); PG8_WAIT_L(0); PG8_BAR; PG8_MMA(0, 0, At, B0); PG8_MMA(0, 1, At, B1); PG8_BAR; PG8_SCHED;
            PG8_LDA(At, 0, 1); PG8_STAGE(PG8_SB(0, 0), b2, voffB); PG8_STAGE(PG8_SB(0, 1), b2 + hstep, voffB); PG8_STAGE(PG8_SA(0, 0), a2, voffA);
            PG8_WAIT_V(8); PG8_WAIT_L(0); PG8_BAR; PG8_MMA(1, 0, At, B0); PG8_MMA(1, 1, At, B1); PG8_BAR; PG8_SCHED;
            PG8_LDB(B0, 1, 0); PG8_LDB(B1, 1, 1); PG8_SCHED; PG8_LDA(At, 1, 0); PG8_STAGE(PG8_SA(0, 1), a2 + hstep, voffA);
            PG8_WAIT_V(8); PG8_WAIT_L(0); PG8_BAR; PG8_MMA(0, 0, At, B0); PG8_MMA(0, 1, At, B1); PG8_BAR; PG8_SCHED;
            PG8_LDA(At, 1, 1); PG8_STAGE(PG8_SB(1, 0), b3, voffB); PG8_STAGE(PG8_SB(1, 1), b3 + hstep, voffB); PG8_STAGE(PG8_SA(1, 0), a3, voffA);
            PG8_WAIT_V(8); PG8_WAIT_L(0); PG8_BAR; PG8_MMA(1, 0, At, B0); PG8_MMA(1, 1, At, B1); PG8_BAR; PG8_SCHED;
            } else {
            PG8_LDB(B0, 0, 0); PG8_SCHED; PG8_LDA(At, 0, 0); PG8_STAGE(PG8_SA(1, 1), a1 + hstep, voffA);
            PG8_WAIT_L(8); PG8_BAR; PG8_WAIT_L(0); PG8_MMA(0, 0, At, B0); PG8_BAR; PG8_SCHED;
            PG8_LDB(B1, 0, 1); PG8_STAGE(PG8_SB(0, 0), b2, voffB);
            PG8_BAR; PG8_WAIT_L(0); PG8_MMA(0, 1, At, B1); PG8_BAR;
            PG8_LDA(At, 0, 1); PG8_STAGE(PG8_SA(0, 0), a2, voffA);
            PG8_BAR; PG8_WAIT_L(0); PG8_MMA(1, 0, At, B0); PG8_BAR; PG8_SCHED;
            PG8_STAGE(PG8_SB(0, 1), b2 + hstep, voffB);
            PG8_WAIT_V(6); PG8_BAR; PG8_MMA(1, 1, At, B1); PG8_BAR;
            PG8_LDB(B0, 1, 0); PG8_SCHED; PG8_LDA(At, 1, 0); PG8_STAGE(PG8_SA(0, 1), a2 + hstep, voffA);
            PG8_WAIT_L(8); PG8_BAR; PG8_WAIT_L(0); PG8_MMA(0, 0, At, B0); PG8_BAR; PG8_SCHED;
            PG8_LDB(B1, 1, 1); PG8_STAGE(PG8_SB(1, 0), b3, voffB);
            PG8_BAR; PG8_WAIT_L(0); PG8_MMA(0, 1, At, B1); PG8_BAR;
            PG8_LDA(At, 1, 1); PG8_STAGE(PG8_SA(1, 0), a3, voffA);
            PG8_BAR; PG8_WAIT_L(0); PG8_MMA(1, 0, At, B0); PG8_BAR; PG8_SCHED;
            PG8_STAGE(PG8_SB(1, 1), b3 + hstep, voffB);
            PG8_WAIT_V(6); PG8_BAR; PG8_MMA(1, 1, At, B1); PG8_BAR;
            }
        }
        if constexpr (ALIGN_EPI) { if (wr == 0) PG8_BAR; }
        if constexpr (!Epi::AFTER_DRAIN) { E(acc, cur, wr, wc, fr, fq); S.done(cur); }
        if (!has_next) break;
#pragma unroll
        for (int a = 0; a < 2; ++a)
#pragma unroll
            for (int b = 0; b < 2; ++b)
#pragma unroll
                for (int m = 0; m < 4; ++m)
#pragma unroll
                    for (int n = 0; n < 2; ++n) acc[a][b][m][n] = (f32x4){0.f, 0.f, 0.f, 0.f};
        cur = nxt; cA = nA; cB = nB; ++ui;
        if constexpr (ALIGN_EPI) { if (wr == 1) PG8_BAR; }
    }
    PG8_WAIT_V(0);
    if constexpr (!ALIGN_EPI) { if (wr == 0) PG8_BAR; }
    PG8_BAR;
    if constexpr (Epi::AFTER_DRAIN) { E.fused(acc, cur, wr, wc, fr, fq, lds, wid, lane); S.done(cur); }
#undef PG8_SA
#undef PG8_SB
#undef PG8_STAGE
#undef PG8_LDA
#undef PG8_LDB
#undef PG8_MMA
#undef PG8_WAIT_V
#undef PG8_WAIT_L
#undef PG8_BAR
#undef PG8_SCHED
}

__device__ __forceinline__ unsigned cvt_pk_bf16(float lo, float hi) { unsigned r; asm volatile("v_cvt_pk_bf16_f32 %0, %1, %2" : "=v"(r) : "v"(lo), "v"(hi)); return r; }
struct EpiBf16 {
    static constexpr bool PERM = true, AFTER_DRAIN = false;
    bf16_t* O; int ldc; unsigned smask; float s;
    __device__ __forceinline__ void operator()(const f32x4 (&acc)[2][2][4][2], const Unit& u, int wr, int wc, int fr, int fq) const {
        const int row0 = u.pm * BM + wr * 64 + fr, col0 = u.pn * BM + wc * 32 + 8 * fq; const float sc = ((smask >> u.pn) & 1u) ? s : 1.f;
#pragma unroll
        for (int ai = 0; ai < 2; ++ai)
#pragma unroll
            for (int m = 0; m < 4; ++m) { bf16_t* rowp = O + (size_t)(row0 + ai * HALF + m * 16) * ldc + col0;
#pragma unroll
                for (int bj = 0; bj < 2; ++bj) { const f32x4 v0 = acc[ai][bj][m][0] * sc, v1 = acc[ai][bj][m][1] * sc;
                    u32x4 w; w.x = cvt_pk_bf16(v0[0], v0[1]); w.y = cvt_pk_bf16(v0[2], v0[3]); w.z = cvt_pk_bf16(v1[0], v1[1]); w.w = cvt_pk_bf16(v1[2], v1[3]);
                    *(u32x4*)(rowp + bj * HALF) = w; } }
    }
};
struct EpiResF32 {
    static constexpr bool PERM = false, AFTER_DRAIN = false;
    const float* base; float* out; int ldc; float alpha;
    __device__ __forceinline__ void operator()(const f32x4 (&acc)[2][2][4][2], const Unit& u, int wr, int wc, int fr, int fq) const {
        const int col0 = u.pn * BM + wc * 32 + 4 * fq;
#pragma unroll
        for (int ai = 0; ai < 2; ++ai)
#pragma unroll
            for (int m = 0; m < 4; ++m) { const size_t off = (size_t)(u.pm * BM + ai * HALF + wr * 64 + m * 16 + fr) * ldc + col0;
#pragma unroll
                for (int bj = 0; bj < 2; ++bj)
#pragma unroll
                    for (int n = 0; n < 2; ++n) { const f32x4 bs = *(const f32x4*)(base + off + bj * HALF + n * 16); *(f32x4*)(out + off + bj * HALF + n * 16) = bs * alpha + acc[ai][bj][m][n]; }
                if (m & 1) asm volatile("" ::: "memory"); }
    }
};
struct EpiGateUp {
    static constexpr bool PERM = true, AFTER_DRAIN = false;
    bf16_t* O; const float* bias;
    __device__ __forceinline__ void operator()(const f32x4 (&acc)[2][2][4][2], const Unit& u, int wr, int wc, int fr, int fq) const {
        const int row0 = u.pm * BM + wr * 64 + fr, f0 = u.pn * 128 + wc * 32 + 8 * fq;
        const float* bp = bias + (size_t)u.e * 2048 + 2 * f0;
        const f32x4 b0 = *(const f32x4*)(bp), b1 = *(const f32x4*)(bp + 4), b2 = *(const f32x4*)(bp + 8), b3 = *(const f32x4*)(bp + 12);
        const float bg[8] = {b0[0], b0[2], b1[0], b1[2], b2[0], b2[2], b3[0], b3[2]}, bl[8] = {b0[1], b0[3], b1[1], b1[3], b2[1], b2[3], b3[1], b3[3]};
#pragma unroll
        for (int ai = 0; ai < 2; ++ai)
#pragma unroll
            for (int m = 0; m < 4; ++m) { float a[8];
#pragma unroll
                for (int n = 0; n < 2; ++n)
#pragma unroll
                    for (int q = 0; q < 4; ++q) { const float g = fminf(acc[ai][0][m][n][q] + bg[4 * n + q], 7.f), l = fminf(fmaxf(acc[ai][1][m][n][q] + bl[4 * n + q], -7.f), 7.f);
                        a[4 * n + q] = g * __builtin_amdgcn_rcpf(1.f + __builtin_amdgcn_exp2f(-1.702f * 1.4426950408889634f * g)) * (l + 1.f); }
                u32x4 w; w.x = cvt_pk_bf16(a[0], a[1]); w.y = cvt_pk_bf16(a[2], a[3]); w.z = cvt_pk_bf16(a[4], a[5]); w.w = cvt_pk_bf16(a[6], a[7]);
                *(u32x4*)(O + (size_t)(row0 + ai * HALF + m * 16) * 1024 + f0) = w; }
    }
};
struct EpiDown {
    static constexpr bool PERM = true, AFTER_DRAIN = false;
    bf16_t* Y; const float* bias; const int* rowslot; const float* rowgate; const int* blkv;
    __device__ __forceinline__ void operator()(const f32x4 (&acc)[2][2][4][2], const Unit& u, int wr, int wc, int fr, int fq) const {
        const int col0 = u.pn * BM + wc * 32 + 8 * fq, nv = blkv[u.pm];
        const float* bp = bias + (size_t)u.e * 1024 + col0;
        f32x4 bv[2][2];
#pragma unroll
        for (int bj = 0; bj < 2; ++bj)
#pragma unroll
            for (int n = 0; n < 2; ++n) bv[bj][n] = *(const f32x4*)(bp + bj * HALF + 4 * n);
#pragma unroll
        for (int ai = 0; ai < 2; ++ai)
#pragma unroll
            for (int m = 0; m < 4; ++m) { const int r = ai * HALF + wr * 64 + m * 16 + fr;
                if (r < nv) { const int slot = rowslot[u.pm * BM + r]; const float g = rowgate[u.pm * BM + r]; bf16_t* rowp = Y + (size_t)slot * 1024 + col0;
#pragma unroll
                    for (int bj = 0; bj < 2; ++bj) { const f32x4 v0 = (acc[ai][bj][m][0] + bv[bj][0]) * g, v1 = (acc[ai][bj][m][1] + bv[bj][1]) * g;
                        u32x4 w; w.x = cvt_pk_bf16(v0[0], v0[1]); w.y = cvt_pk_bf16(v0[2], v0[3]); w.z = cvt_pk_bf16(v1[0], v1[1]); w.w = cvt_pk_bf16(v1[2], v1[3]);
                        *(u32x4*)(rowp + bj * HALF) = w; } } }
    }
};
struct MoeOrder {
    const int* blke; int nunits, npn, gpx, c;
    __device__ __forceinline__ bool next(int i, Unit& u) const {
        const int L = (i * 8 + (c & 7)) * gpx + (c >> 3); if (L >= nunits) return false;
        const int blk = L / npn; u.pm = blk; u.pn = L - blk * npn; u.e = __builtin_amdgcn_readfirstlane(blke[blk]); u.pb = u.e * npn + u.pn; return true;
    }
    __device__ __forceinline__ void a_ready(const Unit&) const {}
    __device__ __forceinline__ void done(const Unit&) const {}
};
}

struct Frame {
    LAS unsigned char* lds;
    volatile LAS unsigned* MISC;
    gu32* ctl;
    int tid, lane, wave, vcu, G;
    const float* in[23]; float* out; unsigned char* ws;
};
#define WSP(T_, off) ((T_*)(F.ws + (off)))

template <int MODE>
__device__ __forceinline__ void p0_transpose_item(const float* W, int K, int N, bf16* WT, LAS float* scr, int item, int lane) {
    const int nblk = N / 32, kb = item / nblk, nb = item % nblk, k0 = 64 * kb, n0 = 32 * nb;
#pragma unroll 8
    for (int i = 0; i < 32; ++i) { const int kk = 2 * i + (lane >> 5); scr[kk * 33 + (lane & 31)] = W[(size_t)(k0 + kk) * N + n0 + (lane & 31)]; }
    asm volatile("s_waitcnt lgkmcnt(0)" ::: "memory");
    const int c = lane & 7;
#pragma unroll
    for (int j = 0; j < 4; ++j) { const int n = (lane >> 3) + 8 * j; const LAS float* s = scr + (8 * c) * 33 + n;
        v4u o; o.x = pk2(s[0 * 33], s[1 * 33]); o.y = pk2(s[2 * 33], s[3 * 33]); o.z = pk2(s[4 * 33], s[5 * 33]); o.w = pk2(s[6 * 33], s[7 * 33]);
        int col = n0 + n, drow = col;
        if (MODE == 1) { const int pn = col >> 8, w = col & 255; drow = 256 * pn + 128 * (w & 1) + (w >> 1); }
        *(GAS v4u*)(WT + (size_t)drow * K + k0 + 8 * c) = o; }
    asm volatile("s_waitcnt lgkmcnt(0)" ::: "memory");
}
__device__ __forceinline__ void row_to_bf16(const float* xrow, bf16* orow, int lane) {
    const GAS f32x4* xr = (const GAS f32x4*)xrow + lane;
    GAS v2u* o8 = (GAS v2u*)orow + lane;
#pragma unroll
    for (int j = 0; j < 4; ++j) { const f32x4 v = xr[64 * j]; v2u w; w.x = pk2(v.x, v.y); w.y = pk2(v.z, v.w); o8[64 * j] = w; }
}
__device__ __forceinline__ void p0_prologue(Frame& F) {
    LAS float* scr = (LAS float*)(F.lds + F.wave * 16384);
    const int gw = F.vcu * NWAVES + F.wave, NGW = F.G * NWAVES;
    constexpr int I_IN = 16 * (NIN / 32), I_KV = 16 * (512 / 32), I_O = 16 * (1024 / 32), I_GU = 16 * (2048 / 32), I_DN = 16 * (1024 / 32);
    constexpr int NITEMS = I_IN + I_KV + I_O + NE * I_GU + NE * I_DN;
    for (int it = gw; it < NITEMS; it += NGW) {
        int r = it;
        if (r < I_IN) { p0_transpose_item<0>(F.in[2], DM, NIN, WSP(bf16, WS_WIN), scr, r, F.lane); continue; } r -= I_IN;
        if (r < I_KV) { p0_transpose_item<0>(F.in[11], DM, 512, WSP(bf16, WS_WKV), scr, r, F.lane); continue; } r -= I_KV;
        if (r < I_O) { p0_transpose_item<0>(F.in[12], DM, DM, WSP(bf16, WS_WO), scr, r, F.lane); continue; } r -= I_O;
        if (r < NE * I_GU) { const int e = r / I_GU; p0_transpose_item<1>(F.in[17] + (size_t)e * DM * 2048, DM, 2048, WSP(bf16, WS_WGU) + (size_t)e * 2048 * DM, scr, r % I_GU, F.lane); continue; } r -= NE * I_GU;
        { const int e = r / I_DN; p0_transpose_item<0>(F.in[19] + (size_t)e * DM * DM, DM, DM, WSP(bf16, WS_WDN) + (size_t)e * DM * DM, scr, r % I_DN, F.lane); }
    }
    for (int m = gw; m < T; m += NGW) row_to_bf16(F.in[0] + (size_t)m * DM, WSP(bf16, WS_XB) + (size_t)m * DM, F.lane);
    for (int m = gw; m < NB * MEML; m += NGW) row_to_bf16(F.in[1] + (size_t)m * DM, WSP(bf16, WS_MEMB) + (size_t)m * DM, F.lane);
}

__device__ __forceinline__ void p1_inproj(Frame& F) {
    { pg8::Gemm g{WSP(bf16, WS_XB), WSP(bf16, WS_WIN), T, NIN, DM}; pg8::StaticOrder S; S.init(T, NIN, F.G, (int)blockIdx.x);
      pg8::EpiBf16 E{WSP(bf16, WS_U), NIN, (1u << 0) | (1u << 1) | (1u << 11), C2};
      pg8::gemm_phase<pg8::EpiBf16, pg8::StaticOrder, true, true>(F.lds, g, S, E); }
    { pg8::Gemm g{WSP(bf16, WS_MEMB), WSP(bf16, WS_WKV), NB * MEML, 512, DM}; pg8::StaticOrder S; S.init(NB * MEML, 512, F.G, (int)blockIdx.x);
      pg8::EpiBf16 E{WSP(bf16, WS_MKV), 512, 0u, 1.f};
      pg8::gemm_phase<pg8::EpiBf16, pg8::StaticOrder, true, true>(F.lds, g, S, E); }
}

template <int DV>
__device__ __forceinline__ void attn_naive_unit(const bf16* q, const bf16* kbase, size_t kstride, const bf16* vbase, size_t vstride, int nk, float slope2, int qpos, bf16* out, LAS float* sc, int lane) {
    float qf[64];
#pragma unroll
    for (int i = 0; i < 8; ++i) { const v4u w = *(const GAS v4u*)(q + 8 * i);
        qf[8 * i + 0] = bflo(w.x); qf[8 * i + 1] = bfhi(w.x); qf[8 * i + 2] = bflo(w.y); qf[8 * i + 3] = bfhi(w.y); qf[8 * i + 4] = bflo(w.z); qf[8 * i + 5] = bfhi(w.z); qf[8 * i + 6] = bflo(w.w); qf[8 * i + 7] = bfhi(w.w); }
    float mx = -INFINITY;
    for (int k = lane; k < nk; k += 64) {
        const bf16* kr = kbase + (size_t)k * kstride; float s = 0.f;
#pragma unroll
        for (int i = 0; i < 8; ++i) { const v4u w = *(const GAS v4u*)(kr + 8 * i);
            s += qf[8 * i + 0] * bflo(w.x) + qf[8 * i + 1] * bfhi(w.x) + qf[8 * i + 2] * bflo(w.y) + qf[8 * i + 3] * bfhi(w.y) + qf[8 * i + 4] * bflo(w.z) + qf[8 * i + 5] * bfhi(w.z) + qf[8 * i + 6] * bflo(w.w) + qf[8 * i + 7] * bfhi(w.w); }
        const int dist = qpos > k ? qpos - k : k - qpos;
        s -= slope2 * (float)dist;
        sc[k] = s; mx = fmaxf(mx, s);
    }
    mx = wave_max(mx);
    float l = 0.f;
    for (int k = lane; k < nk; k += 64) { const float p = exp2f(sc[k] - mx); sc[k] = p; l += p; }
    l = wave_sum(l);
    asm volatile("s_waitcnt lgkmcnt(0)" ::: "memory");
    const float rl = 1.f / l;
    float o[DV / 64];
#pragma unroll
    for (int j = 0; j < DV / 64; ++j) o[j] = 0.f;
    for (int k = 0; k < nk; ++k) { const float p = sc[k]; const bf16* vr = vbase + (size_t)k * vstride;
#pragma unroll
        for (int j = 0; j < DV / 64; ++j) o[j] += p * bf2f(vr[lane + 64 * j]); }
#pragma unroll
    for (int j = 0; j < DV / 64; ++j) out[lane + 64 * j] = (bf16)f2bf(o[j] * rl);
    asm volatile("s_waitcnt lgkmcnt(0)" ::: "memory");
}

__device__ __forceinline__ void p2_naive_mix(Frame& F) {
    LAS float* sc = (LAS float*)(F.lds + F.wave * 16384);
    const int gw = F.vcu * NWAVES + F.wave, NGW = F.G * NWAVES, lane = F.lane;
    const bf16* U = WSP(bf16, WS_U);
    if (gw < 32) {
        const int b = gw >> 3, h = (gw >> 1) & 3, dir = gw & 1;
        const float* lbp = dir ? F.in[9] : F.in[8];
        const float a0 = lbp[h * 64 + lane], a1 = lbp[256 + h * 64 + lane];
        const float lb = 1.f / (1.f + __expf(a1 - a0));
        float S[64];
#pragma unroll
        for (int d = 0; d < 64; ++d) S[d] = 0.f;
        float* OH = WSP(float, WS_OH);
        for (int step = 0; step < SEQ; ++step) {
            const int t = dir ? SEQ - 1 - step : step; const size_t row = (size_t)b * SEQ + t;
            const bf16* ur = U + row * NIN;
            const float hq = bf2f(ur[U_HQ + h * 64 + lane]), hf = bf2f(ur[U_HF + dir * 256 + h * 64 + lane]), vi = bf2f(ur[U_HI + h * 64 + lane]);
            const float ql = hq * sigmoidf_(hq), fl = lb + (1.f - lb) * sigmoidf_(hf);
            float o = 0.f;
#pragma unroll
            for (int d = 0; d < 64; ++d) { const float fdd = __int_as_float(__builtin_amdgcn_readlane(__float_as_int(fl), d)), qd = __int_as_float(__builtin_amdgcn_readlane(__float_as_int(ql), d));
                S[d] = fdd * S[d] + (1.f - fdd) * vi; o += qd * S[d]; }
            OH[(row * 4 + h) * 128 + dir * 64 + lane] = o;
        }
    }
    for (int u = gw; u < T * 8; u += NGW) {
        const int row = u >> 3, h = (u >> 1) & 3, m = u & 1, b = row / SEQ, qpos = row % SEQ;
        attn_naive_unit<128>(U + (size_t)row * NIN + U_DQ + h * 128 + m * 64, U + (size_t)b * SEQ * NIN + U_DK + h * 128 + m * 64, NIN, U + (size_t)b * SEQ * NIN + U_DV + h * 128, NIN, SEQ,
                             __builtin_ldexpf(LOG2E, -2 * (h + 1)), qpos, WSP(bf16, WS_OD) + (size_t)row * DM + h * 256 + m * 128, sc, lane);
    }
    const bf16* MKV = WSP(bf16, WS_MKV);
    for (int u = gw; u < T * 4; u += NGW) {
        const int row = u >> 2, h = u & 3, b = row / SEQ;
        attn_naive_unit<64>(U + (size_t)row * NIN + U_MQ + h * 64, MKV + (size_t)b * MEML * 512 + h * 64, 512, MKV + (size_t)b * MEML * 512 + 256 + h * 64, 512, MEML, 0.f, 0,
                            WSP(bf16, WS_CAT) + (size_t)row * DM + 768 + h * 64, sc, lane);
    }
}

__device__ __forceinline__ void p3_naive_combine(Frame& F) {
    const int gw = F.vcu * NWAVES + F.wave, NGW = F.G * NWAVES, lane = F.lane;
    const float sa = wave_sum(F.in[3][lane] * F.in[4][lane]), sb = wave_sum(F.in[5][lane] * F.in[6][lane]);
    const float lam = __expf(sa) - __expf(sb) + 0.2f;
    const bf16* OD = WSP(bf16, WS_OD); const float* OH = WSP(float, WS_OH); const bf16* U = WSP(bf16, WS_U); bf16* CAT = WSP(bf16, WS_CAT);
    const float dnw0 = F.in[7][lane], dnw1 = F.in[7][lane + 64];
    for (int row = gw; row < T; row += NGW) {
#pragma unroll
        for (int h = 0; h < 4; ++h) {
            const bf16* p0 = OD + (size_t)row * DM + h * 256; const bf16* p1 = p0 + 128;
            const float o0 = bf2f(p0[lane]) - lam * bf2f(p1[lane]), o1 = bf2f(p0[lane + 64]) - lam * bf2f(p1[lane + 64]);
            const float ss = wave_sum(o0 * o0 + o1 * o1), r = rsqrtf(ss * (1.f / 128.f) + EPS) * 0.8f;
            CAT[(size_t)row * DM + h * 128 + lane] = (bf16)f2bf(o0 * r * dnw0); CAT[(size_t)row * DM + h * 128 + 64 + lane] = (bf16)f2bf(o1 * r * dnw1);
        }
#pragma unroll
        for (int h = 0; h < 4; ++h) {
            const float* p = OH + ((size_t)row * 4 + h) * 128; const float o = p[lane] + p[64 + lane];
            const float ss = wave_sum(o * o), r = rsqrtf(ss * (1.f / 64.f) + EPS);
            const float g = sigmoidf_(bf2f(U[(size_t)row * NIN + U_HG + h * 64 + lane]));
            CAT[(size_t)row * DM + 512 + h * 64 + lane] = (bf16)f2bf(o * r * F.in[10][h * 64 + lane] * g);
        }
    }
}

__device__ __forceinline__ void p4_wo(Frame& F) {
    pg8::Gemm g{WSP(bf16, WS_CAT), WSP(bf16, WS_WO), T, DM, DM}; pg8::StaticOrder S; S.init(T, DM, F.G, (int)blockIdx.x);
    pg8::EpiResF32 E{F.in[0], WSP(float, WS_Z1), DM, ALPHA};
    pg8::gemm_phase<pg8::EpiResF32, pg8::StaticOrder, true, true>(F.lds, g, S, E);
}

__device__ __forceinline__ void ln_row(f32x4 (&v)[4], const float* g, const float* bb, int lane, float& mean, float& rstd) {
    float s = 0.f;
#pragma unroll
    for (int j = 0; j < 4; ++j) s += (v[j].x + v[j].y) + (v[j].z + v[j].w);
    mean = wave_sum(s) * (1.f / DM); float s2 = 0.f;
#pragma unroll
    for (int j = 0; j < 4; ++j) { v[j] = v[j] - mean; s2 += (v[j].x * v[j].x + v[j].y * v[j].y) + (v[j].z * v[j].z + v[j].w * v[j].w); }
    rstd = rsqrtf(wave_sum(s2) * (1.f / DM) + EPS);
#pragma unroll
    for (int j = 0; j < 4; ++j) { const f32x4 gv = *(const GAS f32x4*)(g + 4 * lane + 256 * j), bv = *(const GAS f32x4*)(bb + 4 * lane + 256 * j); v[j] = v[j] * rstd * gv + bv; }
}

__device__ __forceinline__ void p5_router(Frame& F) {
    LAS float* rw = (LAS float*)F.lds;
    for (int i = F.tid; i < DM * 8; i += NTHREADS) { const int col = i >> 3, e4 = i & 7; const int l = (col & 255) >> 2, q = 4 * (col >> 8) + (col & 3);
        const f32x4 w = *(const GAS f32x4*)(F.in[15] + (size_t)col * 32 + e4 * 4);
        *(LAS f32x4*)&rw[(q * 64 + l) * 32 + ((e4 ^ ((l >> 1) & 7)) * 4)] = w; }
    __syncthreads();
    const int gw = F.vcu * NWAVES + F.wave, NGW = F.G * NWAVES, lane = F.lane;
    int* TOPI = WSP(int, WS_ROUTE); float* TOPG = WSP(float, WS_ROUTE + 256 * 1024); int* RANK = WSP(int, WS_ROUTE + 512 * 1024); float* STATS = WSP(float, WS_ROUTE + 768 * 1024);
    const float rbias = F.in[16][lane >> 1];
    for (int row = gw; row < T; row += NGW) {
        f32x4 v[4];
#pragma unroll
        for (int j = 0; j < 4; ++j) v[j] = *(const GAS f32x4*)(WSP(float, WS_Z1) + (size_t)row * DM + 4 * lane + 256 * j);
        float mean, rstd; ln_row(v, F.in[13], F.in[14], lane, mean, rstd);
        if (lane == 0) { STATS[2 * row] = mean; STATS[2 * row + 1] = rstd; }
        float acc[32];
#pragma unroll
        for (int e = 0; e < 32; ++e) acc[e] = 0.f;
#pragma unroll
        for (int j = 0; j < 4; ++j)
#pragma unroll
            for (int c = 0; c < 4; ++c) { const float hv = v[j][c]; const int q = 4 * j + c;
#pragma unroll
                for (int e4 = 0; e4 < 8; ++e4) { const f32x4 w = *(const LAS f32x4*)&rw[(q * 64 + lane) * 32 + ((e4 ^ ((lane >> 1) & 7)) * 4)];
                    acc[4 * e4 + 0] += hv * w.x; acc[4 * e4 + 1] += hv * w.y; acc[4 * e4 + 2] += hv * w.z; acc[4 * e4 + 3] += hv * w.w; }
                asm volatile("" ::: "memory"); }
        float r16[16];
#pragma unroll
        for (int i = 0; i < 16; ++i) { const bool up = (lane & 32) != 0; const float keep = up ? acc[16 + i] : acc[i], send = up ? acc[i] : acc[16 + i]; r16[i] = keep + __shfl_xor(send, 32); }
        float r8[8];
#pragma unroll
        for (int i = 0; i < 8; ++i) { const bool up = (lane & 16) != 0; const float keep = up ? r16[8 + i] : r16[i], send = up ? r16[i] : r16[8 + i]; r8[i] = keep + __shfl_xor(send, 16); }
        float r4[4];
#pragma unroll
        for (int i = 0; i < 4; ++i) { const bool up = (lane & 8) != 0; const float keep = up ? r8[4 + i] : r8[i], send = up ? r8[i] : r8[4 + i]; r4[i] = keep + __shfl_xor(send, 8); }
        float r2[2];
#pragma unroll
        for (int i = 0; i < 2; ++i) { const bool up = (lane & 4) != 0; const float keep = up ? r4[2 + i] : r4[i], send = up ? r4[i] : r4[2 + i]; r2[i] = keep + __shfl_xor(send, 4); }
        float r1; { const bool up = (lane & 2) != 0; const float keep = up ? r2[1] : r2[0], send = up ? r2[0] : r2[1]; r1 = keep + __shfl_xor(send, 2); }
        float logit = r1 + __shfl_xor(r1, 1) + rbias;
        float tv[4]; int ti[4]; float cur = logit; const int myi = lane >> 1;
#pragma unroll
        for (int k = 0; k < 4; ++k) {
            float bv = cur; int bi = myi;
#pragma unroll
            for (int o = 1; o < 64; o <<= 1) { const float ov = __shfl_xor(bv, o); const int oi = __shfl_xor(bi, o); if (ov > bv || (ov == bv && oi < bi)) { bv = ov; bi = oi; } }
            tv[k] = bv; ti[k] = bi; if (myi == bi) cur = -INFINITY;
        }
        const float e1 = __expf(tv[1] - tv[0]), e2 = __expf(tv[2] - tv[0]), e3 = __expf(tv[3] - tv[0]); const float inv = 1.f / (1.f + e1 + e2 + e3);
        if (lane < 4) { const int e = lane == 0 ? ti[0] : lane == 1 ? ti[1] : lane == 2 ? ti[2] : ti[3]; const float g = (lane == 0 ? 1.f : lane == 1 ? e1 : lane == 2 ? e2 : e3) * inv;
            const unsigned rk = __hip_atomic_fetch_add((unsigned*)(F.ctl + CW_CNT + e), 1u, RLX_AGENT);
            TOPI[row * 4 + lane] = e; TOPG[row * 4 + lane] = g; RANK[row * 4 + lane] = (int)rk; }
    }
    __syncthreads();
}

__device__ __forceinline__ void p6_dispatch(Frame& F) {
    LAS int* pst = (LAS int*)F.lds;
    if (F.tid == 0) { int acc = 0; for (int e = 0; e < NE; ++e) { pst[e] = acc; const int c = (int)__hip_atomic_load((unsigned*)(F.ctl + CW_CNT + e), RLX_AGENT); acc += (c + 255) / 256 * 256; } pst[NE] = acc; }
    __syncthreads();
    int* ROWSLOT = WSP(int, WS_ROWS); float* ROWGATE = WSP(float, WS_ROWS + MAXROWS * 4); int* BLKE = WSP(int, WS_ROWS + 2 * MAXROWS * 4); int* BLKV = BLKE + 512; int* NBLK = BLKE + 1024;
    if (blockIdx.x == 0 && F.tid < NE) { const int e = F.tid, c = (int)__hip_atomic_load((unsigned*)(F.ctl + CW_CNT + e), RLX_AGENT); const int b0 = pst[e] / 256, nb = (pst[e + 1] - pst[e]) / 256;
        for (int i = 0; i < nb; ++i) { BLKE[b0 + i] = e; BLKV[b0 + i] = min(256, c - 256 * i); }
        if (e == 0) NBLK[0] = pst[NE] / 256; }
    const int gw = F.vcu * NWAVES + F.wave, NGW = F.G * NWAVES, lane = F.lane;
    const int* TOPI = WSP(int, WS_ROUTE); const float* TOPG = WSP(float, WS_ROUTE + 256 * 1024); const int* RANK = WSP(int, WS_ROUTE + 512 * 1024);
    for (int row = gw; row < T; row += NGW) {
        f32x4 v[4];
#pragma unroll
        for (int j = 0; j < 4; ++j) v[j] = *(const GAS f32x4*)(WSP(float, WS_Z1) + (size_t)row * DM + 4 * lane + 256 * j);
        float mean, rstd; ln_row(v, F.in[13], F.in[14], lane, mean, rstd);
        v2u w[4];
#pragma unroll
        for (int j = 0; j < 4; ++j) { w[j].x = pk2(v[j].x, v[j].y); w[j].y = pk2(v[j].z, v[j].w); }
#pragma unroll
        for (int k = 0; k < 4; ++k) { const int e = TOPI[row * 4 + k], dest = pst[e] + RANK[row * 4 + k];
            GAS v2u* o8 = (GAS v2u*)(WSP(bf16, WS_XS) + (size_t)dest * DM) + lane;
#pragma unroll
            for (int j = 0; j < 4; ++j) o8[64 * j] = w[j];
            if (lane == 0) { ROWSLOT[dest] = row * 4 + k; ROWGATE[dest] = TOPG[row * 4 + k]; } }
    }
    __syncthreads();
}

__device__ __forceinline__ void p7_gateup(Frame& F) {
    const int* BLKE = WSP(int, WS_ROWS + 2 * MAXROWS * 4); const int nblk = __builtin_amdgcn_readfirstlane(BLKE[1024]);
    pg8::Gemm g{WSP(bf16, WS_XS), WSP(bf16, WS_WGU), MAXROWS, 2048, DM}; pg8::MoeOrder S{BLKE, nblk * 8, 8, F.G / 8, (int)blockIdx.x};
    pg8::EpiGateUp E{WSP(bf16, WS_ACT), F.in[18]};
    pg8::gemm_phase<pg8::EpiGateUp, pg8::MoeOrder, true, true>(F.lds, g, S, E);
}

__device__ __forceinline__ void p8_down(Frame& F) {
    const int* BLKE = WSP(int, WS_ROWS + 2 * MAXROWS * 4); const int nblk = __builtin_amdgcn_readfirstlane(BLKE[1024]);
    pg8::Gemm g{WSP(bf16, WS_ACT), WSP(bf16, WS_WDN), MAXROWS, 1024, DM}; pg8::MoeOrder S{BLKE, nblk * 4, 4, F.G / 8, (int)blockIdx.x};
    pg8::EpiDown E{WSP(bf16, WS_Y), F.in[20], WSP(int, WS_ROWS), WSP(float, WS_ROWS + MAXROWS * 4), BLKE + 512};
    pg8::gemm_phase<pg8::EpiDown, pg8::MoeOrder, true, true>(F.lds, g, S, E);
}

__device__ __forceinline__ void p9_final(Frame& F) {
    const int gw = F.vcu * NWAVES + F.wave, NGW = F.G * NWAVES, lane = F.lane;
    for (int row = gw; row < T; row += NGW) {
        f32x4 v[4];
#pragma unroll
        for (int j = 0; j < 4; ++j) v[j] = *(const GAS f32x4*)(WSP(float, WS_Z1) + (size_t)row * DM + 4 * lane + 256 * j);
        float mean, rstd; ln_row(v, F.in[13], F.in[14], lane, mean, rstd);
#pragma unroll
        for (int j = 0; j < 4; ++j) v[j] = v[j] * ALPHA;
#pragma unroll
        for (int k = 0; k < 4; ++k) { const GAS v2u* y8 = (const GAS v2u*)(WSP(bf16, WS_Y) + (size_t)(row * 4 + k) * DM) + lane;
#pragma unroll
            for (int j = 0; j < 4; ++j) { const v2u w = y8[64 * j]; v[j].x += bflo(w.x); v[j].y += bfhi(w.x); v[j].z += bflo(w.y); v[j].w += bfhi(w.y); } }
        ln_row(v, F.in[21], F.in[22], lane, mean, rstd);
#pragma unroll
        for (int j = 0; j < 4; ++j) *(GAS f32x4*)(F.out + (size_t)row * DM + 4 * lane + 256 * j) = v[j];
    }
}

constexpr int NPHASE = 10;
struct Args { const float* in[23]; float* out; unsigned char* ws; int ph_lo, ph_hi; };
__global__ void __launch_bounds__(NTHREADS, 2) mega_fwd(Args args) {
    extern __shared__ __attribute__((aligned(16))) unsigned char lds[];
    Frame F;
    F.lds = (LAS unsigned char*)lds; F.MISC = (volatile LAS unsigned*)(F.lds + MISC_OFF);
    F.tid = threadIdx.x; F.lane = F.tid & 63; F.wave = __builtin_amdgcn_readfirstlane(F.tid >> 6);
    F.G = gridDim.x; { const int bx = blockIdx.x; F.vcu = (F.G % 8 == 0) ? (bx % 8) * (F.G / 8) + bx / 8 : bx; }
    F.ws = args.ws; F.ctl = (gu32*)(args.ws + WS_CTL); F.out = args.out;
#pragma unroll
    for (int i = 0; i < 23; ++i) F.in[i] = args.in[i];
    for (int u = F.tid; u < (LDS_BYTES - LDSCTL_OFF) / 4; u += NTHREADS) ((LAS unsigned*)(F.lds + LDSCTL_OFF))[u] = 0u;
    __syncthreads();
    const bool single = (args.ph_lo == 0 && args.ph_hi == NPHASE);
    XcdBarrier bar; bar.bar = (unsigned*)(F.ctl + CW_BAR); bar.x = 0; bar.st = nullptr;
    if (single) bar = xcd_barrier_post((unsigned*)(F.ctl + CW_BAR), F.MISC + 8);
    const int lo = args.ph_lo, hi = args.ph_hi;
#ifndef PH_MASK
#define PH_MASK 0x3ff
#endif
#define IN(k) (((PH_MASK >> (k)) & 1) && lo <= (k) && (k) < hi)
#define SEAM(k) do { if (IN(k) && IN((k) + 1)) xcd_barrier(bar); } while (0)
    if (IN(0)) { p0_prologue(F); } SEAM(0);
    if (IN(1)) { p1_inproj(F); } SEAM(1);
    if (IN(2)) { p2_naive_mix(F); } SEAM(2);
    if (IN(3)) { p3_naive_combine(F); } SEAM(3);
    if (IN(4)) { p4_wo(F); } SEAM(4);
    if (IN(5)) { p5_router(F); } SEAM(5);
    if (IN(6)) { p6_dispatch(F); } SEAM(6);
    if (IN(7)) { p7_gateup(F); } SEAM(7);
    if (IN(8)) { p8_down(F); } SEAM(8);
    if (IN(9)) { p9_final(F); }
#undef IN
#undef SEAM
}

#ifndef MK_MULTI
#define MK_MULTI 0
#endif
extern "C" void kernel_launch(void* const* d_in, const int* in_sizes, int n_in, void* d_out, int out_size, void* d_ws, size_t ws_size, hipStream_t stream) {
    static int grid = 0;
    if (grid == 0) {
        if (n_in != 23 || out_size != T * DM || ws_size < WS_END) { fprintf(stderr, "kernel_launch: unexpected shapes n_in %d out %d ws %zu\n", n_in, out_size, ws_size); grid = -1; return; }
        int dev = 0, cus = 0;
        if (hipGetDevice(&dev) != hipSuccess || hipDeviceGetAttribute(&cus, hipDeviceAttributeMultiprocessorCount, dev) != hipSuccess) { grid = -1; return; }
        if (hipFuncSetAttribute((const void*)mega_fwd, hipFuncAttributeMaxDynamicSharedMemorySize, LDS_BYTES) != hipSuccess) { fprintf(stderr, "kernel_launch: hipFuncSetAttribute failed\n"); grid = -1; return; }
        int per_cu = 0;
        if (hipOccupancyMaxActiveBlocksPerMultiprocessor(&per_cu, (const void*)mega_fwd, NTHREADS, LDS_BYTES) != hipSuccess || per_cu < 1) fprintf(stderr, "kernel_launch: occupancy query says %d\n", per_cu);
        (void)hipGetLastError();
        grid = cus;
    }
    if (grid < 0) return;
    (void)hipMemsetAsync((char*)d_ws + WS_CTL, 0, CTL_ZERO_BYTES, stream);
    Args a{};
    for (int i = 0; i < 23; ++i) a.in[i] = (const float*)d_in[i];
    a.out = (float*)d_out; a.ws = (unsigned char*)d_ws;
#if MK_MULTI
    for (int p = 0; p < NPHASE; ++p) { a.ph_lo = p; a.ph_hi = p + 1; hipLaunchKernelGGL(mega_fwd, dim3(grid), dim3(NTHREADS), LDS_BYTES, stream, a); }
#else
    a.ph_lo = 0; a.ph_hi = NPHASE;
    hipLaunchKernelGGL(mega_fwd, dim3(grid), dim3(NTHREADS), LDS_BYTES, stream, a);
#endif
}
```

```cpp
#include <hip/hip_runtime.h>
#include <cstdio>
#include <cstdint>

constexpr int NB = 4, SEQ = 4096, DM = 1024, T = NB * SEQ, MEML = 256, NIN = 3072, NE = 32, TOPK = 4;
constexpr int TK = T * TOPK, MAXBLK = TK / 256 + NE, MAXROWS = MAXBLK * 256;
constexpr float LOG2E = 1.4426950408889634f, C2 = 0.125f * LOG2E, ALPHA = 1.189207115002721f, EPS = 1e-5f;
constexpr int U_DQ = 0, U_DK = 512, U_DV = 1024, U_HQ = 1536, U_HF = 1792, U_HI = 2304, U_HG = 2560, U_MQ = 2816;

constexpr size_t MiB = 1u << 20;
constexpr size_t WS_CTL = 0, CTL_ZERO_BYTES = 1 * MiB;
constexpr size_t WS_WIN = 2 * MiB, WS_WKV = 8 * MiB, WS_WO = 10 * MiB, WS_MEMB = 12 * MiB, WS_MKV = 14 * MiB;
constexpr size_t WS_XB = 16 * MiB, WS_U = 48 * MiB, WS_OD = 144 * MiB, WS_CAT = 176 * MiB, WS_Z1 = 208 * MiB;
constexpr size_t WS_ROUTE = 272 * MiB;
constexpr size_t WS_HU = 280 * MiB, WS_SS = 316 * MiB;
constexpr size_t WS_WGU = 336 * MiB, WS_WDN = 464 * MiB, WS_XS = 528 * MiB, WS_ACT = 672 * MiB, WS_Y = 816 * MiB;
constexpr size_t WS_ROWS = 944 * MiB;
constexpr size_t WS_OH = 948 * MiB;
constexpr size_t WS_END = 980 * MiB;
constexpr int CW_TMO = 0, CW_CODE = 1, CW_CNT = 64  , CW_BAR = 4096;

constexpr int RING_BYTES = 131072, LDSCTL_OFF = RING_BYTES, MISC_OFF = LDSCTL_OFF + 320, LDS_BYTES = 147456;
constexpr int NWAVES = 8, NTHREADS = 512;

#define GAS __attribute__((address_space(1)))
#define LAS __attribute__((address_space(3)))
typedef unsigned short bf16;
typedef unsigned v4u __attribute__((ext_vector_type(4)));
typedef unsigned v2u __attribute__((ext_vector_type(2)));
typedef float f32x4 __attribute__((ext_vector_type(4)));
typedef GAS unsigned gu32;
#define RLX_AGENT __ATOMIC_RELAXED, __HIP_MEMORY_SCOPE_AGENT
__device__ __forceinline__ unsigned f2bf(float f) { unsigned u = __builtin_bit_cast(unsigned, f); return (u + 0x7fffu + ((u >> 16) & 1u)) >> 16; }
__device__ __forceinline__ unsigned pk2(float lo, float hi) { return f2bf(lo) | (f2bf(hi) << 16); }
__device__ __forceinline__ float bf2f(unsigned v) { return __uint_as_float(v << 16); }
__device__ __forceinline__ float bflo(unsigned w) { return __uint_as_float(w << 16); }
__device__ __forceinline__ float bfhi(unsigned w) { return __uint_as_float(w & 0xffff0000u); }
__device__ __forceinline__ float wave_sum(float v) {
#pragma unroll
    for (int o = 1; o < 64; o <<= 1) v += __shfl_xor(v, o);
    return v;
}
__device__ __forceinline__ float wave_max(float v) {
#pragma unroll
    for (int o = 1; o < 64; o <<= 1) v = fmaxf(v, __shfl_xor(v, o));
    return v;
}
__device__ __forceinline__ float sigmoidf_(float x) { return 1.f / (1.f + __expf(-x)); }

#define XB_TMO      128
#define XB_XCNT(j)  (256  + 64 * (j))
#define XB_XSUB(j)  (1280 + 64 * (j))
#define XB_XGEN(j)  (2304 + 64 * (j))
#define XB_TOP      3328
#define XB_TOPGEN   3392
#define XCD_BAR_WORDS 3456
#define XB_SPIN_CAP (1u << 20)
__device__ __forceinline__ unsigned xb_ld(unsigned* p)              { return __hip_atomic_load(p, __ATOMIC_RELAXED, __HIP_MEMORY_SCOPE_AGENT); }
__device__ __forceinline__ unsigned xb_add(unsigned* p, unsigned v) { return __hip_atomic_fetch_add(p, v, __ATOMIC_RELAXED, __HIP_MEMORY_SCOPE_AGENT); }
__device__ __forceinline__ unsigned xb_xcc_id() { return (unsigned)__builtin_amdgcn_s_getreg((3 << 11) | 20) & 0xFu; }
#define XB_SPIN(cond, bar) do { unsigned _sp = 0; while (cond) { __builtin_amdgcn_s_sleep(1); \
    if ((++_sp & 255u) == 0u) { if (xb_ld(&(bar)[XB_TMO])) break; if (_sp > XB_SPIN_CAP) { atomicAdd(&(bar)[XB_TMO], 1u); break; } } } } while (0)
struct XcdBarrier { unsigned* bar; unsigned x; volatile LAS unsigned* st; };
__device__ __forceinline__ XcdBarrier xcd_barrier_post(unsigned* bar, volatile LAS unsigned* st) {
    XcdBarrier b; b.bar = bar; b.x = xb_xcc_id(); b.st = st;
    if (threadIdx.x == 0) (void)xb_add(&bar[XB_XCNT(b.x)], 1u);
    return b;
}
__device__ __forceinline__ void xcd_barrier_complete(unsigned* bar, unsigned x, unsigned& nloc, unsigned& nx) {
    const unsigned G = gridDim.x * gridDim.y * gridDim.z;
    unsigned sum, cnt, mine, sp = 0u;
    for (;;) {
        sum = 0u; cnt = 0u; mine = 0u;
#pragma unroll
        for (unsigned j = 0; j < 16; ++j) { const unsigned c = xb_ld(&bar[XB_XCNT(j)]); sum += c; cnt += (c > 0u) ? 1u : 0u; mine = (j == x) ? c : mine; }
        if (sum == G) break;
        __builtin_amdgcn_s_sleep(1);
        if ((++sp & 255u) == 0u) { if (xb_ld(&bar[XB_TMO])) break; if (sp > XB_SPIN_CAP) { atomicAdd(&bar[XB_TMO], 1u); break; } }
    }
    nloc = mine > 0u ? mine : 1u; nx = cnt > 0u ? cnt : 1u;
}
__device__ __forceinline__ void xcd_barrier(const XcdBarrier& b) {
    asm volatile("s_waitcnt vmcnt(0)" ::: "memory");
    __syncthreads();
    if (threadIdx.x == 0) {
        unsigned* bar = b.bar;
        __builtin_amdgcn_s_waitcnt(0);
        unsigned nloc = b.st[0], nx = b.st[1];
        if (nloc == 0u) { xcd_barrier_complete(bar, b.x, nloc, nx); b.st[0] = nloc; b.st[1] = nx; }
        const unsigned old = xb_add(&bar[XB_XSUB(b.x)], 1u);
        const unsigned gen = old / nloc;
        if (old + 1u == (gen + 1u) * nloc) {
            __builtin_amdgcn_fence(__ATOMIC_RELEASE, "agent");
            asm volatile("s_waitcnt vmcnt(0)" ::: "memory");
            const unsigned og = xb_add(&bar[XB_TOP], 1u);
            const unsigned tg = og / nx;
            if (og + 1u == (tg + 1u) * nx) xb_add(&bar[XB_TOPGEN], 1u);
            else XB_SPIN(xb_ld(&bar[XB_TOPGEN]) == tg, bar);
            __builtin_amdgcn_fence(__ATOMIC_ACQUIRE, "agent");
            xb_add(&bar[XB_XGEN(b.x)], 1u);
            asm volatile("s_waitcnt vmcnt(0)" ::: "memory");
        } else {
            XB_SPIN(xb_ld(&bar[XB_XGEN(b.x)]) == gen, bar);
            __builtin_amdgcn_fence(__ATOMIC_ACQUIRE, "agent");
            asm volatile("s_waitcnt vmcnt(0)" ::: "memory");
        }
    }
    __syncthreads();
}

namespace pg8 {
#define PG8_LAS __attribute__((address_space(3)))
typedef unsigned short bf16_t;
typedef short bf16x8 __attribute__((ext_vector_type(8)));
typedef float f32x4 __attribute__((ext_vector_type(4)));
typedef unsigned u32x4 __attribute__((ext_vector_type(4)));
constexpr int BM = 256, BK = 64, HALF = 128, HTB = HALF * BK * 2  , STAGE_BYTES = 8 * HTB, NXCD = 8, WGM = 8;

__host__ __device__ __forceinline__ int lds_byte(int r, int c) { const int st = (r >> 4) * 2 + (c >> 5), rr = r & 15, cc = c & 31, ob = rr * 64 + cc * 2; return st * 1024 + (ob ^ (((ob >> 9) & 1) << 5)); }
__host__ __device__ __forceinline__ void stage_rc(int b, int& R, int& C) { const int st = b / 1024, sb = b % 1024, swz = sb ^ (((sb >> 9) & 1) << 5); R = (st >> 1) * 16 + swz / 64; C = (st & 1) * 32 + (swz % 64) / 2; }
__host__ __device__ __forceinline__ int perm32(int rho) { const int n = rho >> 4, i = rho & 15; return 8 * (i >> 2) + 4 * n + (i & 3); }

struct Unit { int pm, pn, pb, e; };
struct Gemm { const bf16_t* A; const bf16_t* Bt; int M, N, K; };

struct StaticOrder {
    int nM, nN, nwg, G, c;
    __host__ __device__ void init(int M, int N, int G_, int c_) { nM = M / BM; nN = N / BM; nwg = nM * nN; G = G_; c = c_; }
    __host__ __device__ bool next(int i, Unit& u) const {
        const long L = (long)i * G + c; if (L >= nwg) return false;
        int wgid = (int)L; { const int q = nwg / NXCD, r = nwg % NXCD, xcd = wgid % NXCD, off = wgid / NXCD; wgid = (xcd < r ? xcd * (q + 1) : r * (q + 1) + (xcd - r) * q) + off; }
        const int nig = WGM * nN, gid = wgid / nig, fm = gid * WGM, gsz = (nM - fm) < WGM ? (nM - fm) : WGM;
        u.pm = fm + ((wgid % nig) % gsz); u.pn = (wgid % nig) / gsz; u.pb = u.pn; u.e = 0; return true;
    }
    __device__ __forceinline__ void a_ready(const Unit&) const {}
    __device__ __forceinline__ void done(const Unit&) const {}
};

template <class Epi, class Sched, bool ALIGN_EPI = false, bool SP2 = false>
__device__ __forceinline__ void gemm_phase(PG8_LAS unsigned char* lds, const Gemm g, const Sched& S, const Epi& E) {
    const int tid = threadIdx.x, wid = __builtin_amdgcn_readfirstlane(tid >> 6), lane = tid & 63, wr = wid >> 2, wc = wid & 3, fr = lane & 15, fq = lane >> 4;
    const int K = g.K, nt = K / BK;
    unsigned voffA[2], voffB[2];
#pragma unroll
    for (int i = 0; i < 2; ++i) { int R, C; stage_rc(tid * 16 + i * 8192, R, C); const int Rb = Epi::PERM ? ((R & ~31) + perm32(R & 31)) : R;
        voffA[i] = (unsigned)(R * K + C) * 2u; voffB[i] = (unsigned)(Rb * K + C) * 2u; }
    const size_t kstep = (size_t)(BK * 2);
    const size_t hstep = (size_t)HALF * K * 2;
    const size_t tstep = 2 * hstep;
    const unsigned ldsw = (unsigned)wid * 1024u;
    const int aoff = lds_byte(wr * 64 + fr, fq * 8), boff = lds_byte(wc * 32 + fr, fq * 8);
#define PG8_SA(b, h) (((b) * 2 + (h)) * HTB)
#define PG8_SB(b, h) ((4 + (b) * 2 + (h)) * HTB)
#define PG8_STAGE(bufoff, gbase, voff) do { _Pragma("unroll") for (int _i = 0; _i < 2; ++_i) \
        __builtin_amdgcn_global_load_lds((const unsigned*)((const char*)(gbase) + (voff)[_i]), (PG8_LAS unsigned*)(lds + (bufoff) + ldsw + _i * 8192), 16, 0, 0); } while (0)
#define PG8_LDA(dst, b, h) do { _Pragma("unroll") for (int m = 0; m < 4; ++m) _Pragma("unroll") for (int k = 0; k < 2; ++k) dst[m][k] = *(const PG8_LAS bf16x8*)(lds + PG8_SA(b, h) + aoff + m * 2048 + k * 1024); } while (0)
#define PG8_LDB(dst, b, h) do { _Pragma("unroll") for (int n = 0; n < 2; ++n) _Pragma("unroll") for (int k = 0; k < 2; ++k) dst[n][k] = *(const PG8_LAS bf16x8*)(lds + PG8_SB(b, h) + boff + n * 2048 + k * 1024); } while (0)
#define PG8_MMA(ai, bj, At, Bt) do { __builtin_amdgcn_s_setprio(1); _Pragma("unroll") for (int m = 0; m < 4; ++m) _Pragma("unroll") for (int n = 0; n < 2; ++n) _Pragma("unroll") for (int k = 0; k < 2; ++k) \
        acc[ai][bj][m][n] = __builtin_amdgcn_mfma_f32_16x16x32_bf16(Bt[n][k], At[m][k], acc[ai][bj][m][n], 0, 0, 0); __builtin_amdgcn_s_setprio(0); } while (0)
#define PG8_WAIT_V(n) asm volatile("s_waitcnt vmcnt(" #n ")" ::: "memory")
#define PG8_WAIT_L(n) asm volatile("s_waitcnt lgkmcnt(" #n ")" ::: "memory")
#define PG8_BAR __builtin_amdgcn_s_barrier()
#define PG8_SCHED __builtin_amdgcn_sched_barrier(0)
    Unit cur, nxt; int ui = 0;
    if (!S.next(0, cur)) return;
    f32x4 acc[2][2][4][2];
#pragma unroll
    for (int a = 0; a < 2; ++a)
#pragma unroll
        for (int b = 0; b < 2; ++b)
#pragma unroll
            for (int m = 0; m < 4; ++m)
#pragma unroll
                for (int n = 0; n < 2; ++n) acc[a][b][m][n] = (f32x4){0.f, 0.f, 0.f, 0.f};
    bf16x8 At[4][2], B0[2][2], B1[2][2];
    const char* cA = (const char*)g.A + (size_t)cur.pm * tstep; const char* cB = (const char*)g.Bt + (size_t)cur.pb * tstep;
    S.a_ready(cur);
    if constexpr (SP2) {
        PG8_STAGE(PG8_SB(0, 0), cB, voffB); PG8_STAGE(PG8_SB(0, 1), cB + hstep, voffB); PG8_STAGE(PG8_SA(0, 0), cA, voffA); PG8_STAGE(PG8_SA(0, 1), cA + hstep, voffA);
        if (wr == 1) PG8_BAR;
        PG8_WAIT_V(2); PG8_BAR;
        PG8_STAGE(PG8_SB(1, 0), cB + kstep, voffB); PG8_STAGE(PG8_SA(1, 0), cA + kstep, voffA); PG8_STAGE(PG8_SB(1, 1), cB + hstep + kstep, voffB);
        PG8_WAIT_V(6); PG8_BAR;
    } else {
        PG8_STAGE(PG8_SB(0, 0), cB, voffB); PG8_STAGE(PG8_SA(0, 0), cA, voffA); PG8_STAGE(PG8_SB(0, 1), cB + hstep, voffB); PG8_STAGE(PG8_SA(0, 1), cA + hstep, voffA);
        if (wr == 1) PG8_BAR;
        PG8_WAIT_V(4); PG8_BAR;
        PG8_STAGE(PG8_SB(1, 0), cB + kstep, voffB); PG8_STAGE(PG8_SA(1, 0), cA + kstep, voffA); PG8_STAGE(PG8_SB(1, 1), cB + hstep + kstep, voffB);
        PG8_WAIT_V(6); PG8_BAR;
    }
    for (;;) {
        const bool has_next = S.next(ui + 1, nxt);
        const char* nA = has_next ? (const char*)g.A + (size_t)nxt.pm * tstep : cA; const char* nB = has_next ? (const char*)g.Bt + (size_t)nxt.pb * tstep : cB;
        for (int t = 0; t < nt; t += 2) {
            const bool last = (t == nt - 2);
            const char* a1 = cA + (size_t)(t + 1) * kstep;
            const char* a2 = last ? nA : cA + (size_t)(t + 2) * kstep; const char* b2 = last ? nB : cB + (size_t)(t + 2) * kstep;
            const char* a3 = a2 + kstep; const char* b3 = b2 + kstep;
            if (last && has_next) S.a_ready(nxt);
            if constexpr (SP2) {
            PG8_LDB(B0, 0, 0); PG8_LDB(B1, 0, 1); PG8_SCHED; PG8_LDA(At, 0, 0); PG8_STAGE(PG8_SA(1, 1), a1 + hstep, voffA);
            PG8_WAIT_V(8); PG8_WAIT_L(0); PG8_BAR; PG8_MMA(0, 0, At, B0); PG8_MMA(0, 1, At, B1); PG8_BAR; PG8_SCHED;
            PG8_LDA(At, 0, 1); PG8_STAGE(PG8_SB(0, 0), b2, voffB); PG8_STAGE(PG8_SB(0, 1), b2 + hstep, voffB); PG8_STAGE(PG8_SA(0, 0), a2, voffA);
            PG8_WAIT_V(8); PG8_WAIT_L(0); PG8_BAR; PG8_MMA(1, 0, At, B0); PG8_MMA(1, 1, At, B1); PG8_BAR; PG8_SCHED;
            PG8_LDB(B0, 1, 0); PG8_LDB(B1, 1, 1); PG8_SCHED; PG8_LDA(At, 1, 0); PG8_STAGE(PG8_SA(0, 1), a2 + hstep, voffA);
            PG8_WAIT_V(8); PG8_WAIT_L(0); PG8_BAR; PG8_MMA(0, 0, At, B0); PG8_MMA(0, 1, At, B1); PG8_BAR; PG8_SCHED;
            PG8_LDA(At, 1, 1); PG8_STAGE(PG8_SB(1, 0), b3, voffB); PG8_STAGE(PG8_SB(1, 1), b3 + hstep, voffB); PG8_STAGE(PG8_SA(1, 0), a3, voffA);
            PG8_WAIT_V(8); PG8_WAIT_L(0); PG8_BAR; PG8_MMA(1, 0, At, B0); PG8_MMA(1, 1, At, B1); PG8_BAR; PG8_SCHED;
            } else {
            PG8_LDB(B0, 0, 0); PG8_SCHED; PG8_LDA(At, 0, 0); PG8_STAGE(PG8_SA(1, 1), a1 + hstep, voffA);
            PG8_WAIT_L(8); PG8_BAR; PG8_WAIT_L(0); PG8_MMA(0, 0, At, B0); PG8_BAR; PG8_SCHED;
            PG8_LDB(B1, 0, 1); PG8_STAGE(PG8_SB(0, 0), b2, voffB);
            PG8_BAR; PG8_WAIT_L(0); PG8_MMA(0, 1, At, B1); PG8_BAR;
            PG8_LDA(At, 0, 1); PG8_STAGE(PG8_SA(0, 0), a2, voffA);
            PG8_BAR; PG8_WAIT_L(0); PG8_MMA(1, 0, At, B0); PG8_BAR; PG8_SCHED;
            PG8_STAGE(PG8_SB(0, 1), b2 + hstep, voffB);
            PG8_WAIT_V(6); PG8_BAR; PG8_MMA(1, 1, At, B1); PG8_BAR;
            PG8_LDB(B0, 1, 0); PG8_SCHED; PG8_LDA(At, 1, 0); PG8_STAGE(PG8_SA(0, 1), a2 + hstep, voffA);
            PG8_WAIT_L(8); PG8_BAR; PG8_WAIT_L(0); PG8_MMA(0, 0, At, B0); PG8_BAR; PG8_SCHED;
            PG8_LDB(B1, 1, 1); PG8_STAGE(PG8_SB(1, 0), b3, voffB);
            PG8_BAR; PG8_WAIT_L(0); PG8_MMA(0, 1, At, B1); PG8_BAR;
            PG8_LDA(At, 1, 1); PG8_STAGE(PG8_SA(1, 0), a3, voffA);
            PG8_BAR; PG8_WAIT_L(0); PG8_MMA(1, 0, At, B0); PG8_BAR; PG8_SCHED;
            PG8_STAGE(PG8_SB(1, 1), b3 + hstep, voffB);
            PG8_WAIT_V(6); PG8_BAR; PG8_MMA(1, 1, At, B1); PG8_BAR;
            }
        }
        if constexpr (ALIGN_EPI) { if (wr == 0) PG8_BAR; }
        if constexpr (!Epi::AFTER_DRAIN) { E(acc, cur, wr, wc, fr, fq); S.done(cur); }
        if (!has_next) break;
#pragma unroll
        for (int a = 0; a < 2; ++a)
#pragma unroll
            for (int b = 0; b < 2; ++b)
#pragma unroll
                for (int m = 0; m < 4; ++m)
#pragma unroll
                    for (int n = 0; n < 2; ++n) acc[a][b][m][n] = (f32x4){0.f, 0.f, 0.f, 0.f};
        cur = nxt; cA = nA; cB = nB; ++ui;
        if constexpr (ALIGN_EPI) { if (wr == 1) PG8_BAR; }
    }
    PG8_WAIT_V(0);
    if constexpr (!ALIGN_EPI) { if (wr == 0) PG8_BAR; }
    PG8_BAR;
    if constexpr (Epi::AFTER_DRAIN) { E.fused(acc, cur, wr, wc, fr, fq, lds, wid, lane); S.done(cur); }
#undef PG8_SA
#undef PG8_SB
#undef PG8_STAGE
#undef PG8_LDA
#undef PG8_LDB
#undef PG8_MMA
#undef PG8_WAIT_V
#undef PG8_WAIT_L
#undef PG8_BAR
#undef PG8_SCHED
}

__device__ __forceinline__ unsigned cvt_pk_bf16(float lo, float hi) { unsigned r; asm volatile("v_cvt_pk_bf16_f32 %0, %1, %2" : "=v"(r) : "v"(lo), "v"(hi)); return r; }
struct EpiBf16 {
    static constexpr bool PERM = true, AFTER_DRAIN = false;
    bf16_t* O; int ldc; unsigned smask; float s;
    __device__ __forceinline__ void operator()(const f32x4 (&acc)[2][2][4][2], const Unit& u, int wr, int wc, int fr, int fq) const {
        const int row0 = u.pm * BM + wr * 64 + fr, col0 = u.pn * BM + wc * 32 + 8 * fq; const float sc = ((smask >> u.pn) & 1u) ? s : 1.f;
#pragma unroll
        for (int ai = 0; ai < 2; ++ai)
#pragma unroll
            for (int m = 0; m < 4; ++m) { bf16_t* rowp = O + (size_t)(row0 + ai * HALF + m * 16) * ldc + col0;
#pragma unroll
                for (int bj = 0; bj < 2; ++bj) { const f32x4 v0 = acc[ai][bj][m][0] * sc, v1 = acc[ai][bj][m][1] * sc;
                    u32x4 w; w.x = cvt_pk_bf16(v0[0], v0[1]); w.y = cvt_pk_bf16(v0[2], v0[3]); w.z = cvt_pk_bf16(v1[0], v1[1]); w.w = cvt_pk_bf16(v1[2], v1[3]);
                    *(u32x4*)(rowp + bj * HALF) = w; } }
    }
};
struct EpiResF32 {
    static constexpr bool PERM = false, AFTER_DRAIN = false;
    const float* base; float* out; int ldc; float alpha;
    __device__ __forceinline__ void operator()(const f32x4 (&acc)[2][2][4][2], const Unit& u, int wr, int wc, int fr, int fq) const {
        const int col0 = u.pn * BM + wc * 32 + 4 * fq;
#pragma unroll
        for (int ai = 0; ai < 2; ++ai)
#pragma unroll
            for (int m = 0; m < 4; ++m) { const size_t off = (size_t)(u.pm * BM + ai * HALF + wr * 64 + m * 16 + fr) * ldc + col0;
#pragma unroll
                for (int bj = 0; bj < 2; ++bj)
#pragma unroll
                    for (int n = 0; n < 2; ++n) { const f32x4 bs = *(const f32x4*)(base + off + bj * HALF + n * 16); *(f32x4*)(out + off + bj * HALF + n * 16) = bs * alpha + acc[ai][bj][m][n]; }
                if (m & 1) asm volatile("" ::: "memory"); }
    }
};
struct EpiGateUp {
    static constexpr bool PERM = true, AFTER_DRAIN = false;
    bf16_t* O; const float* bias;
    __device__ __forceinline__ void operator()(const f32x4 (&acc)[2][2][4][2], const Unit& u, int wr, int wc, int fr, int fq) const {
        const int row0 = u.pm * BM + wr * 64 + fr, f0 = u.pn * 128 + wc * 32 + 8 * fq;
        const float* bp = bias + (size_t)u.e * 2048 + 2 * f0;
        const f32x4 b0 = *(const f32x4*)(bp), b1 = *(const f32x4*)(bp + 4), b2 = *(const f32x4*)(bp + 8), b3 = *(const f32x4*)(bp + 12);
        const float bg[8] = {b0[0], b0[2], b1[0], b1[2], b2[0], b2[2], b3[0], b3[2]}, bl[8] = {b0[1], b0[3], b1[1], b1[3], b2[1], b2[3], b3[1], b3[3]};
#pragma unroll
        for (int ai = 0; ai < 2; ++ai)
#pragma unroll
            for (int m = 0; m < 4; ++m) { float a[8];
#pragma unroll
                for (int n = 0; n < 2; ++n)
#pragma unroll
                    for (int q = 0; q < 4; ++q) { const float g = fminf(acc[ai][0][m][n][q] + bg[4 * n + q], 7.f), l = fminf(fmaxf(acc[ai][1][m][n][q] + bl[4 * n + q], -7.f), 7.f);
                        a[4 * n + q] = g * __builtin_amdgcn_rcpf(1.f + __builtin_amdgcn_exp2f(-1.702f * 1.4426950408889634f * g)) * (l + 1.f); }
                u32x4 w; w.x = cvt_pk_bf16(a[0], a[1]); w.y = cvt_pk_bf16(a[2], a[3]); w.z = cvt_pk_bf16(a[4], a[5]); w.w = cvt_pk_bf16(a[6], a[7]);
                *(u32x4*)(O + (size_t)(row0 + ai * HALF + m * 16) * 1024 + f0) = w; }
    }
};
struct EpiDown {
    static constexpr bool PERM = true, AFTER_DRAIN = false;
    bf16_t* Y; const float* bias; const int* rowslot; const float* rowgate; const int* blkv;
    __device__ __forceinline__ void operator()(const f32x4 (&acc)[2][2][4][2], const Unit& u, int wr, int wc, int fr, int fq) const {
        const int col0 = u.pn * BM + wc * 32 + 8 * fq, nv = blkv[u.pm];
        const float* bp = bias + (size_t)u.e * 1024 + col0;
        f32x4 bv[2][2];
#pragma unroll
        for (int bj = 0; bj < 2; ++bj)
#pragma unroll
            for (int n = 0; n < 2; ++n) bv[bj][n] = *(const f32x4*)(bp + bj * HALF + 4 * n);
#pragma unroll
        for (int ai = 0; ai < 2; ++ai)
#pragma unroll
            for (int m = 0; m < 4; ++m) { const int r = ai * HALF + wr * 64 + m * 16 + fr;
                if (r < nv) { const int slot = rowslot[u.pm * BM + r]; const float g = rowgate[u.pm * BM + r]; bf16_t* rowp = Y + (size_t)slot * 1024 + col0;
#pragma unroll
                    for (int bj = 0; bj < 2; ++bj) { const f32x4 v0 = (acc[ai][bj][m][0] + bv[bj][0]) * g, v1 = (acc[ai][bj][m][1] + bv[bj][1]) * g;
                        u32x4 w; w.x = cvt_pk_bf16(v0[0], v0[1]); w.y = cvt_pk_bf16(v0[2], v0[3]); w.z = cvt_pk_bf16(v1[0], v1[1]); w.w = cvt_pk_bf16(v1[2], v1[3]);
                        *(u32x4*)(rowp + bj * HALF) = w; } } }
    }
};
struct MoeOrder {
    const int* blke; int nunits, npn, gpx, c;
    __device__ __forceinline__ bool next(int i, Unit& u) const {
        const int L = (i * 8 + (c & 7)) * gpx + (c >> 3); if (L >= nunits) return false;
        const int blk = L / npn; u.pm = blk; u.pn = L - blk * npn; u.e = __builtin_amdgcn_readfirstlane(blke[blk]); u.pb = u.e * npn + u.pn; return true;
    }
    __device__ __forceinline__ void a_ready(const Unit&) const {}
    __device__ __forceinline__ void done(const Unit&) const {}
};
}

namespace attn_body {
typedef unsigned short abf;
using bf16x8=__attribute__((ext_vector_type(8)))short;
using s16x4=__attribute__((ext_vector_type(4)))short;
using f32x16=__attribute__((ext_vector_type(16)))float;
using u32x4=__attribute__((ext_vector_type(4)))unsigned;
constexpr int NW=8,QBLK=32,QB=QBLK*NW,KVBLK=64;
__device__ __forceinline__ int crow(int r,int hi){return (r&3)+8*(r>>2)+4*hi;}
#define SBAR() __builtin_amdgcn_sched_barrier(0)
constexpr int NSLOT=3, SLOTB=8192;
constexpr int LDS_K=0, LDS_V=NSLOT*SLOTB, LDS_WS=2*NSLOT*SLOTB, LDS_OST=LDS_WS+NW*64*4, LDS_BYTES=LDS_OST+NW*4096;
__device__ __forceinline__ void glds16(const void*gsrc,unsigned lds_dst){unsigned keep;
  asm volatile("s_mov_b32 %0, m0\n\ts_mov_b32 m0, %2\n\ts_nop 0\n\tglobal_load_lds_dwordx4 %1, off\n\ts_mov_b32 m0, %0":"=&s"(keep):"v"(gsrc),"s"(lds_dst):"memory");}
__device__ __forceinline__ float max3f(float a,float b,float c){float r;asm("v_max3_f32 %0, %1, %2, %3":"=v"(r):"v"(a),"v"(b),"v"(c));return r;}
__device__ __forceinline__ float max2f(float a,float b){float r;asm("v_max_f32_e32 %0, %1, %2":"=v"(r):"v"(a),"v"(b));return r;}
__device__ __forceinline__ float fadd_s(float a,float b){float r;asm("v_add_f32_e32 %0, %1, %2":"=v"(r):"v"(a),"v"(b));return r;}
__device__ __forceinline__ float fsub_s(float a,float b){float r;asm("v_sub_f32_e32 %0, %1, %2":"=v"(r):"v"(a),"v"(b));return r;}
typedef float f32x2_t __attribute__((ext_vector_type(2))); typedef __bf16 bf16x2_t __attribute__((ext_vector_type(2)));
__device__ __forceinline__ unsigned cvtpk_s(float lo,float hi){f32x2_t v={lo,hi};bf16x2_t b=__builtin_convertvector(v,bf16x2_t);return __builtin_bit_cast(unsigned,b);}
#define WAIT_BAR(N) asm volatile("s_waitcnt vmcnt(" #N ") lgkmcnt(0)\n\ts_barrier":::"memory")
__device__ __forceinline__ void qkt(f32x16&p0,f32x16&p1,const char*Kslot,const bf16x8*qr,const f32x16&c0,const f32x16&c1,int r32,int hi){
  const char*kb=Kslot+hi*1024+r32*16;
  #pragma unroll
  for(int d0=0;d0<4;++d0){
    const bf16x8 b0=*reinterpret_cast<const bf16x8*>(kb+d0*2048);
    const bf16x8 b1=*reinterpret_cast<const bf16x8*>(kb+d0*2048+512);
    if(d0==0){p0=__builtin_amdgcn_mfma_f32_32x32x16_bf16(b0,qr[0],c0,0,0,0);p1=__builtin_amdgcn_mfma_f32_32x32x16_bf16(b1,qr[0],c1,0,0,0);}
    else{p0=__builtin_amdgcn_mfma_f32_32x32x16_bf16(b0,qr[d0],p0,0,0,0);p1=__builtin_amdgcn_mfma_f32_32x32x16_bf16(b1,qr[d0],p1,0,0,0);}}
}
typedef __attribute__((address_space(3))) const char* lds_cptr;
typedef short v4i16_t __attribute__((ext_vector_type(4)));
__device__ __forceinline__ void kload8(bf16x8*kf,lds_cptr kp){
  kf[0]=*(const __attribute__((address_space(3))) bf16x8*)(kp);      kf[1]=*(const __attribute__((address_space(3))) bf16x8*)(kp+512);
  kf[2]=*(const __attribute__((address_space(3))) bf16x8*)(kp+2048); kf[3]=*(const __attribute__((address_space(3))) bf16x8*)(kp+2560);
  kf[4]=*(const __attribute__((address_space(3))) bf16x8*)(kp+4096); kf[5]=*(const __attribute__((address_space(3))) bf16x8*)(kp+4608);
  kf[6]=*(const __attribute__((address_space(3))) bf16x8*)(kp+6144); kf[7]=*(const __attribute__((address_space(3))) bf16x8*)(kp+6656);
}
__device__ __forceinline__ void kload2(bf16x8*kf,lds_cptr kp,int j){ kf[2*j]=*(const __attribute__((address_space(3))) bf16x8*)(kp+j*2048); kf[2*j+1]=*(const __attribute__((address_space(3))) bf16x8*)(kp+j*2048+512); }
__device__ __forceinline__ s16x4 vtr(lds_cptr p){ return __builtin_bit_cast(s16x4,__builtin_amdgcn_ds_read_tr16_b64_v4i16((__attribute__((address_space(3))) v4i16_t*)p)); }
__device__ __forceinline__ float rowmax(const f32x16&p0,const f32x16&p1){
  float a=max3f(p0[0],p0[1],p1[0]),b=max3f(p0[2],p0[3],p1[1]);a=max3f(a,p1[2],p1[3]);
  #pragma unroll
  for(int r=4;r<16;r+=4){a=max3f(a,p0[r],p0[r+1]);b=max3f(b,p0[r+2],p0[r+3]);a=max3f(a,p1[r],p1[r+1]);b=max3f(b,p1[r+2],p1[r+3]);}
  const float m=max2f(a,b);
  auto rr=__builtin_amdgcn_permlane32_swap(__float_as_uint(m),__float_as_uint(m),false,false);
  return max2f(__uint_as_float(rr[0]),__uint_as_float(rr[1]));
}
__device__ __forceinline__ void pv(f32x16*o,int vb,bf16x8 pa0,bf16x8 pa1,bf16x8 pa2,bf16x8 pa3){
  #pragma unroll
  for(int d0=0;d0<2;++d0){s16x4 lo[4],hi[4];
    #pragma unroll
    for(int ks=0;ks<4;++ks){
      asm volatile("ds_read_b64_tr_b16 %0,%1 offset:%c2":"=&v"(lo[ks]):"v"(vb),"i"(d0*4096+ks*1024):"memory");
      asm volatile("ds_read_b64_tr_b16 %0,%1 offset:%c2":"=&v"(hi[ks]):"v"(vb),"i"(d0*4096+ks*1024+512):"memory");}
    asm volatile("s_waitcnt lgkmcnt(0)":::"memory");SBAR();
    #define PK(k) (bf16x8){lo[k][0],lo[k][1],lo[k][2],lo[k][3],hi[k][0],hi[k][1],hi[k][2],hi[k][3]}
    o[d0]=__builtin_amdgcn_mfma_f32_32x32x16_bf16(pa0,PK(0),o[d0],0,0,0);
    o[d0]=__builtin_amdgcn_mfma_f32_32x32x16_bf16(pa1,PK(1),o[d0],0,0,0);
    o[d0]=__builtin_amdgcn_mfma_f32_32x32x16_bf16(pa2,PK(2),o[d0],0,0,0);
    o[d0]=__builtin_amdgcn_mfma_f32_32x32x16_bf16(pa3,PK(3),o[d0],0,0,0);
    #undef PK
  }
}
#ifndef ATTN_STORE16
#define ATTN_STORE16(p,v) (*(u32x4*)(p)=(v))
#endif
template<int THRL> __device__ __forceinline__ void attn_unit(const abf*Qw0,int QP,const abf*Kh,int KP,const abf*Vh,int VP,abf*Ow0,int OP,int NT,float c2,int q0,char*shm){
  const int tid=threadIdx.x,lane=tid&63,r32=lane&31,hi=lane>>5; const int wid=__builtin_amdgcn_readfirstlane(tid>>6);
  const abf*Qw=Qw0+(long)(wid*QBLK)*QP;
  const unsigned lds0=(unsigned)(uintptr_t)shm;
  float*wsf=(float*)(shm+LDS_WS)+wid*64;
  const abf*ksrc=Kh+(long)lane*KP+wid*8;
  const abf*vsrc=Vh+(long)(16*(wid&3)+(lane>>2))*VP+(wid>>2)*32+(lane&3)*8;
  const unsigned kdst=lds0+LDS_K+wid*1024, vdst=lds0+LDS_V+wid*1024;
  #define DMA_K(t,slot) glds16(ksrc+(long)(t)*KVBLK*KP,(unsigned)__builtin_amdgcn_readfirstlane(kdst+(slot)))
  #define DMA_V(t,slot) glds16(vsrc+(long)(t)*KVBLK*VP,(unsigned)__builtin_amdgcn_readfirstlane(vdst+(slot)))
  const int vb0=(int)(lds0+LDS_V)+((lane>>4)&1)*32+(lane&3)*8+(4*hi+((lane&15)>>2))*64;
  const char*Kbase=shm+LDS_K; bf16x8 kf[8];
  const lds_cptr shm3=(lds_cptr)shm; const lds_cptr kp0=shm3+LDS_K+hi*1024+r32*16; const lds_cptr vp0=shm3+LDS_V+((lane>>4)&1)*32+(lane&3)*8+(4*hi+((lane&15)>>2))*64;
  DMA_K(0,0);DMA_V(0,0);DMA_K(1,SLOTB);
  bf16x8 qr[4];
  #pragma unroll
  for(int d0=0;d0<4;++d0)qr[d0]=*reinterpret_cast<const bf16x8*>(&Qw[(long)r32*QP+d0*16+hi*8]);
  float mhat=0.f,l_reg=0.f;f32x16 o[2];o[0]=f32x16{};o[1]=f32x16{};
  const int tdiag=__builtin_amdgcn_readfirstlane((q0+wid*QBLK)>>6);
  const float qrel4=(float)(q0+wid*QBLK+r32-4*hi);
  #define CINIT(C0,C1,t) do{ const int tt_=(t); const float dq_=qrel4-64.f*(float)tt_; \
    if(tt_!=tdiag){ const float sc_=tt_<tdiag?c2:-c2; const float b0_=-mhat-sc_*dq_, b1_=b0_+32.f*sc_; \
      _Pragma("unroll") for(int r=0;r<16;++r){ const float cr_=(float)((r&3)+8*(r>>2)); C0[r]=sc_*cr_+b0_; C1[r]=sc_*cr_+b1_; } } \
    else { _Pragma("unroll") for(int r=0;r<16;++r){ const float cr_=(float)((r&3)+8*(r>>2)); C0[r]=-mhat-c2*__builtin_fabsf(dq_-cr_); C1[r]=-mhat-c2*__builtin_fabsf(dq_-cr_-32.f); } } }while(0)
  bool resc=false;
  #define START(P0,P1) do{ const float rm=rowmax(P0,P1); resc=false; \
    { const float dl=rm; mhat=fadd_s(mhat,dl); \
      _Pragma("unroll") for(int r=0;r<16;++r){P0[r]=fsub_s(P0[r],dl);P1[r]=fsub_s(P1[r],dl);} } \
    _Pragma("unroll") for(int r=0;r<16;++r)P0[r]=__builtin_amdgcn_exp2f(P0[r]); }while(0)
  #define RESC() do{ if(resc){ asm volatile("s_waitcnt lgkmcnt(0)":::"memory"); \
      _Pragma("unroll") for(int d_=0;d_<2;++d_) _Pragma("unroll") for(int r=0;r<16;++r)o[d_][r]*=wsf[crow(r,hi)]; } }while(0)
  f32x16 pA0,pA1,pB0,pB1;
  int sl_prev=0,sl_cur=0,sl_next=SLOTB;
  #define ROT() do{sl_prev=sl_cur;sl_cur=sl_next;sl_next=(sl_next==(NSLOT-1)*SLOTB)?0:sl_next+SLOTB;}while(0)
  DMA_K(2,2*SLOTB);
  WAIT_BAR(3);
  CINIT(pA0,pA1,0);
  qkt(pA0,pA1,Kbase,qr,pA0,pA1,r32,hi);asm volatile("s_nop 15\n\ts_nop 7":"+v"(pA0),"+v"(pA1));
  START(pA0,pA1);
  _Pragma("unroll") for(int r=0;r<16;++r)pA1[r]=__builtin_amdgcn_exp2f(pA1[r]);
  WAIT_BAR(0);
  DMA_K(3,0);DMA_V(1,SLOTB);
  ROT();
  kload8(kf,kp0+sl_cur);
  WAIT_BAR(2);
  s16x4 vlo[8],vhi[8]; u32x4 pw0,pw1,pw2,pw3;
  #define PKW(P,B) cvtpk_s(P[B],P[B+1])
  #define PAF(k) __builtin_bit_cast(bf16x8,pw##k)
  #define VFR(i) (bf16x8){vlo[i][0],vlo[i][1],vlo[i][2],vlo[i][3],vhi[i][0],vhi[i][1],vhi[i][2],vhi[i][3]}
  #define PIN(x) asm volatile("":"+v"(x))
  #define MX3(a,b,c) __builtin_fmaxf(__builtin_fmaxf((a),(b)),(c))
  #define GAPA(MF,A0,A1,A2,A3,W0,W1,PW) do{ MF; sacc+=A0; sacc+=A1; sacc+=A2; sacc+=A3; PIN(sacc); W0; W1; PIN(PW); SBAR(); }while(0)
  #define EX(v) __builtin_amdgcn_exp2f(v)
  #define GAPB(MF,X,B) do{ MF; X[B]=EX(X[B]); X[B+1]=EX(X[B+1]); X[B+2]=EX(X[B+2]); X[B+3]=EX(X[B+3]); PIN(X); SBAR(); }while(0)
  #define VRD(i) do{ vlo[i]=vtr(vp_+(((i)>>2)*4096+((i)&3)*1024)); vhi[i]=vtr(vp_+(((i)>>2)*4096+((i)&3)*1024+512)); }while(0)
  #define KRD(G,j) do{ if(G){ kload2(kf,kp0+sl_next,j); SBAR(); } }while(0)
  #define STEP(C0,C1,P0,P1,t,GK,GV,GL) do{ SBAR(); \
    CINIT(C0,C1,t); SBAR(); \
    const lds_cptr vp_=vp0+sl_prev; \
    VRD(0); SBAR(); float sacc=(P0[0]+P0[1]); \
    GAPA(C0=__builtin_amdgcn_mfma_f32_32x32x16_bf16(kf[0],qr[0],C0,0,0,0), P0[2],P0[3],P0[4],P0[5],     pw0[0]=PKW(P0,0), pw0[1]=PKW(P0,2), pw0); \
    VRD(4); SBAR(); GAPA(C1=__builtin_amdgcn_mfma_f32_32x32x16_bf16(kf[1],qr[0],C1,0,0,0), P0[6],P0[7],P0[8],P0[9],     pw0[2]=PKW(P0,4), pw0[3]=PKW(P0,6), pw0); \
    VRD(1); SBAR(); GAPA(C0=__builtin_amdgcn_mfma_f32_32x32x16_bf16(kf[2],qr[1],C0,0,0,0),   P0[10],P0[11],P0[12],P0[13], pw1[0]=PKW(P0,8), pw1[1]=PKW(P0,10), pw1); \
    VRD(5); SBAR(); GAPA(C1=__builtin_amdgcn_mfma_f32_32x32x16_bf16(kf[3],qr[1],C1,0,0,0),   P0[14],P0[15],P1[0],P1[1],   pw1[2]=PKW(P0,12),pw1[3]=PKW(P0,14), pw1); \
    VRD(2); SBAR(); GAPA(C0=__builtin_amdgcn_mfma_f32_32x32x16_bf16(kf[4],qr[2],C0,0,0,0),   P1[2],P1[3],P1[4],P1[5],     pw2[0]=PKW(P1,0), pw2[1]=PKW(P1,2), pw2); \
    VRD(6); SBAR(); GAPA(C1=__builtin_amdgcn_mfma_f32_32x32x16_bf16(kf[5],qr[2],C1,0,0,0),   P1[6],P1[7],P1[8],P1[9],     pw2[2]=PKW(P1,4), pw2[3]=PKW(P1,6), pw2); \
    VRD(3); SBAR(); GAPA(C0=__builtin_amdgcn_mfma_f32_32x32x16_bf16(kf[6],qr[3],C0,0,0,0),   P1[10],P1[11],P1[12],P1[13], pw3[0]=PKW(P1,8), pw3[1]=PKW(P1,10), pw3); \
    VRD(7); SBAR(); GAPA(C1=__builtin_amdgcn_mfma_f32_32x32x16_bf16(kf[7],qr[3],C1,0,0,0),   P1[14],P1[15],0.f,0.f,       pw3[2]=PKW(P1,12),pw3[3]=PKW(P1,14), pw3); \
    l_reg+=sacc; \
    if(GK){DMA_K((t)+3,sl_cur);} if(GV){DMA_V((t)+1,sl_next);} \
    { float a=MX3(C0[0],C0[1],C1[0]),b=MX3(C0[2],C0[3],C1[1]); a=MX3(a,C1[2],C1[3]); \
      _Pragma("unroll") for(int r=4;r<16;r+=4){a=MX3(a,C0[r],C0[r+1]);b=MX3(b,C0[r+2],C0[r+3]);a=MX3(a,C1[r],C1[r+1]);b=MX3(b,C1[r+2],C1[r+3]);} \
      float rm=__builtin_fmaxf(a,b); { auto rr=__builtin_amdgcn_permlane32_swap(__float_as_uint(rm),__float_as_uint(rm),false,false); rm=__builtin_fmaxf(__uint_as_float(rr[0]),__uint_as_float(rr[1])); } \
      resc=false; \
      if(__builtin_expect(__any(rm>(float)THRL),0)){ const float dl=__builtin_fmaxf(rm,0.f); mhat+=dl; \
        _Pragma("unroll") for(int r=0;r<16;++r){C0[r]-=dl;C1[r]-=dl;} \
        const float f=__builtin_amdgcn_exp2f(-dl); l_reg*=f; if(hi==0)wsf[r32]=f; resc=true; } } \
    SBAR(); \
    GAPB(o[0]=__builtin_amdgcn_mfma_f32_32x32x16_bf16(PAF(0),VFR(0),o[0],0,0,0), C0,0); \
    GAPB(o[1]=__builtin_amdgcn_mfma_f32_32x32x16_bf16(PAF(0),VFR(4),o[1],0,0,0), C0,4); \
    KRD(GL,0); GAPB(o[0]=__builtin_amdgcn_mfma_f32_32x32x16_bf16(PAF(1),VFR(1),o[0],0,0,0), C0,8); \
    KRD(GL,1); GAPB(o[1]=__builtin_amdgcn_mfma_f32_32x32x16_bf16(PAF(1),VFR(5),o[1],0,0,0), C0,12); \
    KRD(GL,2); GAPB(o[0]=__builtin_amdgcn_mfma_f32_32x32x16_bf16(PAF(2),VFR(2),o[0],0,0,0), C1,0); \
    KRD(GL,3); GAPB(o[1]=__builtin_amdgcn_mfma_f32_32x32x16_bf16(PAF(2),VFR(6),o[1],0,0,0), C1,4); \
    GAPB(o[0]=__builtin_amdgcn_mfma_f32_32x32x16_bf16(PAF(3),VFR(3),o[0],0,0,0), C1,8); \
    GAPB(o[1]=__builtin_amdgcn_mfma_f32_32x32x16_bf16(PAF(3),VFR(7),o[1],0,0,0), C1,12); \
    }while(0)
  int t=1;
  for(;t+5<NT;t+=2){
    STEP(pB0,pB1,pA0,pA1,t,true,true,true);     WAIT_BAR(2); RESC(); ROT();
    STEP(pA0,pA1,pB0,pB1,t+1,true,true,true);   WAIT_BAR(2); RESC(); ROT();
  }
  #define ENDW(tt) do{ if((tt)+3<NT){WAIT_BAR(2);} else if((tt)+2<NT){WAIT_BAR(1);} else {WAIT_BAR(0);} }while(0)
  for(;t+1<NT;t+=2){
    STEP(pB0,pB1,pA0,pA1,t,(t+3<NT),(t+1<NT),(t+1<NT));       ENDW(t);   RESC(); ROT();
    STEP(pA0,pA1,pB0,pB1,t+1,(t+4<NT),(t+2<NT),(t+2<NT));     ENDW(t+1); RESC(); ROT();
  }
  STEP(pB0,pB1,pA0,pA1,NT-1,false,false,false); RESC();
  { float sacc=pB0[0]+pB0[1]; _Pragma("unroll") for(int r=2;r<16;++r)sacc+=pB0[r]; _Pragma("unroll") for(int r=0;r<16;++r)sacc+=pB1[r]; l_reg+=sacc;
    pw0=(u32x4){PKW(pB0,0),PKW(pB0,2),PKW(pB0,4),PKW(pB0,6)};pw1=(u32x4){PKW(pB0,8),PKW(pB0,10),PKW(pB0,12),PKW(pB0,14)};pw2=(u32x4){PKW(pB1,0),PKW(pB1,2),PKW(pB1,4),PKW(pB1,6)};pw3=(u32x4){PKW(pB1,8),PKW(pB1,10),PKW(pB1,12),PKW(pB1,14)};
    SBAR(); pv(o,vb0+sl_cur,PAF(0),PAF(1),PAF(2),PAF(3)); }
  #undef PKW
  #undef PAF
  #undef VFR
  #undef PIN
  #undef MX3
  #undef GAPA
  #undef GAPB
  #undef EX
  #undef VRD
  #undef KRD
  #undef STEP
  #undef ENDW
  {auto rr=__builtin_amdgcn_permlane32_swap(__float_as_uint(l_reg),__float_as_uint(l_reg),false,false);l_reg=__uint_as_float(rr[0])+__uint_as_float(rr[1]);}
  if(hi==0)wsf[32+r32]=l_reg;asm volatile("s_waitcnt lgkmcnt(0)":::"memory");
  float rli[16];
  #pragma unroll
  for(int r=0;r<16;++r)rli[r]=__builtin_amdgcn_rcpf(wsf[32+crow(r,hi)]);
  abf*Ow=Ow0+(long)(wid*QBLK)*OP;
  { abf*stg=(abf*)(shm+LDS_OST)+wid*2048;
    #pragma unroll
    for(int r=0;r<16;++r){const int orow=crow(r,hi);
      #pragma unroll
      for(int d0=0;d0<2;++d0)stg[orow*64+d0*32+r32]=(abf)f2bf(o[d0][r]*rli[r]);}
    asm volatile("s_waitcnt lgkmcnt(0)":::"memory");
    #pragma unroll
    for(int i=0;i<4;++i){const int row=i*8+(lane>>3),ch=lane&7; const u32x4 v=*(const u32x4*)(stg+row*64+ch*8); ATTN_STORE16(Ow+(long)row*OP+ch*8,v);} }
  asm volatile("s_waitcnt lgkmcnt(0)\n\ts_barrier":::"memory");
  #undef DMA_K
  #undef DMA_V
  #undef CINIT
  #undef START
  #undef RESC
  #undef ROT
}
constexpr int ATTN_LDS_BYTES=LDS_BYTES;
#undef SBAR
#undef WAIT_BAR
}

struct Frame {
    LAS unsigned char* lds; char* ldsg;
    volatile LAS unsigned* MISC;
    gu32* ctl;
    int tid, lane, wave, vcu, G;
    const float* in[23]; float* out; unsigned char* ws;
};
#define WSP(T_, off) ((T_*)(F.ws + (off)))

template <int MODE>
__device__ __forceinline__ void p0_transpose_item(const float* W, int K, int N, bf16* WT, LAS float* scr, int item, int lane) {
    const int nblk = N / 32, kb = item / nblk, nb = item % nblk, k0 = 64 * kb, n0 = 32 * nb;
#pragma unroll 8
    for (int i = 0; i < 32; ++i) { const int kk = 2 * i + (lane >> 5); scr[kk * 33 + (lane & 31)] = W[(size_t)(k0 + kk) * N + n0 + (lane & 31)]; }
    asm volatile("s_waitcnt lgkmcnt(0)" ::: "memory");
    const int c = lane & 7;
#pragma unroll
    for (int j = 0; j < 4; ++j) { const int n = (lane >> 3) + 8 * j; const LAS float* s = scr + (8 * c) * 33 + n;
        v4u o; o.x = pk2(s[0 * 33], s[1 * 33]); o.y = pk2(s[2 * 33], s[3 * 33]); o.z = pk2(s[4 * 33], s[5 * 33]); o.w = pk2(s[6 * 33], s[7 * 33]);
        int col = n0 + n, drow = col;
        if (MODE == 1) { const int pn = col >> 8, w = col & 255; drow = 256 * pn + 128 * (w & 1) + (w >> 1); }
        *(GAS v4u*)(WT + (size_t)drow * K + k0 + 8 * c) = o; }
    asm volatile("s_waitcnt lgkmcnt(0)" ::: "memory");
}
__device__ __forceinline__ void row_to_bf16(const float* xrow, bf16* orow, int lane) {
    const GAS f32x4* xr = (const GAS f32x4*)xrow + lane;
    GAS v2u* o8 = (GAS v2u*)orow + lane;
#pragma unroll
    for (int j = 0; j < 4; ++j) { const f32x4 v = xr[64 * j]; v2u w; w.x = pk2(v.x, v.y); w.y = pk2(v.z, v.w); o8[64 * j] = w; }
}
__device__ __forceinline__ void p0_prologue(Frame& F) {
    LAS float* scr = (LAS float*)(F.lds + F.wave * 16384);
    const int gw = F.vcu * NWAVES + F.wave, NGW = F.G * NWAVES;
    constexpr int I_IN = 16 * (NIN / 32), I_KV = 16 * (512 / 32), I_O = 16 * (1024 / 32), I_GU = 16 * (2048 / 32), I_DN = 16 * (1024 / 32);
    constexpr int NITEMS = I_IN + I_KV + I_O + NE * I_GU + NE * I_DN;
    for (int it = gw; it < NITEMS; it += NGW) {
        int r = it;
        if (r < I_IN) { p0_transpose_item<0>(F.in[2], DM, NIN, WSP(bf16, WS_WIN), scr, r, F.lane); continue; } r -= I_IN;
        if (r < I_KV) { p0_transpose_item<0>(F.in[11], DM, 512, WSP(bf16, WS_WKV), scr, r, F.lane); continue; } r -= I_KV;
        if (r < I_O) { p0_transpose_item<0>(F.in[12], DM, DM, WSP(bf16, WS_WO), scr, r, F.lane); continue; } r -= I_O;
        if (r < NE * I_GU) { const int e = r / I_GU; p0_transpose_item<1>(F.in[17] + (size_t)e * DM * 2048, DM, 2048, WSP(bf16, WS_WGU) + (size_t)e * 2048 * DM, scr, r % I_GU, F.lane); continue; } r -= NE * I_GU;
        { const int e = r / I_DN; p0_transpose_item<0>(F.in[19] + (size_t)e * DM * DM, DM, DM, WSP(bf16, WS_WDN) + (size_t)e * DM * DM, scr, r % I_DN, F.lane); }
    }
    for (int m = gw; m < T; m += NGW) row_to_bf16(F.in[0] + (size_t)m * DM, WSP(bf16, WS_XB) + (size_t)m * DM, F.lane);
    for (int m = gw; m < NB * MEML; m += NGW) row_to_bf16(F.in[1] + (size_t)m * DM, WSP(bf16, WS_MEMB) + (size_t)m * DM, F.lane);
}

__device__ __forceinline__ void p1_inproj(Frame& F) {
    { pg8::Gemm g{WSP(bf16, WS_XB), WSP(bf16, WS_WIN), T, NIN, DM}; pg8::StaticOrder S; S.init(T, NIN, F.G, (int)blockIdx.x);
      pg8::EpiBf16 E{WSP(bf16, WS_U), NIN, (1u << 0) | (1u << 1) | (1u << 11), C2};
      pg8::gemm_phase<pg8::EpiBf16, pg8::StaticOrder, true, true>(F.lds, g, S, E); }
    { pg8::Gemm g{WSP(bf16, WS_MEMB), WSP(bf16, WS_WKV), NB * MEML, 512, DM}; pg8::StaticOrder S; S.init(NB * MEML, 512, F.G, (int)blockIdx.x);
      pg8::EpiBf16 E{WSP(bf16, WS_MKV), 512, 0u, 1.f};
      pg8::gemm_phase<pg8::EpiBf16, pg8::StaticOrder, true, true>(F.lds, g, S, E); }
}

__device__ __forceinline__ void p2_mix(Frame& F) {
    const int gw = F.vcu * NWAVES + F.wave, lane = F.lane;
    const bf16* U = WSP(bf16, WS_U);
    if (gw < 32) {
        const int b = gw >> 3, h = (gw >> 1) & 3, dir = gw & 1;
        const float* lbp = dir ? F.in[9] : F.in[8];
        const float a0 = lbp[h * 64 + lane], a1 = lbp[256 + h * 64 + lane];
        const float lb = 1.f / (1.f + __expf(a1 - a0));
        float S[64];
#pragma unroll
        for (int d = 0; d < 64; ++d) S[d] = 0.f;
        float* OH = WSP(float, WS_OH);
        for (int step = 0; step < SEQ; ++step) {
            const int t = dir ? SEQ - 1 - step : step; const size_t row = (size_t)b * SEQ + t;
            const bf16* ur = U + row * NIN;
            const float hq = bf2f(ur[U_HQ + h * 64 + lane]), hf = bf2f(ur[U_HF + dir * 256 + h * 64 + lane]), vi = bf2f(ur[U_HI + h * 64 + lane]);
            const float ql = hq * sigmoidf_(hq), fl = lb + (1.f - lb) * sigmoidf_(hf);
            float o = 0.f;
#pragma unroll
            for (int d = 0; d < 64; ++d) { const float fdd = __int_as_float(__builtin_amdgcn_readlane(__float_as_int(fl), d)), qd = __int_as_float(__builtin_amdgcn_readlane(__float_as_int(ql), d));
                S[d] = fdd * S[d] + (1.f - fdd) * vi; o += qd * S[d]; }
            OH[(row * 4 + h) * 128 + dir * 64 + lane] = o;
        }
    }
    __syncthreads();
    const bf16* MKV = WSP(bf16, WS_MKV);
    for (int u = F.vcu; u < 256; u += F.G) {
        const int b = u >> 6, h = (u >> 4) & 3, qb = u & 15; const size_t row0 = (size_t)b * SEQ + qb * 256;
#pragma unroll 1
        for (int j = 0; j < 5; ++j) {
            const bf16 *Qp, *Kp, *Vp; bf16* Op; int KP, VP, NT; float c2;
            if (j == 0) { Qp = U + row0 * NIN + U_MQ + h * 64; Kp = MKV + (size_t)b * MEML * 512 + h * 64; Vp = Kp + 256; Op = WSP(bf16, WS_CAT) + row0 * DM + 768 + h * 64; KP = 512; VP = 512; NT = MEML / 64; c2 = 0.f; }
            else { const int m = (j - 1) >> 1, vh = (j - 1) & 1; Qp = U + row0 * NIN + U_DQ + h * 128 + m * 64; Kp = U + (size_t)b * SEQ * NIN + U_DK + h * 128 + m * 64; Vp = U + (size_t)b * SEQ * NIN + U_DV + h * 128 + vh * 64;
                Op = WSP(bf16, WS_OD) + row0 * DM + h * 256 + m * 128 + vh * 64; KP = NIN; VP = NIN; NT = SEQ / 64; c2 = __builtin_ldexpf(LOG2E, -2 * (h + 1)); }
            attn_body::attn_unit<8>(Qp, NIN, Kp, KP, Vp, VP, Op, DM, NT, c2, qb * 256, F.ldsg);
        }
    }
}

__device__ __forceinline__ void p3_naive_combine(Frame& F) {
    const int gw = F.vcu * NWAVES + F.wave, NGW = F.G * NWAVES, lane = F.lane;
    const float sa = wave_sum(F.in[3][lane] * F.in[4][lane]), sb = wave_sum(F.in[5][lane] * F.in[6][lane]);
    const float lam = __expf(sa) - __expf(sb) + 0.2f;
    const bf16* OD = WSP(bf16, WS_OD); const float* OH = WSP(float, WS_OH); const bf16* U = WSP(bf16, WS_U); bf16* CAT = WSP(bf16, WS_CAT);
    const float dnw0 = F.in[7][lane], dnw1 = F.in[7][lane + 64];
    for (int row = gw; row < T; row += NGW) {
#pragma unroll
        for (int h = 0; h < 4; ++h) {
            const bf16* p0 = OD + (size_t)row * DM + h * 256; const bf16* p1 = p0 + 128;
            const float o0 = bf2f(p0[lane]) - lam * bf2f(p1[lane]), o1 = bf2f(p0[lane + 64]) - lam * bf2f(p1[lane + 64]);
            const float ss = wave_sum(o0 * o0 + o1 * o1), r = rsqrtf(ss * (1.f / 128.f) + EPS) * 0.8f;
            CAT[(size_t)row * DM + h * 128 + lane] = (bf16)f2bf(o0 * r * dnw0); CAT[(size_t)row * DM + h * 128 + 64 + lane] = (bf16)f2bf(o1 * r * dnw1);
        }
#pragma unroll
        for (int h = 0; h < 4; ++h) {
            const float* p = OH + ((size_t)row * 4 + h) * 128; const float o = p[lane] + p[64 + lane];
            const float ss = wave_sum(o * o), r = rsqrtf(ss * (1.f / 64.f) + EPS);
            const float g = sigmoidf_(bf2f(U[(size_t)row * NIN + U_HG + h * 64 + lane]));
            CAT[(size_t)row * DM + 512 + h * 64 + lane] = (bf16)f2bf(o * r * F.in[10][h * 64 + lane] * g);
        }
    }
}

__device__ __forceinline__ void p4_wo(Frame& F) {
    pg8::Gemm g{WSP(bf16, WS_CAT), WSP(bf16, WS_WO), T, DM, DM}; pg8::StaticOrder S; S.init(T, DM, F.G, (int)blockIdx.x);
    pg8::EpiResF32 E{F.in[0], WSP(float, WS_Z1), DM, ALPHA};
    pg8::gemm_phase<pg8::EpiResF32, pg8::StaticOrder, true, true>(F.lds, g, S, E);
}

__device__ __forceinline__ void ln_row(f32x4 (&v)[4], const float* g, const float* bb, int lane, float& mean, float& rstd) {
    float s = 0.f;
#pragma unroll
    for (int j = 0; j < 4; ++j) s += (v[j].x + v[j].y) + (v[j].z + v[j].w);
    mean = wave_sum(s) * (1.f / DM); float s2 = 0.f;
#pragma unroll
    for (int j = 0; j < 4; ++j) { v[j] = v[j] - mean; s2 += (v[j].x * v[j].x + v[j].y * v[j].y) + (v[j].z * v[j].z + v[j].w * v[j].w); }
    rstd = rsqrtf(wave_sum(s2) * (1.f / DM) + EPS);
#pragma unroll
    for (int j = 0; j < 4; ++j) { const f32x4 gv = *(const GAS f32x4*)(g + 4 * lane + 256 * j), bv = *(const GAS f32x4*)(bb + 4 * lane + 256 * j); v[j] = v[j] * rstd * gv + bv; }
}

__device__ __forceinline__ void p5_router(Frame& F) {
    LAS float* rw = (LAS float*)F.lds;
    for (int i = F.tid; i < DM * 8; i += NTHREADS) { const int col = i >> 3, e4 = i & 7; const int l = (col & 255) >> 2, q = 4 * (col >> 8) + (col & 3);
        const f32x4 w = *(const GAS f32x4*)(F.in[15] + (size_t)col * 32 + e4 * 4);
        *(LAS f32x4*)&rw[(q * 64 + l) * 32 + ((e4 ^ ((l >> 1) & 7)) * 4)] = w; }
    __syncthreads();
    const int gw = F.vcu * NWAVES + F.wave, NGW = F.G * NWAVES, lane = F.lane;
    int* TOPI = WSP(int, WS_ROUTE); float* TOPG = WSP(float, WS_ROUTE + 256 * 1024); int* RANK = WSP(int, WS_ROUTE + 512 * 1024); float* STATS = WSP(float, WS_ROUTE + 768 * 1024);
    const float rbias = F.in[16][lane >> 1];
    for (int row = gw; row < T; row += NGW) {
        f32x4 v[4];
#pragma unroll
        for (int j = 0; j < 4; ++j) v[j] = *(const GAS f32x4*)(WSP(float, WS_Z1) + (size_t)row * DM + 4 * lane + 256 * j);
        float mean, rstd; ln_row(v, F.in[13], F.in[14], lane, mean, rstd);
        if (lane == 0) { STATS[2 * row] = mean; STATS[2 * row + 1] = rstd; }
        float acc[32];
#pragma unroll
        for (int e = 0; e < 32; ++e) acc[e] = 0.f;
#pragma unroll
        for (int j = 0; j < 4; ++j)
#pragma unroll
            for (int c = 0; c < 4; ++c) { const float hv = v[j][c]; const int q = 4 * j + c;
#pragma unroll
                for (int e4 = 0; e4 < 8; ++e4) { const f32x4 w = *(const LAS f32x4*)&rw[(q * 64 + lane) * 32 + ((e4 ^ ((lane >> 1) & 7)) * 4)];
                    acc[4 * e4 + 0] += hv * w.x; acc[4 * e4 + 1] += hv * w.y; acc[4 * e4 + 2] += hv * w.z; acc[4 * e4 + 3] += hv * w.w; }
                asm volatile("" ::: "memory"); }
        float r16[16];
#pragma unroll
        for (int i = 0; i < 16; ++i) { const bool up = (lane & 32) != 0; const float keep = up ? acc[16 + i] : acc[i], send = up ? acc[i] : acc[16 + i]; r16[i] = keep + __shfl_xor(send, 32); }
        float r8[8];
#pragma unroll
        for (int i = 0; i < 8; ++i) { const bool up = (lane & 16) != 0; const float keep = up ? r16[8 + i] : r16[i], send = up ? r16[i] : r16[8 + i]; r8[i] = keep + __shfl_xor(send, 16); }
        float r4[4];
#pragma unroll
        for (int i = 0; i < 4; ++i) { const bool up = (lane & 8) != 0; const float keep = up ? r8[4 + i] : r8[i], send = up ? r8[i] : r8[4 + i]; r4[i] = keep + __shfl_xor(send, 8); }
        float r2[2];
#pragma unroll
        for (int i = 0; i < 2; ++i) { const bool up = (lane & 4) != 0; const float keep = up ? r4[2 + i] : r4[i], send = up ? r4[i] : r4[2 + i]; r2[i] = keep + __shfl_xor(send, 4); }
        float r1; { const bool up = (lane & 2) != 0; const float keep = up ? r2[1] : r2[0], send = up ? r2[0] : r2[1]; r1 = keep + __shfl_xor(send, 2); }
        float logit = r1 + __shfl_xor(r1, 1) + rbias;
        float tv[4]; int ti[4]; float cur = logit; const int myi = lane >> 1;
#pragma unroll
        for (int k = 0; k < 4; ++k) {
            float bv = cur; int bi = myi;
#pragma unroll
            for (int o = 1; o < 64; o <<= 1) { const float ov = __shfl_xor(bv, o); const int oi = __shfl_xor(bi, o); if (ov > bv || (ov == bv && oi < bi)) { bv = ov; bi = oi; } }
            tv[k] = bv; ti[k] = bi; if (myi == bi) cur = -INFINITY;
        }
        const float e1 = __expf(tv[1] - tv[0]), e2 = __expf(tv[2] - tv[0]), e3 = __expf(tv[3] - tv[0]); const float inv = 1.f / (1.f + e1 + e2 + e3);
        if (lane < 4) { const int e = lane == 0 ? ti[0] : lane == 1 ? ti[1] : lane == 2 ? ti[2] : ti[3]; const float g = (lane == 0 ? 1.f : lane == 1 ? e1 : lane == 2 ? e2 : e3) * inv;
            const unsigned rk = __hip_atomic_fetch_add((unsigned*)(F.ctl + CW_CNT + e), 1u, RLX_AGENT);
            TOPI[row * 4 + lane] = e; TOPG[row * 4 + lane] = g; RANK[row * 4 + lane] = (int)rk; }
    }
    __syncthreads();
}

__device__ __forceinline__ void p6_dispatch(Frame& F) {
    LAS int* pst = (LAS int*)F.lds;
    if (F.tid == 0) { int acc = 0; for (int e = 0; e < NE; ++e) { pst[e] = acc; const int c = (int)__hip_atomic_load((unsigned*)(F.ctl + CW_CNT + e), RLX_AGENT); acc += (c + 255) / 256 * 256; } pst[NE] = acc; }
    __syncthreads();
    int* ROWSLOT = WSP(int, WS_ROWS); float* ROWGATE = WSP(float, WS_ROWS + MAXROWS * 4); int* BLKE = WSP(int, WS_ROWS + 2 * MAXROWS * 4); int* BLKV = BLKE + 512; int* NBLK = BLKE + 1024;
    if (blockIdx.x == 0 && F.tid < NE) { const int e = F.tid, c = (int)__hip_atomic_load((unsigned*)(F.ctl + CW_CNT + e), RLX_AGENT); const int b0 = pst[e] / 256, nb = (pst[e + 1] - pst[e]) / 256;
        for (int i = 0; i < nb; ++i) { BLKE[b0 + i] = e; BLKV[b0 + i] = min(256, c - 256 * i); }
        if (e == 0) NBLK[0] = pst[NE] / 256; }
    const int gw = F.vcu * NWAVES + F.wave, NGW = F.G * NWAVES, lane = F.lane;
    const int* TOPI = WSP(int, WS_ROUTE); const float* TOPG = WSP(float, WS_ROUTE + 256 * 1024); const int* RANK = WSP(int, WS_ROUTE + 512 * 1024);
    for (int row = gw; row < T; row += NGW) {
        f32x4 v[4];
#pragma unroll
        for (int j = 0; j < 4; ++j) v[j] = *(const GAS f32x4*)(WSP(float, WS_Z1) + (size_t)row * DM + 4 * lane + 256 * j);
        float mean, rstd; ln_row(v, F.in[13], F.in[14], lane, mean, rstd);
        v2u w[4];
#pragma unroll
        for (int j = 0; j < 4; ++j) { w[j].x = pk2(v[j].x, v[j].y); w[j].y = pk2(v[j].z, v[j].w); }
#pragma unroll
        for (int k = 0; k < 4; ++k) { const int e = TOPI[row * 4 + k], dest = pst[e] + RANK[row * 4 + k];
            GAS v2u* o8 = (GAS v2u*)(WSP(bf16, WS_XS) + (size_t)dest * DM) + lane;
#pragma unroll
            for (int j = 0; j < 4; ++j) o8[64 * j] = w[j];
            if (lane == 0) { ROWSLOT[dest] = row * 4 + k; ROWGATE[dest] = TOPG[row * 4 + k]; } }
    }
    __syncthreads();
}

__device__ __forceinline__ void p7_gateup(Frame& F) {
    const int* BLKE = WSP(int, WS_ROWS + 2 * MAXROWS * 4); const int nblk = __builtin_amdgcn_readfirstlane(BLKE[1024]);
    pg8::Gemm g{WSP(bf16, WS_XS), WSP(bf16, WS_WGU), MAXROWS, 2048, DM}; pg8::MoeOrder S{BLKE, nblk * 8, 8, F.G / 8, (int)blockIdx.x};
    pg8::EpiGateUp E{WSP(bf16, WS_ACT), F.in[18]};
    pg8::gemm_phase<pg8::EpiGateUp, pg8::MoeOrder, true, true>(F.lds, g, S, E);
}

__device__ __forceinline__ void p8_down(Frame& F) {
    const int* BLKE = WSP(int, WS_ROWS + 2 * MAXROWS * 4); const int nblk = __builtin_amdgcn_readfirstlane(BLKE[1024]);
    pg8::Gemm g{WSP(bf16, WS_ACT), WSP(bf16, WS_WDN), MAXROWS, 1024, DM}; pg8::MoeOrder S{BLKE, nblk * 4, 4, F.G / 8, (int)blockIdx.x};
    pg8::EpiDown E{WSP(bf16, WS_Y), F.in[20], WSP(int, WS_ROWS), WSP(float, WS_ROWS + MAXROWS * 4), BLKE + 512};
    pg8::gemm_phase<pg8::EpiDown, pg8::MoeOrder, true, true>(F.lds, g, S, E);
}

__device__ __forceinline__ void p9_final(Frame& F) {
    const int gw = F.vcu * NWAVES + F.wave, NGW = F.G * NWAVES, lane = F.lane;
    for (int row = gw; row < T; row += NGW) {
        f32x4 v[4];
#pragma unroll
        for (int j = 0; j < 4; ++j) v[j] = *(const GAS f32x4*)(WSP(float, WS_Z1) + (size_t)row * DM + 4 * lane + 256 * j);
        float mean, rstd; ln_row(v, F.in[13], F.in[14], lane, mean, rstd);
#pragma unroll
        for (int j = 0; j < 4; ++j) v[j] = v[j] * ALPHA;
#pragma unroll
        for (int k = 0; k < 4; ++k) { const GAS v2u* y8 = (const GAS v2u*)(WSP(bf16, WS_Y) + (size_t)(row * 4 + k) * DM) + lane;
#pragma unroll
            for (int j = 0; j < 4; ++j) { const v2u w = y8[64 * j]; v[j].x += bflo(w.x); v[j].y += bfhi(w.x); v[j].z += bflo(w.y); v[j].w += bfhi(w.y); } }
        ln_row(v, F.in[21], F.in[22], lane, mean, rstd);
#pragma unroll
        for (int j = 0; j < 4; ++j) *(GAS f32x4*)(F.out + (size_t)row * DM + 4 * lane + 256 * j) = v[j];
    }
}

constexpr int NPHASE = 10;
struct Args { const float* in[23]; float* out; unsigned char* ws; int ph_lo, ph_hi; };
__global__ void __launch_bounds__(NTHREADS, 2) mega_fwd(Args args) {
    extern __shared__ __attribute__((aligned(16))) unsigned char lds[];
    Frame F;
    F.lds = (LAS unsigned char*)lds; F.ldsg = (char*)lds; F.MISC = (volatile LAS unsigned*)(F.lds + MISC_OFF);
    F.tid = threadIdx.x; F.lane = F.tid & 63; F.wave = __builtin_amdgcn_readfirstlane(F.tid >> 6);
    F.G = gridDim.x; { const int bx = blockIdx.x; F.vcu = (F.G % 8 == 0) ? (bx % 8) * (F.G / 8) + bx / 8 : bx; }
    F.ws = args.ws; F.ctl = (gu32*)(args.ws + WS_CTL); F.out = args.out;
#pragma unroll
    for (int i = 0; i < 23; ++i) F.in[i] = args.in[i];
    for (int u = F.tid; u < (LDS_BYTES - LDSCTL_OFF) / 4; u += NTHREADS) ((LAS unsigned*)(F.lds + LDSCTL_OFF))[u] = 0u;
    __syncthreads();
    const bool single = (args.ph_lo == 0 && args.ph_hi == NPHASE);
    XcdBarrier bar; bar.bar = (unsigned*)(F.ctl + CW_BAR); bar.x = 0; bar.st = nullptr;
    if (single) bar = xcd_barrier_post((unsigned*)(F.ctl + CW_BAR), F.MISC + 8);
    const int lo = args.ph_lo, hi = args.ph_hi;
#ifndef PH_MASK
#define PH_MASK 0x3ff
#endif
#define IN(k) (((PH_MASK >> (k)) & 1) && lo <= (k) && (k) < hi)
#define SEAM(k) do { if (IN(k) && IN((k) + 1)) xcd_barrier(bar); } while (0)
    if (IN(0)) { p0_prologue(F); } SEAM(0);
    if (IN(1)) { p1_inproj(F); } SEAM(1);
    if (IN(2)) { p2_mix(F); } SEAM(2);
    if (IN(3)) { p3_naive_combine(F); } SEAM(3);
    if (IN(4)) { p4_wo(F); } SEAM(4);
    if (IN(5)) { p5_router(F); } SEAM(5);
    if (IN(6)) { p6_dispatch(F); } SEAM(6);
    if (IN(7)) { p7_gateup(F); } SEAM(7);
    if (IN(8)) { p8_down(F); } SEAM(8);
    if (IN(9)) { p9_final(F); }
#undef IN
#undef SEAM
}

#ifndef MK_MULTI
#define MK_MULTI 0
#endif
extern "C" void kernel_launch(void* const* d_in, const int* in_sizes, int n_in, void* d_out, int out_size, void* d_ws, size_t ws_size, hipStream_t stream) {
    static int grid = 0;
    if (grid == 0) {
        if (n_in != 23 || out_size != T * DM || ws_size < WS_END) { fprintf(stderr, "kernel_launch: unexpected shapes n_in %d out %d ws %zu\n", n_in, out_size, ws_size); grid = -1; return; }
        int dev = 0, cus = 0;
        if (hipGetDevice(&dev) != hipSuccess || hipDeviceGetAttribute(&cus, hipDeviceAttributeMultiprocessorCount, dev) != hipSuccess) { grid = -1; return; }
        if (hipFuncSetAttribute((const void*)mega_fwd, hipFuncAttributeMaxDynamicSharedMemorySize, LDS_BYTES) != hipSuccess) { fprintf(stderr, "kernel_launch: hipFuncSetAttribute failed\n"); grid = -1; return; }
        int per_cu = 0;
        if (hipOccupancyMaxActiveBlocksPerMultiprocessor(&per_cu, (const void*)mega_fwd, NTHREADS, LDS_BYTES) != hipSuccess || per_cu < 1) fprintf(stderr, "kernel_launch: occupancy query says %d\n", per_cu);
        (void)hipGetLastError();
        grid = cus;
    }
    if (grid < 0) return;
    (void)hipMemsetAsync((char*)d_ws + WS_CTL, 0, CTL_ZERO_BYTES, stream);
    Args a{};
    for (int i = 0; i < 23; ++i) a.in[i] = (const float*)d_in[i];
    a.out = (float*)d_out; a.ws = (unsigned char*)d_ws;
#if MK_MULTI
    for (int p = 0; p < NPHASE; ++p) { a.ph_lo = p; a.ph_hi = p + 1; hipLaunchKernelGGL(mega_fwd, dim3(grid), dim3(NTHREADS), LDS_BYTES, stream, a); }
#else
    a.ph_lo = 0; a.ph_hi = NPHASE;
    hipLaunchKernelGGL(mega_fwd, dim3(grid), dim3(NTHREADS), LDS_BYTES, stream, a);
#endif
}
```

```cpp
#include <hip/hip_runtime.h>
#include <cstdio>
#include <cstdint>

constexpr int NB = 4, SEQ = 4096, DM = 1024, T = NB * SEQ, MEML = 256, NIN = 3072, NE = 32, TOPK = 4;
constexpr int TK = T * TOPK, MAXBLK = TK / 256 + NE, MAXROWS = MAXBLK * 256;
constexpr float LOG2E = 1.4426950408889634f, C2 = 0.125f * LOG2E, ALPHA = 1.189207115002721f, EPS = 1e-5f;
constexpr int U_DQ = 0, U_DK = 512, U_DV = 1024, U_HQ = 1536, U_HF = 1792, U_HI = 2304, U_HG = 2560, U_MQ = 2816;

constexpr size_t MiB = 1u << 20;
constexpr size_t WS_CTL = 0, CTL_ZERO_BYTES = 1 * MiB;
constexpr size_t WS_WIN = 2 * MiB, WS_WKV = 8 * MiB, WS_WO = 10 * MiB, WS_MEMB = 12 * MiB, WS_MKV = 14 * MiB;
constexpr size_t WS_XB = 16 * MiB, WS_U = 48 * MiB, WS_OD = 144 * MiB, WS_CAT = 176 * MiB, WS_Z1 = 208 * MiB;
constexpr size_t WS_ROUTE = 272 * MiB;
constexpr size_t WS_HU = 280 * MiB;
constexpr size_t WS_WGU = 336 * MiB, WS_WDN = 464 * MiB, WS_XS = 528 * MiB, WS_ACT = 672 * MiB, WS_Y = 816 * MiB;
constexpr size_t WS_ROWS = 944 * MiB;
constexpr size_t WS_SS = WS_XS;
constexpr size_t WS_OH = WS_ACT;
constexpr size_t WS_END = 948 * MiB;
constexpr int CW_TMO = 0, CW_CODE = 1, CW_CNT = 64  , CW_BAR = 4096;

constexpr int RING_BYTES = 131072, LDSCTL_OFF = RING_BYTES, MISC_OFF = LDSCTL_OFF + 320, LDS_BYTES = 147456;
constexpr int NWAVES = 8, NTHREADS = 512;

#define GAS __attribute__((address_space(1)))
#define LAS __attribute__((address_space(3)))
typedef unsigned short bf16;
typedef unsigned v4u __attribute__((ext_vector_type(4)));
typedef unsigned v2u __attribute__((ext_vector_type(2)));
typedef float f32x4 __attribute__((ext_vector_type(4)));
typedef GAS unsigned gu32;
#define RLX_AGENT __ATOMIC_RELAXED, __HIP_MEMORY_SCOPE_AGENT
__device__ __forceinline__ unsigned f2bf(float f) { unsigned u = __builtin_bit_cast(unsigned, f); return (u + 0x7fffu + ((u >> 16) & 1u)) >> 16; }
__device__ __forceinline__ unsigned pk2(float lo, float hi) { return f2bf(lo) | (f2bf(hi) << 16); }
__device__ __forceinline__ float bf2f(unsigned v) { return __uint_as_float(v << 16); }
__device__ __forceinline__ float bflo(unsigned w) { return __uint_as_float(w << 16); }
__device__ __forceinline__ float bfhi(unsigned w) { return __uint_as_float(w & 0xffff0000u); }
__device__ __forceinline__ float wave_sum(float v) {
#pragma unroll
    for (int o = 1; o < 64; o <<= 1) v += __shfl_xor(v, o);
    return v;
}
__device__ __forceinline__ float wave_max(float v) {
#pragma unroll
    for (int o = 1; o < 64; o <<= 1) v = fmaxf(v, __shfl_xor(v, o));
    return v;
}
__device__ __forceinline__ float sigmoidf_(float x) { return 1.f / (1.f + __expf(-x)); }

#define XB_TMO      128
#define XB_XCNT(j)  (256  + 64 * (j))
#define XB_XSUB(j)  (1280 + 64 * (j))
#define XB_XGEN(j)  (2304 + 64 * (j))
#define XB_TOP      3328
#define XB_TOPGEN   3392
#define XCD_BAR_WORDS 3456
#define XB_SPIN_CAP (1u << 20)
__device__ __forceinline__ unsigned xb_ld(unsigned* p)              { return __hip_atomic_load(p, __ATOMIC_RELAXED, __HIP_MEMORY_SCOPE_AGENT); }
__device__ __forceinline__ unsigned xb_add(unsigned* p, unsigned v) { return __hip_atomic_fetch_add(p, v, __ATOMIC_RELAXED, __HIP_MEMORY_SCOPE_AGENT); }
__device__ __forceinline__ unsigned xb_xcc_id() { return (unsigned)__builtin_amdgcn_s_getreg((3 << 11) | 20) & 0xFu; }
#define XB_SPIN(cond, bar) do { unsigned _sp = 0; while (cond) { __builtin_amdgcn_s_sleep(1); \
    if ((++_sp & 255u) == 0u) { if (xb_ld(&(bar)[XB_TMO])) break; if (_sp > XB_SPIN_CAP) { atomicAdd(&(bar)[XB_TMO], 1u); break; } } } } while (0)
struct XcdBarrier { unsigned* bar; unsigned x; volatile LAS unsigned* st; };
__device__ __forceinline__ XcdBarrier xcd_barrier_post(unsigned* bar, volatile LAS unsigned* st) {
    XcdBarrier b; b.bar = bar; b.x = xb_xcc_id(); b.st = st;
    if (threadIdx.x == 0) (void)xb_add(&bar[XB_XCNT(b.x)], 1u);
    return b;
}
__device__ __forceinline__ void xcd_barrier_complete(unsigned* bar, unsigned x, unsigned& nloc, unsigned& nx) {
    const unsigned G = gridDim.x * gridDim.y * gridDim.z;
    unsigned sum, cnt, mine, sp = 0u;
    for (;;) {
        sum = 0u; cnt = 0u; mine = 0u;
#pragma unroll
        for (unsigned j = 0; j < 16; ++j) { const unsigned c = xb_ld(&bar[XB_XCNT(j)]); sum += c; cnt += (c > 0u) ? 1u : 0u; mine = (j == x) ? c : mine; }
        if (sum == G) break;
        __builtin_amdgcn_s_sleep(1);
        if ((++sp & 255u) == 0u) { if (xb_ld(&bar[XB_TMO])) break; if (sp > XB_SPIN_CAP) { atomicAdd(&bar[XB_TMO], 1u); break; } }
    }
    nloc = mine > 0u ? mine : 1u; nx = cnt > 0u ? cnt : 1u;
}
__device__ __forceinline__ void xcd_barrier(const XcdBarrier& b) {
    asm volatile("s_waitcnt vmcnt(0)" ::: "memory");
    __syncthreads();
    if (threadIdx.x == 0) {
        unsigned* bar = b.bar;
        __builtin_amdgcn_s_waitcnt(0);
        unsigned nloc = b.st[0], nx = b.st[1];
        if (nloc == 0u) { xcd_barrier_complete(bar, b.x, nloc, nx); b.st[0] = nloc; b.st[1] = nx; }
        const unsigned old = xb_add(&bar[XB_XSUB(b.x)], 1u);
        const unsigned gen = old / nloc;
        if (old + 1u == (gen + 1u) * nloc) {
            __builtin_amdgcn_fence(__ATOMIC_RELEASE, "agent");
            asm volatile("s_waitcnt vmcnt(0)" ::: "memory");
            const unsigned og = xb_add(&bar[XB_TOP], 1u);
            const unsigned tg = og / nx;
            if (og + 1u == (tg + 1u) * nx) xb_add(&bar[XB_TOPGEN], 1u);
            else XB_SPIN(xb_ld(&bar[XB_TOPGEN]) == tg, bar);
            __builtin_amdgcn_fence(__ATOMIC_ACQUIRE, "agent");
            xb_add(&bar[XB_XGEN(b.x)], 1u);
            asm volatile("s_waitcnt vmcnt(0)" ::: "memory");
        } else {
            XB_SPIN(xb_ld(&bar[XB_XGEN(b.x)]) == gen, bar);
            __builtin_amdgcn_fence(__ATOMIC_ACQUIRE, "agent");
            asm volatile("s_waitcnt vmcnt(0)" ::: "memory");
        }
    }
    __syncthreads();
}

namespace pg8 {
#define PG8_LAS __attribute__((address_space(3)))
typedef unsigned short bf16_t;
typedef short bf16x8 __attribute__((ext_vector_type(8)));
typedef float f32x4 __attribute__((ext_vector_type(4)));
typedef unsigned u32x4 __attribute__((ext_vector_type(4)));
constexpr int BM = 256, BK = 64, HALF = 128, HTB = HALF * BK * 2  , STAGE_BYTES = 8 * HTB, NXCD = 8, WGM = 8;

__host__ __device__ __forceinline__ int lds_byte(int r, int c) { const int st = (r >> 4) * 2 + (c >> 5), rr = r & 15, cc = c & 31, ob = rr * 64 + cc * 2; return st * 1024 + (ob ^ (((ob >> 9) & 1) << 5)); }
__host__ __device__ __forceinline__ void stage_rc(int b, int& R, int& C) { const int st = b / 1024, sb = b % 1024, swz = sb ^ (((sb >> 9) & 1) << 5); R = (st >> 1) * 16 + swz / 64; C = (st & 1) * 32 + (swz % 64) / 2; }
__host__ __device__ __forceinline__ int perm32(int rho) { const int n = rho >> 4, i = rho & 15; return 8 * (i >> 2) + 4 * n + (i & 3); }

struct Unit { int pm, pn, pb, e; };
struct Gemm { const bf16_t* A; const bf16_t* Bt; int M, N, K; };

struct StaticOrder {
    int nM, nN, nwg, G, c;
    __host__ __device__ void init(int M, int N, int G_, int c_) { nM = M / BM; nN = N / BM; nwg = nM * nN; G = G_; c = c_; }
    __host__ __device__ bool next(int i, Unit& u) const {
        const long L = (long)i * G + c; if (L >= nwg) return false;
        int wgid = (int)L; { const int q = nwg / NXCD, r = nwg % NXCD, xcd = wgid % NXCD, off = wgid / NXCD; wgid = (xcd < r ? xcd * (q + 1) : r * (q + 1) + (xcd - r) * q) + off; }
        const int nig = WGM * nN, gid = wgid / nig, fm = gid * WGM, gsz = (nM - fm) < WGM ? (nM - fm) : WGM;
        u.pm = fm + ((wgid % nig) % gsz); u.pn = (wgid % nig) / gsz; u.pb = u.pn; u.e = 0; return true;
    }
    __device__ __forceinline__ void a_ready(const Unit&) const {}
    __device__ __forceinline__ void done(const Unit&) const {}
};

template <class Epi, class Sched, bool ALIGN_EPI = false, bool SP2 = false>
__device__ __forceinline__ void gemm_phase(PG8_LAS unsigned char* lds, const Gemm g, const Sched& S, const Epi& E) {
    const int tid = threadIdx.x, wid = __builtin_amdgcn_readfirstlane(tid >> 6), lane = tid & 63, wr = wid >> 2, wc = wid & 3, fr = lane & 15, fq = lane >> 4;
    const int K = g.K, nt = K / BK;
    unsigned voffA[2], voffB[2];
#pragma unroll
    for (int i = 0; i < 2; ++i) { int R, C; stage_rc(tid * 16 + i * 8192, R, C); const int Rb = Epi::PERM ? ((R & ~31) + perm32(R & 31)) : R;
        voffA[i] = (unsigned)(R * K + C) * 2u; voffB[i] = (unsigned)(Rb * K + C) * 2u; }
    const size_t kstep = (size_t)(BK * 2);
    const size_t hstep = (size_t)HALF * K * 2;
    const size_t tstep = 2 * hstep;
    const unsigned ldsw = (unsigned)wid * 1024u;
    const int aoff = lds_byte(wr * 64 + fr, fq * 8), boff = lds_byte(wc * 32 + fr, fq * 8);
#define PG8_SA(b, h) (((b) * 2 + (h)) * HTB)
#define PG8_SB(b, h) ((4 + (b) * 2 + (h)) * HTB)
#define PG8_STAGE(bufoff, gbase, voff) do { _Pragma("unroll") for (int _i = 0; _i < 2; ++_i) \
        __builtin_amdgcn_global_load_lds((const unsigned*)((const char*)(gbase) + (voff)[_i]), (PG8_LAS unsigned*)(lds + (bufoff) + ldsw + _i * 8192), 16, 0, 0); } while (0)
#define PG8_LDA(dst, b, h) do { _Pragma("unroll") for (int m = 0; m < 4; ++m) _Pragma("unroll") for (int k = 0; k < 2; ++k) dst[m][k] = *(const PG8_LAS bf16x8*)(lds + PG8_SA(b, h) + aoff + m * 2048 + k * 1024); } while (0)
#define PG8_LDB(dst, b, h) do { _Pragma("unroll") for (int n = 0; n < 2; ++n) _Pragma("unroll") for (int k = 0; k < 2; ++k) dst[n][k] = *(const PG8_LAS bf16x8*)(lds + PG8_SB(b, h) + boff + n * 2048 + k * 1024); } while (0)
#define PG8_MMA(ai, bj, At, Bt) do { __builtin_amdgcn_s_setprio(1); _Pragma("unroll") for (int m = 0; m < 4; ++m) _Pragma("unroll") for (int n = 0; n < 2; ++n) _Pragma("unroll") for (int k = 0; k < 2; ++k) \
        acc[ai][bj][m][n] = __builtin_amdgcn_mfma_f32_16x16x32_bf16(Bt[n][k], At[m][k], acc[ai][bj][m][n], 0, 0, 0); __builtin_amdgcn_s_setprio(0); } while (0)
#define PG8_WAIT_V(n) asm volatile("s_waitcnt vmcnt(" #n ")" ::: "memory")
#define PG8_WAIT_L(n) asm volatile("s_waitcnt lgkmcnt(" #n ")" ::: "memory")
#define PG8_BAR __builtin_amdgcn_s_barrier()
#define PG8_SCHED __builtin_amdgcn_sched_barrier(0)
    Unit cur, nxt; int ui = 0;
    if (!S.next(0, cur)) return;
    f32x4 acc[2][2][4][2];
#pragma unroll
    for (int a = 0; a < 2; ++a)
#pragma unroll
        for (int b = 0; b < 2; ++b)
#pragma unroll
            for (int m = 0; m < 4; ++m)
#pragma unroll
                for (int n = 0; n < 2; ++n) acc[a][b][m][n] = (f32x4){0.f, 0.f, 0.f, 0.f};
    bf16x8 At[4][2], B0[2][2], B1[2][2];
    const char* cA = (const char*)g.A + (size_t)cur.pm * tstep; const char* cB = (const char*)g.Bt + (size_t)cur.pb * tstep;
    S.a_ready(cur);
    if constexpr (SP2) {
        PG8_STAGE(PG8_SB(0, 0), cB, voffB); PG8_STAGE(PG8_SB(0, 1), cB + hstep, voffB); PG8_STAGE(PG8_SA(0, 0), cA, voffA); PG8_STAGE(PG8_SA(0, 1), cA + hstep, voffA);
        if (wr == 1) PG8_BAR;
        PG8_WAIT_V(2); PG8_BAR;
        PG8_STAGE(PG8_SB(1, 0), cB + kstep, voffB); PG8_STAGE(PG8_SA(1, 0), cA + kstep, voffA); PG8_STAGE(PG8_SB(1, 1), cB + hstep + kstep, voffB);
        PG8_WAIT_V(6); PG8_BAR;
    } else {
        PG8_STAGE(PG8_SB(0, 0), cB, voffB); PG8_STAGE(PG8_SA(0, 0), cA, voffA); PG8_STAGE(PG8_SB(0, 1), cB + hstep, voffB); PG8_STAGE(PG8_SA(0, 1), cA + hstep, voffA);
        if (wr == 1) PG8_BAR;
        PG8_WAIT_V(4); PG8_BAR;
        PG8_STAGE(PG8_SB(1, 0), cB + kstep, voffB); PG8_STAGE(PG8_SA(1, 0), cA + kstep, voffA); PG8_STAGE(PG8_SB(1, 1), cB + hstep + kstep, voffB);
        PG8_WAIT_V(6); PG8_BAR;
    }
    for (;;) {
        const bool has_next = S.next(ui + 1, nxt);
        const char* nA = has_next ? (const char*)g.A + (size_t)nxt.pm * tstep : cA; const char* nB = has_next ? (const char*)g.Bt + (size_t)nxt.pb * tstep : cB;
        for (int t = 0; t < nt; t += 2) {
            const bool last = (t == nt - 2);
            const char* a1 = cA + (size_t)(t + 1) * kstep;
            const char* a2 = last ? nA : cA + (size_t)(t + 2) * kstep; const char* b2 = last ? nB : cB + (size_t)(t + 2) * kstep;
            const char* a3 = a2 + kstep; const char* b3 = b2 + kstep;
            if (last && has_next) S.a_ready(nxt);
            if constexpr (SP2) {
            PG8_LDB(B0, 0, 0); PG8_LDB(B1, 0, 1); PG8_SCHED; PG8_LDA(At, 0, 0); PG8_STAGE(PG8_SA(1, 1), a1 + hstep, voffA);
            PG8_WAIT_V(8); PG8_WAIT_L(0); PG8_BAR; PG8_MMA(0, 0, At, B0); PG8_MMA(0, 1, At, B1); PG8_BAR; PG8_SCHED;
            PG8_LDA(At, 0, 1); PG8_STAGE(PG8_SB(0, 0), b2, voffB); PG8_STAGE(PG8_SB(0, 1), b2 + hstep, voffB); PG8_STAGE(PG8_SA(0, 0), a2, voffA);
            PG8_WAIT_V(8); PG8_WAIT_L(0); PG8_BAR; PG8_MMA(1, 0, At, B0); PG8_MMA(1, 1, At, B1); PG8_BAR; PG8_SCHED;
            PG8_LDB(B0, 1, 0); PG8_LDB(B1, 1, 1); PG8_SCHED; PG8_LDA(At, 1, 0); PG8_STAGE(PG8_SA(0, 1), a2 + hstep, voffA);
            PG8_WAIT_V(8); PG8_WAIT_L(0); PG8_BAR; PG8_MMA(0, 0, At, B0); PG8_MMA(0, 1, At, B1); PG8_BAR; PG8_SCHED;
            PG8_LDA(At, 1, 1); PG8_STAGE(PG8_SB(1, 0), b3, voffB); PG8_STAGE(PG8_SB(1, 1), b3 + hstep, voffB); PG8_STAGE(PG8_SA(1, 0), a3, voffA);
            PG8_WAIT_V(8); PG8_WAIT_L(0); PG8_BAR; PG8_MMA(1, 0, At, B0); PG8_MMA(1, 1, At, B1); PG8_BAR; PG8_SCHED;
            } else {
            PG8_LDB(B0, 0, 0); PG8_SCHED; PG8_LDA(At, 0, 0); PG8_STAGE(PG8_SA(1, 1), a1 + hstep, voffA);
            PG8_WAIT_L(8); PG8_BAR; PG8_WAIT_L(0); PG8_MMA(0, 0, At, B0); PG8_BAR; PG8_SCHED;
            PG8_LDB(B1, 0, 1); PG8_STAGE(PG8_SB(0, 0), b2, voffB);
            PG8_BAR; PG8_WAIT_L(0); PG8_MMA(0, 1, At, B1); PG8_BAR;
            PG8_LDA(At, 0, 1); PG8_STAGE(PG8_SA(0, 0), a2, voffA);
            PG8_BAR; PG8_WAIT_L(0); PG8_MMA(1, 0, At, B0); PG8_BAR; PG8_SCHED;
            PG8_STAGE(PG8_SB(0, 1), b2 + hstep, voffB);
            PG8_WAIT_V(6); PG8_BAR; PG8_MMA(1, 1, At, B1); PG8_BAR;
            PG8_LDB(B0, 1, 0); PG8_SCHED; PG8_LDA(At, 1, 0); PG8_STAGE(PG8_SA(0, 1), a2 + hstep, voffA);
            PG8_WAIT_L(8); PG8_BAR; PG8_WAIT_L(0); PG8_MMA(0, 0, At, B0); PG8_BAR; PG8_SCHED;
            PG8_LDB(B1, 1, 1); PG8_STAGE(PG8_SB(1, 0), b3, voffB);
            PG8_BAR; PG8_WAIT_L(0); PG8_MMA(0, 1, At, B1); PG8_BAR;
            PG8_LDA(At, 1, 1); PG8_STAGE(PG8_SA(1, 0), a3, voffA);
            PG8_BAR; PG8_WAIT_L(0); PG8_MMA(1, 0, At, B0); PG8_BAR; PG8_SCHED;
            PG8_STAGE(PG8_SB(1, 1), b3 + hstep, voffB);
            PG8_WAIT_V(6); PG8_BAR; PG8_MMA(1, 1, At, B1); PG8_BAR;
            }
        }
        if constexpr (ALIGN_EPI) { if (wr == 0) PG8_BAR; }
        if constexpr (!Epi::AFTER_DRAIN) { E(acc, cur, wr, wc, fr, fq); S.done(cur); }
        if (!has_next) break;
#pragma unroll
        for (int a = 0; a < 2; ++a)
#pragma unroll
            for (int b = 0; b < 2; ++b)
#pragma unroll
                for (int m = 0; m < 4; ++m)
#pragma unroll
                    for (int n = 0; n < 2; ++n) acc[a][b][m][n] = (f32x4){0.f, 0.f, 0.f, 0.f};
        cur = nxt; cA = nA; cB = nB; ++ui;
        if constexpr (ALIGN_EPI) { if (wr == 1) PG8_BAR; }
    }
    PG8_WAIT_V(0);
    if constexpr (!ALIGN_EPI) { if (wr == 0) PG8_BAR; }
    PG8_BAR;
    if constexpr (Epi::AFTER_DRAIN) { E.fused(acc, cur, wr, wc, fr, fq, lds, wid, lane); S.done(cur); }
#undef PG8_SA
#undef PG8_SB
#undef PG8_STAGE
#undef PG8_LDA
#undef PG8_LDB
#undef PG8_MMA
#undef PG8_WAIT_V
#undef PG8_WAIT_L
#undef PG8_BAR
#undef PG8_SCHED
}

__device__ __forceinline__ unsigned cvt_pk_bf16(float lo, float hi) { unsigned r; asm volatile("v_cvt_pk_bf16_f32 %0, %1, %2" : "=v"(r) : "v"(lo), "v"(hi)); return r; }
struct EpiBf16 {
    static constexpr bool PERM = true, AFTER_DRAIN = false;
    bf16_t* O; int ldc; unsigned smask; float s;
    __device__ __forceinline__ void operator()(const f32x4 (&acc)[2][2][4][2], const Unit& u, int wr, int wc, int fr, int fq) const {
        const int row0 = u.pm * BM + wr * 64 + fr, col0 = u.pn * BM + wc * 32 + 8 * fq; const float sc = ((smask >> u.pn) & 1u) ? s : 1.f;
#pragma unroll
        for (int ai = 0; ai < 2; ++ai)
#pragma unroll
            for (int m = 0; m < 4; ++m) { bf16_t* rowp = O + (size_t)(row0 + ai * HALF + m * 16) * ldc + col0;
#pragma unroll
                for (int bj = 0; bj < 2; ++bj) { const f32x4 v0 = acc[ai][bj][m][0] * sc, v1 = acc[ai][bj][m][1] * sc;
                    u32x4 w; w.x = cvt_pk_bf16(v0[0], v0[1]); w.y = cvt_pk_bf16(v0[2], v0[3]); w.z = cvt_pk_bf16(v1[0], v1[1]); w.w = cvt_pk_bf16(v1[2], v1[3]);
                    *(u32x4*)(rowp + bj * HALF) = w; } }
    }
};
struct EpiResF32 {
    static constexpr bool PERM = false, AFTER_DRAIN = false;
    const float* base; float* out; int ldc; float alpha;
    __device__ __forceinline__ void operator()(const f32x4 (&acc)[2][2][4][2], const Unit& u, int wr, int wc, int fr, int fq) const {
        const int col0 = u.pn * BM + wc * 32 + 4 * fq;
#pragma unroll
        for (int ai = 0; ai < 2; ++ai)
#pragma unroll
            for (int m = 0; m < 4; ++m) { const size_t off = (size_t)(u.pm * BM + ai * HALF + wr * 64 + m * 16 + fr) * ldc + col0;
#pragma unroll
                for (int bj = 0; bj < 2; ++bj)
#pragma unroll
                    for (int n = 0; n < 2; ++n) { const f32x4 bs = *(const f32x4*)(base + off + bj * HALF + n * 16); *(f32x4*)(out + off + bj * HALF + n * 16) = bs * alpha + acc[ai][bj][m][n]; }
                if (m & 1) asm volatile("" ::: "memory"); }
    }
};
struct EpiGateUp {
    static constexpr bool PERM = true, AFTER_DRAIN = false;
    bf16_t* O; const float* bias;
    __device__ __forceinline__ void operator()(const f32x4 (&acc)[2][2][4][2], const Unit& u, int wr, int wc, int fr, int fq) const {
        const int row0 = u.pm * BM + wr * 64 + fr, f0 = u.pn * 128 + wc * 32 + 8 * fq;
        const float* bp = bias + (size_t)u.e * 2048 + 2 * f0;
        const f32x4 b0 = *(const f32x4*)(bp), b1 = *(const f32x4*)(bp + 4), b2 = *(const f32x4*)(bp + 8), b3 = *(const f32x4*)(bp + 12);
        const float bg[8] = {b0[0], b0[2], b1[0], b1[2], b2[0], b2[2], b3[0], b3[2]}, bl[8] = {b0[1], b0[3], b1[1], b1[3], b2[1], b2[3], b3[1], b3[3]};
#pragma unroll
        for (int ai = 0; ai < 2; ++ai)
#pragma unroll
            for (int m = 0; m < 4; ++m) { float a[8];
#pragma unroll
                for (int n = 0; n < 2; ++n)
#pragma unroll
                    for (int q = 0; q < 4; ++q) { const float g = fminf(acc[ai][0][m][n][q] + bg[4 * n + q], 7.f), l = fminf(fmaxf(acc[ai][1][m][n][q] + bl[4 * n + q], -7.f), 7.f);
                        a[4 * n + q] = g * __builtin_amdgcn_rcpf(1.f + __builtin_amdgcn_exp2f(-1.702f * 1.4426950408889634f * g)) * (l + 1.f); }
                u32x4 w; w.x = cvt_pk_bf16(a[0], a[1]); w.y = cvt_pk_bf16(a[2], a[3]); w.z = cvt_pk_bf16(a[4], a[5]); w.w = cvt_pk_bf16(a[6], a[7]);
                *(u32x4*)(O + (size_t)(row0 + ai * HALF + m * 16) * 1024 + f0) = w; }
    }
};
struct EpiDown {
    static constexpr bool PERM = true, AFTER_DRAIN = false;
    bf16_t* Y; const float* bias; const int* rowslot; const float* rowgate; const int* blkv;
    __device__ __forceinline__ void operator()(const f32x4 (&acc)[2][2][4][2], const Unit& u, int wr, int wc, int fr, int fq) const {
        const int col0 = u.pn * BM + wc * 32 + 8 * fq, nv = blkv[u.pm];
        const float* bp = bias + (size_t)u.e * 1024 + col0;
        f32x4 bv[2][2];
#pragma unroll
        for (int bj = 0; bj < 2; ++bj)
#pragma unroll
            for (int n = 0; n < 2; ++n) bv[bj][n] = *(const f32x4*)(bp + bj * HALF + 4 * n);
#pragma unroll
        for (int ai = 0; ai < 2; ++ai)
#pragma unroll
            for (int m = 0; m < 4; ++m) { const int r = ai * HALF + wr * 64 + m * 16 + fr;
                if (r < nv) { const int slot = rowslot[u.pm * BM + r]; const float g = rowgate[u.pm * BM + r]; bf16_t* rowp = Y + (size_t)slot * 1024 + col0;
#pragma unroll
                    for (int bj = 0; bj < 2; ++bj) { const f32x4 v0 = (acc[ai][bj][m][0] + bv[bj][0]) * g, v1 = (acc[ai][bj][m][1] + bv[bj][1]) * g;
                        u32x4 w; w.x = cvt_pk_bf16(v0[0], v0[1]); w.y = cvt_pk_bf16(v0[2], v0[3]); w.z = cvt_pk_bf16(v1[0], v1[1]); w.w = cvt_pk_bf16(v1[2], v1[3]);
                        *(u32x4*)(rowp + bj * HALF) = w; } } }
    }
};
struct MoeOrder {
    const int* blke; int nunits, npn, gpx, c;
    __device__ __forceinline__ bool next(int i, Unit& u) const {
        const int L = (i * 8 + (c & 7)) * gpx + (c >> 3); if (L >= nunits) return false;
        const int blk = L / npn; u.pm = blk; u.pn = L - blk * npn; u.e = __builtin_amdgcn_readfirstlane(blke[blk]); u.pb = u.e * npn + u.pn; return true;
    }
    __device__ __forceinline__ void a_ready(const Unit&) const {}
    __device__ __forceinline__ void done(const Unit&) const {}
};
}

namespace attn_body {
typedef unsigned short abf;
using bf16x8=__attribute__((ext_vector_type(8)))short;
using s16x4=__attribute__((ext_vector_type(4)))short;
using f32x16=__attribute__((ext_vector_type(16)))float;
using u32x4=__attribute__((ext_vector_type(4)))unsigned;
constexpr int NW=8,QBLK=32,QB=QBLK*NW,KVBLK=64;
__device__ __forceinline__ int crow(int r,int hi){return (r&3)+8*(r>>2)+4*hi;}
#define SBAR() __builtin_amdgcn_sched_barrier(0)
constexpr int NSLOT=3, SLOTB=8192;
constexpr int LDS_K=0, LDS_V=NSLOT*SLOTB, LDS_WS=2*NSLOT*SLOTB, LDS_OST=LDS_WS+NW*64*4, LDS_BYTES=LDS_OST+NW*4096;
__device__ __forceinline__ void glds16(const void*gsrc,unsigned lds_dst){unsigned keep;
  asm volatile("s_mov_b32 %0, m0\n\ts_mov_b32 m0, %2\n\ts_nop 0\n\tglobal_load_lds_dwordx4 %1, off\n\ts_mov_b32 m0, %0":"=&s"(keep):"v"(gsrc),"s"(lds_dst):"memory");}
__device__ __forceinline__ float max3f(float a,float b,float c){float r;asm("v_max3_f32 %0, %1, %2, %3":"=v"(r):"v"(a),"v"(b),"v"(c));return r;}
__device__ __forceinline__ float max2f(float a,float b){float r;asm("v_max_f32_e32 %0, %1, %2":"=v"(r):"v"(a),"v"(b));return r;}
__device__ __forceinline__ float fadd_s(float a,float b){float r;asm("v_add_f32_e32 %0, %1, %2":"=v"(r):"v"(a),"v"(b));return r;}
__device__ __forceinline__ float fsub_s(float a,float b){float r;asm("v_sub_f32_e32 %0, %1, %2":"=v"(r):"v"(a),"v"(b));return r;}
typedef float f32x2_t __attribute__((ext_vector_type(2))); typedef __bf16 bf16x2_t __attribute__((ext_vector_type(2)));
__device__ __forceinline__ unsigned cvtpk_s(float lo,float hi){f32x2_t v={lo,hi};bf16x2_t b=__builtin_convertvector(v,bf16x2_t);return __builtin_bit_cast(unsigned,b);}
#define WAIT_BAR(N) asm volatile("s_waitcnt vmcnt(" #N ") lgkmcnt(0)\n\ts_barrier":::"memory")
__device__ __forceinline__ void qkt(f32x16&p0,f32x16&p1,const char*Kslot,const bf16x8*qr,const f32x16&c0,const f32x16&c1,int r32,int hi){
  const char*kb=Kslot+hi*1024+r32*16;
  #pragma unroll
  for(int d0=0;d0<4;++d0){
    const bf16x8 b0=*reinterpret_cast<const bf16x8*>(kb+d0*2048);
    const bf16x8 b1=*reinterpret_cast<const bf16x8*>(kb+d0*2048+512);
    if(d0==0){p0=__builtin_amdgcn_mfma_f32_32x32x16_bf16(b0,qr[0],c0,0,0,0);p1=__builtin_amdgcn_mfma_f32_32x32x16_bf16(b1,qr[0],c1,0,0,0);}
    else{p0=__builtin_amdgcn_mfma_f32_32x32x16_bf16(b0,qr[d0],p0,0,0,0);p1=__builtin_amdgcn_mfma_f32_32x32x16_bf16(b1,qr[d0],p1,0,0,0);}}
}
typedef __attribute__((address_space(3))) const char* lds_cptr;
typedef short v4i16_t __attribute__((ext_vector_type(4)));
__device__ __forceinline__ void kload8(bf16x8*kf,lds_cptr kp){
  kf[0]=*(const __attribute__((address_space(3))) bf16x8*)(kp);      kf[1]=*(const __attribute__((address_space(3))) bf16x8*)(kp+512);
  kf[2]=*(const __attribute__((address_space(3))) bf16x8*)(kp+2048); kf[3]=*(const __attribute__((address_space(3))) bf16x8*)(kp+2560);
  kf[4]=*(const __attribute__((address_space(3))) bf16x8*)(kp+4096); kf[5]=*(const __attribute__((address_space(3))) bf16x8*)(kp+4608);
  kf[6]=*(const __attribute__((address_space(3))) bf16x8*)(kp+6144); kf[7]=*(const __attribute__((address_space(3))) bf16x8*)(kp+6656);
}
__device__ __forceinline__ void kload2(bf16x8*kf,lds_cptr kp,int j){ kf[2*j]=*(const __attribute__((address_space(3))) bf16x8*)(kp+j*2048); kf[2*j+1]=*(const __attribute__((address_space(3))) bf16x8*)(kp+j*2048+512); }
__device__ __forceinline__ s16x4 vtr(lds_cptr p){ return __builtin_bit_cast(s16x4,__builtin_amdgcn_ds_read_tr16_b64_v4i16((__attribute__((address_space(3))) v4i16_t*)p)); }
__device__ __forceinline__ float rowmax(const f32x16&p0,const f32x16&p1){
  float a=max3f(p0[0],p0[1],p1[0]),b=max3f(p0[2],p0[3],p1[1]);a=max3f(a,p1[2],p1[3]);
  #pragma unroll
  for(int r=4;r<16;r+=4){a=max3f(a,p0[r],p0[r+1]);b=max3f(b,p0[r+2],p0[r+3]);a=max3f(a,p1[r],p1[r+1]);b=max3f(b,p1[r+2],p1[r+3]);}
  const float m=max2f(a,b);
  auto rr=__builtin_amdgcn_permlane32_swap(__float_as_uint(m),__float_as_uint(m),false,false);
  return max2f(__uint_as_float(rr[0]),__uint_as_float(rr[1]));
}
__device__ __forceinline__ void pv(f32x16*o,int vb,bf16x8 pa0,bf16x8 pa1,bf16x8 pa2,bf16x8 pa3){
  #pragma unroll
  for(int d0=0;d0<2;++d0){s16x4 lo[4],hi[4];
    #pragma unroll
    for(int ks=0;ks<4;++ks){
      asm volatile("ds_read_b64_tr_b16 %0,%1 offset:%c2":"=&v"(lo[ks]):"v"(vb),"i"(d0*4096+ks*1024):"memory");
      asm volatile("ds_read_b64_tr_b16 %0,%1 offset:%c2":"=&v"(hi[ks]):"v"(vb),"i"(d0*4096+ks*1024+512):"memory");}
    asm volatile("s_waitcnt lgkmcnt(0)":::"memory");SBAR();
    #define PK(k) (bf16x8){lo[k][0],lo[k][1],lo[k][2],lo[k][3],hi[k][0],hi[k][1],hi[k][2],hi[k][3]}
    o[d0]=__builtin_amdgcn_mfma_f32_32x32x16_bf16(pa0,PK(0),o[d0],0,0,0);
    o[d0]=__builtin_amdgcn_mfma_f32_32x32x16_bf16(pa1,PK(1),o[d0],0,0,0);
    o[d0]=__builtin_amdgcn_mfma_f32_32x32x16_bf16(pa2,PK(2),o[d0],0,0,0);
    o[d0]=__builtin_amdgcn_mfma_f32_32x32x16_bf16(pa3,PK(3),o[d0],0,0,0);
    #undef PK
  }
}
#ifndef ATTN_STORE16
#define ATTN_STORE16(p,v) (*(u32x4*)(p)=(v))
#endif
template<int THRL> __device__ __forceinline__ void attn_unit(const abf*Qw0,int QP,const abf*Kh,int KP,const abf*Vh,int VP,abf*Ow0,int OP,int NT,float c2,int q0,char*shm){
  const int tid=threadIdx.x,lane=tid&63,r32=lane&31,hi=lane>>5; const int wid=__builtin_amdgcn_readfirstlane(tid>>6);
  const abf*Qw=Qw0+(long)(wid*QBLK)*QP;
  const unsigned lds0=(unsigned)(uintptr_t)shm;
  float*wsf=(float*)(shm+LDS_WS)+wid*64;
  const abf*ksrc=Kh+(long)lane*KP+wid*8;
  const abf*vsrc=Vh+(long)(16*(wid&3)+(lane>>2))*VP+(wid>>2)*32+(lane&3)*8;
  const unsigned kdst=lds0+LDS_K+wid*1024, vdst=lds0+LDS_V+wid*1024;
  #define DMA_K(t,slot) glds16(ksrc+(long)(t)*KVBLK*KP,(unsigned)__builtin_amdgcn_readfirstlane(kdst+(slot)))
  #define DMA_V(t,slot) glds16(vsrc+(long)(t)*KVBLK*VP,(unsigned)__builtin_amdgcn_readfirstlane(vdst+(slot)))
  const int vb0=(int)(lds0+LDS_V)+((lane>>4)&1)*32+(lane&3)*8+(4*hi+((lane&15)>>2))*64;
  const char*Kbase=shm+LDS_K; bf16x8 kf[8];
  const lds_cptr shm3=(lds_cptr)shm; const lds_cptr kp0=shm3+LDS_K+hi*1024+r32*16; const lds_cptr vp0=shm3+LDS_V+((lane>>4)&1)*32+(lane&3)*8+(4*hi+((lane&15)>>2))*64;
  DMA_K(0,0);DMA_V(0,0);DMA_K(1,SLOTB);
  bf16x8 qr[4];
  #pragma unroll
  for(int d0=0;d0<4;++d0)qr[d0]=*reinterpret_cast<const bf16x8*>(&Qw[(long)r32*QP+d0*16+hi*8]);
  float mhat=0.f,l_reg=0.f;f32x16 o[2];o[0]=f32x16{};o[1]=f32x16{};
  const int tdiag=__builtin_amdgcn_readfirstlane((q0+wid*QBLK)>>6);
  const float qrel4=(float)(q0+wid*QBLK+r32-4*hi);
  #define CINIT(C0,C1,t) do{ const int tt_=(t); const float dq_=qrel4-64.f*(float)tt_; \
    if(tt_!=tdiag){ const float sc_=tt_<tdiag?c2:-c2; const float b0_=-mhat-sc_*dq_, b1_=b0_+32.f*sc_; \
      _Pragma("unroll") for(int r=0;r<16;++r){ const float cr_=(float)((r&3)+8*(r>>2)); C0[r]=sc_*cr_+b0_; C1[r]=sc_*cr_+b1_; } } \
    else { _Pragma("unroll") for(int r=0;r<16;++r){ const float cr_=(float)((r&3)+8*(r>>2)); C0[r]=-mhat-c2*__builtin_fabsf(dq_-cr_); C1[r]=-mhat-c2*__builtin_fabsf(dq_-cr_-32.f); } } }while(0)
  bool resc=false;
  #define START(P0,P1) do{ const float rm=rowmax(P0,P1); resc=false; \
    { const float dl=rm; mhat=fadd_s(mhat,dl); \
      _Pragma("unroll") for(int r=0;r<16;++r){P0[r]=fsub_s(P0[r],dl);P1[r]=fsub_s(P1[r],dl);} } \
    _Pragma("unroll") for(int r=0;r<16;++r)P0[r]=__builtin_amdgcn_exp2f(P0[r]); }while(0)
  #define RESC() do{ if(resc){ asm volatile("s_waitcnt lgkmcnt(0)":::"memory"); \
      _Pragma("unroll") for(int d_=0;d_<2;++d_) _Pragma("unroll") for(int r=0;r<16;++r)o[d_][r]*=wsf[crow(r,hi)]; } }while(0)
  f32x16 pA0,pA1,pB0,pB1;
  int sl_prev=0,sl_cur=0,sl_next=SLOTB;
  #define ROT() do{sl_prev=sl_cur;sl_cur=sl_next;sl_next=(sl_next==(NSLOT-1)*SLOTB)?0:sl_next+SLOTB;}while(0)
  DMA_K(2,2*SLOTB);
  WAIT_BAR(3);
  CINIT(pA0,pA1,0);
  qkt(pA0,pA1,Kbase,qr,pA0,pA1,r32,hi);asm volatile("s_nop 15\n\ts_nop 7":"+v"(pA0),"+v"(pA1));
  START(pA0,pA1);
  _Pragma("unroll") for(int r=0;r<16;++r)pA1[r]=__builtin_amdgcn_exp2f(pA1[r]);
  WAIT_BAR(0);
  DMA_K(3,0);DMA_V(1,SLOTB);
  ROT();
  kload8(kf,kp0+sl_cur);
  WAIT_BAR(2);
  s16x4 vlo[8],vhi[8]; u32x4 pw0,pw1,pw2,pw3;
  #define PKW(P,B) cvtpk_s(P[B],P[B+1])
  #define PAF(k) __builtin_bit_cast(bf16x8,pw##k)
  #define VFR(i) (bf16x8){vlo[i][0],vlo[i][1],vlo[i][2],vlo[i][3],vhi[i][0],vhi[i][1],vhi[i][2],vhi[i][3]}
  #define PIN(x) asm volatile("":"+v"(x))
  #define MX3(a,b,c) __builtin_fmaxf(__builtin_fmaxf((a),(b)),(c))
  #define GAPA(MF,A0,A1,A2,A3,W0,W1,PW) do{ MF; sacc+=A0; sacc+=A1; sacc+=A2; sacc+=A3; PIN(sacc); W0; W1; PIN(PW); SBAR(); }while(0)
  #define EX(v) __builtin_amdgcn_exp2f(v)
  #define GAPB(MF,X,B) do{ MF; X[B]=EX(X[B]); X[B+1]=EX(X[B+1]); X[B+2]=EX(X[B+2]); X[B+3]=EX(X[B+3]); PIN(X); SBAR(); }while(0)
  #define VRD(i) do{ vlo[i]=vtr(vp_+(((i)>>2)*4096+((i)&3)*1024)); vhi[i]=vtr(vp_+(((i)>>2)*4096+((i)&3)*1024+512)); }while(0)
  #define KRD(G,j) do{ if(G){ kload2(kf,kp0+sl_next,j); SBAR(); } }while(0)
  #define STEP(C0,C1,P0,P1,t,GK,GV,GL) do{ SBAR(); \
    CINIT(C0,C1,t); SBAR(); \
    const lds_cptr vp_=vp0+sl_prev; \
    VRD(0); SBAR(); float sacc=(P0[0]+P0[1]); \
    GAPA(C0=__builtin_amdgcn_mfma_f32_32x32x16_bf16(kf[0],qr[0],C0,0,0,0), P0[2],P0[3],P0[4],P0[5],     pw0[0]=PKW(P0,0), pw0[1]=PKW(P0,2), pw0); \
    VRD(4); SBAR(); GAPA(C1=__builtin_amdgcn_mfma_f32_32x32x16_bf16(kf[1],qr[0],C1,0,0,0), P0[6],P0[7],P0[8],P0[9],     pw0[2]=PKW(P0,4), pw0[3]=PKW(P0,6), pw0); \
    VRD(1); SBAR(); GAPA(C0=__builtin_amdgcn_mfma_f32_32x32x16_bf16(kf[2],qr[1],C0,0,0,0),   P0[10],P0[11],P0[12],P0[13], pw1[0]=PKW(P0,8), pw1[1]=PKW(P0,10), pw1); \
    VRD(5); SBAR(); GAPA(C1=__builtin_amdgcn_mfma_f32_32x32x16_bf16(kf[3],qr[1],C1,0,0,0),   P0[14],P0[15],P1[0],P1[1],   pw1[2]=PKW(P0,12),pw1[3]=PKW(P0,14), pw1); \
    VRD(2); SBAR(); GAPA(C0=__builtin_amdgcn_mfma_f32_32x32x16_bf16(kf[4],qr[2],C0,0,0,0),   P1[2],P1[3],P1[4],P1[5],     pw2[0]=PKW(P1,0), pw2[1]=PKW(P1,2), pw2); \
    VRD(6); SBAR(); GAPA(C1=__builtin_amdgcn_mfma_f32_32x32x16_bf16(kf[5],qr[2],C1,0,0,0),   P1[6],P1[7],P1[8],P1[9],     pw2[2]=PKW(P1,4), pw2[3]=PKW(P1,6), pw2); \
    VRD(3); SBAR(); GAPA(C0=__builtin_amdgcn_mfma_f32_32x32x16_bf16(kf[6],qr[3],C0,0,0,0),   P1[10],P1[11],P1[12],P1[13], pw3[0]=PKW(P1,8), pw3[1]=PKW(P1,10), pw3); \
    VRD(7); SBAR(); GAPA(C1=__builtin_amdgcn_mfma_f32_32x32x16_bf16(kf[7],qr[3],C1,0,0,0),   P1[14],P1[15],0.f,0.f,       pw3[2]=PKW(P1,12),pw3[3]=PKW(P1,14), pw3); \
    l_reg+=sacc; \
    if(GK){DMA_K((t)+3,sl_cur);} if(GV){DMA_V((t)+1,sl_next);} \
    { float a=MX3(C0[0],C0[1],C1[0]),b=MX3(C0[2],C0[3],C1[1]); a=MX3(a,C1[2],C1[3]); \
      _Pragma("unroll") for(int r=4;r<16;r+=4){a=MX3(a,C0[r],C0[r+1]);b=MX3(b,C0[r+2],C0[r+3]);a=MX3(a,C1[r],C1[r+1]);b=MX3(b,C1[r+2],C1[r+3]);} \
      float rm=__builtin_fmaxf(a,b); { auto rr=__builtin_amdgcn_permlane32_swap(__float_as_uint(rm),__float_as_uint(rm),false,false); rm=__builtin_fmaxf(__uint_as_float(rr[0]),__uint_as_float(rr[1])); } \
      resc=false; \
      if(__builtin_expect(__any(rm>(float)THRL),0)){ const float dl=__builtin_fmaxf(rm,0.f); mhat+=dl; \
        _Pragma("unroll") for(int r=0;r<16;++r){C0[r]-=dl;C1[r]-=dl;} \
        const float f=__builtin_amdgcn_exp2f(-dl); l_reg*=f; if(hi==0)wsf[r32]=f; resc=true; } } \
    SBAR(); \
    GAPB(o[0]=__builtin_amdgcn_mfma_f32_32x32x16_bf16(PAF(0),VFR(0),o[0],0,0,0), C0,0); \
    GAPB(o[1]=__builtin_amdgcn_mfma_f32_32x32x16_bf16(PAF(0),VFR(4),o[1],0,0,0), C0,4); \
    KRD(GL,0); GAPB(o[0]=__builtin_amdgcn_mfma_f32_32x32x16_bf16(PAF(1),VFR(1),o[0],0,0,0), C0,8); \
    KRD(GL,1); GAPB(o[1]=__builtin_amdgcn_mfma_f32_32x32x16_bf16(PAF(1),VFR(5),o[1],0,0,0), C0,12); \
    KRD(GL,2); GAPB(o[0]=__builtin_amdgcn_mfma_f32_32x32x16_bf16(PAF(2),VFR(2),o[0],0,0,0), C1,0); \
    KRD(GL,3); GAPB(o[1]=__builtin_amdgcn_mfma_f32_32x32x16_bf16(PAF(2),VFR(6),o[1],0,0,0), C1,4); \
    GAPB(o[0]=__builtin_amdgcn_mfma_f32_32x32x16_bf16(PAF(3),VFR(3),o[0],0,0,0), C1,8); \
    GAPB(o[1]=__builtin_amdgcn_mfma_f32_32x32x16_bf16(PAF(3),VFR(7),o[1],0,0,0), C1,12); \
    }while(0)
  int t=1;
  for(;t+5<NT;t+=2){
    STEP(pB0,pB1,pA0,pA1,t,true,true,true);     WAIT_BAR(2); RESC(); ROT();
    STEP(pA0,pA1,pB0,pB1,t+1,true,true,true);   WAIT_BAR(2); RESC(); ROT();
  }
  #define ENDW(tt) do{ if((tt)+3<NT){WAIT_BAR(2);} else if((tt)+2<NT){WAIT_BAR(1);} else {WAIT_BAR(0);} }while(0)
  for(;t+1<NT;t+=2){
    STEP(pB0,pB1,pA0,pA1,t,(t+3<NT),(t+1<NT),(t+1<NT));       ENDW(t);   RESC(); ROT();
    STEP(pA0,pA1,pB0,pB1,t+1,(t+4<NT),(t+2<NT),(t+2<NT));     ENDW(t+1); RESC(); ROT();
  }
  STEP(pB0,pB1,pA0,pA1,NT-1,false,false,false); RESC();
  { float sacc=pB0[0]+pB0[1]; _Pragma("unroll") for(int r=2;r<16;++r)sacc+=pB0[r]; _Pragma("unroll") for(int r=0;r<16;++r)sacc+=pB1[r]; l_reg+=sacc;
    pw0=(u32x4){PKW(pB0,0),PKW(pB0,2),PKW(pB0,4),PKW(pB0,6)};pw1=(u32x4){PKW(pB0,8),PKW(pB0,10),PKW(pB0,12),PKW(pB0,14)};pw2=(u32x4){PKW(pB1,0),PKW(pB1,2),PKW(pB1,4),PKW(pB1,6)};pw3=(u32x4){PKW(pB1,8),PKW(pB1,10),PKW(pB1,12),PKW(pB1,14)};
    SBAR(); pv(o,vb0+sl_cur,PAF(0),PAF(1),PAF(2),PAF(3)); }
  #undef PKW
  #undef PAF
  #undef VFR
  #undef PIN
  #undef MX3
  #undef GAPA
  #undef GAPB
  #undef EX
  #undef VRD
  #undef KRD
  #undef STEP
  #undef ENDW
  {auto rr=__builtin_amdgcn_permlane32_swap(__float_as_uint(l_reg),__float_as_uint(l_reg),false,false);l_reg=__uint_as_float(rr[0])+__uint_as_float(rr[1]);}
  if(hi==0)wsf[32+r32]=l_reg;asm volatile("s_waitcnt lgkmcnt(0)":::"memory");
  float rli[16];
  #pragma unroll
  for(int r=0;r<16;++r)rli[r]=__builtin_amdgcn_rcpf(wsf[32+crow(r,hi)]);
  abf*Ow=Ow0+(long)(wid*QBLK)*OP;
  { abf*stg=(abf*)(shm+LDS_OST)+wid*2048;
    #pragma unroll
    for(int r=0;r<16;++r){const int orow=crow(r,hi);
      #pragma unroll
      for(int d0=0;d0<2;++d0)stg[orow*64+d0*32+r32]=(abf)f2bf(o[d0][r]*rli[r]);}
    asm volatile("s_waitcnt lgkmcnt(0)":::"memory");
    #pragma unroll
    for(int i=0;i<4;++i){const int row=i*8+(lane>>3),ch=lane&7; const u32x4 v=*(const u32x4*)(stg+row*64+ch*8); ATTN_STORE16(Ow+(long)row*OP+ch*8,v);} }
  asm volatile("s_waitcnt lgkmcnt(0)\n\ts_barrier":::"memory");
  #undef DMA_K
  #undef DMA_V
  #undef CINIT
  #undef START
  #undef RESC
  #undef ROT
}
constexpr int ATTN_LDS_BYTES=LDS_BYTES;
#undef SBAR
#undef WAIT_BAR
}

struct Frame {
    LAS unsigned char* lds; char* ldsg;
    volatile LAS unsigned* MISC;
    gu32* ctl;
    int tid, lane, wave, vcu, G;
    const float* in[23]; float* out; unsigned char* ws;
};
#define WSP(T_, off) ((T_*)(F.ws + (off)))

template <int MODE>
__device__ __forceinline__ void p0_transpose_item(const float* W, int K, int N, bf16* WT, LAS float* scr, int item, int lane) {
    const int nblk = N / 32, kb = item / nblk, nb = item % nblk, k0 = 64 * kb, n0 = 32 * nb;
#pragma unroll 8
    for (int i = 0; i < 32; ++i) { const int kk = 2 * i + (lane >> 5); scr[kk * 33 + (lane & 31)] = W[(size_t)(k0 + kk) * N + n0 + (lane & 31)]; }
    asm volatile("s_waitcnt lgkmcnt(0)" ::: "memory");
    const int c = lane & 7;
#pragma unroll
    for (int j = 0; j < 4; ++j) { const int n = (lane >> 3) + 8 * j; const LAS float* s = scr + (8 * c) * 33 + n;
        v4u o; o.x = pk2(s[0 * 33], s[1 * 33]); o.y = pk2(s[2 * 33], s[3 * 33]); o.z = pk2(s[4 * 33], s[5 * 33]); o.w = pk2(s[6 * 33], s[7 * 33]);
        int col = n0 + n, drow = col;
        if (MODE == 1) { const int pn = col >> 8, w = col & 255; drow = 256 * pn + 128 * (w & 1) + (w >> 1); }
        *(GAS v4u*)(WT + (size_t)drow * K + k0 + 8 * c) = o; }
    asm volatile("s_waitcnt lgkmcnt(0)" ::: "memory");
}
__device__ __forceinline__ void row_to_bf16(const float* xrow, bf16* orow, int lane) {
    const GAS f32x4* xr = (const GAS f32x4*)xrow + lane;
    GAS v2u* o8 = (GAS v2u*)orow + lane;
#pragma unroll
    for (int j = 0; j < 4; ++j) { const f32x4 v = xr[64 * j]; v2u w; w.x = pk2(v.x, v.y); w.y = pk2(v.z, v.w); o8[64 * j] = w; }
}
__device__ __forceinline__ void p0_prologue(Frame& F) {
    LAS float* scr = (LAS float*)(F.lds + F.wave * 16384);
    const int gw = F.vcu * NWAVES + F.wave, NGW = F.G * NWAVES;
    constexpr int I_IN = 16 * (NIN / 32), I_KV = 16 * (512 / 32), I_O = 16 * (1024 / 32), I_GU = 16 * (2048 / 32), I_DN = 16 * (1024 / 32);
    constexpr int NITEMS = I_IN + I_KV + I_O + NE * I_GU + NE * I_DN;
    for (int it = gw; it < NITEMS; it += NGW) {
        int r = it;
        if (r < I_IN) { p0_transpose_item<0>(F.in[2], DM, NIN, WSP(bf16, WS_WIN), scr, r, F.lane); continue; } r -= I_IN;
        if (r < I_KV) { p0_transpose_item<0>(F.in[11], DM, 512, WSP(bf16, WS_WKV), scr, r, F.lane); continue; } r -= I_KV;
        if (r < I_O) { p0_transpose_item<0>(F.in[12], DM, DM, WSP(bf16, WS_WO), scr, r, F.lane); continue; } r -= I_O;
        if (r < NE * I_GU) { const int e = r / I_GU; p0_transpose_item<1>(F.in[17] + (size_t)e * DM * 2048, DM, 2048, WSP(bf16, WS_WGU) + (size_t)e * 2048 * DM, scr, r % I_GU, F.lane); continue; } r -= NE * I_GU;
        { const int e = r / I_DN; p0_transpose_item<0>(F.in[19] + (size_t)e * DM * DM, DM, DM, WSP(bf16, WS_WDN) + (size_t)e * DM * DM, scr, r % I_DN, F.lane); }
    }
    for (int m = gw; m < T; m += NGW) row_to_bf16(F.in[0] + (size_t)m * DM, WSP(bf16, WS_XB) + (size_t)m * DM, F.lane);
    for (int m = gw; m < NB * MEML; m += NGW) row_to_bf16(F.in[1] + (size_t)m * DM, WSP(bf16, WS_MEMB) + (size_t)m * DM, F.lane);
}

__device__ __forceinline__ void p1_inproj(Frame& F) {
    { pg8::Gemm g{WSP(bf16, WS_XB), WSP(bf16, WS_WIN), T, NIN, DM}; pg8::StaticOrder S; S.init(T, NIN, F.G, (int)blockIdx.x);
      pg8::EpiBf16 E{WSP(bf16, WS_U), NIN, (1u << 0) | (1u << 1) | (1u << 11), C2};
      pg8::gemm_phase<pg8::EpiBf16, pg8::StaticOrder, true, true>(F.lds, g, S, E); }
    { pg8::Gemm g{WSP(bf16, WS_MEMB), WSP(bf16, WS_WKV), NB * MEML, 512, DM}; pg8::StaticOrder S; S.init(NB * MEML, 512, F.G, (int)blockIdx.x);
      pg8::EpiBf16 E{WSP(bf16, WS_MKV), 512, 0u, 1.f};
      pg8::gemm_phase<pg8::EpiBf16, pg8::StaticOrder, true, true>(F.lds, g, S, E); }
}

constexpr int HCH = 64, NCH = SEQ / HCH, HU_STRIDE = 64 * 64 + 64;
template <bool OUT>
__device__ __forceinline__ void hgrn_chunk(const bf16* U, int b, int h, int dir, int c, float lb, float (&S)[64], float& aprod, LAS float* OL, int lane) {
#pragma unroll 2
    for (int i = 0; i < HCH; ++i) {
        const int t = dir ? HCH * c + HCH - 1 - i : HCH * c + i; const size_t row = (size_t)b * SEQ + t;
        const bf16* ur = U + row * NIN;
        const float hf = bf2f(ur[U_HF + dir * 256 + h * 64 + lane]), vi = bf2f(ur[U_HI + h * 64 + lane]);
        const float fl = lb + (1.f - lb) * sigmoidf_(hf); aprod *= fl;
        float ql = 0.f; if (OUT) { const float hq = bf2f(ur[U_HQ + h * 64 + lane]); ql = hq * sigmoidf_(hq); }
        float o = 0.f;
#pragma unroll
        for (int d = 0; d < 64; ++d) { const float fd = __int_as_float(__builtin_amdgcn_readlane(__float_as_int(fl), d));
            S[d] = fd * S[d] + (1.f - fd) * vi;
            if (OUT) { const float qd = __int_as_float(__builtin_amdgcn_readlane(__float_as_int(ql), d)); o += qd * S[d]; } }
        if (OUT) OL[i * 64 + lane] = o;
    }
}
__device__ __forceinline__ float hgrn_lb(Frame& F, int h, int dir, int lane) {
    const float* lbp = dir ? F.in[9] : F.in[8];
    const float a0 = lbp[h * 64 + lane], a1 = lbp[256 + h * 64 + lane];
    return 1.f / (1.f + __expf(a1 - a0));
}
__device__ __forceinline__ void p2_hgrn_local(Frame& F) {
    const int gw = F.vcu * NWAVES + F.wave, NGW = F.G * NWAVES, lane = F.lane;
    for (int u = gw; u < 32 * NCH; u += NGW) {
        const int seq = u / NCH, cp = u % NCH, b = seq >> 3, h = (seq >> 1) & 3, dir = seq & 1, c = dir ? NCH - 1 - cp : cp;
        const float lb = hgrn_lb(F, h, dir, lane);
        float S[64];
#pragma unroll
        for (int d = 0; d < 64; ++d) S[d] = 0.f;
        float aprod = 1.f;
        hgrn_chunk<false>(WSP(bf16, WS_U), b, h, dir, c, lb, S, aprod, nullptr, lane);
        float* hu = WSP(float, WS_HU) + (size_t)u * HU_STRIDE;
#pragma unroll
        for (int d = 0; d < 64; ++d) hu[d * 64 + lane] = S[d];
        hu[4096 + lane] = aprod;
    }
}
__device__ __forceinline__ void hgrn_scan(Frame& F) {
    for (int idx = F.vcu * NTHREADS + F.tid; idx < 32 * 4096; idx += F.G * NTHREADS) {
        const int seq = idx >> 12, dv = idx & 4095, d = dv >> 6;
        const float* hu = WSP(float, WS_HU) + (size_t)seq * NCH * HU_STRIDE; float* ss = WSP(float, WS_SS) + (size_t)seq * NCH * 4096 + dv;
        float st = 0.f;
#pragma unroll 8
        for (int cp = 0; cp < NCH; ++cp) { ss[(size_t)cp * 4096] = st; st = hu[(size_t)cp * HU_STRIDE + 4096 + d] * st + hu[(size_t)cp * HU_STRIDE + dv]; }
    }
}
__device__ __forceinline__ void p3_attn(Frame& F) {
    hgrn_scan(F);
    const bf16* U = WSP(bf16, WS_U);
    const bf16* MKV = WSP(bf16, WS_MKV);
    for (int u = F.vcu; u < 256; u += F.G) {
        const int b = u >> 6, h = (u >> 4) & 3, qb = u & 15; const size_t row0 = (size_t)b * SEQ + qb * 256;
#pragma unroll 1
        for (int j = 0; j < 5; ++j) {
            const bf16 *Qp, *Kp, *Vp; bf16* Op; int KP, VP, NT; float c2;
            if (j == 0) { Qp = U + row0 * NIN + U_MQ + h * 64; Kp = MKV + (size_t)b * MEML * 512 + h * 64; Vp = Kp + 256; Op = WSP(bf16, WS_CAT) + row0 * DM + 768 + h * 64; KP = 512; VP = 512; NT = MEML / 64; c2 = 0.f; }
            else { const int m = (j - 1) >> 1, vh = (j - 1) & 1; Qp = U + row0 * NIN + U_DQ + h * 128 + m * 64; Kp = U + (size_t)b * SEQ * NIN + U_DK + h * 128 + m * 64; Vp = U + (size_t)b * SEQ * NIN + U_DV + h * 128 + vh * 64;
                Op = WSP(bf16, WS_OD) + row0 * DM + h * 256 + m * 128 + vh * 64; KP = NIN; VP = NIN; NT = SEQ / 64; c2 = __builtin_ldexpf(LOG2E, -2 * (h + 1)); }
            attn_body::attn_unit<8>(Qp, NIN, Kp, KP, Vp, VP, Op, DM, NT, c2, qb * 256, F.ldsg);
        }
    }
}
__device__ __forceinline__ void hgrn_out(Frame& F) {
    const int lane = F.lane, wave = F.wave;
    LAS float* OL = (LAS float*)(F.lds + wave * 16384);
    for (int u0 = F.vcu * NWAVES; u0 < 32 * NCH; u0 += F.G * NWAVES) {
        const int u = u0 + wave, bhc = u >> 1, dir = u & 1, b = bhc / (4 * NCH), h = (bhc / NCH) & 3, c = bhc % NCH, cp = dir ? NCH - 1 - c : c, seq = b * 8 + h * 2 + dir;
        const float lb = hgrn_lb(F, h, dir, lane);
        const float* ss = WSP(float, WS_SS) + ((size_t)seq * NCH + cp) * 4096;
        float S[64];
#pragma unroll
        for (int d = 0; d < 64; ++d) S[d] = ss[d * 64 + lane];
        float aprod = 1.f;
        hgrn_chunk<true>(WSP(bf16, WS_U), b, h, dir, c, lb, S, aprod, OL, lane);
        __syncthreads();
        const LAS float* Of = (const LAS float*)(F.lds + (wave & ~1) * 16384); const LAS float* Ob = Of + 4096;
        const float nw = F.in[10][h * 64 + lane];
        for (int k = 0; k < 32; ++k) { const int tl = dir * 32 + k; const size_t row = (size_t)b * SEQ + c * HCH + tl;
            const float o = Of[tl * 64 + lane] + Ob[(HCH - 1 - tl) * 64 + lane];
            const float ss2 = wave_sum(o * o), r = rsqrtf(ss2 * (1.f / 64.f) + EPS);
            const float g = sigmoidf_(bf2f(WSP(bf16, WS_U)[row * NIN + U_HG + h * 64 + lane]));
            WSP(bf16, WS_CAT)[row * DM + 512 + h * 64 + lane] = (bf16)f2bf(o * r * nw * g); }
        __syncthreads();
    }
}

__device__ __forceinline__ void p4_combine(Frame& F) {
    hgrn_out(F);
    const int gw = F.vcu * NWAVES + F.wave, NGW = F.G * NWAVES, lane = F.lane;
    const float sa = wave_sum(F.in[3][lane] * F.in[4][lane]), sb = wave_sum(F.in[5][lane] * F.in[6][lane]);
    const float lam = __expf(sa) - __expf(sb) + 0.2f;
    const bf16* OD = WSP(bf16, WS_OD); bf16* CAT = WSP(bf16, WS_CAT);
    const float dnw0 = F.in[7][lane], dnw1 = F.in[7][lane + 64];
    for (int row = gw; row < T; row += NGW) {
#pragma unroll
        for (int h = 0; h < 4; ++h) {
            const bf16* p0 = OD + (size_t)row * DM + h * 256; const bf16* p1 = p0 + 128;
            const float o0 = bf2f(p0[lane]) - lam * bf2f(p1[lane]), o1 = bf2f(p0[lane + 64]) - lam * bf2f(p1[lane + 64]);
            const float ss = wave_sum(o0 * o0 + o1 * o1), r = rsqrtf(ss * (1.f / 128.f) + EPS) * 0.8f;
            CAT[(size_t)row * DM + h * 128 + lane] = (bf16)f2bf(o0 * r * dnw0); CAT[(size_t)row * DM + h * 128 + 64 + lane] = (bf16)f2bf(o1 * r * dnw1);
        }
    }
}

__device__ __forceinline__ void p4_wo(Frame& F) {
    pg8::Gemm g{WSP(bf16, WS_CAT), WSP(bf16, WS_WO), T, DM, DM}; pg8::StaticOrder S; S.init(T, DM, F.G, (int)blockIdx.x);
    pg8::EpiResF32 E{F.in[0], WSP(float, WS_Z1), DM, ALPHA};
    pg8::gemm_phase<pg8::EpiResF32, pg8::StaticOrder, true, true>(F.lds, g, S, E);
}

__device__ __forceinline__ void ln_row(f32x4 (&v)[4], const float* g, const float* bb, int lane, float& mean, float& rstd) {
    float s = 0.f;
#pragma unroll
    for (int j = 0; j < 4; ++j) s += (v[j].x + v[j].y) + (v[j].z + v[j].w);
    mean = wave_sum(s) * (1.f / DM); float s2 = 0.f;
#pragma unroll
    for (int j = 0; j < 4; ++j) { v[j] = v[j] - mean; s2 += (v[j].x * v[j].x + v[j].y * v[j].y) + (v[j].z * v[j].z + v[j].w * v[j].w); }
    rstd = rsqrtf(wave_sum(s2) * (1.f / DM) + EPS);
#pragma unroll
    for (int j = 0; j < 4; ++j) { const f32x4 gv = *(const GAS f32x4*)(g + 4 * lane + 256 * j), bv = *(const GAS f32x4*)(bb + 4 * lane + 256 * j); v[j] = v[j] * rstd * gv + bv; }
}

__device__ __forceinline__ void p5_router(Frame& F) {
    LAS float* rw = (LAS float*)F.lds;
    for (int i = F.tid; i < DM * 8; i += NTHREADS) { const int col = i >> 3, e4 = i & 7; const int l = (col & 255) >> 2, q = 4 * (col >> 8) + (col & 3);
        const f32x4 w = *(const GAS f32x4*)(F.in[15] + (size_t)col * 32 + e4 * 4);
        *(LAS f32x4*)&rw[(q * 64 + l) * 32 + ((e4 ^ ((l >> 1) & 7)) * 4)] = w; }
    __syncthreads();
    const int gw = F.vcu * NWAVES + F.wave, NGW = F.G * NWAVES, lane = F.lane;
    int* TOPI = WSP(int, WS_ROUTE); float* TOPG = WSP(float, WS_ROUTE + 256 * 1024); int* RANK = WSP(int, WS_ROUTE + 512 * 1024); float* STATS = WSP(float, WS_ROUTE + 768 * 1024);
    const float rbias = F.in[16][lane >> 1];
    for (int row = gw; row < T; row += NGW) {
        f32x4 v[4];
#pragma unroll
        for (int j = 0; j < 4; ++j) v[j] = *(const GAS f32x4*)(WSP(float, WS_Z1) + (size_t)row * DM + 4 * lane + 256 * j);
        float mean, rstd; ln_row(v, F.in[13], F.in[14], lane, mean, rstd);
        if (lane == 0) { STATS[2 * row] = mean; STATS[2 * row + 1] = rstd; }
        float acc[32];
#pragma unroll
        for (int e = 0; e < 32; ++e) acc[e] = 0.f;
#pragma unroll
        for (int j = 0; j < 4; ++j)
#pragma unroll
            for (int c = 0; c < 4; ++c) { const float hv = v[j][c]; const int q = 4 * j + c;
#pragma unroll
                for (int e4 = 0; e4 < 8; ++e4) { const f32x4 w = *(const LAS f32x4*)&rw[(q * 64 + lane) * 32 + ((e4 ^ ((lane >> 1) & 7)) * 4)];
                    acc[4 * e4 + 0] += hv * w.x; acc[4 * e4 + 1] += hv * w.y; acc[4 * e4 + 2] += hv * w.z; acc[4 * e4 + 3] += hv * w.w; }
                asm volatile("" ::: "memory"); }
        float r16[16];
#pragma unroll
        for (int i = 0; i < 16; ++i) { const bool up = (lane & 32) != 0; const float keep = up ? acc[16 + i] : acc[i], send = up ? acc[i] : acc[16 + i]; r16[i] = keep + __shfl_xor(send, 32); }
        float r8[8];
#pragma unroll
        for (int i = 0; i < 8; ++i) { const bool up = (lane & 16) != 0; const float keep = up ? r16[8 + i] : r16[i], send = up ? r16[i] : r16[8 + i]; r8[i] = keep + __shfl_xor(send, 16); }
        float r4[4];
#pragma unroll
        for (int i = 0; i < 4; ++i) { const bool up = (lane & 8) != 0; const float keep = up ? r8[4 + i] : r8[i], send = up ? r8[i] : r8[4 + i]; r4[i] = keep + __shfl_xor(send, 8); }
        float r2[2];
#pragma unroll
        for (int i = 0; i < 2; ++i) { const bool up = (lane & 4) != 0; const float keep = up ? r4[2 + i] : r4[i], send = up ? r4[i] : r4[2 + i]; r2[i] = keep + __shfl_xor(send, 4); }
        float r1; { const bool up = (lane & 2) != 0; const float keep = up ? r2[1] : r2[0], send = up ? r2[0] : r2[1]; r1 = keep + __shfl_xor(send, 2); }
        float logit = r1 + __shfl_xor(r1, 1) + rbias;
        float tv[4]; int ti[4]; float cur = logit; const int myi = lane >> 1;
#pragma unroll
        for (int k = 0; k < 4; ++k) {
            float bv = cur; int bi = myi;
#pragma unroll
            for (int o = 1; o < 64; o <<= 1) { const float ov = __shfl_xor(bv, o); const int oi = __shfl_xor(bi, o); if (ov > bv || (ov == bv && oi < bi)) { bv = ov; bi = oi; } }
            tv[k] = bv; ti[k] = bi; if (myi == bi) cur = -INFINITY;
        }
        const float e1 = __expf(tv[1] - tv[0]), e2 = __expf(tv[2] - tv[0]), e3 = __expf(tv[3] - tv[0]); const float inv = 1.f / (1.f + e1 + e2 + e3);
        if (lane < 4) { const int e = lane == 0 ? ti[0] : lane == 1 ? ti[1] : lane == 2 ? ti[2] : ti[3]; const float g = (lane == 0 ? 1.f : lane == 1 ? e1 : lane == 2 ? e2 : e3) * inv;
            const unsigned rk = __hip_atomic_fetch_add((unsigned*)(F.ctl + CW_CNT + e), 1u, RLX_AGENT);
            TOPI[row * 4 + lane] = e; TOPG[row * 4 + lane] = g; RANK[row * 4 + lane] = (int)rk; }
    }
    __syncthreads();
}

__device__ __forceinline__ void p6_dispatch(Frame& F) {
    LAS int* pst = (LAS int*)F.lds;
    if (F.tid == 0) { int acc = 0; for (int e = 0; e < NE; ++e) { pst[e] = acc; const int c = (int)__hip_atomic_load((unsigned*)(F.ctl + CW_CNT + e), RLX_AGENT); acc += (c + 255) / 256 * 256; } pst[NE] = acc; }
    __syncthreads();
    int* ROWSLOT = WSP(int, WS_ROWS); float* ROWGATE = WSP(float, WS_ROWS + MAXROWS * 4); int* BLKE = WSP(int, WS_ROWS + 2 * MAXROWS * 4); int* BLKV = BLKE + 512; int* NBLK = BLKE + 1024;
    if (blockIdx.x == 0 && F.tid < NE) { const int e = F.tid, c = (int)__hip_atomic_load((unsigned*)(F.ctl + CW_CNT + e), RLX_AGENT); const int b0 = pst[e] / 256, nb = (pst[e + 1] - pst[e]) / 256;
        for (int i = 0; i < nb; ++i) { BLKE[b0 + i] = e; BLKV[b0 + i] = min(256, c - 256 * i); }
        if (e == 0) NBLK[0] = pst[NE] / 256; }
    const int gw = F.vcu * NWAVES + F.wave, NGW = F.G * NWAVES, lane = F.lane;
    const int* TOPI = WSP(int, WS_ROUTE); const float* TOPG = WSP(float, WS_ROUTE + 256 * 1024); const int* RANK = WSP(int, WS_ROUTE + 512 * 1024);
    for (int row = gw; row < T; row += NGW) {
        f32x4 v[4];
#pragma unroll
        for (int j = 0; j < 4; ++j) v[j] = *(const GAS f32x4*)(WSP(float, WS_Z1) + (size_t)row * DM + 4 * lane + 256 * j);
        float mean, rstd; ln_row(v, F.in[13], F.in[14], lane, mean, rstd);
        v2u w[4];
#pragma unroll
        for (int j = 0; j < 4; ++j) { w[j].x = pk2(v[j].x, v[j].y); w[j].y = pk2(v[j].z, v[j].w); }
#pragma unroll
        for (int k = 0; k < 4; ++k) { const int e = TOPI[row * 4 + k], dest = pst[e] + RANK[row * 4 + k];
            GAS v2u* o8 = (GAS v2u*)(WSP(bf16, WS_XS) + (size_t)dest * DM) + lane;
#pragma unroll
            for (int j = 0; j < 4; ++j) o8[64 * j] = w[j];
            if (lane == 0) { ROWSLOT[dest] = row * 4 + k; ROWGATE[dest] = TOPG[row * 4 + k]; } }
    }
    __syncthreads();
}

__device__ __forceinline__ void p7_gateup(Frame& F) {
    const int* BLKE = WSP(int, WS_ROWS + 2 * MAXROWS * 4); const int nblk = __builtin_amdgcn_readfirstlane(BLKE[1024]);
    pg8::Gemm g{WSP(bf16, WS_XS), WSP(bf16, WS_WGU), MAXROWS, 2048, DM}; pg8::MoeOrder S{BLKE, nblk * 8, 8, F.G / 8, (int)blockIdx.x};
    pg8::EpiGateUp E{WSP(bf16, WS_ACT), F.in[18]};
    pg8::gemm_phase<pg8::EpiGateUp, pg8::MoeOrder, true, true>(F.lds, g, S, E);
}

__device__ __forceinline__ void p8_down(Frame& F) {
    const int* BLKE = WSP(int, WS_ROWS + 2 * MAXROWS * 4); const int nblk = __builtin_amdgcn_readfirstlane(BLKE[1024]);
    pg8::Gemm g{WSP(bf16, WS_ACT), WSP(bf16, WS_WDN), MAXROWS, 1024, DM}; pg8::MoeOrder S{BLKE, nblk * 4, 4, F.G / 8, (int)blockIdx.x};
    pg8::EpiDown E{WSP(bf16, WS_Y), F.in[20], WSP(int, WS_ROWS), WSP(float, WS_ROWS + MAXROWS * 4), BLKE + 512};
    pg8::gemm_phase<pg8::EpiDown, pg8::MoeOrder, true, true>(F.lds, g, S, E);
}

__device__ __forceinline__ void p9_final(Frame& F) {
    const int gw = F.vcu * NWAVES + F.wave, NGW = F.G * NWAVES, lane = F.lane;
    for (int row = gw; row < T; row += NGW) {
        f32x4 v[4];
#pragma unroll
        for (int j = 0; j < 4; ++j) v[j] = *(const GAS f32x4*)(WSP(float, WS_Z1) + (size_t)row * DM + 4 * lane + 256 * j);
        float mean, rstd; ln_row(v, F.in[13], F.in[14], lane, mean, rstd);
#pragma unroll
        for (int j = 0; j < 4; ++j) v[j] = v[j] * ALPHA;
#pragma unroll
        for (int k = 0; k < 4; ++k) { const GAS v2u* y8 = (const GAS v2u*)(WSP(bf16, WS_Y) + (size_t)(row * 4 + k) * DM) + lane;
#pragma unroll
            for (int j = 0; j < 4; ++j) { const v2u w = y8[64 * j]; v[j].x += bflo(w.x); v[j].y += bfhi(w.x); v[j].z += bflo(w.y); v[j].w += bfhi(w.y); } }
        ln_row(v, F.in[21], F.in[22], lane, mean, rstd);
#pragma unroll
        for (int j = 0; j < 4; ++j) *(GAS f32x4*)(F.out + (size_t)row * DM + 4 * lane + 256 * j) = v[j];
    }
}

constexpr int NPHASE = 11;
struct Args { const float* in[23]; float* out; unsigned char* ws; int ph_lo, ph_hi; };
__global__ void __launch_bounds__(NTHREADS, 2) mega_fwd(Args args) {
    extern __shared__ __attribute__((aligned(16))) unsigned char lds[];
    Frame F;
    F.lds = (LAS unsigned char*)lds; F.ldsg = (char*)lds; F.MISC = (volatile LAS unsigned*)(F.lds + MISC_OFF);
    F.tid = threadIdx.x; F.lane = F.tid & 63; F.wave = __builtin_amdgcn_readfirstlane(F.tid >> 6);
    F.G = gridDim.x; { const int bx = blockIdx.x; F.vcu = (F.G % 8 == 0) ? (bx % 8) * (F.G / 8) + bx / 8 : bx; }
    F.ws = args.ws; F.ctl = (gu32*)(args.ws + WS_CTL); F.out = args.out;
#pragma unroll
    for (int i = 0; i < 23; ++i) F.in[i] = args.in[i];
    for (int u = F.tid; u < (LDS_BYTES - LDSCTL_OFF) / 4; u += NTHREADS) ((LAS unsigned*)(F.lds + LDSCTL_OFF))[u] = 0u;
    __syncthreads();
    const bool single = (args.ph_lo == 0 && args.ph_hi == NPHASE);
    XcdBarrier bar; bar.bar = (unsigned*)(F.ctl + CW_BAR); bar.x = 0; bar.st = nullptr;
    if (single) bar = xcd_barrier_post((unsigned*)(F.ctl + CW_BAR), F.MISC + 8);
    const int lo = args.ph_lo, hi = args.ph_hi;
#ifndef PH_MASK
#define PH_MASK 0x7ff
#endif
#define IN(k) (((PH_MASK >> (k)) & 1) && lo <= (k) && (k) < hi)
#define SEAM(k) do { if (IN(k) && IN((k) + 1)) xcd_barrier(bar); } while (0)
    if (IN(0)) { p0_prologue(F); } SEAM(0);
    if (IN(1)) { p1_inproj(F); } SEAM(1);
    if (IN(2)) { p2_hgrn_local(F); } SEAM(2);
    if (IN(3)) { p3_attn(F); } SEAM(3);
    if (IN(4)) { p4_combine(F); } SEAM(4);
    if (IN(5)) { p4_wo(F); } SEAM(5);
    if (IN(6)) { p5_router(F); } SEAM(6);
    if (IN(7)) { p6_dispatch(F); } SEAM(7);
    if (IN(8)) { p7_gateup(F); } SEAM(8);
    if (IN(9)) { p8_down(F); } SEAM(9);
    if (IN(10)) { p9_final(F); }
#undef IN
#undef SEAM
}

#ifndef MK_MULTI
#define MK_MULTI 0
#endif
extern "C" void kernel_launch(void* const* d_in, const int* in_sizes, int n_in, void* d_out, int out_size, void* d_ws, size_t ws_size, hipStream_t stream) {
    static int grid = 0;
    if (grid == 0) {
        if (n_in != 23 || out_size != T * DM || ws_size < WS_END) { fprintf(stderr, "kernel_launch: unexpected shapes n_in %d out %d ws %zu\n", n_in, out_size, ws_size); grid = -1; return; }
        int dev = 0, cus = 0;
        if (hipGetDevice(&dev) != hipSuccess || hipDeviceGetAttribute(&cus, hipDeviceAttributeMultiprocessorCount, dev) != hipSuccess) { grid = -1; return; }
        if (hipFuncSetAttribute((const void*)mega_fwd, hipFuncAttributeMaxDynamicSharedMemorySize, LDS_BYTES) != hipSuccess) { fprintf(stderr, "kernel_launch: hipFuncSetAttribute failed\n"); grid = -1; return; }
        int per_cu = 0;
        if (hipOccupancyMaxActiveBlocksPerMultiprocessor(&per_cu, (const void*)mega_fwd, NTHREADS, LDS_BYTES) != hipSuccess || per_cu < 1) fprintf(stderr, "kernel_launch: occupancy query says %d\n", per_cu);
        (void)hipGetLastError();
        grid = cus;
    }
    if (grid < 0) return;
    (void)hipMemsetAsync((char*)d_ws + WS_CTL, 0, CTL_ZERO_BYTES, stream);
    Args a{};
    for (int i = 0; i < 23; ++i) a.in[i] = (const float*)d_in[i];
    a.out = (float*)d_out; a.ws = (unsigned char*)d_ws;
#if MK_MULTI
    for (int p = 0; p < NPHASE; ++p) { a.ph_lo = p; a.ph_hi = p + 1; hipLaunchKernelGGL(mega_fwd, dim3(grid), dim3(NTHREADS), LDS_BYTES, stream, a); }
#else
    a.ph_lo = 0; a.ph_hi = NPHASE;
    hipLaunchKernelGGL(mega_fwd, dim3(grid), dim3(NTHREADS), LDS_BYTES, stream, a);
#endif
}
```

```cpp
#include <hip/hip_runtime.h>
#include <cstdio>
#include <cstdint>

constexpr int NB = 4, SEQ = 4096, DM = 1024, T = NB * SEQ, MEML = 256, NIN = 3072, NE = 32, TOPK = 4;
constexpr int TK = T * TOPK, MAXBLK = TK / 256 + NE, MAXROWS = MAXBLK * 256;
constexpr float LOG2E = 1.4426950408889634f, C2 = 0.125f * LOG2E, ALPHA = 1.189207115002721f, EPS = 1e-5f;
constexpr int U_DQ = 0, U_DK = 512, U_DV = 1024, U_HQ = 1536, U_HF = 1792, U_HI = 2304, U_HG = 2560, U_MQ = 2816;

constexpr size_t MiB = 1u << 20;
constexpr size_t WS_CTL = 0, CTL_ZERO_BYTES = 1 * MiB;
constexpr size_t WS_WIN = 2 * MiB, WS_WKV = 8 * MiB, WS_WO = 10 * MiB, WS_MEMB = 12 * MiB, WS_MKV = 14 * MiB;
constexpr size_t WS_XB = 16 * MiB, WS_U = 48 * MiB, WS_OD = 144 * MiB, WS_CAT = 176 * MiB, WS_Z1 = 208 * MiB;
constexpr size_t WS_ROUTE = 272 * MiB;
constexpr size_t WS_RWT = WS_ROUTE + 1 * MiB;
constexpr size_t WS_HU = 280 * MiB;
constexpr size_t WS_WGU = 336 * MiB, WS_WDN = 464 * MiB, WS_XS = 528 * MiB, WS_ACT = 672 * MiB, WS_Y = 816 * MiB;
constexpr size_t WS_ROWS = 944 * MiB;
constexpr size_t WS_SS = WS_XS;
constexpr size_t WS_OH = WS_ACT;
constexpr size_t WS_END = 948 * MiB;
constexpr int CW_TMO = 0, CW_CODE = 1, CW_CNT = 64  , CW_KN = 128  , CW_QUEUE = 192  , CW_MKV = 256  , CW_CONVQ = 257  , CW_BAR = 4096;

constexpr int RING_BYTES = 131072, LDSCTL_OFF = RING_BYTES, MISC_OFF = LDSCTL_OFF + 320, LDS_BYTES = 147456;
constexpr int NWAVES = 8, NTHREADS = 512;

#define GAS __attribute__((address_space(1)))
#define LAS __attribute__((address_space(3)))
typedef unsigned short bf16;
typedef unsigned v4u __attribute__((ext_vector_type(4)));
typedef unsigned v2u __attribute__((ext_vector_type(2)));
typedef float f32x4 __attribute__((ext_vector_type(4)));
typedef GAS unsigned gu32;
#define RLX_AGENT __ATOMIC_RELAXED, __HIP_MEMORY_SCOPE_AGENT
__device__ __forceinline__ unsigned f2bf(float f) { unsigned u = __builtin_bit_cast(unsigned, f); return (u + 0x7fffu + ((u >> 16) & 1u)) >> 16; }
__device__ __forceinline__ unsigned pk2(float lo, float hi) { return f2bf(lo) | (f2bf(hi) << 16); }
__device__ __forceinline__ float bf2f(unsigned v) { return __uint_as_float(v << 16); }
__device__ __forceinline__ unsigned pk4_fp8(float a, float b, float c, float d) { int w = 0; w = __builtin_amdgcn_cvt_pk_fp8_f32(a, b, w, false); w = __builtin_amdgcn_cvt_pk_fp8_f32(c, d, w, true); return (unsigned)w; }
constexpr float WDN_SCALE = 64.f;
constexpr float WGU_SCALE = 32.f;
__device__ __forceinline__ float bflo(unsigned w) { return __uint_as_float(w << 16); }
__device__ __forceinline__ float bfhi(unsigned w) { return __uint_as_float(w & 0xffff0000u); }
__device__ __forceinline__ float wave_sum(float v) {
#pragma unroll
    for (int o = 1; o < 64; o <<= 1) v += __shfl_xor(v, o);
    return v;
}
__device__ __forceinline__ float wave_max(float v) {
#pragma unroll
    for (int o = 1; o < 64; o <<= 1) v = fmaxf(v, __shfl_xor(v, o));
    return v;
}
__device__ __forceinline__ float sigmoidf_(float x) { return 1.f / (1.f + __expf(-x)); }

#define XB_TMO      128
#define XB_XCNT(j)  (256  + 64 * (j))
#define XB_XSUB(j)  (1280 + 64 * (j))
#define XB_XGEN(j)  (2304 + 64 * (j))
#define XB_TOP      3328
#define XB_TOPGEN   3392
#define XCD_BAR_WORDS 3456
#define XB_SPIN_CAP (1u << 20)
__device__ __forceinline__ unsigned xb_ld(unsigned* p)              { return __hip_atomic_load(p, __ATOMIC_RELAXED, __HIP_MEMORY_SCOPE_AGENT); }
__device__ __forceinline__ unsigned xb_add(unsigned* p, unsigned v) { return __hip_atomic_fetch_add(p, v, __ATOMIC_RELAXED, __HIP_MEMORY_SCOPE_AGENT); }
__device__ __forceinline__ unsigned xb_xcc_id() { return (unsigned)__builtin_amdgcn_s_getreg((3 << 11) | 20) & 0xFu; }
#define XB_SPIN(cond, bar) do { unsigned _sp = 0; while (cond) { __builtin_amdgcn_s_sleep(1); \
    if ((++_sp & 255u) == 0u) { if (xb_ld(&(bar)[XB_TMO])) break; if (_sp > XB_SPIN_CAP) { atomicAdd(&(bar)[XB_TMO], 1u); break; } } } } while (0)
struct XcdBarrier { unsigned* bar; unsigned x; volatile LAS unsigned* st; };
__device__ __forceinline__ XcdBarrier xcd_barrier_post(unsigned* bar, volatile LAS unsigned* st) {
    XcdBarrier b; b.bar = bar; b.x = xb_xcc_id(); b.st = st;
    if (threadIdx.x == 0) (void)xb_add(&bar[XB_XCNT(b.x)], 1u);
    return b;
}
__device__ __forceinline__ void xcd_barrier_complete(unsigned* bar, unsigned x, unsigned& nloc, unsigned& nx) {
    const unsigned G = gridDim.x * gridDim.y * gridDim.z;
    unsigned sum, cnt, mine, sp = 0u;
    for (;;) {
        sum = 0u; cnt = 0u; mine = 0u;
#pragma unroll
        for (unsigned j = 0; j < 16; ++j) { const unsigned c = xb_ld(&bar[XB_XCNT(j)]); sum += c; cnt += (c > 0u) ? 1u : 0u; mine = (j == x) ? c : mine; }
        if (sum == G) break;
        __builtin_amdgcn_s_sleep(1);
        if ((++sp & 255u) == 0u) { if (xb_ld(&bar[XB_TMO])) break; if (sp > XB_SPIN_CAP) { atomicAdd(&bar[XB_TMO], 1u); break; } }
    }
    nloc = mine > 0u ? mine : 1u; nx = cnt > 0u ? cnt : 1u;
}
__device__ __forceinline__ void xcd_barrier(const XcdBarrier& b) {
    asm volatile("s_waitcnt vmcnt(0)" ::: "memory");
    __syncthreads();
    if (threadIdx.x == 0) {
        unsigned* bar = b.bar;
        __builtin_amdgcn_s_waitcnt(0);
        unsigned nloc = b.st[0], nx = b.st[1];
        if (nloc == 0u) { xcd_barrier_complete(bar, b.x, nloc, nx); b.st[0] = nloc; b.st[1] = nx; }
        const unsigned old = xb_add(&bar[XB_XSUB(b.x)], 1u);
        const unsigned gen = old / nloc;
        if (old + 1u == (gen + 1u) * nloc) {
            __builtin_amdgcn_fence(__ATOMIC_RELEASE, "agent");
            asm volatile("s_waitcnt vmcnt(0)" ::: "memory");
            const unsigned og = xb_add(&bar[XB_TOP], 1u);
            const unsigned tg = og / nx;
            if (og + 1u == (tg + 1u) * nx) xb_add(&bar[XB_TOPGEN], 1u);
            else XB_SPIN(xb_ld(&bar[XB_TOPGEN]) == tg, bar);
            __builtin_amdgcn_fence(__ATOMIC_ACQUIRE, "agent");
            xb_add(&bar[XB_XGEN(b.x)], 1u);
            asm volatile("s_waitcnt vmcnt(0)" ::: "memory");
        } else {
            XB_SPIN(xb_ld(&bar[XB_XGEN(b.x)]) == gen, bar);
            __builtin_amdgcn_fence(__ATOMIC_ACQUIRE, "agent");
            asm volatile("s_waitcnt vmcnt(0)" ::: "memory");
        }
    }
    __syncthreads();
}

namespace pg8 {
#define PG8_LAS __attribute__((address_space(3)))
typedef unsigned short bf16_t;
typedef short bf16x8 __attribute__((ext_vector_type(8)));
typedef float f32x4 __attribute__((ext_vector_type(4)));
typedef unsigned u32x4 __attribute__((ext_vector_type(4)));
typedef int i32x4 __attribute__((ext_vector_type(4)));
typedef int i32x8 __attribute__((ext_vector_type(8)));
constexpr int BM = 256, BK = 64, HALF = 128, HTB = HALF * BK * 2  , STAGE_BYTES = 8 * HTB, NXCD = 8, WGM = 8;

__host__ __device__ __forceinline__ int lds_byte(int r, int c) { const int st = (r >> 4) * 2 + (c >> 5), rr = r & 15, cc = c & 31, ob = rr * 64 + cc * 2; return st * 1024 + (ob ^ (((ob >> 9) & 1) << 5)); }
__host__ __device__ __forceinline__ void stage_rc(int b, int& R, int& C) { const int st = b / 1024, sb = b % 1024, swz = sb ^ (((sb >> 9) & 1) << 5); R = (st >> 1) * 16 + swz / 64; C = (st & 1) * 32 + (swz % 64) / 2; }
__host__ __device__ __forceinline__ int perm32(int rho) { const int n = rho >> 4, i = rho & 15; return 8 * (i >> 2) + 4 * n + (i & 3); }

struct Unit { int pm, pn, pb, e; };
struct Gemm { const bf16_t* A; const bf16_t* Bt; int M, N, K; };

struct StaticOrder {
    int nM, nN, nwg, G, c;
    __host__ __device__ void init(int M, int N, int G_, int c_) { nM = M / BM; nN = N / BM; nwg = nM * nN; G = G_; c = c_; }
    __host__ __device__ bool next(int i, Unit& u) const {
        const long L = (long)i * G + c; if (L >= nwg) return false;
        int wgid = (int)L; { const int q = nwg / NXCD, r = nwg % NXCD, xcd = wgid % NXCD, off = wgid / NXCD; wgid = (xcd < r ? xcd * (q + 1) : r * (q + 1) + (xcd - r) * q) + off; }
        const int nig = WGM * nN, gid = wgid / nig, fm = gid * WGM, gsz = (nM - fm) < WGM ? (nM - fm) : WGM;
        u.pm = fm + ((wgid % nig) % gsz); u.pn = (wgid % nig) / gsz; u.pb = u.pn; u.e = 0; return true;
    }
    __device__ __forceinline__ void a_ready(const Unit&) const {}
    __device__ __forceinline__ void done(const Unit&) const {}
};

__device__ __forceinline__ void mfma8_inplace(f32x4& acc, const i32x8& b, const i32x8& a, int sc) {
    asm volatile("v_mfma_scale_f32_16x16x128_f8f6f4 %0, %1, %2, %0, %3, %3 op_sel_hi:[0,0,0]" : "+v"(acc) : "v"(b), "v"(a), "v"(sc)); }
__device__ __forceinline__ void glds16_s(const char* sbase, unsigned voff, unsigned lds_dst) { unsigned keep;
    asm volatile("s_mov_b32 %0, m0\n\ts_mov_b32 m0, %3\n\ts_nop 0\n\tglobal_load_lds_dwordx4 %1, %2\n\ts_mov_b32 m0, %0" : "=&s"(keep) : "v"(voff), "s"(sbase), "s"(lds_dst) : "memory"); }
template <class Epi, class Sched, bool ALIGN_EPI = false, bool SP2 = false, bool FP8 = false>
__device__ __forceinline__ void gemm_phase(PG8_LAS unsigned char* lds, const Gemm g, const Sched& S, const Epi& E) {
    int tid = threadIdx.x; asm volatile("" : "+v"(tid));
    const int wid = __builtin_amdgcn_readfirstlane(tid >> 6), lane = tid & 63, wr = wid >> 2, wc = wid & 3, fr = lane & 15, fq = lane >> 4;
    const int K = g.K, nt = K / BK;
    unsigned voffA[2], voffB[2];
#pragma unroll
    for (int i = 0; i < 2; ++i) { int R, C; stage_rc(tid * 16 + i * 8192, R, C); const int Rb = Epi::PERM ? ((R & ~31) + perm32(R & 31)) : R;
        voffA[i] = (unsigned)(R * K + C) * 2u; voffB[i] = (unsigned)(Rb * K + C) * 2u; }
    const size_t kstep = (size_t)(BK * 2);
    const size_t hstep = (size_t)HALF * K * 2;
    const size_t tstep = 2 * hstep;
    const unsigned ldsbase = (unsigned)(uintptr_t)lds;
    const unsigned ldsw = (unsigned)wid * 1024u;
    const int aoff = lds_byte(wr * 64 + fr, fq * 8), boff = lds_byte(wc * 32 + fr, fq * 8);
    const PG8_LAS unsigned char* lbaseA = lds + aoff; const PG8_LAS unsigned char* lbaseB = lds + 65536 + boff; asm volatile("" : "+v"(lbaseA), "+v"(lbaseB));
#define PG8_SA(b, h) (((b) * 2 + (h)) * HTB)
#define PG8_SB(b, h) ((4 + (b) * 2 + (h)) * HTB)
#define PG8_STAGE(bufoff, gbase, voff) do { _Pragma("unroll") for (int _i = 0; _i < 2; ++_i) { \
        if constexpr (FP8) glds16_s((const char*)(gbase), (voff)[_i], (unsigned)__builtin_amdgcn_readfirstlane(ldsbase + (unsigned)(bufoff) + ldsw + _i * 8192u)); \
        else __builtin_amdgcn_global_load_lds((const unsigned*)((const char*)(gbase) + (voff)[_i]), (PG8_LAS unsigned*)(lds + (bufoff) + ldsw + _i * 8192), 16, 0, 0); } } while (0)
#define PG8_LDFA(off) (*(const PG8_LAS bf16x8*)(lbaseA + (off)))
#define PG8_LDFB(off) (*(const PG8_LAS bf16x8*)(lbaseB + ((off) - 65536)))
#define PG8_LDA(dst, b, h) do { _Pragma("unroll") for (int m = 0; m < 4; ++m) { if constexpr (FP8) dst##8[m] = PG8_CAT8(PG8_LDFA(PG8_SA(b, h) + m * 2048), PG8_LDFA(PG8_SA(b, h) + m * 2048 + 1024)); \
        else { _Pragma("unroll") for (int k = 0; k < 2; ++k) dst[m][k] = PG8_LDFA(PG8_SA(b, h) + m * 2048 + k * 1024); } } } while (0)
#define PG8_LDB(dst, b, h) do { _Pragma("unroll") for (int n = 0; n < 2; ++n) { if constexpr (FP8) dst##8[n] = PG8_CAT8(PG8_LDFB(PG8_SB(b, h) + n * 2048), PG8_LDFB(PG8_SB(b, h) + n * 2048 + 1024)); \
        else { _Pragma("unroll") for (int k = 0; k < 2; ++k) dst[n][k] = PG8_LDFB(PG8_SB(b, h) + n * 2048 + k * 1024); } } } while (0)
#define PG8_CAT8(x0, x1) __builtin_shufflevector(__builtin_bit_cast(i32x4, x0), __builtin_bit_cast(i32x4, x1), 0, 1, 2, 3, 4, 5, 6, 7)
#define PG8_MMA(ai, bj, At, Bt) do { __builtin_amdgcn_s_setprio(1); _Pragma("unroll") for (int m = 0; m < 4; ++m) _Pragma("unroll") for (int n = 0; n < 2; ++n) { \
        if constexpr (FP8) mfma8_inplace(acc[ai][bj][m][n], Bt##8[n], At##8[m], sc8); \
        else { _Pragma("unroll") for (int k = 0; k < 2; ++k) acc[ai][bj][m][n] = __builtin_amdgcn_mfma_f32_16x16x32_bf16(Bt[n][k], At[m][k], acc[ai][bj][m][n], 0, 0, 0); } } \
        __builtin_amdgcn_s_setprio(0); } while (0)
#define PG8_WAIT_V(n) asm volatile("s_waitcnt vmcnt(" #n ")" ::: "memory")
#define PG8_WAIT_L(n) asm volatile("s_waitcnt lgkmcnt(" #n ")" ::: "memory")
#define PG8_BAR __builtin_amdgcn_s_barrier()
#define PG8_SCHED __builtin_amdgcn_sched_barrier(0)
    Unit cur, nxt; int ui = 0;
    if (!S.next(0, cur)) return;
    f32x4 acc[2][2][4][2];
#pragma unroll
    for (int a = 0; a < 2; ++a)
#pragma unroll
        for (int b = 0; b < 2; ++b)
#pragma unroll
            for (int m = 0; m < 4; ++m)
#pragma unroll
                for (int n = 0; n < 2; ++n) acc[a][b][m][n] = (f32x4){0.f, 0.f, 0.f, 0.f};
    int sc8 = 0x7f7f7f7f; asm volatile("" : "+v"(sc8));
    bf16x8 At[4][2], B0[2][2], B1[2][2]; i32x8 At8[4], B08[2], B18[2];
    const char* cA = (const char*)g.A + (size_t)cur.pm * tstep; const char* cB = (const char*)g.Bt + (size_t)cur.pb * tstep;
    S.a_ready(cur);
    if constexpr (SP2) {
        PG8_STAGE(PG8_SB(0, 0), cB, voffB); PG8_STAGE(PG8_SB(0, 1), cB + hstep, voffB); PG8_STAGE(PG8_SA(0, 0), cA, voffA); PG8_STAGE(PG8_SA(0, 1), cA + hstep, voffA);
        if (wr == 1) PG8_BAR;
        PG8_WAIT_V(2); PG8_BAR;
        PG8_STAGE(PG8_SB(1, 0), cB + kstep, voffB); PG8_STAGE(PG8_SA(1, 0), cA + kstep, voffA); PG8_STAGE(PG8_SB(1, 1), cB + hstep + kstep, voffB);
        PG8_WAIT_V(6); PG8_BAR;
    } else {
        PG8_STAGE(PG8_SB(0, 0), cB, voffB); PG8_STAGE(PG8_SA(0, 0), cA, voffA); PG8_STAGE(PG8_SB(0, 1), cB + hstep, voffB); PG8_STAGE(PG8_SA(0, 1), cA + hstep, voffA);
        if (wr == 1) PG8_BAR;
        PG8_WAIT_V(4); PG8_BAR;
        PG8_STAGE(PG8_SB(1, 0), cB + kstep, voffB); PG8_STAGE(PG8_SA(1, 0), cA + kstep, voffA); PG8_STAGE(PG8_SB(1, 1), cB + hstep + kstep, voffB);
        PG8_WAIT_V(6); PG8_BAR;
    }
    for (;;) {
        const bool has_next = S.next(ui + 1, nxt);
        const char* nA = has_next ? (const char*)g.A + (size_t)nxt.pm * tstep : cA; const char* nB = has_next ? (const char*)g.Bt + (size_t)nxt.pb * tstep : cB;
        for (int t = 0; t < nt; t += 2) {
            const bool last = (t == nt - 2);
            const char* a1 = cA + (size_t)(t + 1) * kstep;
            const char* a2 = last ? nA : cA + (size_t)(t + 2) * kstep; const char* b2 = last ? nB : cB + (size_t)(t + 2) * kstep;
            const char* a3 = a2 + kstep; const char* b3 = b2 + kstep;
            if (last && has_next) S.a_ready(nxt);
            if constexpr (SP2) {
            PG8_LDB(B0, 0, 0); PG8_LDB(B1, 0, 1); PG8_SCHED; PG8_LDA(At, 0, 0); PG8_STAGE(PG8_SA(1, 1), a1 + hstep, voffA);
            PG8_WAIT_V(8); PG8_WAIT_L(0); PG8_BAR; PG8_MMA(0, 0, At, B0); PG8_MMA(0, 1, At, B1); PG8_BAR; PG8_SCHED;
            PG8_LDA(At, 0, 1); PG8_STAGE(PG8_SB(0, 0), b2, voffB); PG8_STAGE(PG8_SB(0, 1), b2 + hstep, voffB); PG8_STAGE(PG8_SA(0, 0), a2, voffA);
            PG8_WAIT_V(8); PG8_WAIT_L(0); PG8_BAR; PG8_MMA(1, 0, At, B0); PG8_MMA(1, 1, At, B1); PG8_BAR; PG8_SCHED;
            PG8_LDB(B0, 1, 0); PG8_LDB(B1, 1, 1); PG8_SCHED; PG8_LDA(At, 1, 0); PG8_STAGE(PG8_SA(0, 1), a2 + hstep, voffA);
            PG8_WAIT_V(8); PG8_WAIT_L(0); PG8_BAR; PG8_MMA(0, 0, At, B0); PG8_MMA(0, 1, At, B1); PG8_BAR; PG8_SCHED;
            PG8_LDA(At, 1, 1); PG8_STAGE(PG8_SB(1, 0), b3, voffB); PG8_STAGE(PG8_SB(1, 1), b3 + hstep, voffB); PG8_STAGE(PG8_SA(1, 0), a3, voffA);
            PG8_WAIT_V(8); PG8_WAIT_L(0); PG8_BAR; PG8_MMA(1, 0, At, B0); PG8_MMA(1, 1, At, B1); PG8_BAR; PG8_SCHED;
            } else {
            PG8_LDB(B0, 0, 0); PG8_SCHED; PG8_LDA(At, 0, 0); PG8_STAGE(PG8_SA(1, 1), a1 + hstep, voffA);
            PG8_WAIT_L(8); PG8_BAR; PG8_WAIT_L(0); PG8_MMA(0, 0, At, B0); PG8_BAR; PG8_SCHED;
            PG8_LDB(B1, 0, 1); PG8_STAGE(PG8_SB(0, 0), b2, voffB);
            PG8_BAR; PG8_WAIT_L(0); PG8_MMA(0, 1, At, B1); PG8_BAR;
            PG8_LDA(At, 0, 1); PG8_STAGE(PG8_SA(0, 0), a2, voffA);
            PG8_BAR; PG8_WAIT_L(0); PG8_MMA(1, 0, At, B0); PG8_BAR; PG8_SCHED;
            PG8_STAGE(PG8_SB(0, 1), b2 + hstep, voffB);
            PG8_WAIT_V(6); PG8_BAR; PG8_MMA(1, 1, At, B1); PG8_BAR;
            PG8_LDB(B0, 1, 0); PG8_SCHED; PG8_LDA(At, 1, 0); PG8_STAGE(PG8_SA(0, 1), a2 + hstep, voffA);
            PG8_WAIT_L(8); PG8_BAR; PG8_WAIT_L(0); PG8_MMA(0, 0, At, B0); PG8_BAR; PG8_SCHED;
            PG8_LDB(B1, 1, 1); PG8_STAGE(PG8_SB(1, 0), b3, voffB);
            PG8_BAR; PG8_WAIT_L(0); PG8_MMA(0, 1, At, B1); PG8_BAR;
            PG8_LDA(At, 1, 1); PG8_STAGE(PG8_SA(1, 0), a3, voffA);
            PG8_BAR; PG8_WAIT_L(0); PG8_MMA(1, 0, At, B0); PG8_BAR; PG8_SCHED;
            PG8_STAGE(PG8_SB(1, 1), b3 + hstep, voffB);
            PG8_WAIT_V(6); PG8_BAR; PG8_MMA(1, 1, At, B1); PG8_BAR;
            }
        }
        if constexpr (ALIGN_EPI) { if (wr == 0) PG8_BAR; }
        if constexpr (FP8) { asm volatile("s_nop 15\n\ts_nop 3" ::: "memory"); __builtin_amdgcn_sched_barrier(0); }
        if constexpr (!Epi::AFTER_DRAIN) { int l2_ = threadIdx.x & 63; asm volatile("" : "+v"(l2_)); E(acc, cur, wr, wc, l2_ & 15, l2_ >> 4); S.done(cur); }
        if (!has_next) break;
#pragma unroll
        for (int a = 0; a < 2; ++a)
#pragma unroll
            for (int b = 0; b < 2; ++b)
#pragma unroll
                for (int m = 0; m < 4; ++m)
#pragma unroll
                    for (int n = 0; n < 2; ++n) acc[a][b][m][n] = (f32x4){0.f, 0.f, 0.f, 0.f};
        cur = nxt; cA = nA; cB = nB; ++ui;
        if constexpr (ALIGN_EPI) { if (wr == 1) PG8_BAR; }
    }
    PG8_WAIT_V(0);
    if constexpr (!ALIGN_EPI) { if (wr == 0) PG8_BAR; }
    PG8_BAR;
    if constexpr (Epi::AFTER_DRAIN) { E.fused(acc, cur, wr, wc, fr, fq, lds, wid, lane); S.done(cur); }
#undef PG8_SA
#undef PG8_SB
#undef PG8_STAGE
#undef PG8_LDA
#undef PG8_LDFA
#undef PG8_LDFB
#undef PG8_LDB
#undef PG8_MMA
#undef PG8_CAT8
#undef PG8_WAIT_V
#undef PG8_WAIT_L
#undef PG8_BAR
#undef PG8_SCHED
}

__device__ __forceinline__ unsigned cvt_pk_bf16(float lo, float hi) { unsigned r; asm volatile("v_cvt_pk_bf16_f32 %0, %1, %2" : "=v"(r) : "v"(lo), "v"(hi)); return r; }
struct EpiBf16 {
    static constexpr bool PERM = true, AFTER_DRAIN = false;
    bf16_t* O; int ldc; unsigned smask; float s;
    __device__ __forceinline__ void operator()(const f32x4 (&acc)[2][2][4][2], const Unit& u, int wr, int wc, int fr, int fq) const {
        const int row0 = u.pm * BM + wr * 64 + fr, col0 = u.pn * BM + wc * 32 + 8 * fq; const float sc = ((smask >> u.pn) & 1u) ? s : 1.f;
#pragma unroll
        for (int ai = 0; ai < 2; ++ai)
#pragma unroll
            for (int m = 0; m < 4; ++m) { bf16_t* rowp = O + (size_t)(row0 + ai * HALF + m * 16) * ldc + col0;
#pragma unroll
                for (int bj = 0; bj < 2; ++bj) { const f32x4 v0 = acc[ai][bj][m][0] * sc, v1 = acc[ai][bj][m][1] * sc;
                    u32x4 w; w.x = cvt_pk_bf16(v0[0], v0[1]); w.y = cvt_pk_bf16(v0[2], v0[3]); w.z = cvt_pk_bf16(v1[0], v1[1]); w.w = cvt_pk_bf16(v1[2], v1[3]);
                    *(u32x4*)(rowp + bj * HALF) = w; } }
    }
};
struct EpiResF32 {
    static constexpr bool PERM = false, AFTER_DRAIN = false;
    const float* base; float* out; int ldc; float alpha;
    __device__ __forceinline__ void operator()(const f32x4 (&acc)[2][2][4][2], const Unit& u, int wr, int wc, int fr, int fq) const {
        const int col0 = u.pn * BM + wc * 32 + 4 * fq;
#pragma unroll
        for (int ai = 0; ai < 2; ++ai)
#pragma unroll
            for (int m = 0; m < 4; ++m) { const size_t off = (size_t)(u.pm * BM + ai * HALF + wr * 64 + m * 16 + fr) * ldc + col0;
#pragma unroll
                for (int bj = 0; bj < 2; ++bj)
#pragma unroll
                    for (int n = 0; n < 2; ++n) { const f32x4 bs = *(const f32x4*)(base + off + bj * HALF + n * 16); *(f32x4*)(out + off + bj * HALF + n * 16) = bs * alpha + acc[ai][bj][m][n]; }
                if (m & 1) asm volatile("" ::: "memory"); }
    }
};
struct EpiGateUp {
    static constexpr bool PERM = true, AFTER_DRAIN = false;
    bf16_t* O; const float* bias; float ascale;
    __device__ __forceinline__ void operator()(const f32x4 (&acc)[2][2][4][2], const Unit& u, int wr, int wc, int fr, int fq) const {
        const int row0 = u.pm * BM + wr * 64 + fr, f0 = u.pn * 128 + wc * 32 + 8 * fq;
        bf16_t* Oo = this->O; const float* bo = this->bias; asm volatile("" : "+s"(Oo), "+s"(bo));
        __attribute__((address_space(1))) bf16_t* O = (__attribute__((address_space(1))) bf16_t*)Oo; const __attribute__((address_space(1))) float* bias = (const __attribute__((address_space(1))) float*)bo;
        const __attribute__((address_space(1))) float* bp = bias + (size_t)u.e * 2048 + 2 * f0;
        typedef __attribute__((address_space(1))) f32x4 gf4; typedef __attribute__((address_space(1))) u32x4 gu4;
        const f32x4 b0 = *(const gf4*)(bp), b1 = *(const gf4*)(bp + 4), b2 = *(const gf4*)(bp + 8), b3 = *(const gf4*)(bp + 12);
        const float bg[8] = {b0[0], b0[2], b1[0], b1[2], b2[0], b2[2], b3[0], b3[2]}, bl[8] = {b0[1], b0[3], b1[1], b1[3], b2[1], b2[3], b3[1], b3[3]};
#pragma unroll
        for (int ai = 0; ai < 2; ++ai)
#pragma unroll
            for (int m = 0; m < 4; ++m) { float a[8];
#pragma unroll
                for (int n = 0; n < 2; ++n)
#pragma unroll
                    for (int q = 0; q < 4; ++q) { const float g = fminf(acc[ai][0][m][n][q] * ascale + bg[4 * n + q], 7.f), l = fminf(fmaxf(acc[ai][1][m][n][q] * ascale + bl[4 * n + q], -7.f), 7.f);
                        a[4 * n + q] = g * __builtin_amdgcn_rcpf(1.f + __builtin_amdgcn_exp2f(-1.702f * 1.4426950408889634f * g)) * (l + 1.f); }
                typedef unsigned u32x2g __attribute__((ext_vector_type(2))); u32x2g w; w.x = pk4_fp8(a[0], a[1], a[2], a[3]); w.y = pk4_fp8(a[4], a[5], a[6], a[7]);
                *(__attribute__((address_space(1))) u32x2g*)((__attribute__((address_space(1))) unsigned char*)O + (size_t)(row0 + ai * HALF + m * 16) * 1024 + f0) = w; }
    }
};
struct EpiDown {
    static constexpr bool PERM = true, AFTER_DRAIN = false;
    bf16_t* Y; const float* bias; const int* rowslot; const float* rowgate; const int* blkv; float ascale;
    __device__ __forceinline__ void operator()(const f32x4 (&acc)[2][2][4][2], const Unit& u, int wr, int wc, int fr, int fq) const {
        const int col0 = u.pn * BM + wc * 32 + 8 * fq, nv = blkv[u.pm];
        const float* bp = bias + (size_t)u.e * 1024 + col0;
        f32x4 bv[2][2];
#pragma unroll
        for (int bj = 0; bj < 2; ++bj)
#pragma unroll
            for (int n = 0; n < 2; ++n) bv[bj][n] = *(const f32x4*)(bp + bj * HALF + 4 * n);
        int slot[2][4]; float gt[2][4];
#pragma unroll
        for (int ai = 0; ai < 2; ++ai)
#pragma unroll
            for (int m = 0; m < 4; ++m) { const int r = ai * HALF + wr * 64 + m * 16 + fr; slot[ai][m] = rowslot[u.pm * BM + r]; gt[ai][m] = rowgate[u.pm * BM + r]; }
#pragma unroll
        for (int ai = 0; ai < 2; ++ai)
#pragma unroll
            for (int m = 0; m < 4; ++m) { const int r = ai * HALF + wr * 64 + m * 16 + fr;
                if (r < nv) { const float g = gt[ai][m]; bf16_t* rowp = Y + (size_t)slot[ai][m] * 1024 + col0;
#pragma unroll
                    for (int bj = 0; bj < 2; ++bj) { const f32x4 v0 = (acc[ai][bj][m][0] * ascale + bv[bj][0]) * g, v1 = (acc[ai][bj][m][1] * ascale + bv[bj][1]) * g;
                        u32x4 w; w.x = cvt_pk_bf16(v0[0], v0[1]); w.y = cvt_pk_bf16(v0[2], v0[3]); w.z = cvt_pk_bf16(v1[0], v1[1]); w.w = cvt_pk_bf16(v1[2], v1[3]);
                        *(u32x4*)(rowp + bj * HALF) = w; } } }
    }
};
struct MoeOrder {
    const int* blke; int nunits, npn, gpx, c;
    __device__ __forceinline__ bool next(int i, Unit& u) const {
        const int L = (i * 8 + (c & 7)) * gpx + (c >> 3); if (L >= nunits) return false;
        const int blk = L / npn; u.pm = blk; u.pn = L - blk * npn; u.e = __builtin_amdgcn_readfirstlane(blke[blk]); u.pb = u.e * npn + u.pn; return true;
    }
    __device__ __forceinline__ void a_ready(const Unit&) const {}
    __device__ __forceinline__ void done(const Unit&) const {}
};
struct OneUnit { int pm, pn; __device__ __forceinline__ bool next(int i, Unit& u) const { if (i) return false; u.pm = pm; u.pn = pn; u.pb = pn; u.e = 0; return true; }
    __device__ __forceinline__ void a_ready(const Unit&) const {} __device__ __forceinline__ void done(const Unit&) const {} };
}

namespace attn_body {
typedef unsigned short abf;
using bf16x8=__attribute__((ext_vector_type(8)))short;
using s16x4=__attribute__((ext_vector_type(4)))short;
using f32x16=__attribute__((ext_vector_type(16)))float;
using u32x4=__attribute__((ext_vector_type(4)))unsigned;
constexpr int NW=8,QBLK=32,QB=QBLK*NW,KVBLK=64;
__device__ __forceinline__ int crow(int r,int hi){return (r&3)+8*(r>>2)+4*hi;}
#define SBAR() __builtin_amdgcn_sched_barrier(0)
constexpr int NSLOT=3, SLOTB=8192;
constexpr int LDS_K=0, LDS_V=NSLOT*SLOTB, LDS_WS=2*NSLOT*SLOTB, LDS_OST=LDS_WS+NW*64*4, LDS_BYTES=LDS_OST+NW*4096;
__device__ __forceinline__ void glds16(const void*gsrc,unsigned lds_dst){unsigned keep;
  asm volatile("s_mov_b32 %0, m0\n\ts_mov_b32 m0, %2\n\ts_nop 0\n\tglobal_load_lds_dwordx4 %1, off\n\ts_mov_b32 m0, %0":"=&s"(keep):"v"(gsrc),"s"(lds_dst):"memory");}
__device__ __forceinline__ float max3f(float a,float b,float c){float r;asm("v_max3_f32 %0, %1, %2, %3":"=v"(r):"v"(a),"v"(b),"v"(c));return r;}
__device__ __forceinline__ float max2f(float a,float b){float r;asm("v_max_f32_e32 %0, %1, %2":"=v"(r):"v"(a),"v"(b));return r;}
__device__ __forceinline__ float fadd_s(float a,float b){float r;asm("v_add_f32_e32 %0, %1, %2":"=v"(r):"v"(a),"v"(b));return r;}
__device__ __forceinline__ float fsub_s(float a,float b){float r;asm("v_sub_f32_e32 %0, %1, %2":"=v"(r):"v"(a),"v"(b));return r;}
typedef float f32x2_t __attribute__((ext_vector_type(2))); typedef __bf16 bf16x2_t __attribute__((ext_vector_type(2)));
__device__ __forceinline__ unsigned cvtpk_s(float lo,float hi){f32x2_t v={lo,hi};bf16x2_t b=__builtin_convertvector(v,bf16x2_t);return __builtin_bit_cast(unsigned,b);}
#define WAIT_BAR(N) asm volatile("s_waitcnt vmcnt(" #N ") lgkmcnt(0)\n\ts_barrier":::"memory")
__device__ __forceinline__ void qkt(f32x16&p0,f32x16&p1,const char*Kslot,const bf16x8*qr,const f32x16&c0,const f32x16&c1,int r32,int hi){
  const char*kb=Kslot+hi*1024+r32*16;
  #pragma unroll
  for(int d0=0;d0<4;++d0){
    const bf16x8 b0=*reinterpret_cast<const bf16x8*>(kb+d0*2048);
    const bf16x8 b1=*reinterpret_cast<const bf16x8*>(kb+d0*2048+512);
    if(d0==0){p0=__builtin_amdgcn_mfma_f32_32x32x16_bf16(b0,qr[0],c0,0,0,0);p1=__builtin_amdgcn_mfma_f32_32x32x16_bf16(b1,qr[0],c1,0,0,0);}
    else{p0=__builtin_amdgcn_mfma_f32_32x32x16_bf16(b0,qr[d0],p0,0,0,0);p1=__builtin_amdgcn_mfma_f32_32x32x16_bf16(b1,qr[d0],p1,0,0,0);}}
}
typedef __attribute__((address_space(3))) const char* lds_cptr;
typedef short v4i16_t __attribute__((ext_vector_type(4)));
__device__ __forceinline__ void kload8(bf16x8*kf,lds_cptr kp){
  kf[0]=*(const __attribute__((address_space(3))) bf16x8*)(kp);      kf[1]=*(const __attribute__((address_space(3))) bf16x8*)(kp+512);
  kf[2]=*(const __attribute__((address_space(3))) bf16x8*)(kp+2048); kf[3]=*(const __attribute__((address_space(3))) bf16x8*)(kp+2560);
  kf[4]=*(const __attribute__((address_space(3))) bf16x8*)(kp+4096); kf[5]=*(const __attribute__((address_space(3))) bf16x8*)(kp+4608);
  kf[6]=*(const __attribute__((address_space(3))) bf16x8*)(kp+6144); kf[7]=*(const __attribute__((address_space(3))) bf16x8*)(kp+6656);
}
__device__ __forceinline__ void kload2(bf16x8*kf,lds_cptr kp,int j){ kf[2*j]=*(const __attribute__((address_space(3))) bf16x8*)(kp+j*2048); kf[2*j+1]=*(const __attribute__((address_space(3))) bf16x8*)(kp+j*2048+512); }
__device__ __forceinline__ s16x4 vtr(lds_cptr p){ return __builtin_bit_cast(s16x4,__builtin_amdgcn_ds_read_tr16_b64_v4i16((__attribute__((address_space(3))) v4i16_t*)p)); }
__device__ __forceinline__ float rowmax(const f32x16&p0,const f32x16&p1){
  float a=max3f(p0[0],p0[1],p1[0]),b=max3f(p0[2],p0[3],p1[1]);a=max3f(a,p1[2],p1[3]);
  #pragma unroll
  for(int r=4;r<16;r+=4){a=max3f(a,p0[r],p0[r+1]);b=max3f(b,p0[r+2],p0[r+3]);a=max3f(a,p1[r],p1[r+1]);b=max3f(b,p1[r+2],p1[r+3]);}
  const float m=max2f(a,b);
  auto rr=__builtin_amdgcn_permlane32_swap(__float_as_uint(m),__float_as_uint(m),false,false);
  return max2f(__uint_as_float(rr[0]),__uint_as_float(rr[1]));
}
__device__ __forceinline__ void pv(f32x16*o,int vb,bf16x8 pa0,bf16x8 pa1,bf16x8 pa2,bf16x8 pa3){
  #pragma unroll
  for(int d0=0;d0<2;++d0){s16x4 lo[4],hi[4];
    #pragma unroll
    for(int ks=0;ks<4;++ks){
      asm volatile("ds_read_b64_tr_b16 %0,%1 offset:%c2":"=&v"(lo[ks]):"v"(vb),"i"(d0*4096+ks*1024):"memory");
      asm volatile("ds_read_b64_tr_b16 %0,%1 offset:%c2":"=&v"(hi[ks]):"v"(vb),"i"(d0*4096+ks*1024+512):"memory");}
    asm volatile("s_waitcnt lgkmcnt(0)":::"memory");SBAR();
    #define PK(k) (bf16x8){lo[k][0],lo[k][1],lo[k][2],lo[k][3],hi[k][0],hi[k][1],hi[k][2],hi[k][3]}
    o[d0]=__builtin_amdgcn_mfma_f32_32x32x16_bf16(pa0,PK(0),o[d0],0,0,0);
    o[d0]=__builtin_amdgcn_mfma_f32_32x32x16_bf16(pa1,PK(1),o[d0],0,0,0);
    o[d0]=__builtin_amdgcn_mfma_f32_32x32x16_bf16(pa2,PK(2),o[d0],0,0,0);
    o[d0]=__builtin_amdgcn_mfma_f32_32x32x16_bf16(pa3,PK(3),o[d0],0,0,0);
    #undef PK
  }
}
#ifndef ATTN_STORE16
#define ATTN_STORE16(p,v) (*(u32x4*)(p)=(v))
#endif
template<int THRL> __device__ __forceinline__ void attn_unit(const abf*Qw0,int QP,const abf*Kh,int KP,const abf*Vh,int VP,abf*Ow0,int OP,int NT,float c2,int q0,char*shm){
  int tid=threadIdx.x; asm volatile("":"+v"(tid)); const int lane=tid&63,r32=lane&31,hi=lane>>5; const int wid=__builtin_amdgcn_readfirstlane(tid>>6);
  const abf*Qw=Qw0+(long)(wid*QBLK)*QP;
  const unsigned lds0=(unsigned)(uintptr_t)shm;
  float*wsf=(float*)(shm+LDS_WS)+wid*64;
  const abf*ksrc=Kh+(long)lane*KP+wid*8;
  const abf*vsrc=Vh+(long)(16*(wid&3)+(lane>>2))*VP+(wid>>2)*32+(lane&3)*8;
  const unsigned kdst=lds0+LDS_K+wid*1024, vdst=lds0+LDS_V+wid*1024;
  #define DMA_K(t,slot) glds16(ksrc+(long)(t)*KVBLK*KP,(unsigned)__builtin_amdgcn_readfirstlane(kdst+(slot)))
  #define DMA_V(t,slot) glds16(vsrc+(long)(t)*KVBLK*VP,(unsigned)__builtin_amdgcn_readfirstlane(vdst+(slot)))
  const int vb0=(int)(lds0+LDS_V)+((lane>>4)&1)*32+(lane&3)*8+(4*hi+((lane&15)>>2))*64;
  const char*Kbase=shm+LDS_K; bf16x8 kf[8];
  const lds_cptr shm3=(lds_cptr)shm; const lds_cptr kp0=shm3+LDS_K+hi*1024+r32*16; const lds_cptr vp0=shm3+LDS_V+((lane>>4)&1)*32+(lane&3)*8+(4*hi+((lane&15)>>2))*64;
  DMA_K(0,0);DMA_V(0,0);DMA_K(1,SLOTB);
  bf16x8 qr[4];
  #pragma unroll
  for(int d0=0;d0<4;++d0)qr[d0]=*reinterpret_cast<const bf16x8*>(&Qw[(long)r32*QP+d0*16+hi*8]);
  float mhat=0.f,l_reg=0.f;f32x16 o[2];o[0]=f32x16{};o[1]=f32x16{};
  const int tdiag=__builtin_amdgcn_readfirstlane((q0+wid*QBLK)>>6);
  const float qrel4=(float)(q0+wid*QBLK+r32-4*hi);
  #define CINIT(C0,C1,t) do{ const int tt_=(t); const float dq_=qrel4-64.f*(float)tt_; \
    if(tt_!=tdiag){ float sc_=tt_<tdiag?c2:-c2; asm volatile("":"+v"(sc_)); const float sc8_=8.f*sc_, sc32_=32.f*sc_; \
      C0[0]=-mhat-sc_*dq_; C0[1]=C0[0]+sc_; C0[2]=C0[1]+sc_; C0[3]=C0[2]+sc_; \
      _Pragma("unroll") for(int r=4;r<16;++r) C0[r]=C0[r-4]+sc8_;          \
      _Pragma("unroll") for(int r=0;r<16;++r) C1[r]=C0[r]+sc32_; } \
    else { _Pragma("unroll") for(int r=0;r<16;++r){ const float cr_=(float)((r&3)+8*(r>>2)); C0[r]=-mhat-c2*__builtin_fabsf(dq_-cr_); C1[r]=-mhat-c2*__builtin_fabsf(dq_-cr_-32.f); } } }while(0)
  bool resc=false;
  #define START(P0,P1) do{ const float rm=rowmax(P0,P1); resc=false; \
    { const float dl=rm; mhat=fadd_s(mhat,dl); \
      _Pragma("unroll") for(int r=0;r<16;++r){P0[r]=fsub_s(P0[r],dl);P1[r]=fsub_s(P1[r],dl);} } \
    _Pragma("unroll") for(int r=0;r<16;++r)P0[r]=__builtin_amdgcn_exp2f(P0[r]); }while(0)
  #define RESC() do{ if(resc){ asm volatile("s_waitcnt lgkmcnt(0)":::"memory"); \
      _Pragma("unroll") for(int d_=0;d_<2;++d_) _Pragma("unroll") for(int r=0;r<16;++r)o[d_][r]*=wsf[crow(r,hi)]; } }while(0)
  f32x16 pA0,pA1,pB0,pB1;
  int sl_prev=0,sl_cur=0,sl_next=SLOTB;
  #define ROT() do{sl_prev=sl_cur;sl_cur=sl_next;sl_next=(sl_next==(NSLOT-1)*SLOTB)?0:sl_next+SLOTB;}while(0)
  DMA_K(2,2*SLOTB);
  WAIT_BAR(3);
  CINIT(pA0,pA1,0);
  qkt(pA0,pA1,Kbase,qr,pA0,pA1,r32,hi);asm volatile("s_nop 15\n\ts_nop 7":"+v"(pA0),"+v"(pA1));
  START(pA0,pA1);
  _Pragma("unroll") for(int r=0;r<16;++r)pA1[r]=__builtin_amdgcn_exp2f(pA1[r]);
  WAIT_BAR(0);
  DMA_K(3,0);DMA_V(1,SLOTB);
  ROT();
  kload8(kf,kp0+sl_cur);
  WAIT_BAR(2);
  s16x4 vlo[8],vhi[8]; u32x4 pw0,pw1,pw2,pw3;
  #define PKW(P,B) cvtpk_s(P[B],P[B+1])
  #define PAF(k) __builtin_bit_cast(bf16x8,pw##k)
  #define VFR(i) (bf16x8){vlo[i][0],vlo[i][1],vlo[i][2],vlo[i][3],vhi[i][0],vhi[i][1],vhi[i][2],vhi[i][3]}
  #define PIN(x) asm volatile("":"+v"(x))
  #define MX3(a,b,c) __builtin_fmaxf(__builtin_fmaxf((a),(b)),(c))
  #define GAPA(MF,A0,A1,A2,A3,W0,W1,PW) do{ MF; sacc+=A0; sacc+=A1; sacc+=A2; sacc+=A3; PIN(sacc); W0; W1; PIN(PW); SBAR(); }while(0)
  #define EX(v) __builtin_amdgcn_exp2f(v)
  #define GAPB(MF,X,B) do{ MF; X[B]=EX(X[B]); X[B+1]=EX(X[B+1]); X[B+2]=EX(X[B+2]); X[B+3]=EX(X[B+3]); PIN(X); SBAR(); }while(0)
  #define VRD(i) do{ vlo[i]=vtr(vp_+(((i)>>2)*4096+((i)&3)*1024)); vhi[i]=vtr(vp_+(((i)>>2)*4096+((i)&3)*1024+512)); }while(0)
  #define KRD(G,j) do{ if(G){ kload2(kf,kp0+sl_next,j); SBAR(); } }while(0)
  #define STEP(C0,C1,P0,P1,t,GK,GV,GL) do{ SBAR(); \
    CINIT(C0,C1,t); SBAR(); \
    const lds_cptr vp_=vp0+sl_prev; \
    VRD(0); SBAR(); float sacc=(P0[0]+P0[1]); \
    GAPA(C0=__builtin_amdgcn_mfma_f32_32x32x16_bf16(kf[0],qr[0],C0,0,0,0), P0[2],P0[3],P0[4],P0[5],     pw0[0]=PKW(P0,0), pw0[1]=PKW(P0,2), pw0); \
    VRD(4); SBAR(); GAPA(C1=__builtin_amdgcn_mfma_f32_32x32x16_bf16(kf[1],qr[0],C1,0,0,0), P0[6],P0[7],P0[8],P0[9],     pw0[2]=PKW(P0,4), pw0[3]=PKW(P0,6), pw0); \
    VRD(1); SBAR(); GAPA(C0=__builtin_amdgcn_mfma_f32_32x32x16_bf16(kf[2],qr[1],C0,0,0,0),   P0[10],P0[11],P0[12],P0[13], pw1[0]=PKW(P0,8), pw1[1]=PKW(P0,10), pw1); \
    VRD(5); SBAR(); GAPA(C1=__builtin_amdgcn_mfma_f32_32x32x16_bf16(kf[3],qr[1],C1,0,0,0),   P0[14],P0[15],P1[0],P1[1],   pw1[2]=PKW(P0,12),pw1[3]=PKW(P0,14), pw1); \
    VRD(2); SBAR(); GAPA(C0=__builtin_amdgcn_mfma_f32_32x32x16_bf16(kf[4],qr[2],C0,0,0,0),   P1[2],P1[3],P1[4],P1[5],     pw2[0]=PKW(P1,0), pw2[1]=PKW(P1,2), pw2); \
    VRD(6); SBAR(); GAPA(C1=__builtin_amdgcn_mfma_f32_32x32x16_bf16(kf[5],qr[2],C1,0,0,0),   P1[6],P1[7],P1[8],P1[9],     pw2[2]=PKW(P1,4), pw2[3]=PKW(P1,6), pw2); \
    VRD(3); SBAR(); GAPA(C0=__builtin_amdgcn_mfma_f32_32x32x16_bf16(kf[6],qr[3],C0,0,0,0),   P1[10],P1[11],P1[12],P1[13], pw3[0]=PKW(P1,8), pw3[1]=PKW(P1,10), pw3); \
    VRD(7); SBAR(); GAPA(C1=__builtin_amdgcn_mfma_f32_32x32x16_bf16(kf[7],qr[3],C1,0,0,0),   P1[14],P1[15],0.f,0.f,       pw3[2]=PKW(P1,12),pw3[3]=PKW(P1,14), pw3); \
    l_reg+=sacc; \
    if(GK){DMA_K((t)+3,sl_cur);} if(GV){DMA_V((t)+1,sl_next);} \
    { float a=MX3(C0[0],C0[1],C1[0]),b=MX3(C0[2],C0[3],C1[1]); a=MX3(a,C1[2],C1[3]); \
      _Pragma("unroll") for(int r=4;r<16;r+=4){a=MX3(a,C0[r],C0[r+1]);b=MX3(b,C0[r+2],C0[r+3]);a=MX3(a,C1[r],C1[r+1]);b=MX3(b,C1[r+2],C1[r+3]);} \
      float rm=__builtin_fmaxf(a,b); { auto rr=__builtin_amdgcn_permlane32_swap(__float_as_uint(rm),__float_as_uint(rm),false,false); rm=__builtin_fmaxf(__uint_as_float(rr[0]),__uint_as_float(rr[1])); } \
      resc=false; \
      if(__builtin_expect(__any(rm>(float)THRL),0)){ const float dl=__builtin_fmaxf(rm,0.f); mhat+=dl; \
        _Pragma("unroll") for(int r=0;r<16;++r){C0[r]-=dl;C1[r]-=dl;} \
        const float f=__builtin_amdgcn_exp2f(-dl); l_reg*=f; if(hi==0)wsf[r32]=f; resc=true; } } \
    SBAR(); \
    GAPB(o[0]=__builtin_amdgcn_mfma_f32_32x32x16_bf16(PAF(0),VFR(0),o[0],0,0,0), C0,0); \
    GAPB(o[1]=__builtin_amdgcn_mfma_f32_32x32x16_bf16(PAF(0),VFR(4),o[1],0,0,0), C0,4); \
    KRD(GL,0); GAPB(o[0]=__builtin_amdgcn_mfma_f32_32x32x16_bf16(PAF(1),VFR(1),o[0],0,0,0), C0,8); \
    KRD(GL,1); GAPB(o[1]=__builtin_amdgcn_mfma_f32_32x32x16_bf16(PAF(1),VFR(5),o[1],0,0,0), C0,12); \
    KRD(GL,2); GAPB(o[0]=__builtin_amdgcn_mfma_f32_32x32x16_bf16(PAF(2),VFR(2),o[0],0,0,0), C1,0); \
    KRD(GL,3); GAPB(o[1]=__builtin_amdgcn_mfma_f32_32x32x16_bf16(PAF(2),VFR(6),o[1],0,0,0), C1,4); \
    GAPB(o[0]=__builtin_amdgcn_mfma_f32_32x32x16_bf16(PAF(3),VFR(3),o[0],0,0,0), C1,8); \
    GAPB(o[1]=__builtin_amdgcn_mfma_f32_32x32x16_bf16(PAF(3),VFR(7),o[1],0,0,0), C1,12); \
    }while(0)
  int t=1;
  for(;t+5<NT;t+=2){
    STEP(pB0,pB1,pA0,pA1,t,true,true,true);     WAIT_BAR(2); RESC(); ROT();
    STEP(pA0,pA1,pB0,pB1,t+1,true,true,true);   WAIT_BAR(2); RESC(); ROT();
  }
  #define ENDW(tt) do{ if((tt)+3<NT){WAIT_BAR(2);} else if((tt)+2<NT){WAIT_BAR(1);} else {WAIT_BAR(0);} }while(0)
  for(;t+1<NT;t+=2){
    STEP(pB0,pB1,pA0,pA1,t,(t+3<NT),(t+1<NT),(t+1<NT));       ENDW(t);   RESC(); ROT();
    STEP(pA0,pA1,pB0,pB1,t+1,(t+4<NT),(t+2<NT),(t+2<NT));     ENDW(t+1); RESC(); ROT();
  }
  STEP(pB0,pB1,pA0,pA1,NT-1,false,false,false); RESC();
  { float sacc=pB0[0]+pB0[1]; _Pragma("unroll") for(int r=2;r<16;++r)sacc+=pB0[r]; _Pragma("unroll") for(int r=0;r<16;++r)sacc+=pB1[r]; l_reg+=sacc;
    pw0=(u32x4){PKW(pB0,0),PKW(pB0,2),PKW(pB0,4),PKW(pB0,6)};pw1=(u32x4){PKW(pB0,8),PKW(pB0,10),PKW(pB0,12),PKW(pB0,14)};pw2=(u32x4){PKW(pB1,0),PKW(pB1,2),PKW(pB1,4),PKW(pB1,6)};pw3=(u32x4){PKW(pB1,8),PKW(pB1,10),PKW(pB1,12),PKW(pB1,14)};
    SBAR(); pv(o,vb0+sl_cur,PAF(0),PAF(1),PAF(2),PAF(3)); }
  #undef PKW
  #undef PAF
  #undef VFR
  #undef PIN
  #undef MX3
  #undef GAPA
  #undef GAPB
  #undef EX
  #undef VRD
  #undef KRD
  #undef STEP
  #undef ENDW
  {auto rr=__builtin_amdgcn_permlane32_swap(__float_as_uint(l_reg),__float_as_uint(l_reg),false,false);l_reg=__uint_as_float(rr[0])+__uint_as_float(rr[1]);}
  if(hi==0)wsf[32+r32]=l_reg;asm volatile("s_waitcnt lgkmcnt(0)":::"memory");
  float rli[16];
  #pragma unroll
  for(int r=0;r<16;++r)rli[r]=__builtin_amdgcn_rcpf(wsf[32+crow(r,hi)]);
  abf*Ow=Ow0+(long)(wid*QBLK)*OP;
  { abf*stg=(abf*)(shm+LDS_OST)+wid*2048;
    #pragma unroll
    for(int r=0;r<16;++r){const int orow=crow(r,hi);
      #pragma unroll
      for(int d0=0;d0<2;++d0)stg[orow*64+d0*32+r32]=(abf)f2bf(o[d0][r]*rli[r]);}
    asm volatile("s_waitcnt lgkmcnt(0)":::"memory");
    #pragma unroll
    for(int i=0;i<4;++i){const int row=i*8+(lane>>3),ch=lane&7; const u32x4 v=*(const u32x4*)(stg+row*64+ch*8); ATTN_STORE16(Ow+(long)row*OP+ch*8,v);} }
  asm volatile("s_waitcnt lgkmcnt(0)\n\ts_barrier":::"memory");
  #undef DMA_K
  #undef DMA_V
  #undef CINIT
  #undef START
  #undef RESC
  #undef ROT
}
constexpr int ATTN_LDS_BYTES=LDS_BYTES;
#undef SBAR
#undef WAIT_BAR
}

struct Args { const float* in[23]; float* out; unsigned char* ws; int ph_lo, ph_hi; };
struct Frame {
    LAS unsigned char* lds; char* ldsg;
    volatile LAS unsigned* MISC;
    gu32* ctl;
    int tid, lane, wave, vcu, G;
    float* out; unsigned char* ws;
};
constexpr int INTAB_OFF = LDSCTL_OFF + 8192;
__device__ __forceinline__ const float* fin(const Frame& F, int i) {
    const LAS unsigned* t = (const LAS unsigned*)(F.lds + INTAB_OFF) + 2 * i;
    const unsigned lo = __builtin_amdgcn_readfirstlane(t[0]), hi = __builtin_amdgcn_readfirstlane(t[1]);
    return (const float*)(const GAS float*)(((unsigned long long)hi << 32) | lo);
}
#define WSP(T_, off) ((T_*)(F.ws + (off)))
__device__ __forceinline__ int fresh_tid() { int t = threadIdx.x; asm volatile("" : "+v"(t)); return t; }

template <int MODE>
__device__ __forceinline__ void p0_transpose_item(const float* W, int K, int N, bf16* WT, LAS float* scr, int item, int lane) {
    const int nblk = N / 32, kb = item / nblk, nb = item % nblk, k0 = 64 * kb, n0 = 32 * nb;
    { f32x4 ld[8];
#pragma unroll
      for (int i = 0; i < 8; ++i) ld[i] = *(const GAS f32x4*)(W + (size_t)(k0 + 8 * i + (lane >> 3)) * N + n0 + (lane & 7) * 4);
#pragma unroll
      for (int i = 0; i < 8; ++i) { LAS float* d = scr + (8 * i + (lane >> 3)) * 33 + (lane & 7) * 4; d[0] = ld[i].x; d[1] = ld[i].y; d[2] = ld[i].z; d[3] = ld[i].w; } }
    asm volatile("s_waitcnt lgkmcnt(0)" ::: "memory");
    const int c = lane & 7;
#pragma unroll
    for (int j = 0; j < 4; ++j) { const int n = (lane >> 3) + 8 * j; const LAS float* s = scr + (8 * c) * 33 + n;
        v4u o; o.x = pk2(s[0 * 33], s[1 * 33]); o.y = pk2(s[2 * 33], s[3 * 33]); o.z = pk2(s[4 * 33], s[5 * 33]); o.w = pk2(s[6 * 33], s[7 * 33]);
        int col = n0 + n, drow = col;
        *(GAS v4u*)(WT + (size_t)drow * K + k0 + 8 * c) = o; }
    asm volatile("s_waitcnt lgkmcnt(0)" ::: "memory");
}
__device__ __forceinline__ void row_to_bf16(const float* xrow, bf16* orow, int lane) {
    const GAS f32x4* xr = (const GAS f32x4*)xrow + lane;
    GAS v2u* o8 = (GAS v2u*)orow + lane;
#pragma unroll
    for (int j = 0; j < 4; ++j) { const f32x4 v = xr[64 * j]; v2u w; w.x = pk2(v.x, v.y); w.y = pk2(v.z, v.w); o8[64 * j] = w; }
}
__device__ __forceinline__ void p0_transpose_fp8_item(bool PERM, const float* W, int K, int N, unsigned char* WT, float wscale, LAS float*  , int item, int lane) {
    const int nblk = N / 32, kb = item / nblk, nb = item % nblk, k0 = 128 * kb, n0 = 32 * nb, kg = lane >> 3, nq = lane & 7;
    f32x4 ld[2][8];
#pragma unroll
    for (int p = 0; p < 2; ++p)
#pragma unroll
        for (int i = 0; i < 8; ++i) ld[p][i] = __builtin_nontemporal_load((const GAS f32x4*)(W + (size_t)(k0 + 64 * p + 8 * kg + i) * N + n0 + 4 * nq));
#pragma unroll
    for (int j = 0; j < 4; ++j) { const int col = n0 + 4 * nq + j, pn = col >> 8, w = col & 255, drow = PERM ? 256 * pn + 128 * (w & 1) + (w >> 1) : col;
        GAS v2u* dp = (GAS v2u*)(WT + (size_t)drow * K + k0 + 8 * kg);
#pragma unroll
        for (int p = 0; p < 2; ++p) { v2u o8; o8.x = pk4_fp8(ld[p][0][j] * wscale, ld[p][1][j] * wscale, ld[p][2][j] * wscale, ld[p][3][j] * wscale); o8.y = pk4_fp8(ld[p][4][j] * wscale, ld[p][5][j] * wscale, ld[p][6][j] * wscale, ld[p][7][j] * wscale);
            __builtin_nontemporal_store(o8, dp + 8 * p); } }
}
__device__ __forceinline__ void p0_prologue(Frame& F) {
    LAS float* scr = (LAS float*)(F.lds + F.wave * 16384);
    const int gw = F.vcu * NWAVES + F.wave, NGW = F.G * NWAVES;
    constexpr int I_IN = 16 * (NIN / 32), I_KV = 16 * (512 / 32), I_O = 16 * (1024 / 32);
    constexpr int NITEMS = I_IN + I_KV + I_O;
    for (int it = gw; it < NITEMS; it += NGW) {
        int r = it;
        if (r < I_IN) { p0_transpose_item<0>(fin(F, 2), DM, NIN, WSP(bf16, WS_WIN), scr, r, F.lane); continue; } r -= I_IN;
        if (r < I_KV) { p0_transpose_item<0>(fin(F, 11), DM, 512, WSP(bf16, WS_WKV), scr, r, F.lane); continue; } r -= I_KV;
        p0_transpose_item<0>(fin(F, 12), DM, DM, WSP(bf16, WS_WO), scr, r, F.lane);
    }
    for (int i = F.vcu * NTHREADS + F.tid; i < DM * NE; i += F.G * NTHREADS) { const int e = i >> 10, k = i & 1023; const float w = fin(F, 15)[(size_t)k * NE + e] * fin(F, 13)[k];
        const unsigned hi = f2bf(w); WSP(bf16, WS_RWT)[i] = (bf16)hi; WSP(bf16, WS_RWT)[DM * NE + i] = (bf16)f2bf(w - bf2f(hi)); }
    if (gw < NE) { float a = 0.f; for (int k = F.lane; k < DM; k += 64) a += fin(F, 14)[k] * fin(F, 15)[(size_t)k * NE + gw];
        a = wave_sum(a); if (F.lane == 0) WSP(float, WS_RWT + 2 * DM * NE * 2)[gw] = a + fin(F, 16)[gw]; }
    for (int m = gw; m < T; m += NGW) row_to_bf16(fin(F, 0) + (size_t)m * DM, WSP(bf16, WS_XB) + (size_t)m * DM, F.lane);
    for (int m = gw; m < NB * MEML; m += NGW) row_to_bf16(fin(F, 1) + (size_t)m * DM, WSP(bf16, WS_MEMB) + (size_t)m * DM, F.lane);
}

__device__ __forceinline__ void p1_inproj(Frame& F) {
    { pg8::Gemm g{WSP(bf16, WS_XB), WSP(bf16, WS_WIN), T, NIN, DM}; pg8::StaticOrder S; S.init(T, NIN, F.G, (int)blockIdx.x);
      pg8::EpiBf16 E{WSP(bf16, WS_U), NIN, (1u << 0) | (1u << 1) | (1u << 11), C2};
      pg8::gemm_phase<pg8::EpiBf16, pg8::StaticOrder, true, true>(F.lds, g, S, E); }
}

constexpr int HCH = 64, NCH = SEQ / HCH, HU_STRIDE = 64 * 64 + 64;
namespace hg {
typedef short bf16x8 __attribute__((ext_vector_type(8)));
typedef short s16x4 __attribute__((ext_vector_type(4)));
typedef float f32x4 __attribute__((ext_vector_type(4)));
typedef unsigned u32x2 __attribute__((ext_vector_type(2)));
typedef short v4i16_t __attribute__((ext_vector_type(4)));
template <int N> __device__ __forceinline__ float row_shr_or(float x, float fill) { return __int_as_float(__builtin_amdgcn_update_dpp(__float_as_int(fill), __float_as_int(x), 0x110 + N, 0xf, 0xf, false)); }
__device__ __forceinline__ float row_cumprod(float x) { x *= row_shr_or<1>(x, 1.f); x *= row_shr_or<2>(x, 1.f); x *= row_shr_or<4>(x, 1.f); x *= row_shr_or<8>(x, 1.f); return x; }
__device__ __forceinline__ float sigm(float x) { return __builtin_amdgcn_rcpf(1.f + __builtin_amdgcn_exp2f(-1.4426950408889634f * x)); }
__device__ __forceinline__ unsigned pkbf(float lo, float hi) { typedef float f2 __attribute__((ext_vector_type(2))); typedef __bf16 b2 __attribute__((ext_vector_type(2))); f2 v = {lo, hi}; b2 o = __builtin_convertvector(v, b2); return __builtin_bit_cast(unsigned, o); }
__device__ __forceinline__ bf16x8 frag8(float a0, float a1, float a2, float a3, float a4, float a5, float a6, float a7) { typedef unsigned u4 __attribute__((ext_vector_type(4))); u4 w = {pkbf(a0, a1), pkbf(a2, a3), pkbf(a4, a5), pkbf(a6, a7)}; return __builtin_bit_cast(bf16x8, w); }
__device__ __forceinline__ s16x4 frag4s(float a0, float a1, float a2, float a3) { u32x2 w = {pkbf(a0, a1), pkbf(a2, a3)}; return __builtin_bit_cast(s16x4, w); }
__device__ __forceinline__ s16x4 trd(const LAS unsigned char* p) { return __builtin_bit_cast(s16x4, __builtin_amdgcn_ds_read_tr16_b64_v4i16((LAS v4i16_t*)p)); }
__device__ __forceinline__ float b2f(short v) { return __uint_as_float(((unsigned)(unsigned short)v) << 16); }

template <bool OUT>
__device__ __forceinline__ void unit(const bf16* U, const float* lbsrc, int b, int h, int dir, int c, f32x4 (&S)[4][4], float (&aprod)[4], LAS unsigned char* wl, int lane) {
    const int r = lane & 15, g = lane >> 4;
    LAS unsigned char* tHQ = wl + 8192; LAS unsigned char* tHF = wl + 10240; LAS unsigned char* tHI = wl + 12288; LAS float* aL = (LAS float*)(wl + 14336);
    LAS float* lbL = aL + 64;
    lbL[lane] = __builtin_amdgcn_rcpf(1.f + __expf(lbsrc[256 + h * 64 + lane] - lbsrc[h * 64 + lane]));
    float lbD[4];
#pragma unroll
    for (int cc = 0; cc < 4; ++cc) lbD[cc] = lbL[16 * cc + r];
#pragma unroll
    for (int mb = 0; mb < 4; ++mb) aprod[mb] = 1.f;
    const int lrow = lane >> 3, piece = lane & 7;
    const bf16* ubase = U + (size_t)b * SEQ * NIN + h * 64 + piece * 8;
    v4u stg[3][2];
#define HG_LOAD(sc) do { _Pragma("unroll") for (int hh = 0; hh < 2; ++hh) { const int i_ = 16 * (sc) + lrow + 8 * hh; const int t_ = dir ? HCH * c + HCH - 1 - i_ : HCH * c + i_; const bf16* p_ = ubase + (size_t)t_ * NIN; \
        stg[1][hh] = *(const GAS v4u*)(p_ + U_HF + dir * 256); stg[2][hh] = *(const GAS v4u*)(p_ + U_HI); } } while (0)
#define HG_LOADQ(sc) do { _Pragma("unroll") for (int hh = 0; hh < 2; ++hh) { const int i_ = 16 * (sc) + lrow + 8 * hh; const int t_ = dir ? HCH * c + HCH - 1 - i_ : HCH * c + i_; \
        stg[0][hh] = *(const GAS v4u*)(ubase + (size_t)t_ * NIN + U_HQ); } } while (0)
    HG_LOAD(0);
#pragma unroll 1
    for (int sc = 0; sc < 4; ++sc) {
        if (OUT) HG_LOADQ(sc);
#pragma unroll
        for (int hh = 0; hh < 2; ++hh) { const int off = (lrow + 8 * hh) * 128 + piece * 16;
            *(LAS v4u*)(tHF + off) = stg[1][hh]; *(LAS v4u*)(tHI + off) = stg[2][hh]; }
        if (sc < 3) HG_LOAD(sc + 1);
        s16x4 kteF[4], vF[4];
        const int q4 = r >> 2, p4 = r & 3;
#pragma unroll
        for (int mb = 0; mb < 4; ++mb) {
            const int toff = (4 * g + q4) * 128 + (16 * mb + 4 * p4) * 2;
            const s16x4 hfv = trd(tHF + toff); vF[mb] = trd(tHI + toff);
            float f[4], lp[4];
#pragma unroll
            for (int j = 0; j < 4; ++j) f[j] = lbD[mb] + (1.f - lbD[mb]) * sigm(b2f(hfv[j]));
            lp[0] = f[0]; lp[1] = lp[0] * f[1]; lp[2] = lp[1] * f[2]; lp[3] = lp[2] * f[3];
            float inc = lp[3];
            { const float u1 = __shfl_up(inc, 16); inc *= (g >= 1 ? u1 : 1.f); const float u2 = __shfl_up(inc, 32); inc *= (g >= 2 ? u2 : 1.f); }
            const float ex0 = __shfl_up(inc, 16), excl = g >= 1 ? ex0 : 1.f, plast = __shfl(inc, 48 + r);
            aprod[mb] *= plast;
            float kt[4];
#pragma unroll
            for (int j = 0; j < 4; ++j) kt[j] = (1.f - f[j]) * plast * __builtin_amdgcn_rcpf(excl * lp[j]);
            kteF[mb] = frag4s(kt[0], kt[1], kt[2], kt[3]);
            aL[16 * mb + r] = plast;
        }
        if (OUT) {
#pragma unroll
            for (int hh = 0; hh < 2; ++hh) *(LAS v4u*)(tHQ + (lrow + 8 * hh) * 128 + piece * 16) = stg[0][hh];
            float qe[4][4], ke[4][4];
#pragma unroll
            for (int cc = 0; cc < 4; ++cc) {
                const u32x2 wq = *(const LAS u32x2*)(tHQ + r * 128 + (16 * cc + 4 * g) * 2), wf = *(const LAS u32x2*)(tHF + r * 128 + (16 * cc + 4 * g) * 2);
                const float hq4[4] = {bflo(wq.x), bfhi(wq.x), bflo(wq.y), bfhi(wq.y)}, hf4[4] = {bflo(wf.x), bfhi(wf.x), bflo(wf.y), bfhi(wf.y)};
                const f32x4 lbv = *(const LAS f32x4*)&lbL[16 * cc + 4 * g];
#pragma unroll
                for (int e = 0; e < 4; ++e) { const float f = lbv[e] + (1.f - lbv[e]) * sigm(hf4[e]); const float P = row_cumprod(f);
                    qe[cc][e] = hq4[e] * sigm(hq4[e]) * P; ke[cc][e] = (1.f - f) * __builtin_amdgcn_rcpf(P); }
            }
            bf16x8 qeF[2], keF[2];
#pragma unroll
            for (int ks = 0; ks < 2; ++ks) { qeF[ks] = frag8(qe[2 * ks][0], qe[2 * ks][1], qe[2 * ks][2], qe[2 * ks][3], qe[2 * ks + 1][0], qe[2 * ks + 1][1], qe[2 * ks + 1][2], qe[2 * ks + 1][3]);
                keF[ks] = frag8(ke[2 * ks][0], ke[2 * ks][1], ke[2 * ks][2], ke[2 * ks][3], ke[2 * ks + 1][0], ke[2 * ks + 1][1], ke[2 * ks + 1][2], ke[2 * ks + 1][3]); }
            f32x4 cp = {0.f, 0.f, 0.f, 0.f};
            cp = __builtin_amdgcn_mfma_f32_16x16x32_bf16(keF[0], qeF[0], cp, 0, 0, 0); cp = __builtin_amdgcn_mfma_f32_16x16x32_bf16(keF[1], qeF[1], cp, 0, 0, 0);
            const s16x4 amF = frag4s(4 * g + 0 <= r ? cp[0] : 0.f, 4 * g + 1 <= r ? cp[1] : 0.f, 4 * g + 2 <= r ? cp[2] : 0.f, 4 * g + 3 <= r ? cp[3] : 0.f);
#pragma unroll
            for (int mb = 0; mb < 4; ++mb) {
                f32x4 ot = {0.f, 0.f, 0.f, 0.f}, oi = {0.f, 0.f, 0.f, 0.f};
                oi = __builtin_amdgcn_mfma_f32_16x16x16bf16_1k(vF[mb], amF, oi, 0, 0, 0);
#pragma unroll
                for (int ks = 0; ks < 2; ++ks) { const f32x4 s0 = S[2 * ks][mb], s1 = S[2 * ks + 1][mb];
                    ot = __builtin_amdgcn_mfma_f32_16x16x32_bf16(frag8(s0[0], s0[1], s0[2], s0[3], s1[0], s1[1], s1[2], s1[3]), qeF[ks], ot, 0, 0, 0); }
                ot = ot + oi;
                u32x2 w; w.x = pkbf(ot[0], ot[1]); w.y = pkbf(ot[2], ot[3]);
                *(LAS u32x2*)(wl + ((16 * sc + r) * 64 + 16 * mb + 4 * g) * 2) = w;
            }
        }
#pragma unroll
        for (int db = 0; db < 4; ++db) { const f32x4 ar = *(const LAS f32x4*)&aL[16 * db + 4 * g];
#pragma unroll
            for (int vb = 0; vb < 4; ++vb) S[db][vb] = __builtin_amdgcn_mfma_f32_16x16x16bf16_1k(kteF[db], vF[vb], S[db][vb] * ar, 0, 0, 0); }
    }
#undef HG_LOAD
#undef HG_LOADQ
}
}

__device__ __forceinline__ void p2_hgrn_local(Frame& F) {
    const int gw = F.vcu * NWAVES + F.wave, NGW = F.G * NWAVES, lane = F.lane;
    for (int u = gw; u < 32 * NCH; u += NGW) {
        const int seq = u / NCH, cp = u % NCH, b = seq >> 3, h = (seq >> 1) & 3, dir = seq & 1, c = dir ? NCH - 1 - cp : cp;
        hg::f32x4 S[4][4]; float aprod[4];
#pragma unroll
        for (int db = 0; db < 4; ++db)
#pragma unroll
            for (int vb = 0; vb < 4; ++vb) S[db][vb] = (hg::f32x4){0.f, 0.f, 0.f, 0.f};
        hg::unit<false>(WSP(bf16, WS_U), dir ? fin(F, 9) : fin(F, 8), b, h, dir, c, S, aprod, F.lds + F.wave * 16384, lane);
        float* hu = WSP(float, WS_HU) + (size_t)u * HU_STRIDE; const int r = lane & 15, g = lane >> 4;
#pragma unroll
        for (int db = 0; db < 4; ++db)
#pragma unroll
            for (int vb = 0; vb < 4; ++vb)
#pragma unroll
                for (int q = 0; q < 4; ++q) hu[(16 * db + 4 * g + q) * 64 + 16 * vb + r] = S[db][vb][q];
#pragma unroll
        for (int mb = 0; mb < 4; ++mb) hu[4096 + 16 * mb + r] = aprod[mb];
    }
    {
        LAS float* red = (LAS float*)(F.lds + LDSCTL_OFF + 1024);
        for (int r0 = F.vcu * 64; r0 < T; r0 += F.G * 64) {
            float mx = 0.f;
            for (int i = 0; i < 8; ++i) { const v4u w = *(const GAS v4u*)(WSP(bf16, WS_U) + (size_t)(r0 + F.wave * 8 + i) * NIN + U_DK + lane * 8);
                float ss = bflo(w.x) * bflo(w.x) + bfhi(w.x) * bfhi(w.x) + bflo(w.y) * bflo(w.y) + bfhi(w.y) * bfhi(w.y) + bflo(w.z) * bflo(w.z) + bfhi(w.z) * bfhi(w.z) + bflo(w.w) * bflo(w.w) + bfhi(w.w) * bfhi(w.w);
                ss += __shfl_xor(ss, 1); ss += __shfl_xor(ss, 2); ss += __shfl_xor(ss, 4); mx = fmaxf(mx, ss); }
            __syncthreads();
            if ((lane & 7) == 0) red[F.wave * 8 + (lane >> 3)] = mx;
            __syncthreads();
            if (F.tid < 8) { float m = red[F.tid]; for (int w = 1; w < 8; ++w) m = fmaxf(m, red[w * 8 + F.tid]);
                __hip_atomic_fetch_max((unsigned*)(F.ctl + CW_KN + (r0 / SEQ) * 8 + F.tid), __float_as_uint(m), RLX_AGENT); }
        }
    }
}
__device__ __forceinline__ void hgrn_scan(Frame& F) {
    for (int idx = F.vcu * NTHREADS + F.tid; idx < 32 * 4096; idx += F.G * NTHREADS) {
        const int seq = idx >> 12, dv = idx & 4095, d = dv >> 6;
        const float* hu = WSP(float, WS_HU) + (size_t)seq * NCH * HU_STRIDE; float* ss = WSP(float, WS_SS) + (size_t)seq * NCH * 4096 + dv;
        float st = 0.f;
#pragma unroll 8
        for (int cp = 0; cp < NCH; ++cp) { ss[(size_t)cp * 4096] = st; st = hu[(size_t)cp * HU_STRIDE + 4096 + d] * st + hu[(size_t)cp * HU_STRIDE + dv]; }
    }
}
constexpr int CV_IGU = 8 * (2048 / 32), CV_IDN = 8 * (1024 / 32), CV_NWAVEITEMS = NE * CV_IGU + NE * CV_IDN, CV_NGROUPS = CV_NWAVEITEMS / NWAVES;
__device__ __forceinline__ bool conv_items(Frame& F, LAS int* qs) {
    if (F.tid == 0) qs[1] = (int)__hip_atomic_fetch_add((unsigned*)(F.ctl + CW_CONVQ), 8u, RLX_AGENT);
    __syncthreads();
    const int g0 = __builtin_amdgcn_readfirstlane(qs[1]);
    __syncthreads();
    if (g0 >= CV_NGROUPS) return false;
    LAS float* scr = (LAS float*)(F.lds + F.wave * 16384);
#pragma unroll 1
    for (int gi = g0; gi < min(g0 + 8, CV_NGROUPS); ++gi) {
        int r = gi * NWAVES + F.wave; const bool gu = r < NE * CV_IGU; if (!gu) r -= NE * CV_IGU;
        const int per = gu ? CV_IGU : CV_IDN, e = r / per, n = gu ? 2048 : 1024;
        p0_transpose_fp8_item(gu, (gu ? fin(F, 17) : fin(F, 19)) + (size_t)e * DM * n, DM, n, (gu ? WSP(unsigned char, WS_WGU) : WSP(unsigned char, WS_WDN)) + (size_t)e * n * DM, gu ? WGU_SCALE : WDN_SCALE, scr, r - e * per, F.lane);
    }
    __syncthreads();
    return true;
}
__device__ __forceinline__ void p3_attn(Frame& F) {
    hgrn_scan(F);
    if (F.vcu < 8) {
        pg8::Gemm g{WSP(bf16, WS_MEMB), WSP(bf16, WS_WKV), NB * MEML, 512, DM}; pg8::OneUnit S{F.vcu >> 1, F.vcu & 1};
        pg8::EpiBf16 E{WSP(bf16, WS_MKV), 512, 0u, 1.f};
        pg8::gemm_phase<pg8::EpiBf16, pg8::OneUnit, false, true>(F.lds, g, S, E);
        asm volatile("s_waitcnt vmcnt(0)" ::: "memory"); __syncthreads();
        if (F.tid == 0) { __builtin_amdgcn_fence(__ATOMIC_RELEASE, "agent"); asm volatile("s_waitcnt vmcnt(0)" ::: "memory"); __hip_atomic_fetch_add((unsigned*)(F.ctl + CW_MKV), 1u, RLX_AGENT); }
    }
    const bf16* U = WSP(bf16, WS_U);
    const bf16* MKV = WSP(bf16, WS_MKV);
    LAS float* red = (LAS float*)(F.lds + LDSCTL_OFF + 1024);
    LAS int* qs = (LAS int*)(red + 16);
    bool conv_more = true, first_it = true;
    for (;;) {
        if (F.tid == 0) qs[0] = (int)__hip_atomic_fetch_add((unsigned*)(F.ctl + CW_QUEUE), 1u, RLX_AGENT);
        __syncthreads();
        const int it = __builtin_amdgcn_readfirstlane(qs[0]);
        __syncthreads();
        if (it >= 512 + 256) break;
        if (conv_more && !(first_it && (F.vcu & 1))) conv_more = conv_items(F, qs);
        first_it = false;
        if (it >= 512) {
            if (F.tid == 0) { unsigned sp = 0; while (__hip_atomic_load((unsigned*)(F.ctl + CW_MKV), RLX_AGENT) < 8u && ++sp < (1u << 22)) __builtin_amdgcn_s_sleep(2);
                __builtin_amdgcn_fence(__ATOMIC_ACQUIRE, "agent"); asm volatile("s_waitcnt vmcnt(0)" ::: "memory"); }
            __syncthreads();
            const int u = it - 512, b = u >> 6, h = (u >> 4) & 3, qb = u & 15; const size_t row0 = (size_t)b * SEQ + qb * 256;
            const bf16* Kp = MKV + (size_t)b * MEML * 512 + h * 64;
            attn_body::attn_unit<8>(U + row0 * NIN + U_MQ + h * 64, NIN, Kp, 512, Kp + 256, 512, WSP(bf16, WS_CAT) + row0 * DM + 768 + h * 64, DM, MEML / 64, 0.f, 0, F.ldsg);
            continue;
        }
        const int h = 3 - (it >> 7), b = (it >> 5) & 3, m = (it >> 4) & 1, qb = it & 15; const size_t row0 = (size_t)b * SEQ + qb * 256;
        const bf16* Qp = U + row0 * NIN + U_DQ + h * 128 + m * 64; const bf16* Kp = U + (size_t)b * SEQ * NIN + U_DK + h * 128 + m * 64; const bf16* Vp = U + (size_t)b * SEQ * NIN + U_DV + h * 128;
        bf16* Op = WSP(bf16, WS_OD) + row0 * DM + h * 256 + m * 128; const float c2 = __builtin_ldexpf(LOG2E, -2 * (h + 1)); int q0 = qb * 256, tlo, thi;
        {
            const int r = F.tid >> 1, hf = F.tid & 1; const bf16* qp = Qp + (size_t)r * NIN + hf * 32; const bf16* kp = Kp + (size_t)(q0 + r) * NIN + hf * 32;
            float qq = 0.f, qk = 0.f;
#pragma unroll
            for (int i = 0; i < 4; ++i) { const v4u a = *(const GAS v4u*)(qp + 8 * i), k4 = *(const GAS v4u*)(kp + 8 * i);
                qq += bflo(a.x) * bflo(a.x) + bfhi(a.x) * bfhi(a.x) + bflo(a.y) * bflo(a.y) + bfhi(a.y) * bfhi(a.y) + bflo(a.z) * bflo(a.z) + bfhi(a.z) * bfhi(a.z) + bflo(a.w) * bflo(a.w) + bfhi(a.w) * bfhi(a.w);
                qk += bflo(a.x) * bflo(k4.x) + bfhi(a.x) * bfhi(k4.x) + bflo(a.y) * bflo(k4.y) + bfhi(a.y) * bfhi(k4.y) + bflo(a.z) * bflo(k4.z) + bfhi(a.z) * bfhi(k4.z) + bflo(a.w) * bflo(k4.w) + bfhi(a.w) * bfhi(k4.w); }
            qq += __shfl_xor(qq, 1); qk += __shfl_xor(qk, 1);
            const float kn = sqrtf(__uint_as_float(__hip_atomic_load((unsigned*)(F.ctl + CW_KN + b * 8 + h * 2 + m), RLX_AGENT))) * 1.0001f;
            float need = wave_max(sqrtf(qq) * 1.0001f * kn - qk + 36.5f);
            if (F.lane == 0) red[F.wave] = need;
            __syncthreads();
            need = red[0];
#pragma unroll
            for (int w = 1; w < 8; ++w) need = fmaxf(need, red[w]);
            const float dist = need / c2;
            const float flo = floorf(((float)(q0 - 63) - dist) * (1.f / 64.f)) + 1.f, fhi = ceilf(((float)(q0 + 255) + dist) * (1.f / 64.f)) - 1.f;
            tlo = flo < 0.f ? 0 : (int)flo; if (tlo > 4 * qb) tlo = 4 * qb;
            thi = fhi > (float)(SEQ / 64 - 1) ? SEQ / 64 - 1 : (int)fhi; if (thi < 4 * qb + 3) thi = 4 * qb + 3;
            if (((thi - tlo + 1) & 1) != 0) { if (tlo > 0) --tlo; else ++thi; }
            tlo = __builtin_amdgcn_readfirstlane(tlo); thi = __builtin_amdgcn_readfirstlane(thi);
            __syncthreads();
        }
        const int NT = thi - tlo + 1; Kp += (size_t)tlo * 64 * NIN; Vp += (size_t)tlo * 64 * NIN; q0 -= tlo * 64;
#pragma unroll 1
        for (int vh = 0; vh < 2; ++vh) attn_body::attn_unit<8>(Qp, NIN, Kp, NIN, Vp + vh * 64, NIN, Op + vh * 64, DM, NT, c2, q0, F.ldsg);
    }
    while (conv_more) conv_more = conv_items(F, qs);
}

__device__ __forceinline__ void hgrn_out(Frame& F) {
    const int lane = F.lane, wave = F.wave, r = lane & 15, g = lane >> 4;
    for (int u0 = F.vcu * NWAVES; u0 < 32 * NCH; u0 += F.G * NWAVES) {
        const int u = u0 + wave, bhc = u >> 1, dir = u & 1, b = bhc / (4 * NCH), h = (bhc / NCH) & 3, c = bhc % NCH, cp = dir ? NCH - 1 - c : c, seq = b * 8 + h * 2 + dir;
        const float* ss = WSP(float, WS_SS) + ((size_t)seq * NCH + cp) * 4096;
        hg::f32x4 S[4][4]; float aprod[4];
#pragma unroll
        for (int db = 0; db < 4; ++db)
#pragma unroll
            for (int vb = 0; vb < 4; ++vb)
#pragma unroll
                for (int q = 0; q < 4; ++q) S[db][vb][q] = ss[(16 * db + 4 * g + q) * 64 + 16 * vb + r];
        hg::unit<true>(WSP(bf16, WS_U), dir ? fin(F, 9) : fin(F, 8), b, h, dir, c, S, aprod, F.lds + wave * 16384, lane);
        __syncthreads();
        const LAS unsigned char* Of = F.lds + (wave & ~1) * 16384; const LAS unsigned char* Ob = F.lds + (wave | 1) * 16384;
        const int i16 = lane & 15, k4 = lane >> 4; const f32x4 nw = *(const GAS f32x4*)(fin(F, 10) + h * 64 + 4 * i16);
#pragma unroll 2
        for (int k0 = 0; k0 < 32; k0 += 4) { const int tl = dir * 32 + k0 + k4; const size_t row = (size_t)b * SEQ + c * HCH + tl;
            const v2u gq = *(const GAS v2u*)(WSP(bf16, WS_U) + row * NIN + U_HG + h * 64 + 4 * i16);
            const v2u a = *(const LAS v2u*)(Of + tl * 128 + 8 * i16), bb = *(const LAS v2u*)(Ob + (HCH - 1 - tl) * 128 + 8 * i16);
            const float o0 = bflo(a.x) + bflo(bb.x), o1 = bfhi(a.x) + bfhi(bb.x), o2 = bflo(a.y) + bflo(bb.y), o3 = bfhi(a.y) + bfhi(bb.y);
            float ss2 = (o0 * o0 + o1 * o1) + (o2 * o2 + o3 * o3);
            ss2 += __shfl_xor(ss2, 1); ss2 += __shfl_xor(ss2, 2); ss2 += __shfl_xor(ss2, 4); ss2 += __shfl_xor(ss2, 8);
            const float rr = rsqrtf(ss2 * (1.f / 64.f) + EPS);
            v2u w; w.x = pk2(o0 * rr * nw.x * sigmoidf_(bflo(gq.x)), o1 * rr * nw.y * sigmoidf_(bfhi(gq.x))); w.y = pk2(o2 * rr * nw.z * sigmoidf_(bflo(gq.y)), o3 * rr * nw.w * sigmoidf_(bfhi(gq.y)));
            *(GAS v2u*)(WSP(bf16, WS_CAT) + row * DM + 512 + h * 64 + 4 * i16) = w; }
        __syncthreads();
    }
}

__device__ __forceinline__ void p4_combine(Frame& F) {
    hgrn_out(F);
    const int gw = F.vcu * NWAVES + F.wave, NGW = F.G * NWAVES, lane = F.lane;
    const float sa = wave_sum(fin(F, 3)[lane] * fin(F, 4)[lane]), sb = wave_sum(fin(F, 5)[lane] * fin(F, 6)[lane]);
    const float lam = __expf(sa) - __expf(sb) + 0.2f;
    const bf16* OD = WSP(bf16, WS_OD); bf16* CAT = WSP(bf16, WS_CAT);
    const int i16 = lane & 15, mm = (lane >> 4) & 1, hh = lane >> 5;
    const f32x4 dw0 = *(const GAS f32x4*)(fin(F, 7) + 8 * i16), dw1 = *(const GAS f32x4*)(fin(F, 7) + 8 * i16 + 4);
    v4u nx[2];
#pragma unroll
    for (int x = 0; x < 2; ++x) nx[x] = *(const GAS v4u*)(OD + (size_t)gw * DM + 512 * x + 8 * lane);
    for (int row = gw; row < T; row += NGW) {
        v4u cur[2] = {nx[0], nx[1]};
        if (row + NGW < T) {
#pragma unroll
            for (int x = 0; x < 2; ++x) nx[x] = *(const GAS v4u*)(OD + (size_t)(row + NGW) * DM + 512 * x + 8 * lane); }
#pragma unroll
        for (int x = 0; x < 2; ++x) {
            const v4u a = cur[x]; v4u b; b.x = __shfl_xor(a.x, 16); b.y = __shfl_xor(a.y, 16); b.z = __shfl_xor(a.z, 16); b.w = __shfl_xor(a.w, 16);
            float o[8] = {bflo(a.x) - lam * bflo(b.x), bfhi(a.x) - lam * bfhi(b.x), bflo(a.y) - lam * bflo(b.y), bfhi(a.y) - lam * bfhi(b.y),
                          bflo(a.z) - lam * bflo(b.z), bfhi(a.z) - lam * bfhi(b.z), bflo(a.w) - lam * bflo(b.w), bfhi(a.w) - lam * bfhi(b.w)};
            float ss = 0.f;
#pragma unroll
            for (int k = 0; k < 8; ++k) ss += o[k] * o[k];
            ss += __shfl_xor(ss, 1); ss += __shfl_xor(ss, 2); ss += __shfl_xor(ss, 4); ss += __shfl_xor(ss, 8);
            const float r = rsqrtf(ss * (1.f / 128.f) + EPS) * 0.8f;
            if (mm == 0) { v4u w; w.x = pk2(o[0] * r * dw0.x, o[1] * r * dw0.y); w.y = pk2(o[2] * r * dw0.z, o[3] * r * dw0.w); w.z = pk2(o[4] * r * dw1.x, o[5] * r * dw1.y); w.w = pk2(o[6] * r * dw1.z, o[7] * r * dw1.w);
                *(GAS v4u*)(CAT + (size_t)row * DM + (2 * x + hh) * 128 + 8 * i16) = w; }
        }
    }
}

__device__ __forceinline__ void p4_wo(Frame& F) {
    pg8::Gemm g{WSP(bf16, WS_CAT), WSP(bf16, WS_WO), T, DM, DM}; pg8::StaticOrder S; S.init(T, DM, F.G, (int)blockIdx.x);
    pg8::EpiResF32 E{fin(F, 0), WSP(float, WS_Z1), DM, ALPHA};
    pg8::gemm_phase<pg8::EpiResF32, pg8::StaticOrder, true, true>(F.lds, g, S, E);
}

__device__ __forceinline__ void ln_row(f32x4 (&v)[4], const float* g, const float* bb, int lane, float& mean, float& rstd) {
    float s = 0.f;
#pragma unroll
    for (int j = 0; j < 4; ++j) s += (v[j].x + v[j].y) + (v[j].z + v[j].w);
    mean = wave_sum(s) * (1.f / DM); float s2 = 0.f;
#pragma unroll
    for (int j = 0; j < 4; ++j) { v[j] = v[j] - mean; s2 += (v[j].x * v[j].x + v[j].y * v[j].y) + (v[j].z * v[j].z + v[j].w * v[j].w); }
    rstd = rsqrtf(wave_sum(s2) * (1.f / DM) + EPS);
#pragma unroll
    for (int j = 0; j < 4; ++j) { const f32x4 gv = *(const GAS f32x4*)(g + 4 * lane + 256 * j), bv = *(const GAS f32x4*)(bb + 4 * lane + 256 * j); v[j] = v[j] * rstd * gv + bv; }
}

__device__ __forceinline__ void ln_row_pre(f32x4 (&v)[4], const f32x4 (&gv)[4], const f32x4 (&bv)[4], float& mean, float& rstd) {
    float s = 0.f;
#pragma unroll
    for (int j = 0; j < 4; ++j) s += (v[j].x + v[j].y) + (v[j].z + v[j].w);
    mean = wave_sum(s) * (1.f / DM); float s2 = 0.f;
#pragma unroll
    for (int j = 0; j < 4; ++j) { v[j] = v[j] - mean; s2 += (v[j].x * v[j].x + v[j].y * v[j].y) + (v[j].z * v[j].z + v[j].w * v[j].w); }
    rstd = rsqrtf(wave_sum(s2) * (1.f / DM) + EPS);
#pragma unroll
    for (int j = 0; j < 4; ++j) v[j] = v[j] * rstd * gv[j] + bv[j];
}
__device__ __forceinline__ void p5_router(Frame& F) {
    typedef short bf16x8r __attribute__((ext_vector_type(8)));
    LAS float* LG = (LAS float*)F.lds;
    LAS float* PX = LG + 64 * 33;
    LAS int* SEL = (LAS int*)(F.lds + LDSCTL_OFF + 1024);
    LAS int* LRK = SEL + 512;
    LAS unsigned* LCNT = (LAS unsigned*)(SEL + 1024);
    LAS unsigned* LBASE = LCNT + 32;
    if (F.tid < 32) LCNT[F.tid] = 0u;
    const int lane = F.lane, r = lane & 15, g = lane >> 4, tg = F.wave & 3, kh = F.wave >> 2;
    int* TOPI = WSP(int, WS_ROUTE); float* TOPG = WSP(float, WS_ROUTE + 256 * 1024); int* RANK = WSP(int, WS_ROUTE + 512 * 1024); float* STATS = WSP(float, WS_ROUTE + 768 * 1024);
    const int rpb = T / F.G;
    const int row = F.vcu * rpb + tg * 16 + r;
    const float* zr = WSP(float, WS_Z1) + (size_t)row * DM + 8 * g + 512 * kh;
    f32x4 z[16][2];
#pragma unroll
    for (int ks = 0; ks < 16; ++ks) { z[ks][0] = *(const GAS f32x4*)(zr + 32 * ks); z[ks][1] = *(const GAS f32x4*)(zr + 32 * ks + 4); }
    const bf16* wh = WSP(bf16, WS_RWT) + (size_t)r * DM + 8 * g + 512 * kh; const bf16* wl = wh + DM * NE;
    bf16x8r Bc[2][2], Bn[2][2];
#pragma unroll
    for (int nb = 0; nb < 2; ++nb) { Bc[nb][0] = *(const GAS bf16x8r*)(wh + (size_t)nb * 16 * DM); Bc[nb][1] = *(const GAS bf16x8r*)(wl + (size_t)nb * 16 * DM); }
    float s1 = 0.f, s2 = 0.f;
#pragma unroll
    for (int ks = 0; ks < 16; ++ks) { const f32x4 a = z[ks][0], b = z[ks][1];
        s1 += (a.x + a.y) + (a.z + a.w) + (b.x + b.y) + (b.z + b.w); s2 += (a.x * a.x + a.y * a.y) + (a.z * a.z + a.w * a.w) + (b.x * b.x + b.y * b.y) + (b.z * b.z + b.w * b.w); }
    s1 += __shfl_xor(s1, 16); s1 += __shfl_xor(s1, 32); s2 += __shfl_xor(s2, 16); s2 += __shfl_xor(s2, 32);
    LAS float* PS = PX + 4 * 2 * 64 * 4;
    if (g == 0) { PS[(F.wave * 16 + r) * 2] = s1; PS[(F.wave * 16 + r) * 2 + 1] = s2; }
    __syncthreads();
    { const int pw = F.wave ^ 4; s1 += PS[(pw * 16 + r) * 2]; s2 += PS[(pw * 16 + r) * 2 + 1]; }
    const float mean = s1 * (1.f / DM), rstd = rsqrtf(fmaxf(s2 * (1.f / DM) - mean * mean, 0.f) + EPS);
    if (kh == 0 && g == 0) { STATS[2 * row] = mean; STATS[2 * row + 1] = rstd; }
    f32x4 acc[2] = {{0.f, 0.f, 0.f, 0.f}, {0.f, 0.f, 0.f, 0.f}};
#pragma unroll
    for (int ks = 0; ks < 16; ++ks) {
        if (ks + 1 < 16) {
#pragma unroll
            for (int nb = 0; nb < 2; ++nb) { Bn[nb][0] = *(const GAS bf16x8r*)(wh + (size_t)nb * 16 * DM + 32 * (ks + 1)); Bn[nb][1] = *(const GAS bf16x8r*)(wl + (size_t)nb * 16 * DM + 32 * (ks + 1)); } }
        const f32x4 ha = (z[ks][0] - mean) * rstd, hb = (z[ks][1] - mean) * rstd;
        const float h[8] = {ha.x, ha.y, ha.z, ha.w, hb.x, hb.y, hb.z, hb.w}; unsigned hi[8]; float lo[8];
#pragma unroll
        for (int j = 0; j < 8; ++j) { hi[j] = f2bf(h[j]); lo[j] = h[j] - bf2f(hi[j]); }
        v4u Ah, Al; Ah.x = hi[0] | (hi[1] << 16); Ah.y = hi[2] | (hi[3] << 16); Ah.z = hi[4] | (hi[5] << 16); Ah.w = hi[6] | (hi[7] << 16);
        Al.x = pk2(lo[0], lo[1]); Al.y = pk2(lo[2], lo[3]); Al.z = pk2(lo[4], lo[5]); Al.w = pk2(lo[6], lo[7]);
        const bf16x8r ah = __builtin_bit_cast(bf16x8r, Ah), al = __builtin_bit_cast(bf16x8r, Al);
#pragma unroll
        for (int nb = 0; nb < 2; ++nb) { acc[nb] = __builtin_amdgcn_mfma_f32_16x16x32_bf16(ah, Bc[nb][0], acc[nb], 0, 0, 0); acc[nb] = __builtin_amdgcn_mfma_f32_16x16x32_bf16(ah, Bc[nb][1], acc[nb], 0, 0, 0);
            acc[nb] = __builtin_amdgcn_mfma_f32_16x16x32_bf16(al, Bc[nb][0], acc[nb], 0, 0, 0); }
#pragma unroll
        for (int nb = 0; nb < 2; ++nb) { Bc[nb][0] = Bn[nb][0]; Bc[nb][1] = Bn[nb][1]; }
    }
    if (kh == 1) { *(LAS f32x4*)&PX[((tg * 2 + 0) * 64 + lane) * 4] = acc[0]; *(LAS f32x4*)&PX[((tg * 2 + 1) * 64 + lane) * 4] = acc[1]; }
    __syncthreads();
    if (kh == 0) {
#pragma unroll
        for (int nb = 0; nb < 2; ++nb) { const f32x4 o = acc[nb] + *(const LAS f32x4*)&PX[((tg * 2 + nb) * 64 + lane) * 4]; const float bias = WSP(float, WS_RWT + 2 * DM * NE * 2)[16 * nb + r];
#pragma unroll
            for (int q = 0; q < 4; ++q) LG[(tg * 16 + 4 * g + q) * 33 + 16 * nb + r] = o[q] + bias; }
    }
    __syncthreads();
    LAS float* selv = (LAS float*)(F.lds + LDSCTL_OFF + 6144 + F.wave * 32); LAS int* seli = (LAS int*)(selv + 4);
    for (int rl = F.wave; rl < rpb; rl += NWAVES) {
        const int trow = F.vcu * rpb + rl; const float logit = LG[rl * 33 + (lane >> 1)];
        const int myi = lane >> 1; int rank = 0;
#pragma unroll
        for (int e2 = 0; e2 < 32; ++e2) { const float o = __int_as_float(__builtin_amdgcn_readlane(__float_as_int(logit), 2 * e2)); rank += (o > logit || (o == logit && e2 < myi)) ? 1 : 0; }
        if ((lane & 1) == 0 && rank < 4) { selv[rank] = logit; seli[rank] = myi; }
        float tv[4]; int ti[4];
#pragma unroll
        for (int k = 0; k < 4; ++k) { tv[k] = selv[k]; ti[k] = seli[k]; }
        const float e1 = __expf(tv[1] - tv[0]), e2 = __expf(tv[2] - tv[0]), e3 = __expf(tv[3] - tv[0]); const float inv = 1.f / (1.f + e1 + e2 + e3);
        if (lane < 4) { const int e = lane == 0 ? ti[0] : lane == 1 ? ti[1] : lane == 2 ? ti[2] : ti[3]; const float gt = (lane == 0 ? 1.f : lane == 1 ? e1 : lane == 2 ? e2 : e3) * inv;
            TOPI[trow * 4 + lane] = e; TOPG[trow * 4 + lane] = gt; SEL[rl * 4 + lane] = e;
            LRK[rl * 4 + lane] = (int)__hip_atomic_fetch_add((LAS unsigned*)&LCNT[e], 1u, __ATOMIC_RELAXED, __HIP_MEMORY_SCOPE_WORKGROUP); }
    }
    __syncthreads();
    if (F.tid < 32) LBASE[F.tid] = __hip_atomic_fetch_add((unsigned*)(F.ctl + CW_CNT + F.tid), LCNT[F.tid], RLX_AGENT);
    __syncthreads();
    if (F.tid < rpb * 4) RANK[(F.vcu * rpb) * 4 + F.tid] = (int)LBASE[SEL[F.tid]] + LRK[F.tid];
    __syncthreads();
}

__device__ __forceinline__ void p6_dispatch(Frame& F) {
    LAS int* pst = (LAS int*)F.lds;
    if (F.tid == 0) { int acc = 0; for (int e = 0; e < NE; ++e) { pst[e] = acc; const int c = (int)__hip_atomic_load((unsigned*)(F.ctl + CW_CNT + e), RLX_AGENT); acc += (c + 255) / 256 * 256; } pst[NE] = acc; }
    __syncthreads();
    int* ROWSLOT = WSP(int, WS_ROWS); float* ROWGATE = WSP(float, WS_ROWS + MAXROWS * 4); int* BLKE = WSP(int, WS_ROWS + 2 * MAXROWS * 4); int* BLKV = BLKE + 512; int* NBLK = BLKE + 1024;
    if (blockIdx.x == 0 && F.tid < NE) { const int e = F.tid, c = (int)__hip_atomic_load((unsigned*)(F.ctl + CW_CNT + e), RLX_AGENT); const int b0 = pst[e] / 256, nb = (pst[e + 1] - pst[e]) / 256;
        for (int i = 0; i < nb; ++i) { BLKE[b0 + i] = e; BLKV[b0 + i] = min(256, c - 256 * i); }
        if (e == 0) NBLK[0] = pst[NE] / 256; }
    const int gw = F.vcu * NWAVES + F.wave, NGW = F.G * NWAVES, lane = F.lane;
    const int* TOPI = WSP(int, WS_ROUTE); const float* TOPG = WSP(float, WS_ROUTE + 256 * 1024); const int* RANK = WSP(int, WS_ROUTE + 512 * 1024);
    f32x4 gv[4], bv[4], vn[4]; int ein[4], rkn[4]; float ggn[4];
#pragma unroll
    for (int j = 0; j < 4; ++j) { gv[j] = *(const GAS f32x4*)(fin(F, 13) + 4 * lane + 256 * j); bv[j] = *(const GAS f32x4*)(fin(F, 14) + 4 * lane + 256 * j); vn[j] = *(const GAS f32x4*)(WSP(float, WS_Z1) + (size_t)gw * DM + 4 * lane + 256 * j);
        ein[j] = TOPI[gw * 4 + j]; rkn[j] = RANK[gw * 4 + j]; ggn[j] = TOPG[gw * 4 + j]; }
    for (int row = gw; row < T; row += NGW) {
        f32x4 v[4]; int ei[4], rk[4]; float gg[4];
#pragma unroll
        for (int j = 0; j < 4; ++j) { v[j] = vn[j]; ei[j] = ein[j]; rk[j] = rkn[j]; gg[j] = ggn[j]; }
        if (row + NGW < T) {
#pragma unroll
            for (int j = 0; j < 4; ++j) { vn[j] = *(const GAS f32x4*)(WSP(float, WS_Z1) + (size_t)(row + NGW) * DM + 4 * lane + 256 * j);
                ein[j] = TOPI[(row + NGW) * 4 + j]; rkn[j] = RANK[(row + NGW) * 4 + j]; ggn[j] = TOPG[(row + NGW) * 4 + j]; } }
        float mean, rstd; ln_row_pre(v, gv, bv, mean, rstd);
        unsigned w[4];
#pragma unroll
        for (int j = 0; j < 4; ++j) w[j] = pk4_fp8(v[j].x, v[j].y, v[j].z, v[j].w);
#pragma unroll
        for (int k = 0; k < 4; ++k) { const int dest = pst[ei[k]] + rk[k];
            GAS unsigned* o8 = (GAS unsigned*)(WSP(unsigned char, WS_XS) + (size_t)dest * DM) + lane;
#pragma unroll
            for (int j = 0; j < 4; ++j) o8[64 * j] = w[j];
            if (lane == 0) { ROWSLOT[dest] = row * 4 + k; ROWGATE[dest] = gg[k]; } }
    }
    __syncthreads();
}

__device__ __forceinline__ void p7_gateup(Frame& F) {
    const int* BLKE = WSP(int, WS_ROWS + 2 * MAXROWS * 4); const int nblk = __builtin_amdgcn_readfirstlane(BLKE[1024]);
    int kk = DM / 2; asm volatile("" : "+s"(kk));
    pg8::Gemm g{WSP(bf16, WS_XS), WSP(bf16, WS_WGU), MAXROWS, 2048, kk}; pg8::MoeOrder S{BLKE, nblk * 8, 8, F.G / 8, (int)blockIdx.x};
    pg8::EpiGateUp E{WSP(bf16, WS_ACT), fin(F, 18), 1.f / WGU_SCALE};
    pg8::gemm_phase<pg8::EpiGateUp, pg8::MoeOrder, true, true, true>(F.lds, g, S, E);
}

__device__ __forceinline__ void p8_down(Frame& F) {
    const int* BLKE = WSP(int, WS_ROWS + 2 * MAXROWS * 4); const int nblk = __builtin_amdgcn_readfirstlane(BLKE[1024]);
    int kk = DM / 2; asm volatile("" : "+s"(kk));
    pg8::Gemm g{WSP(bf16, WS_ACT), WSP(bf16, WS_WDN), MAXROWS, 1024, kk}; pg8::MoeOrder S{BLKE, nblk * 4, 4, F.G / 8, (int)blockIdx.x};
    pg8::EpiDown E{WSP(bf16, WS_Y), fin(F, 20), WSP(int, WS_ROWS), WSP(float, WS_ROWS + MAXROWS * 4), BLKE + 512, 1.f / WDN_SCALE};
    pg8::gemm_phase<pg8::EpiDown, pg8::MoeOrder, true, true, true>(F.lds, g, S, E);
}

__device__ __forceinline__ void p9_final(Frame& F) {
    const int gw = F.vcu * NWAVES + F.wave, NGW = F.G * NWAVES, lane = F.lane;
    f32x4 g1[4], b1[4], g2[4], b2[4], vn[4]; v2u yn[4][4];
#pragma unroll
    for (int j = 0; j < 4; ++j) { g1[j] = *(const GAS f32x4*)(fin(F, 13) + 4 * lane + 256 * j); b1[j] = *(const GAS f32x4*)(fin(F, 14) + 4 * lane + 256 * j);
        g2[j] = *(const GAS f32x4*)(fin(F, 21) + 4 * lane + 256 * j); b2[j] = *(const GAS f32x4*)(fin(F, 22) + 4 * lane + 256 * j); }
#define P9_LOAD(r_) do { _Pragma("unroll") for (int j = 0; j < 4; ++j) vn[j] = *(const GAS f32x4*)(WSP(float, WS_Z1) + (size_t)(r_) * DM + 4 * lane + 256 * j); \
        _Pragma("unroll") for (int k = 0; k < 4; ++k) _Pragma("unroll") for (int j = 0; j < 4; ++j) yn[k][j] = ((const GAS v2u*)(WSP(bf16, WS_Y) + (size_t)((r_) * 4 + k) * DM) + lane)[64 * j]; } while (0)
    P9_LOAD(gw);
    for (int row = gw; row < T; row += NGW) {
        f32x4 v[4]; v2u y[4][4];
#pragma unroll
        for (int j = 0; j < 4; ++j) { v[j] = vn[j];
#pragma unroll
            for (int k = 0; k < 4; ++k) y[k][j] = yn[k][j]; }
        if (row + NGW < T) P9_LOAD(row + NGW);
        float mean, rstd; ln_row_pre(v, g1, b1, mean, rstd);
#pragma unroll
        for (int j = 0; j < 4; ++j) { v[j] = v[j] * ALPHA;
#pragma unroll
            for (int k = 0; k < 4; ++k) { const v2u w = y[k][j]; v[j].x += bflo(w.x); v[j].y += bfhi(w.x); v[j].z += bflo(w.y); v[j].w += bfhi(w.y); } }
        ln_row_pre(v, g2, b2, mean, rstd);
#pragma unroll
        for (int j = 0; j < 4; ++j) *(GAS f32x4*)(F.out + (size_t)row * DM + 4 * lane + 256 * j) = v[j];
    }
#undef P9_LOAD
}

constexpr int NPHASE = 11;
#ifndef PROBE_A
#define PROBE_A -1
#define PROBE_B -1
#endif
__global__ void __launch_bounds__(NTHREADS, 2) mega_fwd(Args args) {
    extern __shared__ __attribute__((aligned(16))) unsigned char lds[];
    Frame F;
    F.lds = (LAS unsigned char*)lds; F.ldsg = (char*)lds; F.MISC = (volatile LAS unsigned*)(F.lds + MISC_OFF);
    F.tid = threadIdx.x; F.lane = F.tid & 63; F.wave = __builtin_amdgcn_readfirstlane(F.tid >> 6);
    F.G = gridDim.x; { const int bx = blockIdx.x; F.vcu = (F.G % 8 == 0) ? (bx % 8) * (F.G / 8) + bx / 8 : bx; }
    F.ws = args.ws; F.ctl = (gu32*)(args.ws + WS_CTL); F.out = args.out;
    for (int u = F.tid; u < (LDS_BYTES - LDSCTL_OFF) / 4; u += NTHREADS) ((LAS unsigned*)(F.lds + LDSCTL_OFF))[u] = 0u;
    __syncthreads();
    if (F.tid < 23) ((LAS unsigned long long*)(F.lds + INTAB_OFF))[F.tid] = (unsigned long long)args.in[F.tid];
    __syncthreads();
    const bool single = (args.ph_lo == 0 && args.ph_hi == NPHASE);
    XcdBarrier bar; bar.bar = (unsigned*)(F.ctl + CW_BAR); bar.x = 0; bar.st = nullptr;
    if (single) bar = xcd_barrier_post((unsigned*)(F.ctl + CW_BAR), F.MISC + 8);
    const int lo = args.ph_lo, hi = args.ph_hi;
#ifndef PH_MASK
#define PH_MASK 0x7ff
#endif
#define IN(k) (((PH_MASK >> (k)) & 1) && lo <= (k) && (k) < hi)
#define SEAM(k) do { if (IN(k) && IN((k) + 1)) xcd_barrier(bar); F.tid = fresh_tid(); F.lane = F.tid & 63; if (PROBE_A >= 0 && blockIdx.x == 0 && F.tid == 0) pts[(k) + 1] = __builtin_amdgcn_s_memrealtime(); } while (0)
    unsigned long long* pts = (unsigned long long*)(args.ws + WS_CTL + 512 * 1024);
    if (PROBE_A >= 0 && blockIdx.x == 0 && F.tid == 0) pts[0] = __builtin_amdgcn_s_memrealtime();
    if (IN(0)) { p0_prologue(F); } SEAM(0);
    if (IN(1)) { p1_inproj(F); } SEAM(1);
    if (IN(2)) { p2_hgrn_local(F); } SEAM(2);
    if (IN(3)) { p3_attn(F); } SEAM(3);
    if (IN(4)) { p4_combine(F); } SEAM(4);
    if (IN(5)) { p4_wo(F); } SEAM(5);
    if (IN(6)) { p5_router(F); } SEAM(6);
    if (IN(7)) { p6_dispatch(F); } SEAM(7);
    if (IN(8)) { p7_gateup(F); } SEAM(8);
    if (IN(9)) { p8_down(F); } SEAM(9);
    if (IN(10)) { p9_final(F); }
    if (PROBE_A >= 0 && blockIdx.x == 0 && F.tid == 0) {
        const unsigned long long tend = __builtin_amdgcn_s_memrealtime(); pts[NPHASE] = tend;
        const int pa = PROBE_A >= 0 ? PROBE_A : 0, pb = PROBE_B >= 0 ? PROBE_B : 0;
        unsigned long long qa = (pts[pa + 1] - pts[pa] + 400) / 800, qb = PROBE_B >= 0 ? (pts[pb + 1] - pts[pb] + 400) / 800 : 0; if (qa > 63) qa = 63; if (qb > 63) qb = 63;
        const unsigned long long dly = (qa + 64 * qb) * 1600;
        while (__builtin_amdgcn_s_memrealtime() - tend < dly) __builtin_amdgcn_s_sleep(8);
    }
#undef IN
#undef SEAM
}

#ifndef MK_MULTI
#define MK_MULTI 0
#endif
extern "C" void kernel_launch(void* const* d_in, const int* in_sizes, int n_in, void* d_out, int out_size, void* d_ws, size_t ws_size, hipStream_t stream) {
    static int grid = 0;
    if (grid == 0) {
        if (n_in != 23 || out_size != T * DM || ws_size < WS_END) { fprintf(stderr, "kernel_launch: unexpected shapes n_in %d out %d ws %zu\n", n_in, out_size, ws_size); grid = -1; return; }
        int dev = 0, cus = 0;
        if (hipGetDevice(&dev) != hipSuccess || hipDeviceGetAttribute(&cus, hipDeviceAttributeMultiprocessorCount, dev) != hipSuccess) { grid = -1; return; }
        if (hipFuncSetAttribute((const void*)mega_fwd, hipFuncAttributeMaxDynamicSharedMemorySize, LDS_BYTES) != hipSuccess) { fprintf(stderr, "kernel_launch: hipFuncSetAttribute failed\n"); grid = -1; return; }
        int per_cu = 0;
        if (hipOccupancyMaxActiveBlocksPerMultiprocessor(&per_cu, (const void*)mega_fwd, NTHREADS, LDS_BYTES) != hipSuccess || per_cu < 1) fprintf(stderr, "kernel_launch: occupancy query says %d\n", per_cu);
        (void)hipGetLastError();
        grid = cus;
    }
    if (grid < 0) return;
    (void)hipMemsetAsync((char*)d_ws + WS_CTL, 0, CTL_ZERO_BYTES, stream);
    Args a{};
    for (int i = 0; i < 23; ++i) a.in[i] = (const float*)d_in[i];
    a.out = (float*)d_out; a.ws = (unsigned char*)d_ws;
#if MK_MULTI
    for (int p = 0; p < NPHASE; ++p) { a.ph_lo = p; a.ph_hi = p + 1; hipLaunchKernelGGL(mega_fwd, dim3(grid), dim3(NTHREADS), LDS_BYTES, stream, a); }
#else
    a.ph_lo = 0; a.ph_hi = NPHASE;
    hipLaunchKernelGGL(mega_fwd, dim3(grid), dim3(NTHREADS), LDS_BYTES, stream, a);
#endif
}
```

```cpp
#include <hip/hip_runtime.h>
#include <cstdio>
#include <cstdint>

constexpr int NB = 4, SEQ = 4096, DM = 1024, T = NB * SEQ, MEML = 256, NIN = 3072, NE = 32, TOPK = 4;
constexpr int TK = T * TOPK, MAXBLK = TK / 256 + NE, MAXROWS = MAXBLK * 256;
constexpr float LOG2E = 1.4426950408889634f, C2 = 0.125f * LOG2E, ALPHA = 1.189207115002721f, EPS = 1e-5f;
constexpr int U_DQ = 0, U_DK = 512, U_DV = 1024, U_HQ = 1536, U_HF = 1792, U_HI = 2304, U_HG = 2560, U_MQ = 2816;

constexpr size_t MiB = 1u << 20;
constexpr size_t WS_CTL = 0, CTL_ZERO_BYTES = 1 * MiB;
constexpr size_t WS_WIN = 2 * MiB, WS_WKV = 8 * MiB, WS_WO = 10 * MiB, WS_MEMB = 12 * MiB, WS_MKV = 14 * MiB;
constexpr size_t WS_XB = 16 * MiB, WS_U = 48 * MiB, WS_OD = 144 * MiB, WS_CAT = 176 * MiB, WS_Z1 = 208 * MiB;
constexpr size_t WS_ROUTE = 272 * MiB;
constexpr size_t WS_RWT = WS_ROUTE + 1 * MiB;
constexpr size_t WS_HU = 280 * MiB;
constexpr size_t WS_WGU = 336 * MiB, WS_WDN = 464 * MiB, WS_XS = 528 * MiB, WS_ACT = 672 * MiB, WS_Y = 816 * MiB;
constexpr size_t WS_ROWS = 944 * MiB;
constexpr size_t WS_SS = WS_XS;
constexpr size_t WS_OH = WS_ACT;
constexpr size_t WS_END = 948 * MiB;
constexpr int CW_TMO = 0, CW_CODE = 1, CW_CNT = 64  , CW_KN = 128  , CW_QUEUE = 192  , CW_MKV = 256  , CW_CONVQ = 257  , CW_BAR = 4096;

constexpr int RING_BYTES = 131072, LDSCTL_OFF = RING_BYTES, MISC_OFF = LDSCTL_OFF + 320, LDS_BYTES = 147456;
constexpr int NWAVES = 8, NTHREADS = 512;

#define GAS __attribute__((address_space(1)))
#define LAS __attribute__((address_space(3)))
typedef unsigned short bf16;
typedef unsigned v4u __attribute__((ext_vector_type(4)));
typedef unsigned v2u __attribute__((ext_vector_type(2)));
typedef float f32x4 __attribute__((ext_vector_type(4)));
typedef GAS unsigned gu32;
#define RLX_AGENT __ATOMIC_RELAXED, __HIP_MEMORY_SCOPE_AGENT
__device__ __forceinline__ unsigned f2bf(float f) { unsigned u = __builtin_bit_cast(unsigned, f); return (u + 0x7fffu + ((u >> 16) & 1u)) >> 16; }
__device__ __forceinline__ unsigned pk2(float lo, float hi) { return f2bf(lo) | (f2bf(hi) << 16); }
__device__ __forceinline__ float bf2f(unsigned v) { return __uint_as_float(v << 16); }
__device__ __forceinline__ unsigned pk4_fp8(float a, float b, float c, float d) { int w = 0; w = __builtin_amdgcn_cvt_pk_fp8_f32(a, b, w, false); w = __builtin_amdgcn_cvt_pk_fp8_f32(c, d, w, true); return (unsigned)w; }
constexpr float WDN_SCALE = 64.f;
constexpr float WGU_SCALE = 32.f;
__device__ __forceinline__ float bflo(unsigned w) { return __uint_as_float(w << 16); }
__device__ __forceinline__ float bfhi(unsigned w) { return __uint_as_float(w & 0xffff0000u); }
__device__ __forceinline__ float wave_sum(float v) {
#pragma unroll
    for (int o = 1; o < 64; o <<= 1) v += __shfl_xor(v, o);
    return v;
}
__device__ __forceinline__ float wave_max(float v) {
#pragma unroll
    for (int o = 1; o < 64; o <<= 1) v = fmaxf(v, __shfl_xor(v, o));
    return v;
}
__device__ __forceinline__ float sigmoidf_(float x) { return 1.f / (1.f + __expf(-x)); }

#define XB_TMO      128
#define XB_XCNT(j)  (256  + 64 * (j))
#define XB_XSUB(j)  (1280 + 64 * (j))
#define XB_XGEN(j)  (2304 + 64 * (j))
#define XB_TOP      3328
#define XB_TOPGEN   3392
#define XCD_BAR_WORDS 3456
#define XB_SPIN_CAP (1u << 20)
__device__ __forceinline__ unsigned xb_ld(unsigned* p)              { return __hip_atomic_load(p, __ATOMIC_RELAXED, __HIP_MEMORY_SCOPE_AGENT); }
__device__ __forceinline__ unsigned xb_add(unsigned* p, unsigned v) { return __hip_atomic_fetch_add(p, v, __ATOMIC_RELAXED, __HIP_MEMORY_SCOPE_AGENT); }
__device__ __forceinline__ unsigned xb_xcc_id() { return (unsigned)__builtin_amdgcn_s_getreg((3 << 11) | 20) & 0xFu; }
#define XB_SPIN(cond, bar) do { unsigned _sp = 0; while (cond) { __builtin_amdgcn_s_sleep(1); \
    if ((++_sp & 255u) == 0u) { if (xb_ld(&(bar)[XB_TMO])) break; if (_sp > XB_SPIN_CAP) { atomicAdd(&(bar)[XB_TMO], 1u); break; } } } } while (0)
struct XcdBarrier { unsigned* bar; unsigned x; volatile LAS unsigned* st; };
__device__ __forceinline__ XcdBarrier xcd_barrier_post(unsigned* bar, volatile LAS unsigned* st) {
    XcdBarrier b; b.bar = bar; b.x = xb_xcc_id(); b.st = st;
    if (threadIdx.x == 0) (void)xb_add(&bar[XB_XCNT(b.x)], 1u);
    return b;
}
__device__ __forceinline__ void xcd_barrier_complete(unsigned* bar, unsigned x, unsigned& nloc, unsigned& nx) {
    const unsigned G = gridDim.x * gridDim.y * gridDim.z;
    unsigned sum, cnt, mine, sp = 0u;
    for (;;) {
        sum = 0u; cnt = 0u; mine = 0u;
#pragma unroll
        for (unsigned j = 0; j < 16; ++j) { const unsigned c = xb_ld(&bar[XB_XCNT(j)]); sum += c; cnt += (c > 0u) ? 1u : 0u; mine = (j == x) ? c : mine; }
        if (sum == G) break;
        __builtin_amdgcn_s_sleep(1);
        if ((++sp & 255u) == 0u) { if (xb_ld(&bar[XB_TMO])) break; if (sp > XB_SPIN_CAP) { atomicAdd(&bar[XB_TMO], 1u); break; } }
    }
    nloc = mine > 0u ? mine : 1u; nx = cnt > 0u ? cnt : 1u;
}
__device__ __forceinline__ void xcd_barrier(const XcdBarrier& b) {
    asm volatile("s_waitcnt vmcnt(0)" ::: "memory");
    __syncthreads();
    if (threadIdx.x == 0) {
        unsigned* bar = b.bar;
        __builtin_amdgcn_s_waitcnt(0);
        unsigned nloc = b.st[0], nx = b.st[1];
        if (nloc == 0u) { xcd_barrier_complete(bar, b.x, nloc, nx); b.st[0] = nloc; b.st[1] = nx; }
        const unsigned old = xb_add(&bar[XB_XSUB(b.x)], 1u);
        const unsigned gen = old / nloc;
        if (old + 1u == (gen + 1u) * nloc) {
            __builtin_amdgcn_fence(__ATOMIC_RELEASE, "agent");
            asm volatile("s_waitcnt vmcnt(0)" ::: "memory");
            const unsigned og = xb_add(&bar[XB_TOP], 1u);
            const unsigned tg = og / nx;
            if (og + 1u == (tg + 1u) * nx) xb_add(&bar[XB_TOPGEN], 1u);
            else XB_SPIN(xb_ld(&bar[XB_TOPGEN]) == tg, bar);
            __builtin_amdgcn_fence(__ATOMIC_ACQUIRE, "agent");
            xb_add(&bar[XB_XGEN(b.x)], 1u);
            asm volatile("s_waitcnt vmcnt(0)" ::: "memory");
        } else {
            XB_SPIN(xb_ld(&bar[XB_XGEN(b.x)]) == gen, bar);
            __builtin_amdgcn_fence(__ATOMIC_ACQUIRE, "agent");
            asm volatile("s_waitcnt vmcnt(0)" ::: "memory");
        }
    }
    __syncthreads();
}

namespace pg8 {
#define PG8_LAS __attribute__((address_space(3)))
typedef unsigned short bf16_t;
typedef short bf16x8 __attribute__((ext_vector_type(8)));
typedef float f32x4 __attribute__((ext_vector_type(4)));
typedef unsigned u32x4 __attribute__((ext_vector_type(4)));
typedef int i32x4 __attribute__((ext_vector_type(4)));
typedef int i32x8 __attribute__((ext_vector_type(8)));
constexpr int BM = 256, BK = 64, HALF = 128, HTB = HALF * BK * 2  , STAGE_BYTES = 8 * HTB, NXCD = 8, WGM = 8;

__host__ __device__ __forceinline__ int lds_byte(int r, int c) { const int st = (r >> 4) * 2 + (c >> 5), rr = r & 15, cc = c & 31, ob = rr * 64 + cc * 2; return st * 1024 + (ob ^ (((ob >> 9) & 1) << 5)); }
__host__ __device__ __forceinline__ void stage_rc(int b, int& R, int& C) { const int st = b / 1024, sb = b % 1024, swz = sb ^ (((sb >> 9) & 1) << 5); R = (st >> 1) * 16 + swz / 64; C = (st & 1) * 32 + (swz % 64) / 2; }
__host__ __device__ __forceinline__ int perm32(int rho) { const int n = rho >> 4, i = rho & 15; return 8 * (i >> 2) + 4 * n + (i & 3); }

struct Unit { int pm, pn, pb, e; };
struct Gemm { const bf16_t* A; const bf16_t* Bt; int M, N, K; };

struct StaticOrder {
    int nM, nN, nwg, G, c;
    __host__ __device__ void init(int M, int N, int G_, int c_) { nM = M / BM; nN = N / BM; nwg = nM * nN; G = G_; c = c_; }
    __host__ __device__ bool next(int i, Unit& u) const {
        const long L = (long)i * G + c; if (L >= nwg) return false;
        int wgid = (int)L; { const int q = nwg / NXCD, r = nwg % NXCD, xcd = wgid % NXCD, off = wgid / NXCD; wgid = (xcd < r ? xcd * (q + 1) : r * (q + 1) + (xcd - r) * q) + off; }
        const int nig = WGM * nN, gid = wgid / nig, fm = gid * WGM, gsz = (nM - fm) < WGM ? (nM - fm) : WGM;
        u.pm = fm + ((wgid % nig) % gsz); u.pn = (wgid % nig) / gsz; u.pb = u.pn; u.e = 0; return true;
    }
    __device__ __forceinline__ void a_ready(const Unit&) const {}
    __device__ __forceinline__ void done(const Unit&) const {}
};

__device__ __forceinline__ void mfma8_inplace(f32x4& acc, const i32x8& b, const i32x8& a, int sc) {
    asm volatile("v_mfma_scale_f32_16x16x128_f8f6f4 %0, %1, %2, %0, %3, %3 op_sel_hi:[0,0,0]" : "+v"(acc) : "v"(b), "v"(a), "v"(sc)); }
__device__ __forceinline__ void glds16_s(const char* sbase, unsigned voff, unsigned lds_dst) { unsigned keep;
    asm volatile("s_mov_b32 %0, m0\n\ts_mov_b32 m0, %3\n\ts_nop 0\n\tglobal_load_lds_dwordx4 %1, %2\n\ts_mov_b32 m0, %0" : "=&s"(keep) : "v"(voff), "s"(sbase), "s"(lds_dst) : "memory"); }
template <class Epi, class Sched, bool ALIGN_EPI = false, bool SP2 = false, bool FP8 = false>
__device__ __forceinline__ void gemm_phase(PG8_LAS unsigned char* lds, const Gemm g, const Sched& S, const Epi& E) {
    int tid = threadIdx.x; asm volatile("" : "+v"(tid));
    const int wid = __builtin_amdgcn_readfirstlane(tid >> 6), lane = tid & 63, wr = wid >> 2, wc = wid & 3, fr = lane & 15, fq = lane >> 4;
    const int K = g.K, nt = K / BK;
    unsigned voffA[2], voffB[2];
#pragma unroll
    for (int i = 0; i < 2; ++i) { int R, C; stage_rc(tid * 16 + i * 8192, R, C); const int Rb = Epi::PERM ? ((R & ~31) + perm32(R & 31)) : R;
        voffA[i] = (unsigned)(R * K + C) * 2u; voffB[i] = (unsigned)(Rb * K + C) * 2u; }
    const size_t kstep = (size_t)(BK * 2);
    const size_t hstep = (size_t)HALF * K * 2;
    const size_t tstep = 2 * hstep;
    const unsigned ldsbase = (unsigned)(uintptr_t)lds;
    const unsigned ldsw = (unsigned)wid * 1024u;
    const int aoff = lds_byte(wr * 64 + fr, fq * 8), boff = lds_byte(wc * 32 + fr, fq * 8);
    const PG8_LAS unsigned char* lbaseA = lds + aoff; const PG8_LAS unsigned char* lbaseB = lds + 65536 + boff; asm volatile("" : "+v"(lbaseA), "+v"(lbaseB));
#define PG8_SA(b, h) (((b) * 2 + (h)) * HTB)
#define PG8_SB(b, h) ((4 + (b) * 2 + (h)) * HTB)
#define PG8_STAGE(bufoff, gbase, voff) do { _Pragma("unroll") for (int _i = 0; _i < 2; ++_i) { \
        if constexpr (FP8) glds16_s((const char*)(gbase), (voff)[_i], (unsigned)__builtin_amdgcn_readfirstlane(ldsbase + (unsigned)(bufoff) + ldsw + _i * 8192u)); \
        else __builtin_amdgcn_global_load_lds((const unsigned*)((const char*)(gbase) + (voff)[_i]), (PG8_LAS unsigned*)(lds + (bufoff) + ldsw + _i * 8192), 16, 0, 0); } } while (0)
#define PG8_LDFA(off) (*(const PG8_LAS bf16x8*)(lbaseA + (off)))
#define PG8_LDFB(off) (*(const PG8_LAS bf16x8*)(lbaseB + ((off) - 65536)))
#define PG8_LDA(dst, b, h) do { _Pragma("unroll") for (int m = 0; m < 4; ++m) { if constexpr (FP8) dst##8[m] = PG8_CAT8(PG8_LDFA(PG8_SA(b, h) + m * 2048), PG8_LDFA(PG8_SA(b, h) + m * 2048 + 1024)); \
        else { _Pragma("unroll") for (int k = 0; k < 2; ++k) dst[m][k] = PG8_LDFA(PG8_SA(b, h) + m * 2048 + k * 1024); } } } while (0)
#define PG8_LDB(dst, b, h) do { _Pragma("unroll") for (int n = 0; n < 2; ++n) { if constexpr (FP8) dst##8[n] = PG8_CAT8(PG8_LDFB(PG8_SB(b, h) + n * 2048), PG8_LDFB(PG8_SB(b, h) + n * 2048 + 1024)); \
        else { _Pragma("unroll") for (int k = 0; k < 2; ++k) dst[n][k] = PG8_LDFB(PG8_SB(b, h) + n * 2048 + k * 1024); } } } while (0)
#define PG8_CAT8(x0, x1) __builtin_shufflevector(__builtin_bit_cast(i32x4, x0), __builtin_bit_cast(i32x4, x1), 0, 1, 2, 3, 4, 5, 6, 7)
#define PG8_MMA(ai, bj, At, Bt) do { __builtin_amdgcn_s_setprio(1); _Pragma("unroll") for (int m = 0; m < 4; ++m) _Pragma("unroll") for (int n = 0; n < 2; ++n) { \
        if constexpr (FP8) mfma8_inplace(acc[ai][bj][m][n], Bt##8[n], At##8[m], sc8); \
        else { _Pragma("unroll") for (int k = 0; k < 2; ++k) acc[ai][bj][m][n] = __builtin_amdgcn_mfma_f32_16x16x32_bf16(Bt[n][k], At[m][k], acc[ai][bj][m][n], 0, 0, 0); } } \
        __builtin_amdgcn_s_setprio(0); } while (0)
#define PG8_WAIT_V(n) asm volatile("s_waitcnt vmcnt(" #n ")" ::: "memory")
#define PG8_WAIT_L(n) asm volatile("s_waitcnt lgkmcnt(" #n ")" ::: "memory")
#define PG8_BAR __builtin_amdgcn_s_barrier()
#define PG8_SCHED __builtin_amdgcn_sched_barrier(0)
    Unit cur, nxt; int ui = 0;
    if (!S.next(0, cur)) return;
    f32x4 acc[2][2][4][2];
#pragma unroll
    for (int a = 0; a < 2; ++a)
#pragma unroll
        for (int b = 0; b < 2; ++b)
#pragma unroll
            for (int m = 0; m < 4; ++m)
#pragma unroll
                for (int n = 0; n < 2; ++n) acc[a][b][m][n] = (f32x4){0.f, 0.f, 0.f, 0.f};
    int sc8 = 0x7f7f7f7f; asm volatile("" : "+v"(sc8));
    bf16x8 At[4][2], B0[2][2], B1[2][2]; i32x8 At8[4], B08[2], B18[2];
    const char* cA = (const char*)g.A + (size_t)cur.pm * tstep; const char* cB = (const char*)g.Bt + (size_t)cur.pb * tstep;
    S.a_ready(cur);
    if constexpr (SP2) {
        PG8_STAGE(PG8_SB(0, 0), cB, voffB); PG8_STAGE(PG8_SB(0, 1), cB + hstep, voffB); PG8_STAGE(PG8_SA(0, 0), cA, voffA); PG8_STAGE(PG8_SA(0, 1), cA + hstep, voffA);
        if (wr == 1) PG8_BAR;
        PG8_WAIT_V(2); PG8_BAR;
        PG8_STAGE(PG8_SB(1, 0), cB + kstep, voffB); PG8_STAGE(PG8_SA(1, 0), cA + kstep, voffA); PG8_STAGE(PG8_SB(1, 1), cB + hstep + kstep, voffB);
        PG8_WAIT_V(6); PG8_BAR;
    } else {
        PG8_STAGE(PG8_SB(0, 0), cB, voffB); PG8_STAGE(PG8_SA(0, 0), cA, voffA); PG8_STAGE(PG8_SB(0, 1), cB + hstep, voffB); PG8_STAGE(PG8_SA(0, 1), cA + hstep, voffA);
        if (wr == 1) PG8_BAR;
        PG8_WAIT_V(4); PG8_BAR;
        PG8_STAGE(PG8_SB(1, 0), cB + kstep, voffB); PG8_STAGE(PG8_SA(1, 0), cA + kstep, voffA); PG8_STAGE(PG8_SB(1, 1), cB + hstep + kstep, voffB);
        PG8_WAIT_V(6); PG8_BAR;
    }
    for (;;) {
        const bool has_next = S.next(ui + 1, nxt);
        const char* nA = has_next ? (const char*)g.A + (size_t)nxt.pm * tstep : cA; const char* nB = has_next ? (const char*)g.Bt + (size_t)nxt.pb * tstep : cB;
        for (int t = 0; t < nt; t += 2) {
            const bool last = (t == nt - 2);
            const char* a1 = cA + (size_t)(t + 1) * kstep;
            const char* a2 = last ? nA : cA + (size_t)(t + 2) * kstep; const char* b2 = last ? nB : cB + (size_t)(t + 2) * kstep;
            const char* a3 = a2 + kstep; const char* b3 = b2 + kstep;
            if (last && has_next) S.a_ready(nxt);
            if constexpr (SP2) {
            PG8_LDB(B0, 0, 0); PG8_LDB(B1, 0, 1); PG8_SCHED; PG8_LDA(At, 0, 0); PG8_STAGE(PG8_SA(1, 1), a1 + hstep, voffA);
            PG8_WAIT_V(8); PG8_WAIT_L(0); PG8_BAR; PG8_MMA(0, 0, At, B0); PG8_MMA(0, 1, At, B1); PG8_BAR; PG8_SCHED;
            PG8_LDA(At, 0, 1); PG8_STAGE(PG8_SB(0, 0), b2, voffB); PG8_STAGE(PG8_SB(0, 1), b2 + hstep, voffB); PG8_STAGE(PG8_SA(0, 0), a2, voffA);
            PG8_WAIT_V(8); PG8_WAIT_L(0); PG8_BAR; PG8_MMA(1, 0, At, B0); PG8_MMA(1, 1, At, B1); PG8_BAR; PG8_SCHED;
            PG8_LDB(B0, 1, 0); PG8_LDB(B1, 1, 1); PG8_SCHED; PG8_LDA(At, 1, 0); PG8_STAGE(PG8_SA(0, 1), a2 + hstep, voffA);
            PG8_WAIT_V(8); PG8_WAIT_L(0); PG8_BAR; PG8_MMA(0, 0, At, B0); PG8_MMA(0, 1, At, B1); PG8_BAR; PG8_SCHED;
            PG8_LDA(At, 1, 1); PG8_STAGE(PG8_SB(1, 0), b3, voffB); PG8_STAGE(PG8_SB(1, 1), b3 + hstep, voffB); PG8_STAGE(PG8_SA(1, 0), a3, voffA);
            PG8_WAIT_V(8); PG8_WAIT_L(0); PG8_BAR; PG8_MMA(1, 0, At, B0); PG8_MMA(1, 1, At, B1); PG8_BAR; PG8_SCHED;
            } else {
            PG8_LDB(B0, 0, 0); PG8_SCHED; PG8_LDA(At, 0, 0); PG8_STAGE(PG8_SA(1, 1), a1 + hstep, voffA);
            PG8_WAIT_L(8); PG8_BAR; PG8_WAIT_L(0); PG8_MMA(0, 0, At, B0); PG8_BAR; PG8_SCHED;
            PG8_LDB(B1, 0, 1); PG8_STAGE(PG8_SB(0, 0), b2, voffB);
            PG8_BAR; PG8_WAIT_L(0); PG8_MMA(0, 1, At, B1); PG8_BAR;
            PG8_LDA(At, 0, 1); PG8_STAGE(PG8_SA(0, 0), a2, voffA);
            PG8_BAR; PG8_WAIT_L(0); PG8_MMA(1, 0, At, B0); PG8_BAR; PG8_SCHED;
            PG8_STAGE(PG8_SB(0, 1), b2 + hstep, voffB);
            PG8_WAIT_V(6); PG8_BAR; PG8_MMA(1, 1, At, B1); PG8_BAR;
            PG8_LDB(B0, 1, 0); PG8_SCHED; PG8_LDA(At, 1, 0); PG8_STAGE(PG8_SA(0, 1), a2 + hstep, voffA);
            PG8_WAIT_L(8); PG8_BAR; PG8_WAIT_L(0); PG8_MMA(0, 0, At, B0); PG8_BAR; PG8_SCHED;
            PG8_LDB(B1, 1, 1); PG8_STAGE(PG8_SB(1, 0), b3, voffB);
            PG8_BAR; PG8_WAIT_L(0); PG8_MMA(0, 1, At, B1); PG8_BAR;
            PG8_LDA(At, 1, 1); PG8_STAGE(PG8_SA(1, 0), a3, voffA);
            PG8_BAR; PG8_WAIT_L(0); PG8_MMA(1, 0, At, B0); PG8_BAR; PG8_SCHED;
            PG8_STAGE(PG8_SB(1, 1), b3 + hstep, voffB);
            PG8_WAIT_V(6); PG8_BAR; PG8_MMA(1, 1, At, B1); PG8_BAR;
            }
        }
        int l2_ = threadIdx.x & 63; asm volatile("" : "+v"(l2_));
        typename Epi::Pre pre_; E.pre(pre_, cur, wr, wc, l2_ & 15, l2_ >> 4);
        if constexpr (ALIGN_EPI) { if (wr == 0) PG8_BAR; }
        if constexpr (FP8) { asm volatile("s_nop 15\n\ts_nop 3" ::: "memory"); __builtin_amdgcn_sched_barrier(0); }
        if constexpr (!Epi::AFTER_DRAIN) { E(acc, cur, wr, wc, l2_ & 15, l2_ >> 4, pre_); S.done(cur); }
        if (!has_next) break;
#pragma unroll
        for (int a = 0; a < 2; ++a)
#pragma unroll
            for (int b = 0; b < 2; ++b)
#pragma unroll
                for (int m = 0; m < 4; ++m)
#pragma unroll
                    for (int n = 0; n < 2; ++n) acc[a][b][m][n] = (f32x4){0.f, 0.f, 0.f, 0.f};
        cur = nxt; cA = nA; cB = nB; ++ui;
        if constexpr (ALIGN_EPI) { if (wr == 1) PG8_BAR; }
    }
    PG8_WAIT_V(0);
    if constexpr (!ALIGN_EPI) { if (wr == 0) PG8_BAR; }
    PG8_BAR;
    if constexpr (Epi::AFTER_DRAIN) { E.fused(acc, cur, wr, wc, fr, fq, lds, wid, lane); S.done(cur); }
#undef PG8_SA
#undef PG8_SB
#undef PG8_STAGE
#undef PG8_LDA
#undef PG8_LDFA
#undef PG8_LDFB
#undef PG8_LDB
#undef PG8_MMA
#undef PG8_CAT8
#undef PG8_WAIT_V
#undef PG8_WAIT_L
#undef PG8_BAR
#undef PG8_SCHED
}

__device__ __forceinline__ unsigned cvt_pk_bf16(float lo, float hi) { unsigned r; asm volatile("v_cvt_pk_bf16_f32 %0, %1, %2" : "=v"(r) : "v"(lo), "v"(hi)); return r; }
struct EpiBf16 {
    static constexpr bool PERM = true, AFTER_DRAIN = false;
    bf16_t* O; int ldc; unsigned smask; float s;
    struct Pre {}; __device__ __forceinline__ void pre(Pre&, const Unit&, int, int, int, int) const {}
    __device__ __forceinline__ void operator()(const f32x4 (&acc)[2][2][4][2], const Unit& u, int wr, int wc, int fr, int fq, const Pre&) const {
        const int row0 = u.pm * BM + wr * 64 + fr, col0 = u.pn * BM + wc * 32 + 8 * fq; const float sc = ((smask >> u.pn) & 1u) ? s : 1.f;
#pragma unroll
        for (int ai = 0; ai < 2; ++ai)
#pragma unroll
            for (int m = 0; m < 4; ++m) { bf16_t* rowp = O + (size_t)(row0 + ai * HALF + m * 16) * ldc + col0;
#pragma unroll
                for (int bj = 0; bj < 2; ++bj) { const f32x4 v0 = acc[ai][bj][m][0] * sc, v1 = acc[ai][bj][m][1] * sc;
                    u32x4 w; w.x = cvt_pk_bf16(v0[0], v0[1]); w.y = cvt_pk_bf16(v0[2], v0[3]); w.z = cvt_pk_bf16(v1[0], v1[1]); w.w = cvt_pk_bf16(v1[2], v1[3]);
                    *(u32x4*)(rowp + bj * HALF) = w; } }
    }
};
struct EpiResF32 {
    static constexpr bool PERM = false, AFTER_DRAIN = false;
    const float* base; float* out; int ldc; float alpha;
    struct Pre {}; __device__ __forceinline__ void pre(Pre&, const Unit&, int, int, int, int) const {}
    __device__ __forceinline__ void operator()(const f32x4 (&acc)[2][2][4][2], const Unit& u, int wr, int wc, int fr, int fq, const Pre&) const {
        const int col0 = u.pn * BM + wc * 32 + 4 * fq;
#pragma unroll
        for (int ai = 0; ai < 2; ++ai)
#pragma unroll
            for (int m = 0; m < 4; ++m) { const size_t off = (size_t)(u.pm * BM + ai * HALF + wr * 64 + m * 16 + fr) * ldc + col0;
#pragma unroll
                for (int bj = 0; bj < 2; ++bj)
#pragma unroll
                    for (int n = 0; n < 2; ++n) { const f32x4 bs = *(const f32x4*)(base + off + bj * HALF + n * 16); *(f32x4*)(out + off + bj * HALF + n * 16) = bs * alpha + acc[ai][bj][m][n]; }
                if (m & 1) asm volatile("" ::: "memory"); }
    }
};
struct EpiGateUp {
    static constexpr bool PERM = true, AFTER_DRAIN = false;
    bf16_t* O; const float* bias; float ascale;
    struct Pre { f32x4 b0, b1, b2, b3; };
    __device__ __forceinline__ void pre(Pre& p, const Unit& u, int wr, int wc, int fr, int fq) const {
        const float* bo = this->bias; asm volatile("" : "+s"(bo));
        const __attribute__((address_space(1))) float* bp = (const __attribute__((address_space(1))) float*)bo + (size_t)u.e * 2048 + 2 * (u.pn * 128 + wc * 32 + 8 * fq);
        typedef __attribute__((address_space(1))) f32x4 gf4; p.b0 = *(const gf4*)(bp); p.b1 = *(const gf4*)(bp + 4); p.b2 = *(const gf4*)(bp + 8); p.b3 = *(const gf4*)(bp + 12);
    }
    __device__ __forceinline__ void operator()(const f32x4 (&acc)[2][2][4][2], const Unit& u, int wr, int wc, int fr, int fq, const Pre& p) const {
        const int row0 = u.pm * BM + wr * 64 + fr, f0 = u.pn * 128 + wc * 32 + 8 * fq;
        bf16_t* Oo = this->O; asm volatile("" : "+s"(Oo));
        __attribute__((address_space(1))) bf16_t* O = (__attribute__((address_space(1))) bf16_t*)Oo;
        const f32x4 b0 = p.b0, b1 = p.b1, b2 = p.b2, b3 = p.b3;
        const float bg[8] = {b0[0], b0[2], b1[0], b1[2], b2[0], b2[2], b3[0], b3[2]}, bl[8] = {b0[1], b0[3], b1[1], b1[3], b2[1], b2[3], b3[1], b3[3]};
#pragma unroll
        for (int ai = 0; ai < 2; ++ai)
#pragma unroll
            for (int m = 0; m < 4; ++m) { float a[8];
#pragma unroll
                for (int n = 0; n < 2; ++n)
#pragma unroll
                    for (int q = 0; q < 4; ++q) { const float g = fminf(acc[ai][0][m][n][q] * ascale + bg[4 * n + q], 7.f), l = fminf(fmaxf(acc[ai][1][m][n][q] * ascale + bl[4 * n + q], -7.f), 7.f);
                        a[4 * n + q] = g * __builtin_amdgcn_rcpf(1.f + __builtin_amdgcn_exp2f(-1.702f * 1.4426950408889634f * g)) * (l + 1.f); }
                typedef unsigned u32x2g __attribute__((ext_vector_type(2))); u32x2g w; w.x = pk4_fp8(a[0], a[1], a[2], a[3]); w.y = pk4_fp8(a[4], a[5], a[6], a[7]);
                *(__attribute__((address_space(1))) u32x2g*)((__attribute__((address_space(1))) unsigned char*)O + (size_t)(row0 + ai * HALF + m * 16) * 1024 + f0) = w; }
    }
};
struct EpiDown {
    static constexpr bool PERM = true, AFTER_DRAIN = false;
    bf16_t* Y; const float* bias; const int* rowslot; const float* rowgate; const int* blkv; float ascale;
    struct Pre { f32x4 bv[2][2]; int slot[2][4]; float gt[2][4]; int nv; };
    __device__ __forceinline__ void pre(Pre& p, const Unit& u, int wr, int wc, int fr, int fq) const {
        const int col0 = u.pn * BM + wc * 32 + 8 * fq; p.nv = blkv[u.pm];
        const float* bp = bias + (size_t)u.e * 1024 + col0;
#pragma unroll
        for (int bj = 0; bj < 2; ++bj)
#pragma unroll
            for (int n = 0; n < 2; ++n) p.bv[bj][n] = *(const f32x4*)(bp + bj * HALF + 4 * n);
#pragma unroll
        for (int ai = 0; ai < 2; ++ai)
#pragma unroll
            for (int m = 0; m < 4; ++m) { const int r = ai * HALF + wr * 64 + m * 16 + fr; p.slot[ai][m] = rowslot[u.pm * BM + r]; p.gt[ai][m] = rowgate[u.pm * BM + r]; }
    }
    __device__ __forceinline__ void operator()(const f32x4 (&acc)[2][2][4][2], const Unit& u, int wr, int wc, int fr, int fq, const Pre& p) const {
        const int col0 = u.pn * BM + wc * 32 + 8 * fq, nv = p.nv;
        const f32x4 (&bv)[2][2] = p.bv; const int (&slot)[2][4] = p.slot; const float (&gt)[2][4] = p.gt;
#pragma unroll
        for (int ai = 0; ai < 2; ++ai)
#pragma unroll
            for (int m = 0; m < 4; ++m) { const int r = ai * HALF + wr * 64 + m * 16 + fr;
                if (r < nv) { const float g = gt[ai][m]; bf16_t* rowp = Y + (size_t)slot[ai][m] * 1024 + col0;
#pragma unroll
                    for (int bj = 0; bj < 2; ++bj) { const f32x4 v0 = (acc[ai][bj][m][0] * ascale + bv[bj][0]) * g, v1 = (acc[ai][bj][m][1] * ascale + bv[bj][1]) * g;
                        u32x4 w; w.x = cvt_pk_bf16(v0[0], v0[1]); w.y = cvt_pk_bf16(v0[2], v0[3]); w.z = cvt_pk_bf16(v1[0], v1[1]); w.w = cvt_pk_bf16(v1[2], v1[3]);
                        *(u32x4*)(rowp + bj * HALF) = w; } } }
    }
};
struct MoeOrder {
    const int* blke; int nunits, npn, gpx, c;
    __device__ __forceinline__ bool next(int i, Unit& u) const {
        const int L = (i * 8 + (c & 7)) * gpx + (c >> 3); if (L >= nunits) return false;
        const int blk = L / npn; u.pm = blk; u.pn = L - blk * npn; u.e = __builtin_amdgcn_readfirstlane(blke[blk]); u.pb = u.e * npn + u.pn; return true;
    }
    __device__ __forceinline__ void a_ready(const Unit&) const {}
    __device__ __forceinline__ void done(const Unit&) const {}
};
struct OneUnit { int pm, pn; __device__ __forceinline__ bool next(int i, Unit& u) const { if (i) return false; u.pm = pm; u.pn = pn; u.pb = pn; u.e = 0; return true; }
    __device__ __forceinline__ void a_ready(const Unit&) const {} __device__ __forceinline__ void done(const Unit&) const {} };
}

namespace attn_body {
typedef unsigned short abf;
using bf16x8=__attribute__((ext_vector_type(8)))short;
using s16x4=__attribute__((ext_vector_type(4)))short;
using f32x16=__attribute__((ext_vector_type(16)))float;
using u32x4=__attribute__((ext_vector_type(4)))unsigned;
constexpr int NW=8,QBLK=32,QB=QBLK*NW,KVBLK=64;
__device__ __forceinline__ int crow(int r,int hi){return (r&3)+8*(r>>2)+4*hi;}
#define SBAR() __builtin_amdgcn_sched_barrier(0)
constexpr int NSLOT=3, SLOTB=8192;
constexpr int LDS_K=0, LDS_V=NSLOT*SLOTB, LDS_WS=2*NSLOT*SLOTB, LDS_OST=LDS_WS+NW*64*4, LDS_BYTES=LDS_OST+NW*4096;
__device__ __forceinline__ void glds16(const void*gsrc,unsigned lds_dst){unsigned keep;
  asm volatile("s_mov_b32 %0, m0\n\ts_mov_b32 m0, %2\n\ts_nop 0\n\tglobal_load_lds_dwordx4 %1, off\n\ts_mov_b32 m0, %0":"=&s"(keep):"v"(gsrc),"s"(lds_dst):"memory");}
__device__ __forceinline__ float max3f(float a,float b,float c){float r;asm("v_max3_f32 %0, %1, %2, %3":"=v"(r):"v"(a),"v"(b),"v"(c));return r;}
__device__ __forceinline__ float max2f(float a,float b){float r;asm("v_max_f32_e32 %0, %1, %2":"=v"(r):"v"(a),"v"(b));return r;}
__device__ __forceinline__ float fadd_s(float a,float b){float r;asm("v_add_f32_e32 %0, %1, %2":"=v"(r):"v"(a),"v"(b));return r;}
__device__ __forceinline__ float fsub_s(float a,float b){float r;asm("v_sub_f32_e32 %0, %1, %2":"=v"(r):"v"(a),"v"(b));return r;}
typedef float f32x2_t __attribute__((ext_vector_type(2))); typedef __bf16 bf16x2_t __attribute__((ext_vector_type(2)));
__device__ __forceinline__ unsigned cvtpk_s(float lo,float hi){f32x2_t v={lo,hi};bf16x2_t b=__builtin_convertvector(v,bf16x2_t);return __builtin_bit_cast(unsigned,b);}
#define WAIT_BAR(N) asm volatile("s_waitcnt vmcnt(" #N ") lgkmcnt(0)\n\ts_barrier":::"memory")
__device__ __forceinline__ void qkt(f32x16&p0,f32x16&p1,const char*Kslot,const bf16x8*qr,const f32x16&c0,const f32x16&c1,int r32,int hi){
  const char*kb=Kslot+hi*1024+r32*16;
  #pragma unroll
  for(int d0=0;d0<4;++d0){
    const bf16x8 b0=*reinterpret_cast<const bf16x8*>(kb+d0*2048);
    const bf16x8 b1=*reinterpret_cast<const bf16x8*>(kb+d0*2048+512);
    if(d0==0){p0=__builtin_amdgcn_mfma_f32_32x32x16_bf16(b0,qr[0],c0,0,0,0);p1=__builtin_amdgcn_mfma_f32_32x32x16_bf16(b1,qr[0],c1,0,0,0);}
    else{p0=__builtin_amdgcn_mfma_f32_32x32x16_bf16(b0,qr[d0],p0,0,0,0);p1=__builtin_amdgcn_mfma_f32_32x32x16_bf16(b1,qr[d0],p1,0,0,0);}}
}
typedef __attribute__((address_space(3))) const char* lds_cptr;
typedef short v4i16_t __attribute__((ext_vector_type(4)));
__device__ __forceinline__ void kload8(bf16x8*kf,lds_cptr kp){
  kf[0]=*(const __attribute__((address_space(3))) bf16x8*)(kp);      kf[1]=*(const __attribute__((address_space(3))) bf16x8*)(kp+512);
  kf[2]=*(const __attribute__((address_space(3))) bf16x8*)(kp+2048); kf[3]=*(const __attribute__((address_space(3))) bf16x8*)(kp+2560);
  kf[4]=*(const __attribute__((address_space(3))) bf16x8*)(kp+4096); kf[5]=*(const __attribute__((address_space(3))) bf16x8*)(kp+4608);
  kf[6]=*(const __attribute__((address_space(3))) bf16x8*)(kp+6144); kf[7]=*(const __attribute__((address_space(3))) bf16x8*)(kp+6656);
}
__device__ __forceinline__ void kload2(bf16x8*kf,lds_cptr kp,int j){ kf[2*j]=*(const __attribute__((address_space(3))) bf16x8*)(kp+j*2048); kf[2*j+1]=*(const __attribute__((address_space(3))) bf16x8*)(kp+j*2048+512); }
__device__ __forceinline__ s16x4 vtr(lds_cptr p){ return __builtin_bit_cast(s16x4,__builtin_amdgcn_ds_read_tr16_b64_v4i16((__attribute__((address_space(3))) v4i16_t*)p)); }
__device__ __forceinline__ float rowmax(const f32x16&p0,const f32x16&p1){
  float a=max3f(p0[0],p0[1],p1[0]),b=max3f(p0[2],p0[3],p1[1]);a=max3f(a,p1[2],p1[3]);
  #pragma unroll
  for(int r=4;r<16;r+=4){a=max3f(a,p0[r],p0[r+1]);b=max3f(b,p0[r+2],p0[r+3]);a=max3f(a,p1[r],p1[r+1]);b=max3f(b,p1[r+2],p1[r+3]);}
  const float m=max2f(a,b);
  auto rr=__builtin_amdgcn_permlane32_swap(__float_as_uint(m),__float_as_uint(m),false,false);
  return max2f(__uint_as_float(rr[0]),__uint_as_float(rr[1]));
}
__device__ __forceinline__ void pv(f32x16*o,int vb,bf16x8 pa0,bf16x8 pa1,bf16x8 pa2,bf16x8 pa3){
  #pragma unroll
  for(int d0=0;d0<2;++d0){s16x4 lo[4],hi[4];
    #pragma unroll
    for(int ks=0;ks<4;++ks){
      asm volatile("ds_read_b64_tr_b16 %0,%1 offset:%c2":"=&v"(lo[ks]):"v"(vb),"i"(d0*4096+ks*1024):"memory");
      asm volatile("ds_read_b64_tr_b16 %0,%1 offset:%c2":"=&v"(hi[ks]):"v"(vb),"i"(d0*4096+ks*1024+512):"memory");}
    asm volatile("s_waitcnt lgkmcnt(0)":::"memory");SBAR();
    #define PK(k) (bf16x8){lo[k][0],lo[k][1],lo[k][2],lo[k][3],hi[k][0],hi[k][1],hi[k][2],hi[k][3]}
    o[d0]=__builtin_amdgcn_mfma_f32_32x32x16_bf16(pa0,PK(0),o[d0],0,0,0);
    o[d0]=__builtin_amdgcn_mfma_f32_32x32x16_bf16(pa1,PK(1),o[d0],0,0,0);
    o[d0]=__builtin_amdgcn_mfma_f32_32x32x16_bf16(pa2,PK(2),o[d0],0,0,0);
    o[d0]=__builtin_amdgcn_mfma_f32_32x32x16_bf16(pa3,PK(3),o[d0],0,0,0);
    #undef PK
  }
}
#ifndef ATTN_STORE16
#define ATTN_STORE16(p,v) (*(u32x4*)(p)=(v))
#endif
template<int THRL> __device__ __forceinline__ void attn_unit(const abf*Qw0,int QP,const abf*Kh,int KP,const abf*Vh,int VP,abf*Ow0,int OP,int NT,float c2,int q0,char*shm){
  int tid=threadIdx.x; asm volatile("":"+v"(tid)); const int lane=tid&63,r32=lane&31,hi=lane>>5; const int wid=__builtin_amdgcn_readfirstlane(tid>>6);
  const abf*Qw=Qw0+(long)(wid*QBLK)*QP;
  const unsigned lds0=(unsigned)(uintptr_t)shm;
  float*wsf=(float*)(shm+LDS_WS)+wid*64;
  const abf*ksrc=Kh+(long)lane*KP+wid*8;
  const abf*vsrc=Vh+(long)(16*(wid&3)+(lane>>2))*VP+(wid>>2)*32+(lane&3)*8;
  const unsigned kdst=lds0+LDS_K+wid*1024, vdst=lds0+LDS_V+wid*1024;
  #define DMA_K(t,slot) glds16(ksrc+(long)(t)*KVBLK*KP,(unsigned)__builtin_amdgcn_readfirstlane(kdst+(slot)))
  #define DMA_V(t,slot) glds16(vsrc+(long)(t)*KVBLK*VP,(unsigned)__builtin_amdgcn_readfirstlane(vdst+(slot)))
  const int vb0=(int)(lds0+LDS_V)+((lane>>4)&1)*32+(lane&3)*8+(4*hi+((lane&15)>>2))*64;
  const char*Kbase=shm+LDS_K; bf16x8 kf[8];
  const lds_cptr shm3=(lds_cptr)shm; const lds_cptr kp0=shm3+LDS_K+hi*1024+r32*16; const lds_cptr vp0=shm3+LDS_V+((lane>>4)&1)*32+(lane&3)*8+(4*hi+((lane&15)>>2))*64;
  DMA_K(0,0);DMA_V(0,0);DMA_K(1,SLOTB);
  bf16x8 qr[4];
  #pragma unroll
  for(int d0=0;d0<4;++d0)qr[d0]=*reinterpret_cast<const bf16x8*>(&Qw[(long)r32*QP+d0*16+hi*8]);
  float mhat=0.f,l_reg=0.f;f32x16 o[2];o[0]=f32x16{};o[1]=f32x16{};
  const int tdiag=__builtin_amdgcn_readfirstlane((q0+wid*QBLK)>>6);
  const float qrel4=(float)(q0+wid*QBLK+r32-4*hi);
  #define CINIT(C0,C1,t) do{ const int tt_=(t); const float dq_=qrel4-64.f*(float)tt_; \
    if(tt_!=tdiag){ float sc_=tt_<tdiag?c2:-c2; asm volatile("":"+v"(sc_)); const float sc8_=8.f*sc_, sc32_=32.f*sc_; \
      C0[0]=-mhat-sc_*dq_; C0[1]=C0[0]+sc_; C0[2]=C0[1]+sc_; C0[3]=C0[2]+sc_; \
      _Pragma("unroll") for(int r=4;r<16;++r) C0[r]=C0[r-4]+sc8_;          \
      _Pragma("unroll") for(int r=0;r<16;++r) C1[r]=C0[r]+sc32_; } \
    else { _Pragma("unroll") for(int r=0;r<16;++r){ const float cr_=(float)((r&3)+8*(r>>2)); C0[r]=-mhat-c2*__builtin_fabsf(dq_-cr_); C1[r]=-mhat-c2*__builtin_fabsf(dq_-cr_-32.f); } } }while(0)
  bool resc=false;
  #define START(P0,P1) do{ const float rm=rowmax(P0,P1); resc=false; \
    { const float dl=rm; mhat=fadd_s(mhat,dl); \
      _Pragma("unroll") for(int r=0;r<16;++r){P0[r]=fsub_s(P0[r],dl);P1[r]=fsub_s(P1[r],dl);} } \
    _Pragma("unroll") for(int r=0;r<16;++r)P0[r]=__builtin_amdgcn_exp2f(P0[r]); }while(0)
  #define RESC() do{ if(resc){ asm volatile("s_waitcnt lgkmcnt(0)":::"memory"); \
      _Pragma("unroll") for(int d_=0;d_<2;++d_) _Pragma("unroll") for(int r=0;r<16;++r)o[d_][r]*=wsf[crow(r,hi)]; } }while(0)
  f32x16 pA0,pA1,pB0,pB1;
  int sl_prev=0,sl_cur=0,sl_next=SLOTB;
  #define ROT() do{sl_prev=sl_cur;sl_cur=sl_next;sl_next=(sl_next==(NSLOT-1)*SLOTB)?0:sl_next+SLOTB;}while(0)
  DMA_K(2,2*SLOTB);
  WAIT_BAR(3);
  CINIT(pA0,pA1,0);
  qkt(pA0,pA1,Kbase,qr,pA0,pA1,r32,hi);asm volatile("s_nop 15\n\ts_nop 7":"+v"(pA0),"+v"(pA1));
  START(pA0,pA1);
  _Pragma("unroll") for(int r=0;r<16;++r)pA1[r]=__builtin_amdgcn_exp2f(pA1[r]);
  WAIT_BAR(0);
  DMA_K(3,0);DMA_V(1,SLOTB);
  ROT();
  kload8(kf,kp0+sl_cur);
  WAIT_BAR(2);
  s16x4 vlo[8],vhi[8]; u32x4 pw0,pw1,pw2,pw3;
  #define PKW(P,B) cvtpk_s(P[B],P[B+1])
  #define PAF(k) __builtin_bit_cast(bf16x8,pw##k)
  #define VFR(i) (bf16x8){vlo[i][0],vlo[i][1],vlo[i][2],vlo[i][3],vhi[i][0],vhi[i][1],vhi[i][2],vhi[i][3]}
  #define PIN(x) asm volatile("":"+v"(x))
  #define MX3(a,b,c) __builtin_fmaxf(__builtin_fmaxf((a),(b)),(c))
  #define GAPA(MF,A0,A1,A2,A3,W0,W1,PW) do{ MF; sacc+=A0; sacc+=A1; sacc+=A2; sacc+=A3; PIN(sacc); W0; W1; PIN(PW); SBAR(); }while(0)
  #define EX(v) __builtin_amdgcn_exp2f(v)
  #define GAPB(MF,X,B) do{ MF; X[B]=EX(X[B]); X[B+1]=EX(X[B+1]); X[B+2]=EX(X[B+2]); X[B+3]=EX(X[B+3]); PIN(X); SBAR(); }while(0)
  #define VRD(i) do{ vlo[i]=vtr(vp_+(((i)>>2)*4096+((i)&3)*1024)); vhi[i]=vtr(vp_+(((i)>>2)*4096+((i)&3)*1024+512)); }while(0)
  #define KRD(G,j) do{ if(G){ kload2(kf,kp0+sl_next,j); SBAR(); } }while(0)
  #define STEP(C0,C1,P0,P1,t,GK,GV,GL) do{ SBAR(); \
    CINIT(C0,C1,t); SBAR(); \
    const lds_cptr vp_=vp0+sl_prev; \
    VRD(0); SBAR(); float sacc=(P0[0]+P0[1]); \
    GAPA(C0=__builtin_amdgcn_mfma_f32_32x32x16_bf16(kf[0],qr[0],C0,0,0,0), P0[2],P0[3],P0[4],P0[5],     pw0[0]=PKW(P0,0), pw0[1]=PKW(P0,2), pw0); \
    VRD(4); SBAR(); GAPA(C1=__builtin_amdgcn_mfma_f32_32x32x16_bf16(kf[1],qr[0],C1,0,0,0), P0[6],P0[7],P0[8],P0[9],     pw0[2]=PKW(P0,4), pw0[3]=PKW(P0,6), pw0); \
    VRD(1); SBAR(); GAPA(C0=__builtin_amdgcn_mfma_f32_32x32x16_bf16(kf[2],qr[1],C0,0,0,0),   P0[10],P0[11],P0[12],P0[13], pw1[0]=PKW(P0,8), pw1[1]=PKW(P0,10), pw1); \
    VRD(5); SBAR(); GAPA(C1=__builtin_amdgcn_mfma_f32_32x32x16_bf16(kf[3],qr[1],C1,0,0,0),   P0[14],P0[15],P1[0],P1[1],   pw1[2]=PKW(P0,12),pw1[3]=PKW(P0,14), pw1); \
    VRD(2); SBAR(); GAPA(C0=__builtin_amdgcn_mfma_f32_32x32x16_bf16(kf[4],qr[2],C0,0,0,0),   P1[2],P1[3],P1[4],P1[5],     pw2[0]=PKW(P1,0), pw2[1]=PKW(P1,2), pw2); \
    VRD(6); SBAR(); GAPA(C1=__builtin_amdgcn_mfma_f32_32x32x16_bf16(kf[5],qr[2],C1,0,0,0),   P1[6],P1[7],P1[8],P1[9],     pw2[2]=PKW(P1,4), pw2[3]=PKW(P1,6), pw2); \
    VRD(3); SBAR(); GAPA(C0=__builtin_amdgcn_mfma_f32_32x32x16_bf16(kf[6],qr[3],C0,0,0,0),   P1[10],P1[11],P1[12],P1[13], pw3[0]=PKW(P1,8), pw3[1]=PKW(P1,10), pw3); \
    VRD(7); SBAR(); GAPA(C1=__builtin_amdgcn_mfma_f32_32x32x16_bf16(kf[7],qr[3],C1,0,0,0),   P1[14],P1[15],0.f,0.f,       pw3[2]=PKW(P1,12),pw3[3]=PKW(P1,14), pw3); \
    l_reg+=sacc; \
    if(GK){DMA_K((t)+3,sl_cur);} if(GV){DMA_V((t)+1,sl_next);} \
    { float a=MX3(C0[0],C0[1],C1[0]),b=MX3(C0[2],C0[3],C1[1]); a=MX3(a,C1[2],C1[3]); \
      _Pragma("unroll") for(int r=4;r<16;r+=4){a=MX3(a,C0[r],C0[r+1]);b=MX3(b,C0[r+2],C0[r+3]);a=MX3(a,C1[r],C1[r+1]);b=MX3(b,C1[r+2],C1[r+3]);} \
      float rm=__builtin_fmaxf(a,b); { auto rr=__builtin_amdgcn_permlane32_swap(__float_as_uint(rm),__float_as_uint(rm),false,false); rm=__builtin_fmaxf(__uint_as_float(rr[0]),__uint_as_float(rr[1])); } \
      resc=false; \
      if(__builtin_expect(__any(rm>(float)THRL),0)){ const float dl=__builtin_fmaxf(rm,0.f); mhat+=dl; \
        _Pragma("unroll") for(int r=0;r<16;++r){C0[r]-=dl;C1[r]-=dl;} \
        const float f=__builtin_amdgcn_exp2f(-dl); l_reg*=f; if(hi==0)wsf[r32]=f; resc=true; } } \
    SBAR(); \
    GAPB(o[0]=__builtin_amdgcn_mfma_f32_32x32x16_bf16(PAF(0),VFR(0),o[0],0,0,0), C0,0); \
    GAPB(o[1]=__builtin_amdgcn_mfma_f32_32x32x16_bf16(PAF(0),VFR(4),o[1],0,0,0), C0,4); \
    KRD(GL,0); GAPB(o[0]=__builtin_amdgcn_mfma_f32_32x32x16_bf16(PAF(1),VFR(1),o[0],0,0,0), C0,8); \
    KRD(GL,1); GAPB(o[1]=__builtin_amdgcn_mfma_f32_32x32x16_bf16(PAF(1),VFR(5),o[1],0,0,0), C0,12); \
    KRD(GL,2); GAPB(o[0]=__builtin_amdgcn_mfma_f32_32x32x16_bf16(PAF(2),VFR(2),o[0],0,0,0), C1,0); \
    KRD(GL,3); GAPB(o[1]=__builtin_amdgcn_mfma_f32_32x32x16_bf16(PAF(2),VFR(6),o[1],0,0,0), C1,4); \
    GAPB(o[0]=__builtin_amdgcn_mfma_f32_32x32x16_bf16(PAF(3),VFR(3),o[0],0,0,0), C1,8); \
    GAPB(o[1]=__builtin_amdgcn_mfma_f32_32x32x16_bf16(PAF(3),VFR(7),o[1],0,0,0), C1,12); \
    }while(0)
  int t=1;
  for(;t+5<NT;t+=2){
    STEP(pB0,pB1,pA0,pA1,t,true,true,true);     WAIT_BAR(2); RESC(); ROT();
    STEP(pA0,pA1,pB0,pB1,t+1,true,true,true);   WAIT_BAR(2); RESC(); ROT();
  }
  #define ENDW(tt) do{ if((tt)+3<NT){WAIT_BAR(2);} else if((tt)+2<NT){WAIT_BAR(1);} else {WAIT_BAR(0);} }while(0)
  for(;t+1<NT;t+=2){
    STEP(pB0,pB1,pA0,pA1,t,(t+3<NT),(t+1<NT),(t+1<NT));       ENDW(t);   RESC(); ROT();
    STEP(pA0,pA1,pB0,pB1,t+1,(t+4<NT),(t+2<NT),(t+2<NT));     ENDW(t+1); RESC(); ROT();
  }
  STEP(pB0,pB1,pA0,pA1,NT-1,false,false,false); RESC();
  { float sacc=pB0[0]+pB0[1]; _Pragma("unroll") for(int r=2;r<16;++r)sacc+=pB0[r]; _Pragma("unroll") for(int r=0;r<16;++r)sacc+=pB1[r]; l_reg+=sacc;
    pw0=(u32x4){PKW(pB0,0),PKW(pB0,2),PKW(pB0,4),PKW(pB0,6)};pw1=(u32x4){PKW(pB0,8),PKW(pB0,10),PKW(pB0,12),PKW(pB0,14)};pw2=(u32x4){PKW(pB1,0),PKW(pB1,2),PKW(pB1,4),PKW(pB1,6)};pw3=(u32x4){PKW(pB1,8),PKW(pB1,10),PKW(pB1,12),PKW(pB1,14)};
    SBAR(); pv(o,vb0+sl_cur,PAF(0),PAF(1),PAF(2),PAF(3)); }
  #undef PKW
  #undef PAF
  #undef VFR
  #undef PIN
  #undef MX3
  #undef GAPA
  #undef GAPB
  #undef EX
  #undef VRD
  #undef KRD
  #undef STEP
  #undef ENDW
  {auto rr=__builtin_amdgcn_permlane32_swap(__float_as_uint(l_reg),__float_as_uint(l_reg),false,false);l_reg=__uint_as_float(rr[0])+__uint_as_float(rr[1]);}
  if(hi==0)wsf[32+r32]=l_reg;asm volatile("s_waitcnt lgkmcnt(0)":::"memory");
  float rli[16];
  #pragma unroll
  for(int r=0;r<16;++r)rli[r]=__builtin_amdgcn_rcpf(wsf[32+crow(r,hi)]);
  abf*Ow=Ow0+(long)(wid*QBLK)*OP;
  { abf*stg=(abf*)(shm+LDS_OST)+wid*2048;
    #pragma unroll
    for(int r=0;r<16;++r){const int orow=crow(r,hi);
      #pragma unroll
      for(int d0=0;d0<2;++d0)stg[orow*64+d0*32+r32]=(abf)f2bf(o[d0][r]*rli[r]);}
    asm volatile("s_waitcnt lgkmcnt(0)":::"memory");
    #pragma unroll
    for(int i=0;i<4;++i){const int row=i*8+(lane>>3),ch=lane&7; const u32x4 v=*(const u32x4*)(stg+row*64+ch*8); ATTN_STORE16(Ow+(long)row*OP+ch*8,v);} }
  asm volatile("s_waitcnt lgkmcnt(0)\n\ts_barrier":::"memory");
  #undef DMA_K
  #undef DMA_V
  #undef CINIT
  #undef START
  #undef RESC
  #undef ROT
}
constexpr int ATTN_LDS_BYTES=LDS_BYTES;
#undef SBAR
#undef WAIT_BAR
}

struct Args { const float* in[23]; float* out; unsigned char* ws; int ph_lo, ph_hi; };
struct Frame {
    LAS unsigned char* lds; char* ldsg;
    volatile LAS unsigned* MISC;
    gu32* ctl;
    int tid, lane, wave, vcu, G;
    float* out; unsigned char* ws;
};
constexpr int INTAB_OFF = LDSCTL_OFF + 8192;
__device__ __forceinline__ const float* fin(const Frame& F, int i) {
    const LAS unsigned* t = (const LAS unsigned*)(F.lds + INTAB_OFF) + 2 * i;
    const unsigned lo = __builtin_amdgcn_readfirstlane(t[0]), hi = __builtin_amdgcn_readfirstlane(t[1]);
    return (const float*)(const GAS float*)(((unsigned long long)hi << 32) | lo);
}
#define WSP(T_, off) ((T_*)(F.ws + (off)))
__device__ __forceinline__ int fresh_tid() { int t = threadIdx.x; asm volatile("" : "+v"(t)); return t; }

template <int MODE>
__device__ __forceinline__ void p0_transpose_item(const float* W, int K, int N, bf16* WT, LAS float* scr, int item, int lane) {
    const int nblk = N / 32, kb = item / nblk, nb = item % nblk, k0 = 64 * kb, n0 = 32 * nb;
    { f32x4 ld[8];
#pragma unroll
      for (int i = 0; i < 8; ++i) ld[i] = *(const GAS f32x4*)(W + (size_t)(k0 + 8 * i + (lane >> 3)) * N + n0 + (lane & 7) * 4);
#pragma unroll
      for (int i = 0; i < 8; ++i) { LAS float* d = scr + (8 * i + (lane >> 3)) * 33 + (lane & 7) * 4; d[0] = ld[i].x; d[1] = ld[i].y; d[2] = ld[i].z; d[3] = ld[i].w; } }
    asm volatile("s_waitcnt lgkmcnt(0)" ::: "memory");
    const int c = lane & 7;
#pragma unroll
    for (int j = 0; j < 4; ++j) { const int n = (lane >> 3) + 8 * j; const LAS float* s = scr + (8 * c) * 33 + n;
        v4u o; o.x = pk2(s[0 * 33], s[1 * 33]); o.y = pk2(s[2 * 33], s[3 * 33]); o.z = pk2(s[4 * 33], s[5 * 33]); o.w = pk2(s[6 * 33], s[7 * 33]);
        int col = n0 + n, drow = col;
        *(GAS v4u*)(WT + (size_t)drow * K + k0 + 8 * c) = o; }
    asm volatile("s_waitcnt lgkmcnt(0)" ::: "memory");
}
__device__ __forceinline__ void row_to_bf16(const float* xrow, bf16* orow, int lane) {
    const GAS f32x4* xr = (const GAS f32x4*)xrow + lane;
    GAS v2u* o8 = (GAS v2u*)orow + lane;
#pragma unroll
    for (int j = 0; j < 4; ++j) { const f32x4 v = xr[64 * j]; v2u w; w.x = pk2(v.x, v.y); w.y = pk2(v.z, v.w); o8[64 * j] = w; }
}
__device__ __forceinline__ void p0_transpose_fp8_item(bool PERM, const float* W, int K, int N, unsigned char* WT, float wscale, LAS float* scr, int item, int lane) {
    const int nblk = N / 32, kb = item / nblk, nb = item % nblk, k0 = 128 * kb, n0 = 32 * nb, c = lane & 7;
    v2u o8[2][4];
#pragma unroll
    for (int p = 0; p < 2; ++p) {
        { f32x4 ld[8];
#pragma unroll
          for (int i = 0; i < 8; ++i) ld[i] = __builtin_nontemporal_load((const GAS f32x4*)(W + (size_t)(k0 + 64 * p + 8 * i + (lane >> 3)) * N + n0 + (lane & 7) * 4));
#pragma unroll
          for (int i = 0; i < 8; ++i) { LAS float* d = scr + (8 * i + (lane >> 3)) * 33 + (lane & 7) * 4; d[0] = ld[i].x; d[1] = ld[i].y; d[2] = ld[i].z; d[3] = ld[i].w; } }
        asm volatile("s_waitcnt lgkmcnt(0)" ::: "memory");
#pragma unroll
        for (int j = 0; j < 4; ++j) { const int n = (lane >> 3) + 8 * j; const LAS float* sp = scr + (8 * c) * 33 + n;
            o8[p][j].x = pk4_fp8(sp[0 * 33] * wscale, sp[1 * 33] * wscale, sp[2 * 33] * wscale, sp[3 * 33] * wscale); o8[p][j].y = pk4_fp8(sp[4 * 33] * wscale, sp[5 * 33] * wscale, sp[6 * 33] * wscale, sp[7 * 33] * wscale); }
        asm volatile("s_waitcnt lgkmcnt(0)" ::: "memory");
    }
#pragma unroll
    for (int j = 0; j < 4; ++j) { const int col = n0 + (lane >> 3) + 8 * j, pn = col >> 8, w = col & 255, drow = PERM ? 256 * pn + 128 * (w & 1) + (w >> 1) : col;
        GAS v2u* dp = (GAS v2u*)(WT + (size_t)drow * K + k0 + 8 * c); __builtin_nontemporal_store(o8[0][j], dp); __builtin_nontemporal_store(o8[1][j], dp + 8); }
}
__device__ __forceinline__ void p0_prologue(Frame& F) {
    LAS float* scr = (LAS float*)(F.lds + F.wave * 16384);
    const int gw = F.vcu * NWAVES + F.wave, NGW = F.G * NWAVES;
    constexpr int I_IN = 16 * (NIN / 32), I_KV = 16 * (512 / 32), I_O = 16 * (1024 / 32);
    constexpr int NITEMS = I_IN + I_KV + I_O;
    for (int it = gw; it < NITEMS; it += NGW) {
        int r = it;
        if (r < I_IN) { p0_transpose_item<0>(fin(F, 2), DM, NIN, WSP(bf16, WS_WIN), scr, r, F.lane); continue; } r -= I_IN;
        if (r < I_KV) { p0_transpose_item<0>(fin(F, 11), DM, 512, WSP(bf16, WS_WKV), scr, r, F.lane); continue; } r -= I_KV;
        p0_transpose_item<0>(fin(F, 12), DM, DM, WSP(bf16, WS_WO), scr, r, F.lane);
    }
    for (int i = F.vcu * NTHREADS + F.tid; i < DM * NE; i += F.G * NTHREADS) { const int e = i >> 10, k = i & 1023; const float w = fin(F, 15)[(size_t)k * NE + e] * fin(F, 13)[k];
        const unsigned hi = f2bf(w); WSP(bf16, WS_RWT)[i] = (bf16)hi; WSP(bf16, WS_RWT)[DM * NE + i] = (bf16)f2bf(w - bf2f(hi)); }
    if (gw < NE) { float a = 0.f; for (int k = F.lane; k < DM; k += 64) a += fin(F, 14)[k] * fin(F, 15)[(size_t)k * NE + gw];
        a = wave_sum(a); if (F.lane == 0) WSP(float, WS_RWT + 2 * DM * NE * 2)[gw] = a + fin(F, 16)[gw]; }
    for (int m = gw; m < T; m += NGW) row_to_bf16(fin(F, 0) + (size_t)m * DM, WSP(bf16, WS_XB) + (size_t)m * DM, F.lane);
    for (int m = gw; m < NB * MEML; m += NGW) row_to_bf16(fin(F, 1) + (size_t)m * DM, WSP(bf16, WS_MEMB) + (size_t)m * DM, F.lane);
}

__device__ __forceinline__ void p1_inproj(Frame& F) {
    { pg8::Gemm g{WSP(bf16, WS_XB), WSP(bf16, WS_WIN), T, NIN, DM}; pg8::StaticOrder S; S.init(T, NIN, F.G, (int)blockIdx.x);
      pg8::EpiBf16 E{WSP(bf16, WS_U), NIN, (1u << 0) | (1u << 1) | (1u << 11), C2};
      pg8::gemm_phase<pg8::EpiBf16, pg8::StaticOrder, true, true>(F.lds, g, S, E); }
}

constexpr int HCH = 64, NCH = SEQ / HCH, HU_STRIDE = 64 * 64 + 64;
namespace hg {
typedef short bf16x8 __attribute__((ext_vector_type(8)));
typedef short s16x4 __attribute__((ext_vector_type(4)));
typedef float f32x4 __attribute__((ext_vector_type(4)));
typedef unsigned u32x2 __attribute__((ext_vector_type(2)));
typedef short v4i16_t __attribute__((ext_vector_type(4)));
template <int N> __device__ __forceinline__ float row_shr_or(float x, float fill) { return __int_as_float(__builtin_amdgcn_update_dpp(__float_as_int(fill), __float_as_int(x), 0x110 + N, 0xf, 0xf, false)); }
__device__ __forceinline__ float row_cumprod(float x) { x *= row_shr_or<1>(x, 1.f); x *= row_shr_or<2>(x, 1.f); x *= row_shr_or<4>(x, 1.f); x *= row_shr_or<8>(x, 1.f); return x; }
__device__ __forceinline__ float sigm(float x) { return __builtin_amdgcn_rcpf(1.f + __builtin_amdgcn_exp2f(-1.4426950408889634f * x)); }
__device__ __forceinline__ unsigned pkbf(float lo, float hi) { typedef float f2 __attribute__((ext_vector_type(2))); typedef __bf16 b2 __attribute__((ext_vector_type(2))); f2 v = {lo, hi}; b2 o = __builtin_convertvector(v, b2); return __builtin_bit_cast(unsigned, o); }
__device__ __forceinline__ bf16x8 frag8(float a0, float a1, float a2, float a3, float a4, float a5, float a6, float a7) { typedef unsigned u4 __attribute__((ext_vector_type(4))); u4 w = {pkbf(a0, a1), pkbf(a2, a3), pkbf(a4, a5), pkbf(a6, a7)}; return __builtin_bit_cast(bf16x8, w); }
__device__ __forceinline__ s16x4 frag4s(float a0, float a1, float a2, float a3) { u32x2 w = {pkbf(a0, a1), pkbf(a2, a3)}; return __builtin_bit_cast(s16x4, w); }
__device__ __forceinline__ s16x4 trd(const LAS unsigned char* p) { return __builtin_bit_cast(s16x4, __builtin_amdgcn_ds_read_tr16_b64_v4i16((LAS v4i16_t*)p)); }
__device__ __forceinline__ float b2f(short v) { return __uint_as_float(((unsigned)(unsigned short)v) << 16); }

template <bool OUT>
__device__ __forceinline__ void unit(const bf16* U, const float* lbsrc, int b, int h, int dir, int c, f32x4 (&S)[4][4], float (&aprod)[4], LAS unsigned char* wl, int lane) {
    const int r = lane & 15, g = lane >> 4;
    LAS unsigned char* tHQ = wl + 8192; LAS unsigned char* tHF = wl + 10240; LAS unsigned char* tHI = wl + 12288; LAS float* aL = (LAS float*)(wl + 14336);
    LAS float* lbL = aL + 64;
    lbL[lane] = __builtin_amdgcn_rcpf(1.f + __expf(lbsrc[256 + h * 64 + lane] - lbsrc[h * 64 + lane]));
    float lbD[4];
#pragma unroll
    for (int cc = 0; cc < 4; ++cc) lbD[cc] = lbL[16 * cc + r];
#pragma unroll
    for (int mb = 0; mb < 4; ++mb) aprod[mb] = 1.f;
    const int lrow = lane >> 3, piece = lane & 7;
    const bf16* ubase = U + (size_t)b * SEQ * NIN + h * 64 + piece * 8;
    v4u stg[3][2];
#define HG_LOAD(sc) do { _Pragma("unroll") for (int hh = 0; hh < 2; ++hh) { const int i_ = 16 * (sc) + lrow + 8 * hh; const int t_ = dir ? HCH * c + HCH - 1 - i_ : HCH * c + i_; const bf16* p_ = ubase + (size_t)t_ * NIN; \
        stg[1][hh] = *(const GAS v4u*)(p_ + U_HF + dir * 256); stg[2][hh] = *(const GAS v4u*)(p_ + U_HI); } } while (0)
#define HG_LOADQ(sc) do { _Pragma("unroll") for (int hh = 0; hh < 2; ++hh) { const int i_ = 16 * (sc) + lrow + 8 * hh; const int t_ = dir ? HCH * c + HCH - 1 - i_ : HCH * c + i_; \
        stg[0][hh] = *(const GAS v4u*)(ubase + (size_t)t_ * NIN + U_HQ); } } while (0)
    HG_LOAD(0);
#pragma unroll 1
    for (int sc = 0; sc < 4; ++sc) {
        if (OUT) HG_LOADQ(sc);
#pragma unroll
        for (int hh = 0; hh < 2; ++hh) { const int off = (lrow + 8 * hh) * 128 + piece * 16;
            *(LAS v4u*)(tHF + off) = stg[1][hh]; *(LAS v4u*)(tHI + off) = stg[2][hh]; }
        if (sc < 3) HG_LOAD(sc + 1);
        s16x4 kteF[4], vF[4];
        const int q4 = r >> 2, p4 = r & 3;
#pragma unroll
        for (int mb = 0; mb < 4; ++mb) {
            const int toff = (4 * g + q4) * 128 + (16 * mb + 4 * p4) * 2;
            const s16x4 hfv = trd(tHF + toff); vF[mb] = trd(tHI + toff);
            float f[4], lp[4];
#pragma unroll
            for (int j = 0; j < 4; ++j) f[j] = lbD[mb] + (1.f - lbD[mb]) * sigm(b2f(hfv[j]));
            lp[0] = f[0]; lp[1] = lp[0] * f[1]; lp[2] = lp[1] * f[2]; lp[3] = lp[2] * f[3];
            float inc = lp[3];
            { const float u1 = __shfl_up(inc, 16); inc *= (g >= 1 ? u1 : 1.f); const float u2 = __shfl_up(inc, 32); inc *= (g >= 2 ? u2 : 1.f); }
            const float ex0 = __shfl_up(inc, 16), excl = g >= 1 ? ex0 : 1.f, plast = __shfl(inc, 48 + r);
            aprod[mb] *= plast;
            float kt[4];
#pragma unroll
            for (int j = 0; j < 4; ++j) kt[j] = (1.f - f[j]) * plast * __builtin_amdgcn_rcpf(excl * lp[j]);
            kteF[mb] = frag4s(kt[0], kt[1], kt[2], kt[3]);
            aL[16 * mb + r] = plast;
        }
        if (OUT) {
#pragma unroll
            for (int hh = 0; hh < 2; ++hh) *(LAS v4u*)(tHQ + (lrow + 8 * hh) * 128 + piece * 16) = stg[0][hh];
            float qe[4][4], ke[4][4];
#pragma unroll
            for (int cc = 0; cc < 4; ++cc) {
                const u32x2 wq = *(const LAS u32x2*)(tHQ + r * 128 + (16 * cc + 4 * g) * 2), wf = *(const LAS u32x2*)(tHF + r * 128 + (16 * cc + 4 * g) * 2);
                const float hq4[4] = {bflo(wq.x), bfhi(wq.x), bflo(wq.y), bfhi(wq.y)}, hf4[4] = {bflo(wf.x), bfhi(wf.x), bflo(wf.y), bfhi(wf.y)};
                const f32x4 lbv = *(const LAS f32x4*)&lbL[16 * cc + 4 * g];
#pragma unroll
                for (int e = 0; e < 4; ++e) { const float f = lbv[e] + (1.f - lbv[e]) * sigm(hf4[e]); const float P = row_cumprod(f);
                    qe[cc][e] = hq4[e] * sigm(hq4[e]) * P; ke[cc][e] = (1.f - f) * __builtin_amdgcn_rcpf(P); }
            }
            bf16x8 qeF[2], keF[2];
#pragma unroll
            for (int ks = 0; ks < 2; ++ks) { qeF[ks] = frag8(qe[2 * ks][0], qe[2 * ks][1], qe[2 * ks][2], qe[2 * ks][3], qe[2 * ks + 1][0], qe[2 * ks + 1][1], qe[2 * ks + 1][2], qe[2 * ks + 1][3]);
                keF[ks] = frag8(ke[2 * ks][0], ke[2 * ks][1], ke[2 * ks][2], ke[2 * ks][3], ke[2 * ks + 1][0], ke[2 * ks + 1][1], ke[2 * ks + 1][2], ke[2 * ks + 1][3]); }
            f32x4 cp = {0.f, 0.f, 0.f, 0.f};
            cp = __builtin_amdgcn_mfma_f32_16x16x32_bf16(keF[0], qeF[0], cp, 0, 0, 0); cp = __builtin_amdgcn_mfma_f32_16x16x32_bf16(keF[1], qeF[1], cp, 0, 0, 0);
            const s16x4 amF = frag4s(4 * g + 0 <= r ? cp[0] : 0.f, 4 * g + 1 <= r ? cp[1] : 0.f, 4 * g + 2 <= r ? cp[2] : 0.f, 4 * g + 3 <= r ? cp[3] : 0.f);
#pragma unroll
            for (int mb = 0; mb < 4; ++mb) {
                f32x4 ot = {0.f, 0.f, 0.f, 0.f}, oi = {0.f, 0.f, 0.f, 0.f};
                oi = __builtin_amdgcn_mfma_f32_16x16x16bf16_1k(vF[mb], amF, oi, 0, 0, 0);
#pragma unroll
                for (int ks = 0; ks < 2; ++ks) { const f32x4 s0 = S[2 * ks][mb], s1 = S[2 * ks + 1][mb];
                    ot = __builtin_amdgcn_mfma_f32_16x16x32_bf16(frag8(s0[0], s0[1], s0[2], s0[3], s1[0], s1[1], s1[2], s1[3]), qeF[ks], ot, 0, 0, 0); }
                ot = ot + oi;
                u32x2 w; w.x = pkbf(ot[0], ot[1]); w.y = pkbf(ot[2], ot[3]);
                *(LAS u32x2*)(wl + ((16 * sc + r) * 64 + 16 * mb + 4 * g) * 2) = w;
            }
        }
#pragma unroll
        for (int db = 0; db < 4; ++db) { const f32x4 ar = *(const LAS f32x4*)&aL[16 * db + 4 * g];
#pragma unroll
            for (int vb = 0; vb < 4; ++vb) S[db][vb] = __builtin_amdgcn_mfma_f32_16x16x16bf16_1k(kteF[db], vF[vb], S[db][vb] * ar, 0, 0, 0); }
    }
#undef HG_LOAD
#undef HG_LOADQ
}
}

__device__ __forceinline__ void p2_hgrn_local(Frame& F) {
    const int gw = F.vcu * NWAVES + F.wave, NGW = F.G * NWAVES, lane = F.lane;
    for (int u = gw; u < 32 * NCH; u += NGW) {
        const int seq = u / NCH, cp = u % NCH, b = seq >> 3, h = (seq >> 1) & 3, dir = seq & 1, c = dir ? NCH - 1 - cp : cp;
        hg::f32x4 S[4][4]; float aprod[4];
#pragma unroll
        for (int db = 0; db < 4; ++db)
#pragma unroll
            for (int vb = 0; vb < 4; ++vb) S[db][vb] = (hg::f32x4){0.f, 0.f, 0.f, 0.f};
        hg::unit<false>(WSP(bf16, WS_U), dir ? fin(F, 9) : fin(F, 8), b, h, dir, c, S, aprod, F.lds + F.wave * 16384, lane);
        float* hu = WSP(float, WS_HU) + (size_t)u * HU_STRIDE; const int r = lane & 15, g = lane >> 4;
#pragma unroll
        for (int db = 0; db < 4; ++db)
#pragma unroll
            for (int vb = 0; vb < 4; ++vb)
#pragma unroll
                for (int q = 0; q < 4; ++q) hu[(16 * db + 4 * g + q) * 64 + 16 * vb + r] = S[db][vb][q];
#pragma unroll
        for (int mb = 0; mb < 4; ++mb) hu[4096 + 16 * mb + r] = aprod[mb];
    }
    {
        LAS float* red = (LAS float*)(F.lds + LDSCTL_OFF + 1024);
        for (int r0 = F.vcu * 64; r0 < T; r0 += F.G * 64) {
            float mx = 0.f;
            for (int i = 0; i < 8; ++i) { const v4u w = *(const GAS v4u*)(WSP(bf16, WS_U) + (size_t)(r0 + F.wave * 8 + i) * NIN + U_DK + lane * 8);
                float ss = bflo(w.x) * bflo(w.x) + bfhi(w.x) * bfhi(w.x) + bflo(w.y) * bflo(w.y) + bfhi(w.y) * bfhi(w.y) + bflo(w.z) * bflo(w.z) + bfhi(w.z) * bfhi(w.z) + bflo(w.w) * bflo(w.w) + bfhi(w.w) * bfhi(w.w);
                ss += __shfl_xor(ss, 1); ss += __shfl_xor(ss, 2); ss += __shfl_xor(ss, 4); mx = fmaxf(mx, ss); }
            __syncthreads();
            if ((lane & 7) == 0) red[F.wave * 8 + (lane >> 3)] = mx;
            __syncthreads();
            if (F.tid < 8) { float m = red[F.tid]; for (int w = 1; w < 8; ++w) m = fmaxf(m, red[w * 8 + F.tid]);
                __hip_atomic_fetch_max((unsigned*)(F.ctl + CW_KN + (r0 / SEQ) * 8 + F.tid), __float_as_uint(m), RLX_AGENT); }
        }
    }
}
__device__ __forceinline__ void hgrn_scan(Frame& F) {
    for (int idx = F.vcu * NTHREADS + F.tid; idx < 32 * 4096; idx += F.G * NTHREADS) {
        const int seq = idx >> 12, dv = idx & 4095, d = dv >> 6;
        const float* hu = WSP(float, WS_HU) + (size_t)seq * NCH * HU_STRIDE; float* ss = WSP(float, WS_SS) + (size_t)seq * NCH * 4096 + dv;
        float st = 0.f;
#pragma unroll 8
        for (int cp = 0; cp < NCH; ++cp) { ss[(size_t)cp * 4096] = st; st = hu[(size_t)cp * HU_STRIDE + 4096 + d] * st + hu[(size_t)cp * HU_STRIDE + dv]; }
    }
}
constexpr int CV_IGU = 8 * (2048 / 32), CV_IDN = 8 * (1024 / 32), CV_NWAVEITEMS = NE * CV_IGU + NE * CV_IDN, CV_NGROUPS = CV_NWAVEITEMS / NWAVES;
__device__ __forceinline__ bool conv_items(Frame& F, LAS int* qs) {
    if (F.tid == 0) qs[1] = (int)__hip_atomic_fetch_add((unsigned*)(F.ctl + CW_CONVQ), 8u, RLX_AGENT);
    __syncthreads();
    const int g0 = __builtin_amdgcn_readfirstlane(qs[1]);
    __syncthreads();
    if (g0 >= CV_NGROUPS) return false;
    LAS float* scr = (LAS float*)(F.lds + F.wave * 16384);
#pragma unroll 1
    for (int gi = g0; gi < min(g0 + 8, CV_NGROUPS); ++gi) {
        int r = gi * NWAVES + F.wave; const bool gu = r < NE * CV_IGU; if (!gu) r -= NE * CV_IGU;
        const int per = gu ? CV_IGU : CV_IDN, e = r / per, n = gu ? 2048 : 1024;
        p0_transpose_fp8_item(gu, (gu ? fin(F, 17) : fin(F, 19)) + (size_t)e * DM * n, DM, n, (gu ? WSP(unsigned char, WS_WGU) : WSP(unsigned char, WS_WDN)) + (size_t)e * n * DM, gu ? WGU_SCALE : WDN_SCALE, scr, r - e * per, F.lane);
    }
    __syncthreads();
    return true;
}
__device__ __forceinline__ void p3_attn(Frame& F) {
    hgrn_scan(F);
    if (F.vcu < 8) {
        pg8::Gemm g{WSP(bf16, WS_MEMB), WSP(bf16, WS_WKV), NB * MEML, 512, DM}; pg8::OneUnit S{F.vcu >> 1, F.vcu & 1};
        pg8::EpiBf16 E{WSP(bf16, WS_MKV), 512, 0u, 1.f};
        pg8::gemm_phase<pg8::EpiBf16, pg8::OneUnit, false, true>(F.lds, g, S, E);
        asm volatile("s_waitcnt vmcnt(0)" ::: "memory"); __syncthreads();
        if (F.tid == 0) { __builtin_amdgcn_fence(__ATOMIC_RELEASE, "agent"); asm volatile("s_waitcnt vmcnt(0)" ::: "memory"); __hip_atomic_fetch_add((unsigned*)(F.ctl + CW_MKV), 1u, RLX_AGENT); }
    }
    const bf16* U = WSP(bf16, WS_U);
    const bf16* MKV = WSP(bf16, WS_MKV);
    LAS float* red = (LAS float*)(F.lds + LDSCTL_OFF + 1024);
    LAS int* qs = (LAS int*)(red + 16);
    bool conv_more = true, first_it = true;
    for (;;) {
        if (F.tid == 0) qs[0] = (int)__hip_atomic_fetch_add((unsigned*)(F.ctl + CW_QUEUE), 1u, RLX_AGENT);
        __syncthreads();
        const int it = __builtin_amdgcn_readfirstlane(qs[0]);
        __syncthreads();
        if (it >= 512 + 256) break;
        if (conv_more && !(first_it && (F.vcu & 1))) conv_more = conv_items(F, qs);
        first_it = false;
        if (it >= 512) {
            if (F.tid == 0) { unsigned sp = 0; while (__hip_atomic_load((unsigned*)(F.ctl + CW_MKV), RLX_AGENT) < 8u && ++sp < (1u << 22)) __builtin_amdgcn_s_sleep(2);
                __builtin_amdgcn_fence(__ATOMIC_ACQUIRE, "agent"); asm volatile("s_waitcnt vmcnt(0)" ::: "memory"); }
            __syncthreads();
            const int u = it - 512, b = u >> 6, h = (u >> 4) & 3, qb = u & 15; const size_t row0 = (size_t)b * SEQ + qb * 256;
            const bf16* Kp = MKV + (size_t)b * MEML * 512 + h * 64;
            attn_body::attn_unit<8>(U + row0 * NIN + U_MQ + h * 64, NIN, Kp, 512, Kp + 256, 512, WSP(bf16, WS_CAT) + row0 * DM + 768 + h * 64, DM, MEML / 64, 0.f, 0, F.ldsg);
            continue;
        }
        const int h = 3 - (it >> 7), b = (it >> 5) & 3, m = (it >> 4) & 1, qb = it & 15; const size_t row0 = (size_t)b * SEQ + qb * 256;
        const bf16* Qp = U + row0 * NIN + U_DQ + h * 128 + m * 64; const bf16* Kp = U + (size_t)b * SEQ * NIN + U_DK + h * 128 + m * 64; const bf16* Vp = U + (size_t)b * SEQ * NIN + U_DV + h * 128;
        bf16* Op = WSP(bf16, WS_OD) + row0 * DM + h * 256 + m * 128; const float c2 = __builtin_ldexpf(LOG2E, -2 * (h + 1)); int q0 = qb * 256, tlo, thi;
        {
            const int r = F.tid >> 1, hf = F.tid & 1; const bf16* qp = Qp + (size_t)r * NIN + hf * 32; const bf16* kp = Kp + (size_t)(q0 + r) * NIN + hf * 32;
            float qq = 0.f, qk = 0.f;
#pragma unroll
            for (int i = 0; i < 4; ++i) { const v4u a = *(const GAS v4u*)(qp + 8 * i), k4 = *(const GAS v4u*)(kp + 8 * i);
                qq += bflo(a.x) * bflo(a.x) + bfhi(a.x) * bfhi(a.x) + bflo(a.y) * bflo(a.y) + bfhi(a.y) * bfhi(a.y) + bflo(a.z) * bflo(a.z) + bfhi(a.z) * bfhi(a.z) + bflo(a.w) * bflo(a.w) + bfhi(a.w) * bfhi(a.w);
                qk += bflo(a.x) * bflo(k4.x) + bfhi(a.x) * bfhi(k4.x) + bflo(a.y) * bflo(k4.y) + bfhi(a.y) * bfhi(k4.y) + bflo(a.z) * bflo(k4.z) + bfhi(a.z) * bfhi(k4.z) + bflo(a.w) * bflo(k4.w) + bfhi(a.w) * bfhi(k4.w); }
            qq += __shfl_xor(qq, 1); qk += __shfl_xor(qk, 1);
            const float kn = sqrtf(__uint_as_float(__hip_atomic_load((unsigned*)(F.ctl + CW_KN + b * 8 + h * 2 + m), RLX_AGENT))) * 1.0001f;
            float need = wave_max(sqrtf(qq) * 1.0001f * kn - qk + 36.5f);
            if (F.lane == 0) red[F.wave] = need;
            __syncthreads();
            need = red[0];
#pragma unroll
            for (int w = 1; w < 8; ++w) need = fmaxf(need, red[w]);
            const float dist = need / c2;
            const float flo = floorf(((float)(q0 - 63) - dist) * (1.f / 64.f)) + 1.f, fhi = ceilf(((float)(q0 + 255) + dist) * (1.f / 64.f)) - 1.f;
            tlo = flo < 0.f ? 0 : (int)flo; if (tlo > 4 * qb) tlo = 4 * qb;
            thi = fhi > (float)(SEQ / 64 - 1) ? SEQ / 64 - 1 : (int)fhi; if (thi < 4 * qb + 3) thi = 4 * qb + 3;
            if (((thi - tlo + 1) & 1) != 0) { if (tlo > 0) --tlo; else ++thi; }
            tlo = __builtin_amdgcn_readfirstlane(tlo); thi = __builtin_amdgcn_readfirstlane(thi);
            __syncthreads();
        }
        const int NT = thi - tlo + 1; Kp += (size_t)tlo * 64 * NIN; Vp += (size_t)tlo * 64 * NIN; q0 -= tlo * 64;
#pragma unroll 1
        for (int vh = 0; vh < 2; ++vh) attn_body::attn_unit<8>(Qp, NIN, Kp, NIN, Vp + vh * 64, NIN, Op + vh * 64, DM, NT, c2, q0, F.ldsg);
    }
    while (conv_more) conv_more = conv_items(F, qs);
}

__device__ __forceinline__ void hgrn_out(Frame& F) {
    const int lane = F.lane, wave = F.wave, r = lane & 15, g = lane >> 4;
    for (int u0 = F.vcu * NWAVES; u0 < 32 * NCH; u0 += F.G * NWAVES) {
        const int u = u0 + wave, bhc = u >> 1, dir = u & 1, b = bhc / (4 * NCH), h = (bhc / NCH) & 3, c = bhc % NCH, cp = dir ? NCH - 1 - c : c, seq = b * 8 + h * 2 + dir;
        const float* ss = WSP(float, WS_SS) + ((size_t)seq * NCH + cp) * 4096;
        hg::f32x4 S[4][4]; float aprod[4];
#pragma unroll
        for (int db = 0; db < 4; ++db)
#pragma unroll
            for (int vb = 0; vb < 4; ++vb)
#pragma unroll
                for (int q = 0; q < 4; ++q) S[db][vb][q] = ss[(16 * db + 4 * g + q) * 64 + 16 * vb + r];
        hg::unit<true>(WSP(bf16, WS_U), dir ? fin(F, 9) : fin(F, 8), b, h, dir, c, S, aprod, F.lds + wave * 16384, lane);
        __syncthreads();
        const LAS unsigned char* Of = F.lds + (wave & ~1) * 16384; const LAS unsigned char* Ob = F.lds + (wave | 1) * 16384;
        const int i16 = lane & 15, k4 = lane >> 4; const f32x4 nw = *(const GAS f32x4*)(fin(F, 10) + h * 64 + 4 * i16);
#pragma unroll 2
        for (int k0 = 0; k0 < 32; k0 += 4) { const int tl = dir * 32 + k0 + k4; const size_t row = (size_t)b * SEQ + c * HCH + tl;
            const v2u gq = *(const GAS v2u*)(WSP(bf16, WS_U) + row * NIN + U_HG + h * 64 + 4 * i16);
            const v2u a = *(const LAS v2u*)(Of + tl * 128 + 8 * i16), bb = *(const LAS v2u*)(Ob + (HCH - 1 - tl) * 128 + 8 * i16);
            const float o0 = bflo(a.x) + bflo(bb.x), o1 = bfhi(a.x) + bfhi(bb.x), o2 = bflo(a.y) + bflo(bb.y), o3 = bfhi(a.y) + bfhi(bb.y);
            float ss2 = (o0 * o0 + o1 * o1) + (o2 * o2 + o3 * o3);
            ss2 += __shfl_xor(ss2, 1); ss2 += __shfl_xor(ss2, 2); ss2 += __shfl_xor(ss2, 4); ss2 += __shfl_xor(ss2, 8);
            const float rr = rsqrtf(ss2 * (1.f / 64.f) + EPS);
            v2u w; w.x = pk2(o0 * rr * nw.x * sigmoidf_(bflo(gq.x)), o1 * rr * nw.y * sigmoidf_(bfhi(gq.x))); w.y = pk2(o2 * rr * nw.z * sigmoidf_(bflo(gq.y)), o3 * rr * nw.w * sigmoidf_(bfhi(gq.y)));
            *(GAS v2u*)(WSP(bf16, WS_CAT) + row * DM + 512 + h * 64 + 4 * i16) = w; }
        __syncthreads();
    }
}

__device__ __forceinline__ void p4_combine(Frame& F) {
    hgrn_out(F);
    const int gw = F.vcu * NWAVES + F.wave, NGW = F.G * NWAVES, lane = F.lane;
    const float sa = wave_sum(fin(F, 3)[lane] * fin(F, 4)[lane]), sb = wave_sum(fin(F, 5)[lane] * fin(F, 6)[lane]);
    const float lam = __expf(sa) - __expf(sb) + 0.2f;
    const bf16* OD = WSP(bf16, WS_OD); bf16* CAT = WSP(bf16, WS_CAT);
    const int i16 = lane & 15, mm = (lane >> 4) & 1, hh = lane >> 5;
    const f32x4 dw0 = *(const GAS f32x4*)(fin(F, 7) + 8 * i16), dw1 = *(const GAS f32x4*)(fin(F, 7) + 8 * i16 + 4);
    v4u nx[2];
#pragma unroll
    for (int x = 0; x < 2; ++x) nx[x] = *(const GAS v4u*)(OD + (size_t)gw * DM + 512 * x + 8 * lane);
    for (int row = gw; row < T; row += NGW) {
        v4u cur[2] = {nx[0], nx[1]};
        if (row + NGW < T) {
#pragma unroll
            for (int x = 0; x < 2; ++x) nx[x] = *(const GAS v4u*)(OD + (size_t)(row + NGW) * DM + 512 * x + 8 * lane); }
#pragma unroll
        for (int x = 0; x < 2; ++x) {
            const v4u a = cur[x]; v4u b; b.x = __shfl_xor(a.x, 16); b.y = __shfl_xor(a.y, 16); b.z = __shfl_xor(a.z, 16); b.w = __shfl_xor(a.w, 16);
            float o[8] = {bflo(a.x) - lam * bflo(b.x), bfhi(a.x) - lam * bfhi(b.x), bflo(a.y) - lam * bflo(b.y), bfhi(a.y) - lam * bfhi(b.y),
                          bflo(a.z) - lam * bflo(b.z), bfhi(a.z) - lam * bfhi(b.z), bflo(a.w) - lam * bflo(b.w), bfhi(a.w) - lam * bfhi(b.w)};
            float ss = 0.f;
#pragma unroll
            for (int k = 0; k < 8; ++k) ss += o[k] * o[k];
            ss += __shfl_xor(ss, 1); ss += __shfl_xor(ss, 2); ss += __shfl_xor(ss, 4); ss += __shfl_xor(ss, 8);
            const float r = rsqrtf(ss * (1.f / 128.f) + EPS) * 0.8f;
            if (mm == 0) { v4u w; w.x = pk2(o[0] * r * dw0.x, o[1] * r * dw0.y); w.y = pk2(o[2] * r * dw0.z, o[3] * r * dw0.w); w.z = pk2(o[4] * r * dw1.x, o[5] * r * dw1.y); w.w = pk2(o[6] * r * dw1.z, o[7] * r * dw1.w);
                *(GAS v4u*)(CAT + (size_t)row * DM + (2 * x + hh) * 128 + 8 * i16) = w; }
        }
    }
}

__device__ __forceinline__ void p4_wo(Frame& F) {
    pg8::Gemm g{WSP(bf16, WS_CAT), WSP(bf16, WS_WO), T, DM, DM}; pg8::StaticOrder S; S.init(T, DM, F.G, (int)blockIdx.x);
    pg8::EpiResF32 E{fin(F, 0), WSP(float, WS_Z1), DM, ALPHA};
    pg8::gemm_phase<pg8::EpiResF32, pg8::StaticOrder, true, true>(F.lds, g, S, E);
}

__device__ __forceinline__ void ln_row(f32x4 (&v)[4], const float* g, const float* bb, int lane, float& mean, float& rstd) {
    float s = 0.f;
#pragma unroll
    for (int j = 0; j < 4; ++j) s += (v[j].x + v[j].y) + (v[j].z + v[j].w);
    mean = wave_sum(s) * (1.f / DM); float s2 = 0.f;
#pragma unroll
    for (int j = 0; j < 4; ++j) { v[j] = v[j] - mean; s2 += (v[j].x * v[j].x + v[j].y * v[j].y) + (v[j].z * v[j].z + v[j].w * v[j].w); }
    rstd = rsqrtf(wave_sum(s2) * (1.f / DM) + EPS);
#pragma unroll
    for (int j = 0; j < 4; ++j) { const f32x4 gv = *(const GAS f32x4*)(g + 4 * lane + 256 * j), bv = *(const GAS f32x4*)(bb + 4 * lane + 256 * j); v[j] = v[j] * rstd * gv + bv; }
}

__device__ __forceinline__ void ln_row_pre(f32x4 (&v)[4], const f32x4 (&gv)[4], const f32x4 (&bv)[4], float& mean, float& rstd) {
    float s = 0.f;
#pragma unroll
    for (int j = 0; j < 4; ++j) s += (v[j].x + v[j].y) + (v[j].z + v[j].w);
    mean = wave_sum(s) * (1.f / DM); float s2 = 0.f;
#pragma unroll
    for (int j = 0; j < 4; ++j) { v[j] = v[j] - mean; s2 += (v[j].x * v[j].x + v[j].y * v[j].y) + (v[j].z * v[j].z + v[j].w * v[j].w); }
    rstd = rsqrtf(wave_sum(s2) * (1.f / DM) + EPS);
#pragma unroll
    for (int j = 0; j < 4; ++j) v[j] = v[j] * rstd * gv[j] + bv[j];
}
__device__ __forceinline__ void p5_router(Frame& F) {
    typedef short bf16x8r __attribute__((ext_vector_type(8)));
    LAS float* LG = (LAS float*)F.lds;
    LAS float* PX = LG + 64 * 33;
    LAS int* SEL = (LAS int*)(F.lds + LDSCTL_OFF + 1024);
    LAS int* LRK = SEL + 512;
    LAS unsigned* LCNT = (LAS unsigned*)(SEL + 1024);
    LAS unsigned* LBASE = LCNT + 32;
    if (F.tid < 32) LCNT[F.tid] = 0u;
    const int lane = F.lane, r = lane & 15, g = lane >> 4, tg = F.wave & 3, kh = F.wave >> 2;
    int* TOPI = WSP(int, WS_ROUTE); float* TOPG = WSP(float, WS_ROUTE + 256 * 1024); int* RANK = WSP(int, WS_ROUTE + 512 * 1024); float* STATS = WSP(float, WS_ROUTE + 768 * 1024);
    const int rpb = T / F.G;
    const int row = F.vcu * rpb + tg * 16 + r;
    const float* zr = WSP(float, WS_Z1) + (size_t)row * DM + 8 * g + 512 * kh;
    f32x4 z[16][2];
#pragma unroll
    for (int ks = 0; ks < 16; ++ks) { z[ks][0] = *(const GAS f32x4*)(zr + 32 * ks); z[ks][1] = *(const GAS f32x4*)(zr + 32 * ks + 4); }
    const bf16* wh = WSP(bf16, WS_RWT) + (size_t)r * DM + 8 * g + 512 * kh; const bf16* wl = wh + DM * NE;
    bf16x8r Bc[2][2], Bn[2][2];
#pragma unroll
    for (int nb = 0; nb < 2; ++nb) { Bc[nb][0] = *(const GAS bf16x8r*)(wh + (size_t)nb * 16 * DM); Bc[nb][1] = *(const GAS bf16x8r*)(wl + (size_t)nb * 16 * DM); }
    float s1 = 0.f, s2 = 0.f;
#pragma unroll
    for (int ks = 0; ks < 16; ++ks) { const f32x4 a = z[ks][0], b = z[ks][1];
        s1 += (a.x + a.y) + (a.z + a.w) + (b.x + b.y) + (b.z + b.w); s2 += (a.x * a.x + a.y * a.y) + (a.z * a.z + a.w * a.w) + (b.x * b.x + b.y * b.y) + (b.z * b.z + b.w * b.w); }
    s1 += __shfl_xor(s1, 16); s1 += __shfl_xor(s1, 32); s2 += __shfl_xor(s2, 16); s2 += __shfl_xor(s2, 32);
    LAS float* PS = PX + 4 * 2 * 64 * 4;
    if (g == 0) { PS[(F.wave * 16 + r) * 2] = s1; PS[(F.wave * 16 + r) * 2 + 1] = s2; }
    __syncthreads();
    { const int pw = F.wave ^ 4; s1 += PS[(pw * 16 + r) * 2]; s2 += PS[(pw * 16 + r) * 2 + 1]; }
    const float mean = s1 * (1.f / DM), rstd = rsqrtf(fmaxf(s2 * (1.f / DM) - mean * mean, 0.f) + EPS);
    if (kh == 0 && g == 0) { STATS[2 * row] = mean; STATS[2 * row + 1] = rstd; }
    f32x4 acc[2] = {{0.f, 0.f, 0.f, 0.f}, {0.f, 0.f, 0.f, 0.f}};
#pragma unroll
    for (int ks = 0; ks < 16; ++ks) {
        if (ks + 1 < 16) {
#pragma unroll
            for (int nb = 0; nb < 2; ++nb) { Bn[nb][0] = *(const GAS bf16x8r*)(wh + (size_t)nb * 16 * DM + 32 * (ks + 1)); Bn[nb][1] = *(const GAS bf16x8r*)(wl + (size_t)nb * 16 * DM + 32 * (ks + 1)); } }
        const f32x4 ha = (z[ks][0] - mean) * rstd, hb = (z[ks][1] - mean) * rstd;
        const float h[8] = {ha.x, ha.y, ha.z, ha.w, hb.x, hb.y, hb.z, hb.w}; unsigned hi[8]; float lo[8];
#pragma unroll
        for (int j = 0; j < 8; ++j) { hi[j] = f2bf(h[j]); lo[j] = h[j] - bf2f(hi[j]); }
        v4u Ah, Al; Ah.x = hi[0] | (hi[1] << 16); Ah.y = hi[2] | (hi[3] << 16); Ah.z = hi[4] | (hi[5] << 16); Ah.w = hi[6] | (hi[7] << 16);
        Al.x = pk2(lo[0], lo[1]); Al.y = pk2(lo[2], lo[3]); Al.z = pk2(lo[4], lo[5]); Al.w = pk2(lo[6], lo[7]);
        const bf16x8r ah = __builtin_bit_cast(bf16x8r, Ah), al = __builtin_bit_cast(bf16x8r, Al);
#pragma unroll
        for (int nb = 0; nb < 2; ++nb) { acc[nb] = __builtin_amdgcn_mfma_f32_16x16x32_bf16(ah, Bc[nb][0], acc[nb], 0, 0, 0); acc[nb] = __builtin_amdgcn_mfma_f32_16x16x32_bf16(ah, Bc[nb][1], acc[nb], 0, 0, 0);
            acc[nb] = __builtin_amdgcn_mfma_f32_16x16x32_bf16(al, Bc[nb][0], acc[nb], 0, 0, 0); }
#pragma unroll
        for (int nb = 0; nb < 2; ++nb) { Bc[nb][0] = Bn[nb][0]; Bc[nb][1] = Bn[nb][1]; }
    }
    if (kh == 1) { *(LAS f32x4*)&PX[((tg * 2 + 0) * 64 + lane) * 4] = acc[0]; *(LAS f32x4*)&PX[((tg * 2 + 1) * 64 + lane) * 4] = acc[1]; }
    __syncthreads();
    if (kh == 0) {
#pragma unroll
        for (int nb = 0; nb < 2; ++nb) { const f32x4 o = acc[nb] + *(const LAS f32x4*)&PX[((tg * 2 + nb) * 64 + lane) * 4]; const float bias = WSP(float, WS_RWT + 2 * DM * NE * 2)[16 * nb + r];
#pragma unroll
            for (int q = 0; q < 4; ++q) LG[(tg * 16 + 4 * g + q) * 33 + 16 * nb + r] = o[q] + bias; }
    }
    __syncthreads();
    LAS float* selv = (LAS float*)(F.lds + LDSCTL_OFF + 6144 + F.wave * 32); LAS int* seli = (LAS int*)(selv + 4);
    for (int rl = F.wave; rl < rpb; rl += NWAVES) {
        const int trow = F.vcu * rpb + rl; const float logit = LG[rl * 33 + (lane >> 1)];
        const int myi = lane >> 1; int rank = 0;
#pragma unroll
        for (int e2 = 0; e2 < 32; ++e2) { const float o = __int_as_float(__builtin_amdgcn_readlane(__float_as_int(logit), 2 * e2)); rank += (o > logit || (o == logit && e2 < myi)) ? 1 : 0; }
        if ((lane & 1) == 0 && rank < 4) { selv[rank] = logit; seli[rank] = myi; }
        float tv[4]; int ti[4];
#pragma unroll
        for (int k = 0; k < 4; ++k) { tv[k] = selv[k]; ti[k] = seli[k]; }
        const float e1 = __expf(tv[1] - tv[0]), e2 = __expf(tv[2] - tv[0]), e3 = __expf(tv[3] - tv[0]); const float inv = 1.f / (1.f + e1 + e2 + e3);
        if (lane < 4) { const int e = lane == 0 ? ti[0] : lane == 1 ? ti[1] : lane == 2 ? ti[2] : ti[3]; const float gt = (lane == 0 ? 1.f : lane == 1 ? e1 : lane == 2 ? e2 : e3) * inv;
            TOPI[trow * 4 + lane] = e; TOPG[trow * 4 + lane] = gt; SEL[rl * 4 + lane] = e;
            LRK[rl * 4 + lane] = (int)__hip_atomic_fetch_add((LAS unsigned*)&LCNT[e], 1u, __ATOMIC_RELAXED, __HIP_MEMORY_SCOPE_WORKGROUP); }
    }
    __syncthreads();
    if (F.tid < 32) LBASE[F.tid] = __hip_atomic_fetch_add((unsigned*)(F.ctl + CW_CNT + F.tid), LCNT[F.tid], RLX_AGENT);
    __syncthreads();
    if (F.tid < rpb * 4) RANK[(F.vcu * rpb) * 4 + F.tid] = (int)LBASE[SEL[F.tid]] + LRK[F.tid];
    __syncthreads();
}

__device__ __forceinline__ void p6_dispatch(Frame& F) {
    LAS int* pst = (LAS int*)F.lds;
    if (F.tid == 0) { int acc = 0; for (int e = 0; e < NE; ++e) { pst[e] = acc; const int c = (int)__hip_atomic_load((unsigned*)(F.ctl + CW_CNT + e), RLX_AGENT); acc += (c + 255) / 256 * 256; } pst[NE] = acc; }
    __syncthreads();
    int* ROWSLOT = WSP(int, WS_ROWS); float* ROWGATE = WSP(float, WS_ROWS + MAXROWS * 4); int* BLKE = WSP(int, WS_ROWS + 2 * MAXROWS * 4); int* BLKV = BLKE + 512; int* NBLK = BLKE + 1024;
    if (blockIdx.x == 0 && F.tid < NE) { const int e = F.tid, c = (int)__hip_atomic_load((unsigned*)(F.ctl + CW_CNT + e), RLX_AGENT); const int b0 = pst[e] / 256, nb = (pst[e + 1] - pst[e]) / 256;
        for (int i = 0; i < nb; ++i) { BLKE[b0 + i] = e; BLKV[b0 + i] = min(256, c - 256 * i); }
        if (e == 0) NBLK[0] = pst[NE] / 256; }
    const int gw = F.vcu * NWAVES + F.wave, NGW = F.G * NWAVES, lane = F.lane;
    const int* TOPI = WSP(int, WS_ROUTE); const float* TOPG = WSP(float, WS_ROUTE + 256 * 1024); const int* RANK = WSP(int, WS_ROUTE + 512 * 1024);
    f32x4 gv[4], bv[4], vn[4]; int ein[4], rkn[4]; float ggn[4];
#pragma unroll
    for (int j = 0; j < 4; ++j) { gv[j] = *(const GAS f32x4*)(fin(F, 13) + 4 * lane + 256 * j); bv[j] = *(const GAS f32x4*)(fin(F, 14) + 4 * lane + 256 * j); vn[j] = *(const GAS f32x4*)(WSP(float, WS_Z1) + (size_t)gw * DM + 4 * lane + 256 * j);
        ein[j] = TOPI[gw * 4 + j]; rkn[j] = RANK[gw * 4 + j]; ggn[j] = TOPG[gw * 4 + j]; }
    for (int row = gw; row < T; row += NGW) {
        f32x4 v[4]; int ei[4], rk[4]; float gg[4];
#pragma unroll
        for (int j = 0; j < 4; ++j) { v[j] = vn[j]; ei[j] = ein[j]; rk[j] = rkn[j]; gg[j] = ggn[j]; }
        if (row + NGW < T) {
#pragma unroll
            for (int j = 0; j < 4; ++j) { vn[j] = *(const GAS f32x4*)(WSP(float, WS_Z1) + (size_t)(row + NGW) * DM + 4 * lane + 256 * j);
                ein[j] = TOPI[(row + NGW) * 4 + j]; rkn[j] = RANK[(row + NGW) * 4 + j]; ggn[j] = TOPG[(row + NGW) * 4 + j]; } }
        float mean, rstd; ln_row_pre(v, gv, bv, mean, rstd);
        unsigned w[4];
#pragma unroll
        for (int j = 0; j < 4; ++j) w[j] = pk4_fp8(v[j].x, v[j].y, v[j].z, v[j].w);
#pragma unroll
        for (int k = 0; k < 4; ++k) { const int dest = pst[ei[k]] + rk[k];
            GAS unsigned* o8 = (GAS unsigned*)(WSP(unsigned char, WS_XS) + (size_t)dest * DM) + lane;
#pragma unroll
            for (int j = 0; j < 4; ++j) o8[64 * j] = w[j];
            if (lane == 0) { ROWSLOT[dest] = row * 4 + k; ROWGATE[dest] = gg[k]; } }
    }
    __syncthreads();
}

__device__ __forceinline__ void p7_gateup(Frame& F) {
    const int* BLKE = WSP(int, WS_ROWS + 2 * MAXROWS * 4); const int nblk = __builtin_amdgcn_readfirstlane(BLKE[1024]);
    int kk = DM / 2; asm volatile("" : "+s"(kk));
    pg8::Gemm g{WSP(bf16, WS_XS), WSP(bf16, WS_WGU), MAXROWS, 2048, kk}; pg8::MoeOrder S{BLKE, nblk * 8, 8, F.G / 8, (int)blockIdx.x};
    pg8::EpiGateUp E{WSP(bf16, WS_ACT), fin(F, 18), 1.f / WGU_SCALE};
    pg8::gemm_phase<pg8::EpiGateUp, pg8::MoeOrder, true, true, true>(F.lds, g, S, E);
}

__device__ __forceinline__ void p8_down(Frame& F) {
    const int* BLKE = WSP(int, WS_ROWS + 2 * MAXROWS * 4); const int nblk = __builtin_amdgcn_readfirstlane(BLKE[1024]);
    int kk = DM / 2; asm volatile("" : "+s"(kk));
    pg8::Gemm g{WSP(bf16, WS_ACT), WSP(bf16, WS_WDN), MAXROWS, 1024, kk}; pg8::MoeOrder S{BLKE, nblk * 4, 4, F.G / 8, (int)blockIdx.x};
    pg8::EpiDown E{WSP(bf16, WS_Y), fin(F, 20), WSP(int, WS_ROWS), WSP(float, WS_ROWS + MAXROWS * 4), BLKE + 512, 1.f / WDN_SCALE};
    pg8::gemm_phase<pg8::EpiDown, pg8::MoeOrder, true, true, true>(F.lds, g, S, E);
}

__device__ __forceinline__ void p9_final(Frame& F) {
    const int gw = F.vcu * NWAVES + F.wave, NGW = F.G * NWAVES, lane = F.lane;
    f32x4 g1[4], b1[4], g2[4], b2[4], vn[4]; v2u yn[4][4];
#pragma unroll
    for (int j = 0; j < 4; ++j) { g1[j] = *(const GAS f32x4*)(fin(F, 13) + 4 * lane + 256 * j); b1[j] = *(const GAS f32x4*)(fin(F, 14) + 4 * lane + 256 * j);
        g2[j] = *(const GAS f32x4*)(fin(F, 21) + 4 * lane + 256 * j); b2[j] = *(const GAS f32x4*)(fin(F, 22) + 4 * lane + 256 * j); }
#define P9_LOAD(r_) do { _Pragma("unroll") for (int j = 0; j < 4; ++j) vn[j] = *(const GAS f32x4*)(WSP(float, WS_Z1) + (size_t)(r_) * DM + 4 * lane + 256 * j); \
        _Pragma("unroll") for (int k = 0; k < 4; ++k) _Pragma("unroll") for (int j = 0; j < 4; ++j) yn[k][j] = ((const GAS v2u*)(WSP(bf16, WS_Y) + (size_t)((r_) * 4 + k) * DM) + lane)[64 * j]; } while (0)
    P9_LOAD(gw);
    for (int row = gw; row < T; row += NGW) {
        f32x4 v[4]; v2u y[4][4];
#pragma unroll
        for (int j = 0; j < 4; ++j) { v[j] = vn[j];
#pragma unroll
            for (int k = 0; k < 4; ++k) y[k][j] = yn[k][j]; }
        if (row + NGW < T) P9_LOAD(row + NGW);
        float mean, rstd; ln_row_pre(v, g1, b1, mean, rstd);
#pragma unroll
        for (int j = 0; j < 4; ++j) { v[j] = v[j] * ALPHA;
#pragma unroll
            for (int k = 0; k < 4; ++k) { const v2u w = y[k][j]; v[j].x += bflo(w.x); v[j].y += bfhi(w.x); v[j].z += bflo(w.y); v[j].w += bfhi(w.y); } }
        ln_row_pre(v, g2, b2, mean, rstd);
#pragma unroll
        for (int j = 0; j < 4; ++j) *(GAS f32x4*)(F.out + (size_t)row * DM + 4 * lane + 256 * j) = v[j];
    }
#undef P9_LOAD
}

constexpr int NPHASE = 11;
#ifndef PROBE_A
#define PROBE_A -1
#define PROBE_B -1
#endif
__global__ void __launch_bounds__(NTHREADS, 2) mega_fwd(Args args) {
    extern __shared__ __attribute__((aligned(16))) unsigned char lds[];
    Frame F;
    F.lds = (LAS unsigned char*)lds; F.ldsg = (char*)lds; F.MISC = (volatile LAS unsigned*)(F.lds + MISC_OFF);
    F.tid = threadIdx.x; F.lane = F.tid & 63; F.wave = __builtin_amdgcn_readfirstlane(F.tid >> 6);
    F.G = gridDim.x; { const int bx = blockIdx.x; F.vcu = (F.G % 8 == 0) ? (bx % 8) * (F.G / 8) + bx / 8 : bx; }
    F.ws = args.ws; F.ctl = (gu32*)(args.ws + WS_CTL); F.out = args.out;
    for (int u = F.tid; u < (LDS_BYTES - LDSCTL_OFF) / 4; u += NTHREADS) ((LAS unsigned*)(F.lds + LDSCTL_OFF))[u] = 0u;
    __syncthreads();
    if (F.tid < 23) ((LAS unsigned long long*)(F.lds + INTAB_OFF))[F.tid] = (unsigned long long)args.in[F.tid];
    __syncthreads();
    const bool single = (args.ph_lo == 0 && args.ph_hi == NPHASE);
    XcdBarrier bar; bar.bar = (unsigned*)(F.ctl + CW_BAR); bar.x = 0; bar.st = nullptr;
    if (single) bar = xcd_barrier_post((unsigned*)(F.ctl + CW_BAR), F.MISC + 8);
    const int lo = args.ph_lo, hi = args.ph_hi;
#ifndef PH_MASK
#define PH_MASK 0x7ff
#endif
#define IN(k) (((PH_MASK >> (k)) & 1) && lo <= (k) && (k) < hi)
#define SEAM(k) do { if (IN(k) && IN((k) + 1)) xcd_barrier(bar); F.tid = fresh_tid(); F.lane = F.tid & 63; if (PROBE_A >= 0 && blockIdx.x == 0 && F.tid == 0) pts[(k) + 1] = __builtin_amdgcn_s_memrealtime(); } while (0)
    unsigned long long* pts = (unsigned long long*)(args.ws + WS_CTL + 512 * 1024);
    if (PROBE_A >= 0 && blockIdx.x == 0 && F.tid == 0) pts[0] = __builtin_amdgcn_s_memrealtime();
    if (IN(0)) { p0_prologue(F); } SEAM(0);
    if (IN(1)) { p1_inproj(F); } SEAM(1);
    if (IN(2)) { p2_hgrn_local(F); } SEAM(2);
    if (IN(3)) { p3_attn(F); } SEAM(3);
    if (IN(4)) { p4_combine(F); } SEAM(4);
    if (IN(5)) { p4_wo(F); } SEAM(5);
    if (IN(6)) { p5_router(F); } SEAM(6);
    if (IN(7)) { p6_dispatch(F); } SEAM(7);
    if (IN(8)) { p7_gateup(F); } SEAM(8);
    if (IN(9)) { p8_down(F); } SEAM(9);
    if (IN(10)) { p9_final(F); }
    if (PROBE_A >= 0 && blockIdx.x == 0 && F.tid == 0) {
        const unsigned long long tend = __builtin_amdgcn_s_memrealtime(); pts[NPHASE] = tend;
        const int pa = PROBE_A >= 0 ? PROBE_A : 0, pb = PROBE_B >= 0 ? PROBE_B : 0;
        unsigned long long qa = (pts[pa + 1] - pts[pa] + 400) / 800, qb = PROBE_B >= 0 ? (pts[pb + 1] - pts[pb] + 400) / 800 : 0; if (qa > 63) qa = 63; if (qb > 63) qb = 63;
        const unsigned long long dly = (qa + 64 * qb) * 1600;
        while (__builtin_amdgcn_s_memrealtime() - tend < dly) __builtin_amdgcn_s_sleep(8);
    }
#undef IN
#undef SEAM
}

#ifndef MK_MULTI
#define MK_MULTI 0
#endif
extern "C" void kernel_launch(void* const* d_in, const int* in_sizes, int n_in, void* d_out, int out_size, void* d_ws, size_t ws_size, hipStream_t stream) {
    static int grid = 0;
    if (grid == 0) {
        if (n_in != 23 || out_size != T * DM || ws_size < WS_END) { fprintf(stderr, "kernel_launch: unexpected shapes n_in %d out %d ws %zu\n", n_in, out_size, ws_size); grid = -1; return; }
        int dev = 0, cus = 0;
        if (hipGetDevice(&dev) != hipSuccess || hipDeviceGetAttribute(&cus, hipDeviceAttributeMultiprocessorCount, dev) != hipSuccess) { grid = -1; return; }
        if (hipFuncSetAttribute((const void*)mega_fwd, hipFuncAttributeMaxDynamicSharedMemorySize, LDS_BYTES) != hipSuccess) { fprintf(stderr, "kernel_launch: hipFuncSetAttribute failed\n"); grid = -1; return; }
        int per_cu = 0;
        if (hipOccupancyMaxActiveBlocksPerMultiprocessor(&per_cu, (const void*)mega_fwd, NTHREADS, LDS_BYTES) != hipSuccess || per_cu < 1) fprintf(stderr, "kernel_launch: occupancy query says %d\n", per_cu);
        (void)hipGetLastError();
        grid = cus;
    }
    if (grid < 0) return;
    (void)hipMemsetAsync((char*)d_ws + WS_CTL, 0, CTL_ZERO_BYTES, stream);
    Args a{};
    for (int i = 0; i < 23; ++i) a.in[i] = (const float*)d_in[i];
    a.out = (float*)d_out; a.ws = (unsigned char*)d_ws;
#if MK_MULTI
    for (int p = 0; p < NPHASE; ++p) { a.ph_lo = p; a.ph_hi = p + 1; hipLaunchKernelGGL(mega_fwd, dim3(grid), dim3(NTHREADS), LDS_BYTES, stream, a); }
#else
    a.ph_lo = 0; a.ph_hi = NPHASE;
    hipLaunchKernelGGL(mega_fwd, dim3(grid), dim3(NTHREADS), LDS_BYTES, stream, a);
#endif
}
```

```cpp
#include <hip/hip_runtime.h>
#include <cstdio>
#include <cstdint>

constexpr int NB = 4, SEQ = 4096, DM = 1024, T = NB * SEQ, MEML = 256, NIN = 3072, NE = 32, TOPK = 4;
constexpr int TK = T * TOPK, MAXBLK = TK / 256 + NE, MAXROWS = MAXBLK * 256;
constexpr float LOG2E = 1.4426950408889634f, C2 = 0.125f * LOG2E, ALPHA = 1.189207115002721f, EPS = 1e-5f;
constexpr int U_DQ = 0, U_DK = 512, U_DV = 1024, U_HQ = 1536, U_HF = 1792, U_HI = 2304, U_HG = 2560, U_MQ = 2816;

constexpr size_t MiB = 1u << 20;
constexpr size_t WS_CTL = 0, CTL_ZERO_BYTES = 1 * MiB;
constexpr size_t WS_WIN = 2 * MiB, WS_WKV = 8 * MiB, WS_WO = 10 * MiB, WS_MEMB = 12 * MiB, WS_MKV = 14 * MiB;
constexpr size_t WS_XB = 16 * MiB, WS_U = 48 * MiB, WS_OD = 144 * MiB, WS_CAT = 176 * MiB, WS_Z1 = 208 * MiB;
constexpr size_t WS_ROUTE = 272 * MiB;
constexpr size_t WS_RWT = WS_ROUTE + 1 * MiB;
constexpr size_t WS_HU = 280 * MiB;
constexpr size_t WS_WGU = 336 * MiB, WS_WDN = 464 * MiB, WS_XS = 528 * MiB, WS_ACT = 672 * MiB, WS_Y = 816 * MiB;
constexpr size_t WS_ROWS = 944 * MiB;
constexpr size_t WS_SS = WS_XS;
constexpr size_t WS_OH = WS_ACT;
constexpr size_t WS_END = 948 * MiB;
constexpr int CW_TMO = 0, CW_CODE = 1, CW_CNT = 64  , CW_KN = 128  , CW_QUEUE = 192  , CW_MKV = 256  , CW_CONVQ = 257  , CW_RDONE = 258  , CW_BAR = 4096;

constexpr int RING_BYTES = 131072, LDSCTL_OFF = RING_BYTES, MISC_OFF = LDSCTL_OFF + 320, LDS_BYTES = 147456;
constexpr int NWAVES = 8, NTHREADS = 512;

#define GAS __attribute__((address_space(1)))
#define LAS __attribute__((address_space(3)))
typedef unsigned short bf16;
typedef unsigned v4u __attribute__((ext_vector_type(4)));
typedef unsigned v2u __attribute__((ext_vector_type(2)));
typedef float f32x4 __attribute__((ext_vector_type(4)));
typedef GAS unsigned gu32;
#define RLX_AGENT __ATOMIC_RELAXED, __HIP_MEMORY_SCOPE_AGENT
__device__ __forceinline__ unsigned f2bf(float f) { unsigned u = __builtin_bit_cast(unsigned, f); return (u + 0x7fffu + ((u >> 16) & 1u)) >> 16; }
__device__ __forceinline__ unsigned pk2(float lo, float hi) { return f2bf(lo) | (f2bf(hi) << 16); }
__device__ __forceinline__ float bf2f(unsigned v) { return __uint_as_float(v << 16); }
__device__ __forceinline__ unsigned pk4_fp8(float a, float b, float c, float d) { int w = 0; w = __builtin_amdgcn_cvt_pk_fp8_f32(a, b, w, false); w = __builtin_amdgcn_cvt_pk_fp8_f32(c, d, w, true); return (unsigned)w; }
constexpr float WDN_SCALE = 64.f;
constexpr float WGU_SCALE = 32.f;
__device__ __forceinline__ float bflo(unsigned w) { return __uint_as_float(w << 16); }
__device__ __forceinline__ float bfhi(unsigned w) { return __uint_as_float(w & 0xffff0000u); }
__device__ __forceinline__ float wave_sum(float v) {
#pragma unroll
    for (int o = 1; o < 64; o <<= 1) v += __shfl_xor(v, o);
    return v;
}
__device__ __forceinline__ float wave_max(float v) {
#pragma unroll
    for (int o = 1; o < 64; o <<= 1) v = fmaxf(v, __shfl_xor(v, o));
    return v;
}
__device__ __forceinline__ float sigmoidf_(float x) { return 1.f / (1.f + __expf(-x)); }

#define XB_TMO      128
#define XB_XCNT(j)  (256  + 64 * (j))
#define XB_XSUB(j)  (1280 + 64 * (j))
#define XB_XGEN(j)  (2304 + 64 * (j))
#define XB_TOP      3328
#define XB_TOPGEN   3392
#define XCD_BAR_WORDS 3456
#define XB_SPIN_CAP (1u << 20)
__device__ __forceinline__ unsigned xb_ld(unsigned* p)              { return __hip_atomic_load(p, __ATOMIC_RELAXED, __HIP_MEMORY_SCOPE_AGENT); }
__device__ __forceinline__ unsigned xb_add(unsigned* p, unsigned v) { return __hip_atomic_fetch_add(p, v, __ATOMIC_RELAXED, __HIP_MEMORY_SCOPE_AGENT); }
__device__ __forceinline__ unsigned xb_xcc_id() { return (unsigned)__builtin_amdgcn_s_getreg((3 << 11) | 20) & 0xFu; }
#define XB_SPIN(cond, bar) do { unsigned _sp = 0; while (cond) { __builtin_amdgcn_s_sleep(1); \
    if ((++_sp & 255u) == 0u) { if (xb_ld(&(bar)[XB_TMO])) break; if (_sp > XB_SPIN_CAP) { atomicAdd(&(bar)[XB_TMO], 1u); break; } } } } while (0)
struct XcdBarrier { unsigned* bar; unsigned x; volatile LAS unsigned* st; };
__device__ __forceinline__ XcdBarrier xcd_barrier_post(unsigned* bar, volatile LAS unsigned* st) {
    XcdBarrier b; b.bar = bar; b.x = xb_xcc_id(); b.st = st;
    if (threadIdx.x == 0) (void)xb_add(&bar[XB_XCNT(b.x)], 1u);
    return b;
}
__device__ __forceinline__ void xcd_barrier_complete(unsigned* bar, unsigned x, unsigned& nloc, unsigned& nx) {
    const unsigned G = gridDim.x * gridDim.y * gridDim.z;
    unsigned sum, cnt, mine, sp = 0u;
    for (;;) {
        sum = 0u; cnt = 0u; mine = 0u;
#pragma unroll
        for (unsigned j = 0; j < 16; ++j) { const unsigned c = xb_ld(&bar[XB_XCNT(j)]); sum += c; cnt += (c > 0u) ? 1u : 0u; mine = (j == x) ? c : mine; }
        if (sum == G) break;
        __builtin_amdgcn_s_sleep(1);
        if ((++sp & 255u) == 0u) { if (xb_ld(&bar[XB_TMO])) break; if (sp > XB_SPIN_CAP) { atomicAdd(&bar[XB_TMO], 1u); break; } }
    }
    nloc = mine > 0u ? mine : 1u; nx = cnt > 0u ? cnt : 1u;
}
__device__ __forceinline__ void xcd_barrier(const XcdBarrier& b) {
    asm volatile("s_waitcnt vmcnt(0)" ::: "memory");
    __syncthreads();
    if (threadIdx.x == 0) {
        unsigned* bar = b.bar;
        __builtin_amdgcn_s_waitcnt(0);
        unsigned nloc = b.st[0], nx = b.st[1];
        if (nloc == 0u) { xcd_barrier_complete(bar, b.x, nloc, nx); b.st[0] = nloc; b.st[1] = nx; }
        const unsigned old = xb_add(&bar[XB_XSUB(b.x)], 1u);
        const unsigned gen = old / nloc;
        if (old + 1u == (gen + 1u) * nloc) {
            __builtin_amdgcn_fence(__ATOMIC_RELEASE, "agent");
            asm volatile("s_waitcnt vmcnt(0)" ::: "memory");
            const unsigned og = xb_add(&bar[XB_TOP], 1u);
            const unsigned tg = og / nx;
            if (og + 1u == (tg + 1u) * nx) xb_add(&bar[XB_TOPGEN], 1u);
            else XB_SPIN(xb_ld(&bar[XB_TOPGEN]) == tg, bar);
            __builtin_amdgcn_fence(__ATOMIC_ACQUIRE, "agent");
            xb_add(&bar[XB_XGEN(b.x)], 1u);
            asm volatile("s_waitcnt vmcnt(0)" ::: "memory");
        } else {
            XB_SPIN(xb_ld(&bar[XB_XGEN(b.x)]) == gen, bar);
            __builtin_amdgcn_fence(__ATOMIC_ACQUIRE, "agent");
            asm volatile("s_waitcnt vmcnt(0)" ::: "memory");
        }
    }
    __syncthreads();
}

namespace pg8 {
#define PG8_LAS __attribute__((address_space(3)))
typedef unsigned short bf16_t;
typedef short bf16x8 __attribute__((ext_vector_type(8)));
typedef float f32x4 __attribute__((ext_vector_type(4)));
typedef unsigned u32x4 __attribute__((ext_vector_type(4)));
typedef int i32x4 __attribute__((ext_vector_type(4)));
typedef int i32x8 __attribute__((ext_vector_type(8)));
constexpr int BM = 256, BK = 64, HALF = 128, HTB = HALF * BK * 2  , STAGE_BYTES = 8 * HTB, NXCD = 8, WGM = 8;

__host__ __device__ __forceinline__ int lds_byte(int r, int c) { const int st = (r >> 4) * 2 + (c >> 5), rr = r & 15, cc = c & 31, ob = rr * 64 + cc * 2; return st * 1024 + (ob ^ (((ob >> 9) & 1) << 5)); }
__host__ __device__ __forceinline__ void stage_rc(int b, int& R, int& C) { const int st = b / 1024, sb = b % 1024, swz = sb ^ (((sb >> 9) & 1) << 5); R = (st >> 1) * 16 + swz / 64; C = (st & 1) * 32 + (swz % 64) / 2; }
__host__ __device__ __forceinline__ int perm32(int rho) { const int n = rho >> 4, i = rho & 15; return 8 * (i >> 2) + 4 * n + (i & 3); }

struct Unit { int pm, pn, pb, e; };
struct Gemm { const bf16_t* A; const bf16_t* Bt; int M, N, K; };

struct StaticOrder {
    int nM, nN, nwg, G, c;
    __host__ __device__ void init(int M, int N, int G_, int c_) { nM = M / BM; nN = N / BM; nwg = nM * nN; G = G_; c = c_; }
    __host__ __device__ bool next(int i, Unit& u) const {
        const long L = (long)i * G + c; if (L >= nwg) return false;
        int wgid = (int)L; { const int q = nwg / NXCD, r = nwg % NXCD, xcd = wgid % NXCD, off = wgid / NXCD; wgid = (xcd < r ? xcd * (q + 1) : r * (q + 1) + (xcd - r) * q) + off; }
        const int nig = WGM * nN, gid = wgid / nig, fm = gid * WGM, gsz = (nM - fm) < WGM ? (nM - fm) : WGM;
        u.pm = fm + ((wgid % nig) % gsz); u.pn = (wgid % nig) / gsz; u.pb = u.pn; u.e = 0; return true;
    }
    __device__ __forceinline__ void a_ready(const Unit&) const {}
    __device__ __forceinline__ void done(const Unit&) const {}
};

__device__ __forceinline__ void mfma8_inplace(f32x4& acc, const i32x8& b, const i32x8& a, int sc) {
    asm volatile("v_mfma_scale_f32_16x16x128_f8f6f4 %0, %1, %2, %0, %3, %3 op_sel_hi:[0,0,0]" : "+v"(acc) : "v"(b), "v"(a), "v"(sc)); }
__device__ __forceinline__ void glds16_s(const char* sbase, unsigned voff, unsigned lds_dst) { unsigned keep;
    asm volatile("s_mov_b32 %0, m0\n\ts_mov_b32 m0, %3\n\ts_nop 0\n\tglobal_load_lds_dwordx4 %1, %2\n\ts_mov_b32 m0, %0" : "=&s"(keep) : "v"(voff), "s"(sbase), "s"(lds_dst) : "memory"); }
template <class Epi, class Sched, bool ALIGN_EPI = false, bool SP2 = false, bool FP8 = false>
__device__ __forceinline__ void gemm_phase(PG8_LAS unsigned char* lds, const Gemm g, const Sched& S, const Epi& E) {
    int tid = threadIdx.x; asm volatile("" : "+v"(tid));
    const int wid = __builtin_amdgcn_readfirstlane(tid >> 6), lane = tid & 63, wr = wid >> 2, wc = wid & 3, fr = lane & 15, fq = lane >> 4;
    const int K = g.K, nt = K / BK;
    unsigned voffA[2], voffB[2];
#pragma unroll
    for (int i = 0; i < 2; ++i) { int R, C; stage_rc(tid * 16 + i * 8192, R, C); const int Rb = Epi::PERM ? ((R & ~31) + perm32(R & 31)) : R;
        voffA[i] = (unsigned)(R * K + C) * 2u; voffB[i] = (unsigned)(Rb * K + C) * 2u; }
    const size_t kstep = (size_t)(BK * 2);
    const size_t hstep = (size_t)HALF * K * 2;
    const size_t tstep = 2 * hstep;
    const unsigned ldsbase = (unsigned)(uintptr_t)lds;
    const unsigned ldsw = (unsigned)wid * 1024u;
    const int aoff = lds_byte(wr * 64 + fr, fq * 8), boff = lds_byte(wc * 32 + fr, fq * 8);
    const PG8_LAS unsigned char* lbaseA = lds + aoff; const PG8_LAS unsigned char* lbaseB = lds + 65536 + boff; asm volatile("" : "+v"(lbaseA), "+v"(lbaseB));
#define PG8_SA(b, h) (((b) * 2 + (h)) * HTB)
#define PG8_SB(b, h) ((4 + (b) * 2 + (h)) * HTB)
#define PG8_STAGE(bufoff, gbase, voff) do { _Pragma("unroll") for (int _i = 0; _i < 2; ++_i) { \
        if constexpr (FP8) glds16_s((const char*)(gbase), (voff)[_i], (unsigned)__builtin_amdgcn_readfirstlane(ldsbase + (unsigned)(bufoff) + ldsw + _i * 8192u)); \
        else __builtin_amdgcn_global_load_lds((const unsigned*)((const char*)(gbase) + (voff)[_i]), (PG8_LAS unsigned*)(lds + (bufoff) + ldsw + _i * 8192), 16, 0, 0); } } while (0)
#define PG8_LDFA(off) (*(const PG8_LAS bf16x8*)(lbaseA + (off)))
#define PG8_LDFB(off) (*(const PG8_LAS bf16x8*)(lbaseB + ((off) - 65536)))
#define PG8_LDA(dst, b, h) do { _Pragma("unroll") for (int m = 0; m < 4; ++m) { if constexpr (FP8) dst##8[m] = PG8_CAT8(PG8_LDFA(PG8_SA(b, h) + m * 2048), PG8_LDFA(PG8_SA(b, h) + m * 2048 + 1024)); \
        else { _Pragma("unroll") for (int k = 0; k < 2; ++k) dst[m][k] = PG8_LDFA(PG8_SA(b, h) + m * 2048 + k * 1024); } } } while (0)
#define PG8_LDB(dst, b, h) do { _Pragma("unroll") for (int n = 0; n < 2; ++n) { if constexpr (FP8) dst##8[n] = PG8_CAT8(PG8_LDFB(PG8_SB(b, h) + n * 2048), PG8_LDFB(PG8_SB(b, h) + n * 2048 + 1024)); \
        else { _Pragma("unroll") for (int k = 0; k < 2; ++k) dst[n][k] = PG8_LDFB(PG8_SB(b, h) + n * 2048 + k * 1024); } } } while (0)
#define PG8_CAT8(x0, x1) __builtin_shufflevector(__builtin_bit_cast(i32x4, x0), __builtin_bit_cast(i32x4, x1), 0, 1, 2, 3, 4, 5, 6, 7)
#define PG8_MMA(ai, bj, At, Bt) do { __builtin_amdgcn_s_setprio(1); _Pragma("unroll") for (int m = 0; m < 4; ++m) _Pragma("unroll") for (int n = 0; n < 2; ++n) { \
        if constexpr (FP8) mfma8_inplace(acc[ai][bj][m][n], Bt##8[n], At##8[m], sc8); \
        else { _Pragma("unroll") for (int k = 0; k < 2; ++k) acc[ai][bj][m][n] = __builtin_amdgcn_mfma_f32_16x16x32_bf16(Bt[n][k], At[m][k], acc[ai][bj][m][n], 0, 0, 0); } } \
        __builtin_amdgcn_s_setprio(0); } while (0)
#define PG8_WAIT_V(n) asm volatile("s_waitcnt vmcnt(" #n ")" ::: "memory")
#define PG8_WAIT_L(n) asm volatile("s_waitcnt lgkmcnt(" #n ")" ::: "memory")
#define PG8_BAR __builtin_amdgcn_s_barrier()
#define PG8_SCHED __builtin_amdgcn_sched_barrier(0)
    Unit cur, nxt; int ui = 0;
    if (!S.next(0, cur)) return;
    f32x4 acc[2][2][4][2];
#pragma unroll
    for (int a = 0; a < 2; ++a)
#pragma unroll
        for (int b = 0; b < 2; ++b)
#pragma unroll
            for (int m = 0; m < 4; ++m)
#pragma unroll
                for (int n = 0; n < 2; ++n) acc[a][b][m][n] = (f32x4){0.f, 0.f, 0.f, 0.f};
    int sc8 = 0x7f7f7f7f; asm volatile("" : "+v"(sc8));
    bf16x8 At[4][2], B0[2][2], B1[2][2]; i32x8 At8[4], B08[2], B18[2];
    const char* cA = (const char*)g.A + (size_t)cur.pm * tstep; const char* cB = (const char*)g.Bt + (size_t)cur.pb * tstep;
    S.a_ready(cur);
    if constexpr (SP2) {
        PG8_STAGE(PG8_SB(0, 0), cB, voffB); PG8_STAGE(PG8_SB(0, 1), cB + hstep, voffB); PG8_STAGE(PG8_SA(0, 0), cA, voffA); PG8_STAGE(PG8_SA(0, 1), cA + hstep, voffA);
        if (wr == 1) PG8_BAR;
        PG8_WAIT_V(2); PG8_BAR;
        PG8_STAGE(PG8_SB(1, 0), cB + kstep, voffB); PG8_STAGE(PG8_SA(1, 0), cA + kstep, voffA); PG8_STAGE(PG8_SB(1, 1), cB + hstep + kstep, voffB);
        PG8_WAIT_V(6); PG8_BAR;
    } else {
        PG8_STAGE(PG8_SB(0, 0), cB, voffB); PG8_STAGE(PG8_SA(0, 0), cA, voffA); PG8_STAGE(PG8_SB(0, 1), cB + hstep, voffB); PG8_STAGE(PG8_SA(0, 1), cA + hstep, voffA);
        if (wr == 1) PG8_BAR;
        PG8_WAIT_V(4); PG8_BAR;
        PG8_STAGE(PG8_SB(1, 0), cB + kstep, voffB); PG8_STAGE(PG8_SA(1, 0), cA + kstep, voffA); PG8_STAGE(PG8_SB(1, 1), cB + hstep + kstep, voffB);
        PG8_WAIT_V(6); PG8_BAR;
    }
    for (;;) {
        const bool has_next = S.next(ui + 1, nxt);
        const char* nA = has_next ? (const char*)g.A + (size_t)nxt.pm * tstep : cA; const char* nB = has_next ? (const char*)g.Bt + (size_t)nxt.pb * tstep : cB;
        for (int t = 0; t < nt; t += 2) {
            const bool last = (t == nt - 2);
            const char* a1 = cA + (size_t)(t + 1) * kstep;
            const char* a2 = last ? nA : cA + (size_t)(t + 2) * kstep; const char* b2 = last ? nB : cB + (size_t)(t + 2) * kstep;
            const char* a3 = a2 + kstep; const char* b3 = b2 + kstep;
            if (last && has_next) S.a_ready(nxt);
            if constexpr (SP2) {
            PG8_LDB(B0, 0, 0); PG8_LDB(B1, 0, 1); PG8_SCHED; PG8_LDA(At, 0, 0); PG8_STAGE(PG8_SA(1, 1), a1 + hstep, voffA);
            PG8_WAIT_V(8); PG8_WAIT_L(0); PG8_BAR; PG8_MMA(0, 0, At, B0); PG8_MMA(0, 1, At, B1); PG8_BAR; PG8_SCHED;
            PG8_LDA(At, 0, 1); PG8_STAGE(PG8_SB(0, 0), b2, voffB); PG8_STAGE(PG8_SB(0, 1), b2 + hstep, voffB); PG8_STAGE(PG8_SA(0, 0), a2, voffA);
            PG8_WAIT_V(8); PG8_WAIT_L(0); PG8_BAR; PG8_MMA(1, 0, At, B0); PG8_MMA(1, 1, At, B1); PG8_BAR; PG8_SCHED;
            PG8_LDB(B0, 1, 0); PG8_LDB(B1, 1, 1); PG8_SCHED; PG8_LDA(At, 1, 0); PG8_STAGE(PG8_SA(0, 1), a2 + hstep, voffA);
            PG8_WAIT_V(8); PG8_WAIT_L(0); PG8_BAR; PG8_MMA(0, 0, At, B0); PG8_MMA(0, 1, At, B1); PG8_BAR; PG8_SCHED;
            PG8_LDA(At, 1, 1); PG8_STAGE(PG8_SB(1, 0), b3, voffB); PG8_STAGE(PG8_SB(1, 1), b3 + hstep, voffB); PG8_STAGE(PG8_SA(1, 0), a3, voffA);
            PG8_WAIT_V(8); PG8_WAIT_L(0); PG8_BAR; PG8_MMA(1, 0, At, B0); PG8_MMA(1, 1, At, B1); PG8_BAR; PG8_SCHED;
            } else {
            PG8_LDB(B0, 0, 0); PG8_SCHED; PG8_LDA(At, 0, 0); PG8_STAGE(PG8_SA(1, 1), a1 + hstep, voffA);
            PG8_WAIT_L(8); PG8_BAR; PG8_WAIT_L(0); PG8_MMA(0, 0, At, B0); PG8_BAR; PG8_SCHED;
            PG8_LDB(B1, 0, 1); PG8_STAGE(PG8_SB(0, 0), b2, voffB);
            PG8_BAR; PG8_WAIT_L(0); PG8_MMA(0, 1, At, B1); PG8_BAR;
            PG8_LDA(At, 0, 1); PG8_STAGE(PG8_SA(0, 0), a2, voffA);
            PG8_BAR; PG8_WAIT_L(0); PG8_MMA(1, 0, At, B0); PG8_BAR; PG8_SCHED;
            PG8_STAGE(PG8_SB(0, 1), b2 + hstep, voffB);
            PG8_WAIT_V(6); PG8_BAR; PG8_MMA(1, 1, At, B1); PG8_BAR;
            PG8_LDB(B0, 1, 0); PG8_SCHED; PG8_LDA(At, 1, 0); PG8_STAGE(PG8_SA(0, 1), a2 + hstep, voffA);
            PG8_WAIT_L(8); PG8_BAR; PG8_WAIT_L(0); PG8_MMA(0, 0, At, B0); PG8_BAR; PG8_SCHED;
            PG8_LDB(B1, 1, 1); PG8_STAGE(PG8_SB(1, 0), b3, voffB);
            PG8_BAR; PG8_WAIT_L(0); PG8_MMA(0, 1, At, B1); PG8_BAR;
            PG8_LDA(At, 1, 1); PG8_STAGE(PG8_SA(1, 0), a3, voffA);
            PG8_BAR; PG8_WAIT_L(0); PG8_MMA(1, 0, At, B0); PG8_BAR; PG8_SCHED;
            PG8_STAGE(PG8_SB(1, 1), b3 + hstep, voffB);
            PG8_WAIT_V(6); PG8_BAR; PG8_MMA(1, 1, At, B1); PG8_BAR;
            }
        }
        if constexpr (ALIGN_EPI) { if (wr == 0) PG8_BAR; }
        if constexpr (FP8) { asm volatile("s_nop 15\n\ts_nop 3" ::: "memory"); __builtin_amdgcn_sched_barrier(0); }
        if constexpr (!Epi::AFTER_DRAIN) { int l2_ = threadIdx.x & 63; asm volatile("" : "+v"(l2_)); E(acc, cur, wr, wc, l2_ & 15, l2_ >> 4); S.done(cur); }
        if (!has_next) break;
#pragma unroll
        for (int a = 0; a < 2; ++a)
#pragma unroll
            for (int b = 0; b < 2; ++b)
#pragma unroll
                for (int m = 0; m < 4; ++m)
#pragma unroll
                    for (int n = 0; n < 2; ++n) acc[a][b][m][n] = (f32x4){0.f, 0.f, 0.f, 0.f};
        cur = nxt; cA = nA; cB = nB; ++ui;
        if constexpr (ALIGN_EPI) { if (wr == 1) PG8_BAR; }
    }
    PG8_WAIT_V(0);
    if constexpr (!ALIGN_EPI) { if (wr == 0) PG8_BAR; }
    PG8_BAR;
    if constexpr (Epi::AFTER_DRAIN) { E.fused(acc, cur, wr, wc, fr, fq, lds, wid, lane); S.done(cur); }
#undef PG8_SA
#undef PG8_SB
#undef PG8_STAGE
#undef PG8_LDA
#undef PG8_LDFA
#undef PG8_LDFB
#undef PG8_LDB
#undef PG8_MMA
#undef PG8_CAT8
#undef PG8_WAIT_V
#undef PG8_WAIT_L
#undef PG8_BAR
#undef PG8_SCHED
}

__device__ __forceinline__ unsigned cvt_pk_bf16(float lo, float hi) { unsigned r; asm volatile("v_cvt_pk_bf16_f32 %0, %1, %2" : "=v"(r) : "v"(lo), "v"(hi)); return r; }
struct EpiBf16 {
    static constexpr bool PERM = true, AFTER_DRAIN = false;
    bf16_t* O; int ldc; unsigned smask; float s;
    __device__ __forceinline__ void operator()(const f32x4 (&acc)[2][2][4][2], const Unit& u, int wr, int wc, int fr, int fq) const {
        const int row0 = u.pm * BM + wr * 64 + fr, col0 = u.pn * BM + wc * 32 + 8 * fq; const float sc = ((smask >> u.pn) & 1u) ? s : 1.f;
#pragma unroll
        for (int ai = 0; ai < 2; ++ai)
#pragma unroll
            for (int m = 0; m < 4; ++m) { bf16_t* rowp = O + (size_t)(row0 + ai * HALF + m * 16) * ldc + col0;
#pragma unroll
                for (int bj = 0; bj < 2; ++bj) { const f32x4 v0 = acc[ai][bj][m][0] * sc, v1 = acc[ai][bj][m][1] * sc;
                    u32x4 w; w.x = cvt_pk_bf16(v0[0], v0[1]); w.y = cvt_pk_bf16(v0[2], v0[3]); w.z = cvt_pk_bf16(v1[0], v1[1]); w.w = cvt_pk_bf16(v1[2], v1[3]);
                    *(u32x4*)(rowp + bj * HALF) = w; } }
    }
};
struct EpiResF32 {
    static constexpr bool PERM = false, AFTER_DRAIN = false;
    const float* base; float* out; int ldc; float alpha;
    __device__ __forceinline__ void operator()(const f32x4 (&acc)[2][2][4][2], const Unit& u, int wr, int wc, int fr, int fq) const {
        const int col0 = u.pn * BM + wc * 32 + 4 * fq;
#pragma unroll
        for (int ai = 0; ai < 2; ++ai)
#pragma unroll
            for (int m = 0; m < 4; ++m) { const size_t off = (size_t)(u.pm * BM + ai * HALF + wr * 64 + m * 16 + fr) * ldc + col0;
#pragma unroll
                for (int bj = 0; bj < 2; ++bj)
#pragma unroll
                    for (int n = 0; n < 2; ++n) { const f32x4 bs = *(const f32x4*)(base + off + bj * HALF + n * 16); *(f32x4*)(out + off + bj * HALF + n * 16) = bs * alpha + acc[ai][bj][m][n]; }
                if (m & 1) asm volatile("" ::: "memory"); }
    }
};
struct EpiGateUp {
    static constexpr bool PERM = true, AFTER_DRAIN = false;
    bf16_t* O; const float* bias; float ascale;
    __device__ __forceinline__ void operator()(const f32x4 (&acc)[2][2][4][2], const Unit& u, int wr, int wc, int fr, int fq) const {
        const int row0 = u.pm * BM + wr * 64 + fr, f0 = u.pn * 128 + wc * 32 + 8 * fq;
        bf16_t* Oo = this->O; const float* bo = this->bias; asm volatile("" : "+s"(Oo), "+s"(bo));
        __attribute__((address_space(1))) bf16_t* O = (__attribute__((address_space(1))) bf16_t*)Oo; const __attribute__((address_space(1))) float* bias = (const __attribute__((address_space(1))) float*)bo;
        const __attribute__((address_space(1))) float* bp = bias + (size_t)u.e * 2048 + 2 * f0;
        typedef __attribute__((address_space(1))) f32x4 gf4; typedef __attribute__((address_space(1))) u32x4 gu4;
        const f32x4 b0 = *(const gf4*)(bp), b1 = *(const gf4*)(bp + 4), b2 = *(const gf4*)(bp + 8), b3 = *(const gf4*)(bp + 12);
        const float bg[8] = {b0[0], b0[2], b1[0], b1[2], b2[0], b2[2], b3[0], b3[2]}, bl[8] = {b0[1], b0[3], b1[1], b1[3], b2[1], b2[3], b3[1], b3[3]};
#pragma unroll
        for (int ai = 0; ai < 2; ++ai)
#pragma unroll
            for (int m = 0; m < 4; ++m) { float a[8];
#pragma unroll
                for (int n = 0; n < 2; ++n)
#pragma unroll
                    for (int q = 0; q < 4; ++q) { const float g = fminf(acc[ai][0][m][n][q] * ascale + bg[4 * n + q], 7.f), l = fminf(fmaxf(acc[ai][1][m][n][q] * ascale + bl[4 * n + q], -7.f), 7.f);
                        a[4 * n + q] = g * __builtin_amdgcn_rcpf(1.f + __builtin_amdgcn_exp2f(-1.702f * 1.4426950408889634f * g)) * (l + 1.f); }
                typedef unsigned u32x2g __attribute__((ext_vector_type(2))); u32x2g w; w.x = pk4_fp8(a[0], a[1], a[2], a[3]); w.y = pk4_fp8(a[4], a[5], a[6], a[7]);
                *(__attribute__((address_space(1))) u32x2g*)((__attribute__((address_space(1))) unsigned char*)O + (size_t)(row0 + ai * HALF + m * 16) * 1024 + f0) = w; }
    }
};
struct EpiDown {
    static constexpr bool PERM = true, AFTER_DRAIN = false;
    bf16_t* Y; const float* bias; const int* rowslot; const float* rowgate; const int* blkv; float ascale;
    __device__ __forceinline__ void operator()(const f32x4 (&acc)[2][2][4][2], const Unit& u, int wr, int wc, int fr, int fq) const {
        const int col0 = u.pn * BM + wc * 32 + 8 * fq, nv = blkv[u.pm];
        const float* bp = bias + (size_t)u.e * 1024 + col0;
        f32x4 bv[2][2];
#pragma unroll
        for (int bj = 0; bj < 2; ++bj)
#pragma unroll
            for (int n = 0; n < 2; ++n) bv[bj][n] = *(const f32x4*)(bp + bj * HALF + 4 * n);
        int slot[2][4]; float gt[2][4];
#pragma unroll
        for (int ai = 0; ai < 2; ++ai)
#pragma unroll
            for (int m = 0; m < 4; ++m) { const int r = ai * HALF + wr * 64 + m * 16 + fr; slot[ai][m] = rowslot[u.pm * BM + r]; gt[ai][m] = rowgate[u.pm * BM + r]; }
#pragma unroll
        for (int ai = 0; ai < 2; ++ai)
#pragma unroll
            for (int m = 0; m < 4; ++m) { const int r = ai * HALF + wr * 64 + m * 16 + fr;
                if (r < nv) { const float g = gt[ai][m]; bf16_t* rowp = Y + (size_t)slot[ai][m] * 1024 + col0;
#pragma unroll
                    for (int bj = 0; bj < 2; ++bj) { const f32x4 v0 = (acc[ai][bj][m][0] * ascale + bv[bj][0]) * g, v1 = (acc[ai][bj][m][1] * ascale + bv[bj][1]) * g;
                        u32x4 w; w.x = cvt_pk_bf16(v0[0], v0[1]); w.y = cvt_pk_bf16(v0[2], v0[3]); w.z = cvt_pk_bf16(v1[0], v1[1]); w.w = cvt_pk_bf16(v1[2], v1[3]);
                        *(u32x4*)(rowp + bj * HALF) = w; } } }
    }
};
struct MoeOrder {
    const int* blke; int nunits, npn, gpx, c;
    __device__ __forceinline__ bool next(int i, Unit& u) const {
        const int L = (i * 8 + (c & 7)) * gpx + (c >> 3); if (L >= nunits) return false;
        const int blk = L / npn; u.pm = blk; u.pn = L - blk * npn; u.e = __builtin_amdgcn_readfirstlane(blke[blk]); u.pb = u.e * npn + u.pn; return true;
    }
    __device__ __forceinline__ void a_ready(const Unit&) const {}
    __device__ __forceinline__ void done(const Unit&) const {}
};
struct OneUnit { int pm, pn; __device__ __forceinline__ bool next(int i, Unit& u) const { if (i) return false; u.pm = pm; u.pn = pn; u.pb = pn; u.e = 0; return true; }
    __device__ __forceinline__ void a_ready(const Unit&) const {} __device__ __forceinline__ void done(const Unit&) const {} };
}

namespace attn_body {
typedef unsigned short abf;
using bf16x8=__attribute__((ext_vector_type(8)))short;
using s16x4=__attribute__((ext_vector_type(4)))short;
using f32x16=__attribute__((ext_vector_type(16)))float;
using u32x4=__attribute__((ext_vector_type(4)))unsigned;
constexpr int NW=8,QBLK=32,QB=QBLK*NW,KVBLK=64;
__device__ __forceinline__ int crow(int r,int hi){return (r&3)+8*(r>>2)+4*hi;}
#define SBAR() __builtin_amdgcn_sched_barrier(0)
constexpr int NSLOT=3, SLOTB=8192;
constexpr int LDS_K=0, LDS_V=NSLOT*SLOTB, LDS_WS=2*NSLOT*SLOTB, LDS_OST=LDS_WS+NW*64*4, LDS_BYTES=LDS_OST+NW*4096;
__device__ __forceinline__ void glds16(const void*gsrc,unsigned lds_dst){unsigned keep;
  asm volatile("s_mov_b32 %0, m0\n\ts_mov_b32 m0, %2\n\ts_nop 0\n\tglobal_load_lds_dwordx4 %1, off\n\ts_mov_b32 m0, %0":"=&s"(keep):"v"(gsrc),"s"(lds_dst):"memory");}
__device__ __forceinline__ float max3f(float a,float b,float c){float r;asm("v_max3_f32 %0, %1, %2, %3":"=v"(r):"v"(a),"v"(b),"v"(c));return r;}
__device__ __forceinline__ float max2f(float a,float b){float r;asm("v_max_f32_e32 %0, %1, %2":"=v"(r):"v"(a),"v"(b));return r;}
__device__ __forceinline__ float fadd_s(float a,float b){float r;asm("v_add_f32_e32 %0, %1, %2":"=v"(r):"v"(a),"v"(b));return r;}
__device__ __forceinline__ float fsub_s(float a,float b){float r;asm("v_sub_f32_e32 %0, %1, %2":"=v"(r):"v"(a),"v"(b));return r;}
typedef float f32x2_t __attribute__((ext_vector_type(2))); typedef __bf16 bf16x2_t __attribute__((ext_vector_type(2)));
__device__ __forceinline__ unsigned cvtpk_s(float lo,float hi){f32x2_t v={lo,hi};bf16x2_t b=__builtin_convertvector(v,bf16x2_t);return __builtin_bit_cast(unsigned,b);}
#define WAIT_BAR(N) asm volatile("s_waitcnt vmcnt(" #N ") lgkmcnt(0)\n\ts_barrier":::"memory")
__device__ __forceinline__ void qkt(f32x16&p0,f32x16&p1,const char*Kslot,const bf16x8*qr,const f32x16&c0,const f32x16&c1,int r32,int hi){
  const char*kb=Kslot+hi*1024+r32*16;
  #pragma unroll
  for(int d0=0;d0<4;++d0){
    const bf16x8 b0=*reinterpret_cast<const bf16x8*>(kb+d0*2048);
    const bf16x8 b1=*reinterpret_cast<const bf16x8*>(kb+d0*2048+512);
    if(d0==0){p0=__builtin_amdgcn_mfma_f32_32x32x16_bf16(b0,qr[0],c0,0,0,0);p1=__builtin_amdgcn_mfma_f32_32x32x16_bf16(b1,qr[0],c1,0,0,0);}
    else{p0=__builtin_amdgcn_mfma_f32_32x32x16_bf16(b0,qr[d0],p0,0,0,0);p1=__builtin_amdgcn_mfma_f32_32x32x16_bf16(b1,qr[d0],p1,0,0,0);}}
}
typedef __attribute__((address_space(3))) const char* lds_cptr;
typedef short v4i16_t __attribute__((ext_vector_type(4)));
__device__ __forceinline__ void kload8(bf16x8*kf,lds_cptr kp){
  kf[0]=*(const __attribute__((address_space(3))) bf16x8*)(kp);      kf[1]=*(const __attribute__((address_space(3))) bf16x8*)(kp+512);
  kf[2]=*(const __attribute__((address_space(3))) bf16x8*)(kp+2048); kf[3]=*(const __attribute__((address_space(3))) bf16x8*)(kp+2560);
  kf[4]=*(const __attribute__((address_space(3))) bf16x8*)(kp+4096); kf[5]=*(const __attribute__((address_space(3))) bf16x8*)(kp+4608);
  kf[6]=*(const __attribute__((address_space(3))) bf16x8*)(kp+6144); kf[7]=*(const __attribute__((address_space(3))) bf16x8*)(kp+6656);
}
__device__ __forceinline__ void kload2(bf16x8*kf,lds_cptr kp,int j){ kf[2*j]=*(const __attribute__((address_space(3))) bf16x8*)(kp+j*2048); kf[2*j+1]=*(const __attribute__((address_space(3))) bf16x8*)(kp+j*2048+512); }
__device__ __forceinline__ s16x4 vtr(lds_cptr p){ return __builtin_bit_cast(s16x4,__builtin_amdgcn_ds_read_tr16_b64_v4i16((__attribute__((address_space(3))) v4i16_t*)p)); }
__device__ __forceinline__ float rowmax(const f32x16&p0,const f32x16&p1){
  float a=max3f(p0[0],p0[1],p1[0]),b=max3f(p0[2],p0[3],p1[1]);a=max3f(a,p1[2],p1[3]);
  #pragma unroll
  for(int r=4;r<16;r+=4){a=max3f(a,p0[r],p0[r+1]);b=max3f(b,p0[r+2],p0[r+3]);a=max3f(a,p1[r],p1[r+1]);b=max3f(b,p1[r+2],p1[r+3]);}
  const float m=max2f(a,b);
  auto rr=__builtin_amdgcn_permlane32_swap(__float_as_uint(m),__float_as_uint(m),false,false);
  return max2f(__uint_as_float(rr[0]),__uint_as_float(rr[1]));
}
__device__ __forceinline__ void pv(f32x16*o,int vb,bf16x8 pa0,bf16x8 pa1,bf16x8 pa2,bf16x8 pa3){
  #pragma unroll
  for(int d0=0;d0<2;++d0){s16x4 lo[4],hi[4];
    #pragma unroll
    for(int ks=0;ks<4;++ks){
      asm volatile("ds_read_b64_tr_b16 %0,%1 offset:%c2":"=&v"(lo[ks]):"v"(vb),"i"(d0*4096+ks*1024):"memory");
      asm volatile("ds_read_b64_tr_b16 %0,%1 offset:%c2":"=&v"(hi[ks]):"v"(vb),"i"(d0*4096+ks*1024+512):"memory");}
    asm volatile("s_waitcnt lgkmcnt(0)":::"memory");SBAR();
    #define PK(k) (bf16x8){lo[k][0],lo[k][1],lo[k][2],lo[k][3],hi[k][0],hi[k][1],hi[k][2],hi[k][3]}
    o[d0]=__builtin_amdgcn_mfma_f32_32x32x16_bf16(pa0,PK(0),o[d0],0,0,0);
    o[d0]=__builtin_amdgcn_mfma_f32_32x32x16_bf16(pa1,PK(1),o[d0],0,0,0);
    o[d0]=__builtin_amdgcn_mfma_f32_32x32x16_bf16(pa2,PK(2),o[d0],0,0,0);
    o[d0]=__builtin_amdgcn_mfma_f32_32x32x16_bf16(pa3,PK(3),o[d0],0,0,0);
    #undef PK
  }
}
#ifndef ATTN_STORE16
#define ATTN_STORE16(p,v) (*(u32x4*)(p)=(v))
#endif
template<int THRL> __device__ __forceinline__ void attn_unit(const abf*Qw0,int QP,const abf*Kh,int KP,const abf*Vh,int VP,abf*Ow0,int OP,int NT,float c2,int q0,char*shm){
  int tid=threadIdx.x; asm volatile("":"+v"(tid)); const int lane=tid&63,r32=lane&31,hi=lane>>5; const int wid=__builtin_amdgcn_readfirstlane(tid>>6);
  const abf*Qw=Qw0+(long)(wid*QBLK)*QP;
  const unsigned lds0=(unsigned)(uintptr_t)shm;
  float*wsf=(float*)(shm+LDS_WS)+wid*64;
  const abf*ksrc=Kh+(long)lane*KP+wid*8;
  const abf*vsrc=Vh+(long)(16*(wid&3)+(lane>>2))*VP+(wid>>2)*32+(lane&3)*8;
  const unsigned kdst=lds0+LDS_K+wid*1024, vdst=lds0+LDS_V+wid*1024;
  #define DMA_K(t,slot) glds16(ksrc+(long)(t)*KVBLK*KP,(unsigned)__builtin_amdgcn_readfirstlane(kdst+(slot)))
  #define DMA_V(t,slot) glds16(vsrc+(long)(t)*KVBLK*VP,(unsigned)__builtin_amdgcn_readfirstlane(vdst+(slot)))
  const int vb0=(int)(lds0+LDS_V)+((lane>>4)&1)*32+(lane&3)*8+(4*hi+((lane&15)>>2))*64;
  const char*Kbase=shm+LDS_K; bf16x8 kf[8];
  const lds_cptr shm3=(lds_cptr)shm; const lds_cptr kp0=shm3+LDS_K+hi*1024+r32*16; const lds_cptr vp0=shm3+LDS_V+((lane>>4)&1)*32+(lane&3)*8+(4*hi+((lane&15)>>2))*64;
  DMA_K(0,0);DMA_V(0,0);DMA_K(1,SLOTB);
  bf16x8 qr[4];
  #pragma unroll
  for(int d0=0;d0<4;++d0)qr[d0]=*reinterpret_cast<const bf16x8*>(&Qw[(long)r32*QP+d0*16+hi*8]);
  float mhat=0.f,l_reg=0.f;f32x16 o[2];o[0]=f32x16{};o[1]=f32x16{};
  const int tdiag=__builtin_amdgcn_readfirstlane((q0+wid*QBLK)>>6);
  const float qrel4=(float)(q0+wid*QBLK+r32-4*hi);
  #define CINIT(C0,C1,t) do{ const int tt_=(t); const float dq_=qrel4-64.f*(float)tt_; \
    if(tt_!=tdiag){ float sc_=tt_<tdiag?c2:-c2; asm volatile("":"+v"(sc_)); const float sc8_=8.f*sc_, sc32_=32.f*sc_; \
      C0[0]=-mhat-sc_*dq_; C0[1]=C0[0]+sc_; C0[2]=C0[1]+sc_; C0[3]=C0[2]+sc_; \
      _Pragma("unroll") for(int r=4;r<16;++r) C0[r]=C0[r-4]+sc8_;          \
      _Pragma("unroll") for(int r=0;r<16;++r) C1[r]=C0[r]+sc32_; } \
    else { _Pragma("unroll") for(int r=0;r<16;++r){ const float cr_=(float)((r&3)+8*(r>>2)); C0[r]=-mhat-c2*__builtin_fabsf(dq_-cr_); C1[r]=-mhat-c2*__builtin_fabsf(dq_-cr_-32.f); } } }while(0)
  bool resc=false;
  #define START(P0,P1) do{ const float rm=rowmax(P0,P1); resc=false; \
    { const float dl=rm; mhat=fadd_s(mhat,dl); \
      _Pragma("unroll") for(int r=0;r<16;++r){P0[r]=fsub_s(P0[r],dl);P1[r]=fsub_s(P1[r],dl);} } \
    _Pragma("unroll") for(int r=0;r<16;++r)P0[r]=__builtin_amdgcn_exp2f(P0[r]); }while(0)
  #define RESC() do{ if(resc){ asm volatile("s_waitcnt lgkmcnt(0)":::"memory"); \
      _Pragma("unroll") for(int d_=0;d_<2;++d_) _Pragma("unroll") for(int r=0;r<16;++r)o[d_][r]*=wsf[crow(r,hi)]; } }while(0)
  f32x16 pA0,pA1,pB0,pB1;
  int sl_prev=0,sl_cur=0,sl_next=SLOTB;
  #define ROT() do{sl_prev=sl_cur;sl_cur=sl_next;sl_next=(sl_next==(NSLOT-1)*SLOTB)?0:sl_next+SLOTB;}while(0)
  DMA_K(2,2*SLOTB);
  WAIT_BAR(3);
  CINIT(pA0,pA1,0);
  qkt(pA0,pA1,Kbase,qr,pA0,pA1,r32,hi);asm volatile("s_nop 15\n\ts_nop 7":"+v"(pA0),"+v"(pA1));
  START(pA0,pA1);
  _Pragma("unroll") for(int r=0;r<16;++r)pA1[r]=__builtin_amdgcn_exp2f(pA1[r]);
  WAIT_BAR(0);
  DMA_K(3,0);DMA_V(1,SLOTB);
  ROT();
  kload8(kf,kp0+sl_cur);
  WAIT_BAR(2);
  s16x4 vlo[8],vhi[8]; u32x4 pw0,pw1,pw2,pw3;
  #define PKW(P,B) cvtpk_s(P[B],P[B+1])
  #define PAF(k) __builtin_bit_cast(bf16x8,pw##k)
  #define VFR(i) (bf16x8){vlo[i][0],vlo[i][1],vlo[i][2],vlo[i][3],vhi[i][0],vhi[i][1],vhi[i][2],vhi[i][3]}
  #define PIN(x) asm volatile("":"+v"(x))
  #define MX3(a,b,c) __builtin_fmaxf(__builtin_fmaxf((a),(b)),(c))
  #define GAPA(MF,A0,A1,A2,A3,W0,W1,PW) do{ MF; sacc+=A0; sacc+=A1; sacc+=A2; sacc+=A3; PIN(sacc); W0; W1; PIN(PW); SBAR(); }while(0)
  #define EX(v) __builtin_amdgcn_exp2f(v)
  #define GAPB(MF,X,B) do{ MF; X[B]=EX(X[B]); X[B+1]=EX(X[B+1]); X[B+2]=EX(X[B+2]); X[B+3]=EX(X[B+3]); PIN(X); SBAR(); }while(0)
  #define VRD(i) do{ vlo[i]=vtr(vp_+(((i)>>2)*4096+((i)&3)*1024)); vhi[i]=vtr(vp_+(((i)>>2)*4096+((i)&3)*1024+512)); }while(0)
  #define KRD(G,j) do{ if(G){ kload2(kf,kp0+sl_next,j); SBAR(); } }while(0)
  #define STEP(C0,C1,P0,P1,t,GK,GV,GL) do{ SBAR(); \
    CINIT(C0,C1,t); SBAR(); \
    const lds_cptr vp_=vp0+sl_prev; \
    VRD(0); SBAR(); float sacc=(P0[0]+P0[1]); \
    GAPA(C0=__builtin_amdgcn_mfma_f32_32x32x16_bf16(kf[0],qr[0],C0,0,0,0), P0[2],P0[3],P0[4],P0[5],     pw0[0]=PKW(P0,0), pw0[1]=PKW(P0,2), pw0); \
    VRD(4); SBAR(); GAPA(C1=__builtin_amdgcn_mfma_f32_32x32x16_bf16(kf[1],qr[0],C1,0,0,0), P0[6],P0[7],P0[8],P0[9],     pw0[2]=PKW(P0,4), pw0[3]=PKW(P0,6), pw0); \
    VRD(1); SBAR(); GAPA(C0=__builtin_amdgcn_mfma_f32_32x32x16_bf16(kf[2],qr[1],C0,0,0,0),   P0[10],P0[11],P0[12],P0[13], pw1[0]=PKW(P0,8), pw1[1]=PKW(P0,10), pw1); \
    VRD(5); SBAR(); GAPA(C1=__builtin_amdgcn_mfma_f32_32x32x16_bf16(kf[3],qr[1],C1,0,0,0),   P0[14],P0[15],P1[0],P1[1],   pw1[2]=PKW(P0,12),pw1[3]=PKW(P0,14), pw1); \
    VRD(2); SBAR(); GAPA(C0=__builtin_amdgcn_mfma_f32_32x32x16_bf16(kf[4],qr[2],C0,0,0,0),   P1[2],P1[3],P1[4],P1[5],     pw2[0]=PKW(P1,0), pw2[1]=PKW(P1,2), pw2); \
    VRD(6); SBAR(); GAPA(C1=__builtin_amdgcn_mfma_f32_32x32x16_bf16(kf[5],qr[2],C1,0,0,0),   P1[6],P1[7],P1[8],P1[9],     pw2[2]=PKW(P1,4), pw2[3]=PKW(P1,6), pw2); \
    VRD(3); SBAR(); GAPA(C0=__builtin_amdgcn_mfma_f32_32x32x16_bf16(kf[6],qr[3],C0,0,0,0),   P1[10],P1[11],P1[12],P1[13], pw3[0]=PKW(P1,8), pw3[1]=PKW(P1,10), pw3); \
    VRD(7); SBAR(); GAPA(C1=__builtin_amdgcn_mfma_f32_32x32x16_bf16(kf[7],qr[3],C1,0,0,0),   P1[14],P1[15],0.f,0.f,       pw3[2]=PKW(P1,12),pw3[3]=PKW(P1,14), pw3); \
    l_reg+=sacc; \
    if(GK){DMA_K((t)+3,sl_cur);} if(GV){DMA_V((t)+1,sl_next);} \
    { float a=MX3(C0[0],C0[1],C1[0]),b=MX3(C0[2],C0[3],C1[1]); a=MX3(a,C1[2],C1[3]); \
      _Pragma("unroll") for(int r=4;r<16;r+=4){a=MX3(a,C0[r],C0[r+1]);b=MX3(b,C0[r+2],C0[r+3]);a=MX3(a,C1[r],C1[r+1]);b=MX3(b,C1[r+2],C1[r+3]);} \
      float rm=__builtin_fmaxf(a,b); { auto rr=__builtin_amdgcn_permlane32_swap(__float_as_uint(rm),__float_as_uint(rm),false,false); rm=__builtin_fmaxf(__uint_as_float(rr[0]),__uint_as_float(rr[1])); } \
      resc=false; \
      if(__builtin_expect(__any(rm>(float)THRL),0)){ const float dl=__builtin_fmaxf(rm,0.f); mhat+=dl; \
        _Pragma("unroll") for(int r=0;r<16;++r){C0[r]-=dl;C1[r]-=dl;} \
        const float f=__builtin_amdgcn_exp2f(-dl); l_reg*=f; if(hi==0)wsf[r32]=f; resc=true; } } \
    SBAR(); \
    GAPB(o[0]=__builtin_amdgcn_mfma_f32_32x32x16_bf16(PAF(0),VFR(0),o[0],0,0,0), C0,0); \
    GAPB(o[1]=__builtin_amdgcn_mfma_f32_32x32x16_bf16(PAF(0),VFR(4),o[1],0,0,0), C0,4); \
    KRD(GL,0); GAPB(o[0]=__builtin_amdgcn_mfma_f32_32x32x16_bf16(PAF(1),VFR(1),o[0],0,0,0), C0,8); \
    KRD(GL,1); GAPB(o[1]=__builtin_amdgcn_mfma_f32_32x32x16_bf16(PAF(1),VFR(5),o[1],0,0,0), C0,12); \
    KRD(GL,2); GAPB(o[0]=__builtin_amdgcn_mfma_f32_32x32x16_bf16(PAF(2),VFR(2),o[0],0,0,0), C1,0); \
    KRD(GL,3); GAPB(o[1]=__builtin_amdgcn_mfma_f32_32x32x16_bf16(PAF(2),VFR(6),o[1],0,0,0), C1,4); \
    GAPB(o[0]=__builtin_amdgcn_mfma_f32_32x32x16_bf16(PAF(3),VFR(3),o[0],0,0,0), C1,8); \
    GAPB(o[1]=__builtin_amdgcn_mfma_f32_32x32x16_bf16(PAF(3),VFR(7),o[1],0,0,0), C1,12); \
    }while(0)
  int t=1;
  for(;t+5<NT;t+=2){
    STEP(pB0,pB1,pA0,pA1,t,true,true,true);     WAIT_BAR(2); RESC(); ROT();
    STEP(pA0,pA1,pB0,pB1,t+1,true,true,true);   WAIT_BAR(2); RESC(); ROT();
  }
  #define ENDW(tt) do{ if((tt)+3<NT){WAIT_BAR(2);} else if((tt)+2<NT){WAIT_BAR(1);} else {WAIT_BAR(0);} }while(0)
  for(;t+1<NT;t+=2){
    STEP(pB0,pB1,pA0,pA1,t,(t+3<NT),(t+1<NT),(t+1<NT));       ENDW(t);   RESC(); ROT();
    STEP(pA0,pA1,pB0,pB1,t+1,(t+4<NT),(t+2<NT),(t+2<NT));     ENDW(t+1); RESC(); ROT();
  }
  STEP(pB0,pB1,pA0,pA1,NT-1,false,false,false); RESC();
  { float sacc=pB0[0]+pB0[1]; _Pragma("unroll") for(int r=2;r<16;++r)sacc+=pB0[r]; _Pragma("unroll") for(int r=0;r<16;++r)sacc+=pB1[r]; l_reg+=sacc;
    pw0=(u32x4){PKW(pB0,0),PKW(pB0,2),PKW(pB0,4),PKW(pB0,6)};pw1=(u32x4){PKW(pB0,8),PKW(pB0,10),PKW(pB0,12),PKW(pB0,14)};pw2=(u32x4){PKW(pB1,0),PKW(pB1,2),PKW(pB1,4),PKW(pB1,6)};pw3=(u32x4){PKW(pB1,8),PKW(pB1,10),PKW(pB1,12),PKW(pB1,14)};
    SBAR(); pv(o,vb0+sl_cur,PAF(0),PAF(1),PAF(2),PAF(3)); }
  #undef PKW
  #undef PAF
  #undef VFR
  #undef PIN
  #undef MX3
  #undef GAPA
  #undef GAPB
  #undef EX
  #undef VRD
  #undef KRD
  #undef STEP
  #undef ENDW
  {auto rr=__builtin_amdgcn_permlane32_swap(__float_as_uint(l_reg),__float_as_uint(l_reg),false,false);l_reg=__uint_as_float(rr[0])+__uint_as_float(rr[1]);}
  if(hi==0)wsf[32+r32]=l_reg;asm volatile("s_waitcnt lgkmcnt(0)":::"memory");
  float rli[16];
  #pragma unroll
  for(int r=0;r<16;++r)rli[r]=__builtin_amdgcn_rcpf(wsf[32+crow(r,hi)]);
  abf*Ow=Ow0+(long)(wid*QBLK)*OP;
  { abf*stg=(abf*)(shm+LDS_OST)+wid*2048;
    #pragma unroll
    for(int r=0;r<16;++r){const int orow=crow(r,hi);
      #pragma unroll
      for(int d0=0;d0<2;++d0)stg[orow*64+d0*32+r32]=(abf)f2bf(o[d0][r]*rli[r]);}
    asm volatile("s_waitcnt lgkmcnt(0)":::"memory");
    #pragma unroll
    for(int i=0;i<4;++i){const int row=i*8+(lane>>3),ch=lane&7; const u32x4 v=*(const u32x4*)(stg+row*64+ch*8); ATTN_STORE16(Ow+(long)row*OP+ch*8,v);} }
  asm volatile("s_waitcnt lgkmcnt(0)\n\ts_barrier":::"memory");
  #undef DMA_K
  #undef DMA_V
  #undef CINIT
  #undef START
  #undef RESC
  #undef ROT
}
constexpr int ATTN_LDS_BYTES=LDS_BYTES;
#undef SBAR
#undef WAIT_BAR
}

struct Args { const float* in[23]; float* out; unsigned char* ws; int ph_lo, ph_hi; };
struct Frame {
    LAS unsigned char* lds; char* ldsg;
    volatile LAS unsigned* MISC;
    gu32* ctl;
    int tid, lane, wave, vcu, G;
    float* out; unsigned char* ws;
};
constexpr int INTAB_OFF = LDSCTL_OFF + 8192;
__device__ __forceinline__ const float* fin(const Frame& F, int i) {
    const LAS unsigned* t = (const LAS unsigned*)(F.lds + INTAB_OFF) + 2 * i;
    const unsigned lo = __builtin_amdgcn_readfirstlane(t[0]), hi = __builtin_amdgcn_readfirstlane(t[1]);
    return (const float*)(const GAS float*)(((unsigned long long)hi << 32) | lo);
}
#define WSP(T_, off) ((T_*)(F.ws + (off)))
__device__ __forceinline__ int fresh_tid() { int t = threadIdx.x; asm volatile("" : "+v"(t)); return t; }

template <int MODE>
__device__ __forceinline__ void p0_transpose_item(const float* W, int K, int N, bf16* WT, LAS float* scr, int item, int lane) {
    const int nblk = N / 32, kb = item / nblk, nb = item % nblk, k0 = 64 * kb, n0 = 32 * nb;
    { f32x4 ld[8];
#pragma unroll
      for (int i = 0; i < 8; ++i) ld[i] = *(const GAS f32x4*)(W + (size_t)(k0 + 8 * i + (lane >> 3)) * N + n0 + (lane & 7) * 4);
#pragma unroll
      for (int i = 0; i < 8; ++i) { LAS float* d = scr + (8 * i + (lane >> 3)) * 33 + (lane & 7) * 4; d[0] = ld[i].x; d[1] = ld[i].y; d[2] = ld[i].z; d[3] = ld[i].w; } }
    asm volatile("s_waitcnt lgkmcnt(0)" ::: "memory");
    const int c = lane & 7;
#pragma unroll
    for (int j = 0; j < 4; ++j) { const int n = (lane >> 3) + 8 * j; const LAS float* s = scr + (8 * c) * 33 + n;
        v4u o; o.x = pk2(s[0 * 33], s[1 * 33]); o.y = pk2(s[2 * 33], s[3 * 33]); o.z = pk2(s[4 * 33], s[5 * 33]); o.w = pk2(s[6 * 33], s[7 * 33]);
        int col = n0 + n, drow = col;
        *(GAS v4u*)(WT + (size_t)drow * K + k0 + 8 * c) = o; }
    asm volatile("s_waitcnt lgkmcnt(0)" ::: "memory");
}
__device__ __forceinline__ void row_to_bf16(const float* xrow, bf16* orow, int lane) {
    const GAS f32x4* xr = (const GAS f32x4*)xrow + lane;
    GAS v2u* o8 = (GAS v2u*)orow + lane;
#pragma unroll
    for (int j = 0; j < 4; ++j) { const f32x4 v = xr[64 * j]; v2u w; w.x = pk2(v.x, v.y); w.y = pk2(v.z, v.w); o8[64 * j] = w; }
}
__device__ __forceinline__ void p0_transpose_fp8_item(bool PERM, const float* W, int K, int N, unsigned char* WT, float wscale, LAS float* scr, int item, int lane) {
    const int nblk = N / 32, kb = item / nblk, nb = item % nblk, k0 = 128 * kb, n0 = 32 * nb, c = lane & 7;
    v2u o8[2][4];
#pragma unroll
    for (int p = 0; p < 2; ++p) {
        { f32x4 ld[8];
#pragma unroll
          for (int i = 0; i < 8; ++i) ld[i] = __builtin_nontemporal_load((const GAS f32x4*)(W + (size_t)(k0 + 64 * p + 8 * i + (lane >> 3)) * N + n0 + (lane & 7) * 4));
#pragma unroll
          for (int i = 0; i < 8; ++i) { LAS float* d = scr + (8 * i + (lane >> 3)) * 33 + (lane & 7) * 4; d[0] = ld[i].x; d[1] = ld[i].y; d[2] = ld[i].z; d[3] = ld[i].w; } }
        asm volatile("s_waitcnt lgkmcnt(0)" ::: "memory");
#pragma unroll
        for (int j = 0; j < 4; ++j) { const int n = (lane >> 3) + 8 * j; const LAS float* sp = scr + (8 * c) * 33 + n;
            o8[p][j].x = pk4_fp8(sp[0 * 33] * wscale, sp[1 * 33] * wscale, sp[2 * 33] * wscale, sp[3 * 33] * wscale); o8[p][j].y = pk4_fp8(sp[4 * 33] * wscale, sp[5 * 33] * wscale, sp[6 * 33] * wscale, sp[7 * 33] * wscale); }
        asm volatile("s_waitcnt lgkmcnt(0)" ::: "memory");
    }
#pragma unroll
    for (int j = 0; j < 4; ++j) { const int col = n0 + (lane >> 3) + 8 * j, pn = col >> 8, w = col & 255, drow = PERM ? 256 * pn + 128 * (w & 1) + (w >> 1) : col;
        GAS v2u* dp = (GAS v2u*)(WT + (size_t)drow * K + k0 + 8 * c); __builtin_nontemporal_store(o8[0][j], dp); __builtin_nontemporal_store(o8[1][j], dp + 8); }
}
__device__ __forceinline__ void p0_prologue(Frame& F) {
    LAS float* scr = (LAS float*)(F.lds + F.wave * 16384);
    const int gw = F.vcu * NWAVES + F.wave, NGW = F.G * NWAVES;
    constexpr int I_IN = 16 * (NIN / 32), I_KV = 16 * (512 / 32), I_O = 16 * (1024 / 32);
    constexpr int NITEMS = I_IN + I_KV + I_O;
    for (int it = gw; it < NITEMS; it += NGW) {
        int r = it;
        if (r < I_IN) { p0_transpose_item<0>(fin(F, 2), DM, NIN, WSP(bf16, WS_WIN), scr, r, F.lane); continue; } r -= I_IN;
        if (r < I_KV) { p0_transpose_item<0>(fin(F, 11), DM, 512, WSP(bf16, WS_WKV), scr, r, F.lane); continue; } r -= I_KV;
        p0_transpose_item<0>(fin(F, 12), DM, DM, WSP(bf16, WS_WO), scr, r, F.lane);
    }
    for (int i = F.vcu * NTHREADS + F.tid; i < DM * NE; i += F.G * NTHREADS) { const int e = i >> 10, k = i & 1023; const float w = fin(F, 15)[(size_t)k * NE + e] * fin(F, 13)[k];
        const unsigned hi = f2bf(w); WSP(bf16, WS_RWT)[i] = (bf16)hi; WSP(bf16, WS_RWT)[DM * NE + i] = (bf16)f2bf(w - bf2f(hi)); }
    if (gw < NE) { float a = 0.f; for (int k = F.lane; k < DM; k += 64) a += fin(F, 14)[k] * fin(F, 15)[(size_t)k * NE + gw];
        a = wave_sum(a); if (F.lane == 0) WSP(float, WS_RWT + 2 * DM * NE * 2)[gw] = a + fin(F, 16)[gw]; }
    for (int m = gw; m < T; m += NGW) row_to_bf16(fin(F, 0) + (size_t)m * DM, WSP(bf16, WS_XB) + (size_t)m * DM, F.lane);
    for (int m = gw; m < NB * MEML; m += NGW) row_to_bf16(fin(F, 1) + (size_t)m * DM, WSP(bf16, WS_MEMB) + (size_t)m * DM, F.lane);
}

__device__ __forceinline__ void p1_inproj(Frame& F) {
    { pg8::Gemm g{WSP(bf16, WS_XB), WSP(bf16, WS_WIN), T, NIN, DM}; pg8::StaticOrder S; S.init(T, NIN, F.G, (int)blockIdx.x);
      pg8::EpiBf16 E{WSP(bf16, WS_U), NIN, (1u << 0) | (1u << 1) | (1u << 11), C2};
      pg8::gemm_phase<pg8::EpiBf16, pg8::StaticOrder, true, true>(F.lds, g, S, E); }
}

constexpr int HCH = 64, NCH = SEQ / HCH, HU_STRIDE = 64 * 64 + 64;
namespace hg {
typedef short bf16x8 __attribute__((ext_vector_type(8)));
typedef short s16x4 __attribute__((ext_vector_type(4)));
typedef float f32x4 __attribute__((ext_vector_type(4)));
typedef unsigned u32x2 __attribute__((ext_vector_type(2)));
typedef short v4i16_t __attribute__((ext_vector_type(4)));
template <int N> __device__ __forceinline__ float row_shr_or(float x, float fill) { return __int_as_float(__builtin_amdgcn_update_dpp(__float_as_int(fill), __float_as_int(x), 0x110 + N, 0xf, 0xf, false)); }
__device__ __forceinline__ float row_cumprod(float x) { x *= row_shr_or<1>(x, 1.f); x *= row_shr_or<2>(x, 1.f); x *= row_shr_or<4>(x, 1.f); x *= row_shr_or<8>(x, 1.f); return x; }
__device__ __forceinline__ float sigm(float x) { return __builtin_amdgcn_rcpf(1.f + __builtin_amdgcn_exp2f(-1.4426950408889634f * x)); }
__device__ __forceinline__ unsigned pkbf(float lo, float hi) { typedef float f2 __attribute__((ext_vector_type(2))); typedef __bf16 b2 __attribute__((ext_vector_type(2))); f2 v = {lo, hi}; b2 o = __builtin_convertvector(v, b2); return __builtin_bit_cast(unsigned, o); }
__device__ __forceinline__ bf16x8 frag8(float a0, float a1, float a2, float a3, float a4, float a5, float a6, float a7) { typedef unsigned u4 __attribute__((ext_vector_type(4))); u4 w = {pkbf(a0, a1), pkbf(a2, a3), pkbf(a4, a5), pkbf(a6, a7)}; return __builtin_bit_cast(bf16x8, w); }
__device__ __forceinline__ s16x4 frag4s(float a0, float a1, float a2, float a3) { u32x2 w = {pkbf(a0, a1), pkbf(a2, a3)}; return __builtin_bit_cast(s16x4, w); }
__device__ __forceinline__ s16x4 trd(const LAS unsigned char* p) { return __builtin_bit_cast(s16x4, __builtin_amdgcn_ds_read_tr16_b64_v4i16((LAS v4i16_t*)p)); }
__device__ __forceinline__ float b2f(short v) { return __uint_as_float(((unsigned)(unsigned short)v) << 16); }

template <bool OUT>
__device__ __forceinline__ void unit(const bf16* U, const float* lbsrc, int b, int h, int dir, int c, f32x4 (&S)[4][4], float (&aprod)[4], LAS unsigned char* wl, int lane) {
    const int r = lane & 15, g = lane >> 4;
    LAS unsigned char* tHQ = wl + 8192; LAS unsigned char* tHF = wl + 10240; LAS unsigned char* tHI = wl + 12288; LAS float* aL = (LAS float*)(wl + 14336);
    LAS float* lbL = aL + 64;
    lbL[lane] = __builtin_amdgcn_rcpf(1.f + __expf(lbsrc[256 + h * 64 + lane] - lbsrc[h * 64 + lane]));
    float lbD[4];
#pragma unroll
    for (int cc = 0; cc < 4; ++cc) lbD[cc] = lbL[16 * cc + r];
#pragma unroll
    for (int mb = 0; mb < 4; ++mb) aprod[mb] = 1.f;
    const int lrow = lane >> 3, piece = lane & 7;
    const bf16* ubase = U + (size_t)b * SEQ * NIN + h * 64 + piece * 8;
    v4u stg[3][2];
#define HG_LOAD(sc) do { _Pragma("unroll") for (int hh = 0; hh < 2; ++hh) { const int i_ = 16 * (sc) + lrow + 8 * hh; const int t_ = dir ? HCH * c + HCH - 1 - i_ : HCH * c + i_; const bf16* p_ = ubase + (size_t)t_ * NIN; \
        stg[1][hh] = *(const GAS v4u*)(p_ + U_HF + dir * 256); stg[2][hh] = *(const GAS v4u*)(p_ + U_HI); } } while (0)
#define HG_LOADQ(sc) do { _Pragma("unroll") for (int hh = 0; hh < 2; ++hh) { const int i_ = 16 * (sc) + lrow + 8 * hh; const int t_ = dir ? HCH * c + HCH - 1 - i_ : HCH * c + i_; \
        stg[0][hh] = *(const GAS v4u*)(ubase + (size_t)t_ * NIN + U_HQ); } } while (0)
    HG_LOAD(0);
#pragma unroll 1
    for (int sc = 0; sc < 4; ++sc) {
        if (OUT) HG_LOADQ(sc);
#pragma unroll
        for (int hh = 0; hh < 2; ++hh) { const int off = (lrow + 8 * hh) * 128 + piece * 16;
            *(LAS v4u*)(tHF + off) = stg[1][hh]; *(LAS v4u*)(tHI + off) = stg[2][hh]; }
        if (sc < 3) HG_LOAD(sc + 1);
        s16x4 kteF[4], vF[4];
        const int q4 = r >> 2, p4 = r & 3;
#pragma unroll
        for (int mb = 0; mb < 4; ++mb) {
            const int toff = (4 * g + q4) * 128 + (16 * mb + 4 * p4) * 2;
            const s16x4 hfv = trd(tHF + toff); vF[mb] = trd(tHI + toff);
            float f[4], lp[4];
#pragma unroll
            for (int j = 0; j < 4; ++j) f[j] = lbD[mb] + (1.f - lbD[mb]) * sigm(b2f(hfv[j]));
            lp[0] = f[0]; lp[1] = lp[0] * f[1]; lp[2] = lp[1] * f[2]; lp[3] = lp[2] * f[3];
            float inc = lp[3];
            { const float u1 = __shfl_up(inc, 16); inc *= (g >= 1 ? u1 : 1.f); const float u2 = __shfl_up(inc, 32); inc *= (g >= 2 ? u2 : 1.f); }
            const float ex0 = __shfl_up(inc, 16), excl = g >= 1 ? ex0 : 1.f, plast = __shfl(inc, 48 + r);
            aprod[mb] *= plast;
            float kt[4];
#pragma unroll
            for (int j = 0; j < 4; ++j) kt[j] = (1.f - f[j]) * plast * __builtin_amdgcn_rcpf(excl * lp[j]);
            kteF[mb] = frag4s(kt[0], kt[1], kt[2], kt[3]);
            aL[16 * mb + r] = plast;
        }
        if (OUT) {
#pragma unroll
            for (int hh = 0; hh < 2; ++hh) *(LAS v4u*)(tHQ + (lrow + 8 * hh) * 128 + piece * 16) = stg[0][hh];
            float qe[4][4], ke[4][4];
#pragma unroll
            for (int cc = 0; cc < 4; ++cc) {
                const u32x2 wq = *(const LAS u32x2*)(tHQ + r * 128 + (16 * cc + 4 * g) * 2), wf = *(const LAS u32x2*)(tHF + r * 128 + (16 * cc + 4 * g) * 2);
                const float hq4[4] = {bflo(wq.x), bfhi(wq.x), bflo(wq.y), bfhi(wq.y)}, hf4[4] = {bflo(wf.x), bfhi(wf.x), bflo(wf.y), bfhi(wf.y)};
                const f32x4 lbv = *(const LAS f32x4*)&lbL[16 * cc + 4 * g];
#pragma unroll
                for (int e = 0; e < 4; ++e) { const float f = lbv[e] + (1.f - lbv[e]) * sigm(hf4[e]); const float P = row_cumprod(f);
                    qe[cc][e] = hq4[e] * sigm(hq4[e]) * P; ke[cc][e] = (1.f - f) * __builtin_amdgcn_rcpf(P); }
            }
            bf16x8 qeF[2], keF[2];
#pragma unroll
            for (int ks = 0; ks < 2; ++ks) { qeF[ks] = frag8(qe[2 * ks][0], qe[2 * ks][1], qe[2 * ks][2], qe[2 * ks][3], qe[2 * ks + 1][0], qe[2 * ks + 1][1], qe[2 * ks + 1][2], qe[2 * ks + 1][3]);
                keF[ks] = frag8(ke[2 * ks][0], ke[2 * ks][1], ke[2 * ks][2], ke[2 * ks][3], ke[2 * ks + 1][0], ke[2 * ks + 1][1], ke[2 * ks + 1][2], ke[2 * ks + 1][3]); }
            f32x4 cp = {0.f, 0.f, 0.f, 0.f};
            cp = __builtin_amdgcn_mfma_f32_16x16x32_bf16(keF[0], qeF[0], cp, 0, 0, 0); cp = __builtin_amdgcn_mfma_f32_16x16x32_bf16(keF[1], qeF[1], cp, 0, 0, 0);
            const s16x4 amF = frag4s(4 * g + 0 <= r ? cp[0] : 0.f, 4 * g + 1 <= r ? cp[1] : 0.f, 4 * g + 2 <= r ? cp[2] : 0.f, 4 * g + 3 <= r ? cp[3] : 0.f);
#pragma unroll
            for (int mb = 0; mb < 4; ++mb) {
                f32x4 ot = {0.f, 0.f, 0.f, 0.f}, oi = {0.f, 0.f, 0.f, 0.f};
                oi = __builtin_amdgcn_mfma_f32_16x16x16bf16_1k(vF[mb], amF, oi, 0, 0, 0);
#pragma unroll
                for (int ks = 0; ks < 2; ++ks) { const f32x4 s0 = S[2 * ks][mb], s1 = S[2 * ks + 1][mb];
                    ot = __builtin_amdgcn_mfma_f32_16x16x32_bf16(frag8(s0[0], s0[1], s0[2], s0[3], s1[0], s1[1], s1[2], s1[3]), qeF[ks], ot, 0, 0, 0); }
                ot = ot + oi;
                u32x2 w; w.x = pkbf(ot[0], ot[1]); w.y = pkbf(ot[2], ot[3]);
                *(LAS u32x2*)(wl + ((16 * sc + r) * 64 + 16 * mb + 4 * g) * 2) = w;
            }
        }
#pragma unroll
        for (int db = 0; db < 4; ++db) { const f32x4 ar = *(const LAS f32x4*)&aL[16 * db + 4 * g];
#pragma unroll
            for (int vb = 0; vb < 4; ++vb) S[db][vb] = __builtin_amdgcn_mfma_f32_16x16x16bf16_1k(kteF[db], vF[vb], S[db][vb] * ar, 0, 0, 0); }
    }
#undef HG_LOAD
#undef HG_LOADQ
}
}

__device__ __forceinline__ void p2_hgrn_local(Frame& F) {
    const int gw = F.vcu * NWAVES + F.wave, NGW = F.G * NWAVES, lane = F.lane;
    for (int u = gw; u < 32 * NCH; u += NGW) {
        const int seq = u / NCH, cp = u % NCH, b = seq >> 3, h = (seq >> 1) & 3, dir = seq & 1, c = dir ? NCH - 1 - cp : cp;
        hg::f32x4 S[4][4]; float aprod[4];
#pragma unroll
        for (int db = 0; db < 4; ++db)
#pragma unroll
            for (int vb = 0; vb < 4; ++vb) S[db][vb] = (hg::f32x4){0.f, 0.f, 0.f, 0.f};
        hg::unit<false>(WSP(bf16, WS_U), dir ? fin(F, 9) : fin(F, 8), b, h, dir, c, S, aprod, F.lds + F.wave * 16384, lane);
        float* hu = WSP(float, WS_HU) + (size_t)u * HU_STRIDE; const int r = lane & 15, g = lane >> 4;
#pragma unroll
        for (int db = 0; db < 4; ++db)
#pragma unroll
            for (int vb = 0; vb < 4; ++vb)
#pragma unroll
                for (int q = 0; q < 4; ++q) hu[(16 * db + 4 * g + q) * 64 + 16 * vb + r] = S[db][vb][q];
#pragma unroll
        for (int mb = 0; mb < 4; ++mb) hu[4096 + 16 * mb + r] = aprod[mb];
    }
    {
        LAS float* red = (LAS float*)(F.lds + LDSCTL_OFF + 1024);
        for (int r0 = F.vcu * 64; r0 < T; r0 += F.G * 64) {
            float mx = 0.f;
            for (int i = 0; i < 8; ++i) { const v4u w = *(const GAS v4u*)(WSP(bf16, WS_U) + (size_t)(r0 + F.wave * 8 + i) * NIN + U_DK + lane * 8);
                float ss = bflo(w.x) * bflo(w.x) + bfhi(w.x) * bfhi(w.x) + bflo(w.y) * bflo(w.y) + bfhi(w.y) * bfhi(w.y) + bflo(w.z) * bflo(w.z) + bfhi(w.z) * bfhi(w.z) + bflo(w.w) * bflo(w.w) + bfhi(w.w) * bfhi(w.w);
                ss += __shfl_xor(ss, 1); ss += __shfl_xor(ss, 2); ss += __shfl_xor(ss, 4); mx = fmaxf(mx, ss); }
            __syncthreads();
            if ((lane & 7) == 0) red[F.wave * 8 + (lane >> 3)] = mx;
            __syncthreads();
            if (F.tid < 8) { float m = red[F.tid]; for (int w = 1; w < 8; ++w) m = fmaxf(m, red[w * 8 + F.tid]);
                __hip_atomic_fetch_max((unsigned*)(F.ctl + CW_KN + (r0 / SEQ) * 8 + F.tid), __float_as_uint(m), RLX_AGENT); }
        }
    }
}
__device__ __forceinline__ void hgrn_scan(Frame& F) {
    for (int idx = F.vcu * NTHREADS + F.tid; idx < 32 * 4096; idx += F.G * NTHREADS) {
        const int seq = idx >> 12, dv = idx & 4095, d = dv >> 6;
        const float* hu = WSP(float, WS_HU) + (size_t)seq * NCH * HU_STRIDE; float* ss = WSP(float, WS_SS) + (size_t)seq * NCH * 4096 + dv;
        float st = 0.f;
#pragma unroll 8
        for (int cp = 0; cp < NCH; ++cp) { ss[(size_t)cp * 4096] = st; st = hu[(size_t)cp * HU_STRIDE + 4096 + d] * st + hu[(size_t)cp * HU_STRIDE + dv]; }
    }
}
constexpr int CV_IGU = 8 * (2048 / 32), CV_IDN = 8 * (1024 / 32), CV_NWAVEITEMS = NE * CV_IGU + NE * CV_IDN, CV_NGROUPS = CV_NWAVEITEMS / NWAVES;
__device__ __forceinline__ bool conv_items(Frame& F, LAS int* qs) {
    if (F.tid == 0) qs[1] = (int)__hip_atomic_fetch_add((unsigned*)(F.ctl + CW_CONVQ), 8u, RLX_AGENT);
    __syncthreads();
    const int g0 = __builtin_amdgcn_readfirstlane(qs[1]);
    __syncthreads();
    if (g0 >= CV_NGROUPS) return false;
    LAS float* scr = (LAS float*)(F.lds + F.wave * 16384);
#pragma unroll 1
    for (int gi = g0; gi < min(g0 + 8, CV_NGROUPS); ++gi) {
        int r = gi * NWAVES + F.wave; const bool gu = r < NE * CV_IGU; if (!gu) r -= NE * CV_IGU;
        const int per = gu ? CV_IGU : CV_IDN, e = r / per, n = gu ? 2048 : 1024;
        p0_transpose_fp8_item(gu, (gu ? fin(F, 17) : fin(F, 19)) + (size_t)e * DM * n, DM, n, (gu ? WSP(unsigned char, WS_WGU) : WSP(unsigned char, WS_WDN)) + (size_t)e * n * DM, gu ? WGU_SCALE : WDN_SCALE, scr, r - e * per, F.lane);
    }
    __syncthreads();
    return true;
}
__device__ __forceinline__ void p3_attn(Frame& F) {
    hgrn_scan(F);
    if (F.vcu < 8) {
        pg8::Gemm g{WSP(bf16, WS_MEMB), WSP(bf16, WS_WKV), NB * MEML, 512, DM}; pg8::OneUnit S{F.vcu >> 1, F.vcu & 1};
        pg8::EpiBf16 E{WSP(bf16, WS_MKV), 512, 0u, 1.f};
        pg8::gemm_phase<pg8::EpiBf16, pg8::OneUnit, false, true>(F.lds, g, S, E);
        asm volatile("s_waitcnt vmcnt(0)" ::: "memory"); __syncthreads();
        if (F.tid == 0) { __builtin_amdgcn_fence(__ATOMIC_RELEASE, "agent"); asm volatile("s_waitcnt vmcnt(0)" ::: "memory"); __hip_atomic_fetch_add((unsigned*)(F.ctl + CW_MKV), 1u, RLX_AGENT); }
    }
    const bf16* U = WSP(bf16, WS_U);
    const bf16* MKV = WSP(bf16, WS_MKV);
    LAS float* red = (LAS float*)(F.lds + LDSCTL_OFF + 1024);
    LAS int* qs = (LAS int*)(red + 16);
    bool conv_more = true, first_it = true;
    for (;;) {
        if (F.tid == 0) qs[0] = (int)__hip_atomic_fetch_add((unsigned*)(F.ctl + CW_QUEUE), 1u, RLX_AGENT);
        __syncthreads();
        const int it = __builtin_amdgcn_readfirstlane(qs[0]);
        __syncthreads();
        if (it >= 512 + 256) break;
        if (conv_more && !(first_it && (F.vcu & 1))) conv_more = conv_items(F, qs);
        first_it = false;
        if (it >= 512) {
            if (F.tid == 0) { unsigned sp = 0; while (__hip_atomic_load((unsigned*)(F.ctl + CW_MKV), RLX_AGENT) < 8u && ++sp < (1u << 22)) __builtin_amdgcn_s_sleep(2);
                __builtin_amdgcn_fence(__ATOMIC_ACQUIRE, "agent"); asm volatile("s_waitcnt vmcnt(0)" ::: "memory"); }
            __syncthreads();
            const int u = it - 512, b = u >> 6, h = (u >> 4) & 3, qb = u & 15; const size_t row0 = (size_t)b * SEQ + qb * 256;
            const bf16* Kp = MKV + (size_t)b * MEML * 512 + h * 64;
            attn_body::attn_unit<8>(U + row0 * NIN + U_MQ + h * 64, NIN, Kp, 512, Kp + 256, 512, WSP(bf16, WS_CAT) + row0 * DM + 768 + h * 64, DM, MEML / 64, 0.f, 0, F.ldsg);
            continue;
        }
        const int h = 3 - (it >> 7), b = (it >> 5) & 3, m = (it >> 4) & 1, qb = it & 15; const size_t row0 = (size_t)b * SEQ + qb * 256;
        const bf16* Qp = U + row0 * NIN + U_DQ + h * 128 + m * 64; const bf16* Kp = U + (size_t)b * SEQ * NIN + U_DK + h * 128 + m * 64; const bf16* Vp = U + (size_t)b * SEQ * NIN + U_DV + h * 128;
        bf16* Op = WSP(bf16, WS_OD) + row0 * DM + h * 256 + m * 128; const float c2 = __builtin_ldexpf(LOG2E, -2 * (h + 1)); int q0 = qb * 256, tlo, thi;
        {
            const int r = F.tid >> 1, hf = F.tid & 1; const bf16* qp = Qp + (size_t)r * NIN + hf * 32; const bf16* kp = Kp + (size_t)(q0 + r) * NIN + hf * 32;
            float qq = 0.f, qk = 0.f;
#pragma unroll
            for (int i = 0; i < 4; ++i) { const v4u a = *(const GAS v4u*)(qp + 8 * i), k4 = *(const GAS v4u*)(kp + 8 * i);
                qq += bflo(a.x) * bflo(a.x) + bfhi(a.x) * bfhi(a.x) + bflo(a.y) * bflo(a.y) + bfhi(a.y) * bfhi(a.y) + bflo(a.z) * bflo(a.z) + bfhi(a.z) * bfhi(a.z) + bflo(a.w) * bflo(a.w) + bfhi(a.w) * bfhi(a.w);
                qk += bflo(a.x) * bflo(k4.x) + bfhi(a.x) * bfhi(k4.x) + bflo(a.y) * bflo(k4.y) + bfhi(a.y) * bfhi(k4.y) + bflo(a.z) * bflo(k4.z) + bfhi(a.z) * bfhi(k4.z) + bflo(a.w) * bflo(k4.w) + bfhi(a.w) * bfhi(k4.w); }
            qq += __shfl_xor(qq, 1); qk += __shfl_xor(qk, 1);
            const float kn = sqrtf(__uint_as_float(__hip_atomic_load((unsigned*)(F.ctl + CW_KN + b * 8 + h * 2 + m), RLX_AGENT))) * 1.0001f;
            float need = wave_max(sqrtf(qq) * 1.0001f * kn - qk + 36.5f);
            if (F.lane == 0) red[F.wave] = need;
            __syncthreads();
            need = red[0];
#pragma unroll
            for (int w = 1; w < 8; ++w) need = fmaxf(need, red[w]);
            const float dist = need / c2;
            const float flo = floorf(((float)(q0 - 63) - dist) * (1.f / 64.f)) + 1.f, fhi = ceilf(((float)(q0 + 255) + dist) * (1.f / 64.f)) - 1.f;
            tlo = flo < 0.f ? 0 : (int)flo; if (tlo > 4 * qb) tlo = 4 * qb;
            thi = fhi > (float)(SEQ / 64 - 1) ? SEQ / 64 - 1 : (int)fhi; if (thi < 4 * qb + 3) thi = 4 * qb + 3;
            if (((thi - tlo + 1) & 1) != 0) { if (tlo > 0) --tlo; else ++thi; }
            tlo = __builtin_amdgcn_readfirstlane(tlo); thi = __builtin_amdgcn_readfirstlane(thi);
            __syncthreads();
        }
        const int NT = thi - tlo + 1; Kp += (size_t)tlo * 64 * NIN; Vp += (size_t)tlo * 64 * NIN; q0 -= tlo * 64;
#pragma unroll 1
        for (int vh = 0; vh < 2; ++vh) attn_body::attn_unit<8>(Qp, NIN, Kp, NIN, Vp + vh * 64, NIN, Op + vh * 64, DM, NT, c2, q0, F.ldsg);
    }
    while (conv_more) conv_more = conv_items(F, qs);
}

__device__ __forceinline__ void hgrn_out(Frame& F) {
    const int lane = F.lane, wave = F.wave, r = lane & 15, g = lane >> 4;
    for (int u0 = F.vcu * NWAVES; u0 < 32 * NCH; u0 += F.G * NWAVES) {
        const int u = u0 + wave, bhc = u >> 1, dir = u & 1, b = bhc / (4 * NCH), h = (bhc / NCH) & 3, c = bhc % NCH, cp = dir ? NCH - 1 - c : c, seq = b * 8 + h * 2 + dir;
        const float* ss = WSP(float, WS_SS) + ((size_t)seq * NCH + cp) * 4096;
        hg::f32x4 S[4][4]; float aprod[4];
#pragma unroll
        for (int db = 0; db < 4; ++db)
#pragma unroll
            for (int vb = 0; vb < 4; ++vb)
#pragma unroll
                for (int q = 0; q < 4; ++q) S[db][vb][q] = ss[(16 * db + 4 * g + q) * 64 + 16 * vb + r];
        hg::unit<true>(WSP(bf16, WS_U), dir ? fin(F, 9) : fin(F, 8), b, h, dir, c, S, aprod, F.lds + wave * 16384, lane);
        __syncthreads();
        const LAS unsigned char* Of = F.lds + (wave & ~1) * 16384; const LAS unsigned char* Ob = F.lds + (wave | 1) * 16384;
        const int i16 = lane & 15, k4 = lane >> 4; const f32x4 nw = *(const GAS f32x4*)(fin(F, 10) + h * 64 + 4 * i16);
#pragma unroll 2
        for (int k0 = 0; k0 < 32; k0 += 4) { const int tl = dir * 32 + k0 + k4; const size_t row = (size_t)b * SEQ + c * HCH + tl;
            const v2u gq = *(const GAS v2u*)(WSP(bf16, WS_U) + row * NIN + U_HG + h * 64 + 4 * i16);
            const v2u a = *(const LAS v2u*)(Of + tl * 128 + 8 * i16), bb = *(const LAS v2u*)(Ob + (HCH - 1 - tl) * 128 + 8 * i16);
            const float o0 = bflo(a.x) + bflo(bb.x), o1 = bfhi(a.x) + bfhi(bb.x), o2 = bflo(a.y) + bflo(bb.y), o3 = bfhi(a.y) + bfhi(bb.y);
            float ss2 = (o0 * o0 + o1 * o1) + (o2 * o2 + o3 * o3);
            ss2 += __shfl_xor(ss2, 1); ss2 += __shfl_xor(ss2, 2); ss2 += __shfl_xor(ss2, 4); ss2 += __shfl_xor(ss2, 8);
            const float rr = rsqrtf(ss2 * (1.f / 64.f) + EPS);
            v2u w; w.x = pk2(o0 * rr * nw.x * sigmoidf_(bflo(gq.x)), o1 * rr * nw.y * sigmoidf_(bfhi(gq.x))); w.y = pk2(o2 * rr * nw.z * sigmoidf_(bflo(gq.y)), o3 * rr * nw.w * sigmoidf_(bfhi(gq.y)));
            *(GAS v2u*)(WSP(bf16, WS_CAT) + row * DM + 512 + h * 64 + 4 * i16) = w; }
        __syncthreads();
    }
}

__device__ __forceinline__ void p4_combine(Frame& F) {
    hgrn_out(F);
    const int gw = F.vcu * NWAVES + F.wave, NGW = F.G * NWAVES, lane = F.lane;
    const float sa = wave_sum(fin(F, 3)[lane] * fin(F, 4)[lane]), sb = wave_sum(fin(F, 5)[lane] * fin(F, 6)[lane]);
    const float lam = __expf(sa) - __expf(sb) + 0.2f;
    const bf16* OD = WSP(bf16, WS_OD); bf16* CAT = WSP(bf16, WS_CAT);
    const int i16 = lane & 15, mm = (lane >> 4) & 1, hh = lane >> 5;
    const f32x4 dw0 = *(const GAS f32x4*)(fin(F, 7) + 8 * i16), dw1 = *(const GAS f32x4*)(fin(F, 7) + 8 * i16 + 4);
    v4u nx[2];
#pragma unroll
    for (int x = 0; x < 2; ++x) nx[x] = *(const GAS v4u*)(OD + (size_t)gw * DM + 512 * x + 8 * lane);
    for (int row = gw; row < T; row += NGW) {
        v4u cur[2] = {nx[0], nx[1]};
        if (row + NGW < T) {
#pragma unroll
            for (int x = 0; x < 2; ++x) nx[x] = *(const GAS v4u*)(OD + (size_t)(row + NGW) * DM + 512 * x + 8 * lane); }
#pragma unroll
        for (int x = 0; x < 2; ++x) {
            const v4u a = cur[x]; v4u b; b.x = __shfl_xor(a.x, 16); b.y = __shfl_xor(a.y, 16); b.z = __shfl_xor(a.z, 16); b.w = __shfl_xor(a.w, 16);
            float o[8] = {bflo(a.x) - lam * bflo(b.x), bfhi(a.x) - lam * bfhi(b.x), bflo(a.y) - lam * bflo(b.y), bfhi(a.y) - lam * bfhi(b.y),
                          bflo(a.z) - lam * bflo(b.z), bfhi(a.z) - lam * bfhi(b.z), bflo(a.w) - lam * bflo(b.w), bfhi(a.w) - lam * bfhi(b.w)};
            float ss = 0.f;
#pragma unroll
            for (int k = 0; k < 8; ++k) ss += o[k] * o[k];
            ss += __shfl_xor(ss, 1); ss += __shfl_xor(ss, 2); ss += __shfl_xor(ss, 4); ss += __shfl_xor(ss, 8);
            const float r = rsqrtf(ss * (1.f / 128.f) + EPS) * 0.8f;
            if (mm == 0) { v4u w; w.x = pk2(o[0] * r * dw0.x, o[1] * r * dw0.y); w.y = pk2(o[2] * r * dw0.z, o[3] * r * dw0.w); w.z = pk2(o[4] * r * dw1.x, o[5] * r * dw1.y); w.w = pk2(o[6] * r * dw1.z, o[7] * r * dw1.w);
                *(GAS v4u*)(CAT + (size_t)row * DM + (2 * x + hh) * 128 + 8 * i16) = w; }
        }
    }
}

__device__ __forceinline__ void p4_wo(Frame& F) {
    pg8::Gemm g{WSP(bf16, WS_CAT), WSP(bf16, WS_WO), T, DM, DM}; pg8::StaticOrder S; S.init(T, DM, F.G, (int)blockIdx.x);
    pg8::EpiResF32 E{fin(F, 0), WSP(float, WS_Z1), DM, ALPHA};
    pg8::gemm_phase<pg8::EpiResF32, pg8::StaticOrder, true, true>(F.lds, g, S, E);
}

__device__ __forceinline__ void ln_row(f32x4 (&v)[4], const float* g, const float* bb, int lane, float& mean, float& rstd) {
    float s = 0.f;
#pragma unroll
    for (int j = 0; j < 4; ++j) s += (v[j].x + v[j].y) + (v[j].z + v[j].w);
    mean = wave_sum(s) * (1.f / DM); float s2 = 0.f;
#pragma unroll
    for (int j = 0; j < 4; ++j) { v[j] = v[j] - mean; s2 += (v[j].x * v[j].x + v[j].y * v[j].y) + (v[j].z * v[j].z + v[j].w * v[j].w); }
    rstd = rsqrtf(wave_sum(s2) * (1.f / DM) + EPS);
#pragma unroll
    for (int j = 0; j < 4; ++j) { const f32x4 gv = *(const GAS f32x4*)(g + 4 * lane + 256 * j), bv = *(const GAS f32x4*)(bb + 4 * lane + 256 * j); v[j] = v[j] * rstd * gv + bv; }
}

__device__ __forceinline__ void ln_row_pre(f32x4 (&v)[4], const f32x4 (&gv)[4], const f32x4 (&bv)[4], float& mean, float& rstd) {
    float s = 0.f;
#pragma unroll
    for (int j = 0; j < 4; ++j) s += (v[j].x + v[j].y) + (v[j].z + v[j].w);
    mean = wave_sum(s) * (1.f / DM); float s2 = 0.f;
#pragma unroll
    for (int j = 0; j < 4; ++j) { v[j] = v[j] - mean; s2 += (v[j].x * v[j].x + v[j].y * v[j].y) + (v[j].z * v[j].z + v[j].w * v[j].w); }
    rstd = rsqrtf(wave_sum(s2) * (1.f / DM) + EPS);
#pragma unroll
    for (int j = 0; j < 4; ++j) v[j] = v[j] * rstd * gv[j] + bv[j];
}
__device__ __forceinline__ void p5_router(Frame& F) {
    typedef short bf16x8r __attribute__((ext_vector_type(8)));
    LAS float* LG = (LAS float*)F.lds;
    LAS float* PX = LG + 64 * 33;
    LAS int* SEL = (LAS int*)(F.lds + LDSCTL_OFF + 1024);
    LAS int* LRK = SEL + 512;
    LAS unsigned* LCNT = (LAS unsigned*)(SEL + 1024);
    LAS unsigned* LBASE = LCNT + 32;
    LAS float* GTL = (LAS float*)(F.lds + LDSCTL_OFF + 6656);
    LAS unsigned char* XT = F.lds + 17920;
    LAS float* GB = (LAS float*)(F.lds + 17920 + 65536);
    if (F.tid < 32) LCNT[F.tid] = 0u;
    { const f32x4 gq = *(const GAS f32x4*)(fin(F, 13) + 4 * (F.tid & 255)), bq = *(const GAS f32x4*)(fin(F, 14) + 4 * (F.tid & 255)); if (F.tid < 256) *(LAS f32x4*)&GB[4 * F.tid] = gq; else *(LAS f32x4*)&GB[1024 + 4 * (F.tid - 256)] = bq; }
    const int lane = F.lane, r = lane & 15, g = lane >> 4, tg = F.wave & 3, kh = F.wave >> 2;
    const int rpb = T / F.G;
    const int row = F.vcu * rpb + tg * 16 + r;
    const float* zr = WSP(float, WS_Z1) + (size_t)row * DM + 8 * g + 512 * kh;
    f32x4 z[16][2];
#pragma unroll
    for (int ks = 0; ks < 16; ++ks) { z[ks][0] = *(const GAS f32x4*)(zr + 32 * ks); z[ks][1] = *(const GAS f32x4*)(zr + 32 * ks + 4); }
    const bf16* wh = WSP(bf16, WS_RWT) + (size_t)r * DM + 8 * g + 512 * kh; const bf16* wl = wh + DM * NE;
    bf16x8r Bc[2][2], Bn[2][2];
#pragma unroll
    for (int nb = 0; nb < 2; ++nb) { Bc[nb][0] = *(const GAS bf16x8r*)(wh + (size_t)nb * 16 * DM); Bc[nb][1] = *(const GAS bf16x8r*)(wl + (size_t)nb * 16 * DM); }
    float s1 = 0.f, s2 = 0.f;
#pragma unroll
    for (int ks = 0; ks < 16; ++ks) { const f32x4 a = z[ks][0], b = z[ks][1];
        s1 += (a.x + a.y) + (a.z + a.w) + (b.x + b.y) + (b.z + b.w); s2 += (a.x * a.x + a.y * a.y) + (a.z * a.z + a.w * a.w) + (b.x * b.x + b.y * b.y) + (b.z * b.z + b.w * b.w); }
    s1 += __shfl_xor(s1, 16); s1 += __shfl_xor(s1, 32); s2 += __shfl_xor(s2, 16); s2 += __shfl_xor(s2, 32);
    LAS float* PS = PX + 4 * 2 * 64 * 4;
    if (g == 0) { PS[(F.wave * 16 + r) * 2] = s1; PS[(F.wave * 16 + r) * 2 + 1] = s2; }
    __syncthreads();
    { const int pw = F.wave ^ 4; s1 += PS[(pw * 16 + r) * 2]; s2 += PS[(pw * 16 + r) * 2 + 1]; }
    const float mean = s1 * (1.f / DM), rstd = rsqrtf(fmaxf(s2 * (1.f / DM) - mean * mean, 0.f) + EPS);
    f32x4 acc[2] = {{0.f, 0.f, 0.f, 0.f}, {0.f, 0.f, 0.f, 0.f}};
#pragma unroll
    for (int ks = 0; ks < 16; ++ks) {
        if (ks + 1 < 16) {
#pragma unroll
            for (int nb = 0; nb < 2; ++nb) { Bn[nb][0] = *(const GAS bf16x8r*)(wh + (size_t)nb * 16 * DM + 32 * (ks + 1)); Bn[nb][1] = *(const GAS bf16x8r*)(wl + (size_t)nb * 16 * DM + 32 * (ks + 1)); } }
        const f32x4 ha = (z[ks][0] - mean) * rstd, hb = (z[ks][1] - mean) * rstd;
        const float h[8] = {ha.x, ha.y, ha.z, ha.w, hb.x, hb.y, hb.z, hb.w}; unsigned hi[8]; float lo[8];
#pragma unroll
        for (int j = 0; j < 8; ++j) { hi[j] = f2bf(h[j]); lo[j] = h[j] - bf2f(hi[j]); }
        v4u Ah, Al; Ah.x = hi[0] | (hi[1] << 16); Ah.y = hi[2] | (hi[3] << 16); Ah.z = hi[4] | (hi[5] << 16); Ah.w = hi[6] | (hi[7] << 16);
        Al.x = pk2(lo[0], lo[1]); Al.y = pk2(lo[2], lo[3]); Al.z = pk2(lo[4], lo[5]); Al.w = pk2(lo[6], lo[7]);
        const bf16x8r ah = __builtin_bit_cast(bf16x8r, Ah), al = __builtin_bit_cast(bf16x8r, Al);
#pragma unroll
        for (int nb = 0; nb < 2; ++nb) { acc[nb] = __builtin_amdgcn_mfma_f32_16x16x32_bf16(ah, Bc[nb][0], acc[nb], 0, 0, 0); acc[nb] = __builtin_amdgcn_mfma_f32_16x16x32_bf16(ah, Bc[nb][1], acc[nb], 0, 0, 0);
            acc[nb] = __builtin_amdgcn_mfma_f32_16x16x32_bf16(al, Bc[nb][0], acc[nb], 0, 0, 0); }
#pragma unroll
        for (int nb = 0; nb < 2; ++nb) { Bc[nb][0] = Bn[nb][0]; Bc[nb][1] = Bn[nb][1]; }
    }
#pragma unroll
    for (int ks = 0; ks < 16; ++ks) { const int col = 512 * kh + 32 * ks + 8 * g;
        const f32x4 g0 = *(const LAS f32x4*)&GB[col], g1 = *(const LAS f32x4*)&GB[col + 4], b0 = *(const LAS f32x4*)&GB[1024 + col], b1 = *(const LAS f32x4*)&GB[1024 + col + 4];
        const f32x4 ha = (z[ks][0] - mean) * rstd * g0 + b0, hb = (z[ks][1] - mean) * rstd * g1 + b1;
        v2u w; w.x = pk4_fp8(ha.x, ha.y, ha.z, ha.w); w.y = pk4_fp8(hb.x, hb.y, hb.z, hb.w);
        *(LAS v2u*)(XT + (tg * 16 + r) * 1024 + col) = w; }
    if (kh == 1) { *(LAS f32x4*)&PX[((tg * 2 + 0) * 64 + lane) * 4] = acc[0]; *(LAS f32x4*)&PX[((tg * 2 + 1) * 64 + lane) * 4] = acc[1]; }
    __syncthreads();
    if (kh == 0) {
#pragma unroll
        for (int nb = 0; nb < 2; ++nb) { const f32x4 o = acc[nb] + *(const LAS f32x4*)&PX[((tg * 2 + nb) * 64 + lane) * 4]; const float bias = WSP(float, WS_RWT + 2 * DM * NE * 2)[16 * nb + r];
#pragma unroll
            for (int q = 0; q < 4; ++q) LG[(tg * 16 + 4 * g + q) * 33 + 16 * nb + r] = o[q] + bias; }
    }
    __syncthreads();
    LAS float* selv = (LAS float*)(F.lds + LDSCTL_OFF + 6144 + F.wave * 32); LAS int* seli = (LAS int*)(selv + 4);
    for (int rl = F.wave; rl < rpb; rl += NWAVES) {
        const float logit = LG[rl * 33 + (lane >> 1)];
        const int myi = lane >> 1; int rank = 0;
#pragma unroll
        for (int e2 = 0; e2 < 32; ++e2) { const float o = __int_as_float(__builtin_amdgcn_readlane(__float_as_int(logit), 2 * e2)); rank += (o > logit || (o == logit && e2 < myi)) ? 1 : 0; }
        if ((lane & 1) == 0 && rank < 4) { selv[rank] = logit; seli[rank] = myi; }
        float tv[4]; int ti[4];
#pragma unroll
        for (int k = 0; k < 4; ++k) { tv[k] = selv[k]; ti[k] = seli[k]; }
        const float e1 = __expf(tv[1] - tv[0]), e2 = __expf(tv[2] - tv[0]), e3 = __expf(tv[3] - tv[0]); const float inv = 1.f / (1.f + e1 + e2 + e3);
        if (lane < 4) { const int e = lane == 0 ? ti[0] : lane == 1 ? ti[1] : lane == 2 ? ti[2] : ti[3]; const float gt = (lane == 0 ? 1.f : lane == 1 ? e1 : lane == 2 ? e2 : e3) * inv;
            SEL[rl * 4 + lane] = e; GTL[rl * 4 + lane] = gt;
            LRK[rl * 4 + lane] = (int)__hip_atomic_fetch_add((LAS unsigned*)&LCNT[e], 1u, __ATOMIC_RELAXED, __HIP_MEMORY_SCOPE_WORKGROUP); }
    }
    __syncthreads();
    if (F.tid < 32) LBASE[F.tid] = __hip_atomic_fetch_add((unsigned*)(F.ctl + CW_CNT + F.tid), LCNT[F.tid], RLX_AGENT);
    __syncthreads();
    if (F.tid == 0) { __hip_atomic_fetch_add((unsigned*)(F.ctl + CW_RDONE), 1u, RLX_AGENT); unsigned sp = 0;
        while (__hip_atomic_load((unsigned*)(F.ctl + CW_RDONE), RLX_AGENT) < (unsigned)F.G && ++sp < (1u << 24)) __builtin_amdgcn_s_sleep(1); }
    __syncthreads();
    LAS int* pst = (LAS int*)(F.lds + LDSCTL_OFF + 7680);
    if (F.tid == 0) { int a = 0; for (int e = 0; e < NE; ++e) { pst[e] = a; const int c = (int)__hip_atomic_load((unsigned*)(F.ctl + CW_CNT + e), RLX_AGENT); a += (c + 255) / 256 * 256; } pst[NE] = a; }
    __syncthreads();
    int* ROWSLOT = WSP(int, WS_ROWS); float* ROWGATE = WSP(float, WS_ROWS + MAXROWS * 4); int* BLKE = WSP(int, WS_ROWS + 2 * MAXROWS * 4); int* BLKV = BLKE + 512; int* NBLK = BLKE + 1024;
    if (blockIdx.x == 0 && F.tid < NE) { const int e = F.tid, c = (int)__hip_atomic_load((unsigned*)(F.ctl + CW_CNT + e), RLX_AGENT); const int b0 = pst[e] / 256, nb = (pst[e + 1] - pst[e]) / 256;
        for (int i = 0; i < nb; ++i) { BLKE[b0 + i] = e; BLKV[b0 + i] = min(256, c - 256 * i); }
        if (e == 0) NBLK[0] = pst[NE] / 256; }
    for (int rl = F.wave; rl < rpb; rl += NWAVES) {
        const v4u rowv = *(const LAS v4u*)(XT + rl * 1024 + 16 * lane);
#pragma unroll
        for (int k = 0; k < 4; ++k) { const int e = SEL[rl * 4 + k], dest = pst[e] + (int)LBASE[e] + LRK[rl * 4 + k];
            *(GAS v4u*)(WSP(unsigned char, WS_XS) + (size_t)dest * DM + 16 * lane) = rowv;
            if (lane == 0) { ROWSLOT[dest] = (F.vcu * rpb + rl) * 4 + k; ROWGATE[dest] = GTL[rl * 4 + k]; } }
    }
    __syncthreads();
}

__device__ __forceinline__ void p7_gateup(Frame& F) {
    const int* BLKE = WSP(int, WS_ROWS + 2 * MAXROWS * 4); const int nblk = __builtin_amdgcn_readfirstlane(BLKE[1024]);
    int kk = DM / 2; asm volatile("" : "+s"(kk));
    pg8::Gemm g{WSP(bf16, WS_XS), WSP(bf16, WS_WGU), MAXROWS, 2048, kk}; pg8::MoeOrder S{BLKE, nblk * 8, 8, F.G / 8, (int)blockIdx.x};
    pg8::EpiGateUp E{WSP(bf16, WS_ACT), fin(F, 18), 1.f / WGU_SCALE};
    pg8::gemm_phase<pg8::EpiGateUp, pg8::MoeOrder, true, true, true>(F.lds, g, S, E);
}

__device__ __forceinline__ void p8_down(Frame& F) {
    const int* BLKE = WSP(int, WS_ROWS + 2 * MAXROWS * 4); const int nblk = __builtin_amdgcn_readfirstlane(BLKE[1024]);
    int kk = DM / 2; asm volatile("" : "+s"(kk));
    pg8::Gemm g{WSP(bf16, WS_ACT), WSP(bf16, WS_WDN), MAXROWS, 1024, kk}; pg8::MoeOrder S{BLKE, nblk * 4, 4, F.G / 8, (int)blockIdx.x};
    pg8::EpiDown E{WSP(bf16, WS_Y), fin(F, 20), WSP(int, WS_ROWS), WSP(float, WS_ROWS + MAXROWS * 4), BLKE + 512, 1.f / WDN_SCALE};
    pg8::gemm_phase<pg8::EpiDown, pg8::MoeOrder, true, true, true>(F.lds, g, S, E);
}

__device__ __forceinline__ void p9_final(Frame& F) {
    const int gw = F.vcu * NWAVES + F.wave, NGW = F.G * NWAVES, lane = F.lane;
    f32x4 g1[4], b1[4], g2[4], b2[4], vn[4]; v2u yn[4][4];
#pragma unroll
    for (int j = 0; j < 4; ++j) { g1[j] = *(const GAS f32x4*)(fin(F, 13) + 4 * lane + 256 * j); b1[j] = *(const GAS f32x4*)(fin(F, 14) + 4 * lane + 256 * j);
        g2[j] = *(const GAS f32x4*)(fin(F, 21) + 4 * lane + 256 * j); b2[j] = *(const GAS f32x4*)(fin(F, 22) + 4 * lane + 256 * j); }
#define P9_LOAD(r_) do { _Pragma("unroll") for (int j = 0; j < 4; ++j) vn[j] = *(const GAS f32x4*)(WSP(float, WS_Z1) + (size_t)(r_) * DM + 4 * lane + 256 * j); \
        _Pragma("unroll") for (int k = 0; k < 4; ++k) _Pragma("unroll") for (int j = 0; j < 4; ++j) yn[k][j] = ((const GAS v2u*)(WSP(bf16, WS_Y) + (size_t)((r_) * 4 + k) * DM) + lane)[64 * j]; } while (0)
    P9_LOAD(gw);
    for (int row = gw; row < T; row += NGW) {
        f32x4 v[4]; v2u y[4][4];
#pragma unroll
        for (int j = 0; j < 4; ++j) { v[j] = vn[j];
#pragma unroll
            for (int k = 0; k < 4; ++k) y[k][j] = yn[k][j]; }
        if (row + NGW < T) P9_LOAD(row + NGW);
        float mean, rstd; ln_row_pre(v, g1, b1, mean, rstd);
#pragma unroll
        for (int j = 0; j < 4; ++j) { v[j] = v[j] * ALPHA;
#pragma unroll
            for (int k = 0; k < 4; ++k) { const v2u w = y[k][j]; v[j].x += bflo(w.x); v[j].y += bfhi(w.x); v[j].z += bflo(w.y); v[j].w += bfhi(w.y); } }
        ln_row_pre(v, g2, b2, mean, rstd);
#pragma unroll
        for (int j = 0; j < 4; ++j) *(GAS f32x4*)(F.out + (size_t)row * DM + 4 * lane + 256 * j) = v[j];
    }
#undef P9_LOAD
}

constexpr int NPHASE = 10;
#ifndef PROBE_A
#define PROBE_A -1
#define PROBE_B -1
#endif
__global__ void __launch_bounds__(NTHREADS, 2) mega_fwd(Args args) {
    extern __shared__ __attribute__((aligned(16))) unsigned char lds[];
    Frame F;
    F.lds = (LAS unsigned char*)lds; F.ldsg = (char*)lds; F.MISC = (volatile LAS unsigned*)(F.lds + MISC_OFF);
    F.tid = threadIdx.x; F.lane = F.tid & 63; F.wave = __builtin_amdgcn_readfirstlane(F.tid >> 6);
    F.G = gridDim.x; { const int bx = blockIdx.x; F.vcu = (F.G % 8 == 0) ? (bx % 8) * (F.G / 8) + bx / 8 : bx; }
    F.ws = args.ws; F.ctl = (gu32*)(args.ws + WS_CTL); F.out = args.out;
    for (int u = F.tid; u < (LDS_BYTES - LDSCTL_OFF) / 4; u += NTHREADS) ((LAS unsigned*)(F.lds + LDSCTL_OFF))[u] = 0u;
    __syncthreads();
    if (F.tid < 23) ((LAS unsigned long long*)(F.lds + INTAB_OFF))[F.tid] = (unsigned long long)args.in[F.tid];
    __syncthreads();
    const bool single = (args.ph_lo == 0 && args.ph_hi == NPHASE);
    XcdBarrier bar; bar.bar = (unsigned*)(F.ctl + CW_BAR); bar.x = 0; bar.st = nullptr;
    if (single) bar = xcd_barrier_post((unsigned*)(F.ctl + CW_BAR), F.MISC + 8);
    const int lo = args.ph_lo, hi = args.ph_hi;
#ifndef PH_MASK
#define PH_MASK 0x3ff
#endif
#define IN(k) (((PH_MASK >> (k)) & 1) && lo <= (k) && (k) < hi)
#define SEAM(k) do { if (IN(k) && IN((k) + 1)) xcd_barrier(bar); F.tid = fresh_tid(); F.lane = F.tid & 63; if (PROBE_A >= 0 && blockIdx.x == 0 && F.tid == 0) pts[(k) + 1] = __builtin_amdgcn_s_memrealtime(); } while (0)
    unsigned long long* pts = (unsigned long long*)(args.ws + WS_CTL + 512 * 1024);
    if (PROBE_A >= 0 && blockIdx.x == 0 && F.tid == 0) pts[0] = __builtin_amdgcn_s_memrealtime();
    if (IN(0)) { p0_prologue(F); } SEAM(0);
    if (IN(1)) { p1_inproj(F); } SEAM(1);
    if (IN(2)) { p2_hgrn_local(F); } SEAM(2);
    if (IN(3)) { p3_attn(F); } SEAM(3);
    if (IN(4)) { p4_combine(F); } SEAM(4);
    if (IN(5)) { p4_wo(F); } SEAM(5);
    if (IN(6)) { p5_router(F); } SEAM(6);
    if (IN(7)) { p7_gateup(F); } SEAM(7);
    if (IN(8)) { p8_down(F); } SEAM(8);
    if (IN(9)) { p9_final(F); }
    if (PROBE_A >= 0 && blockIdx.x == 0 && F.tid == 0) {
        const unsigned long long tend = __builtin_amdgcn_s_memrealtime(); pts[NPHASE] = tend;
        const int pa = PROBE_A >= 0 ? PROBE_A : 0, pb = PROBE_B >= 0 ? PROBE_B : 0;
        unsigned long long qa = (pts[pa + 1] - pts[pa] + 400) / 800, qb = PROBE_B >= 0 ? (pts[pb + 1] - pts[pb] + 400) / 800 : 0; if (qa > 63) qa = 63; if (qb > 63) qb = 63;
        const unsigned long long dly = (qa + 64 * qb) * 1600;
        while (__builtin_amdgcn_s_memrealtime() - tend < dly) __builtin_amdgcn_s_sleep(8);
    }
#undef IN
#undef SEAM
}

#ifndef MK_MULTI
#define MK_MULTI 0
#endif
extern "C" void kernel_launch(void* const* d_in, const int* in_sizes, int n_in, void* d_out, int out_size, void* d_ws, size_t ws_size, hipStream_t stream) {
    static int grid = 0;
    if (grid == 0) {
        if (n_in != 23 || out_size != T * DM || ws_size < WS_END) { fprintf(stderr, "kernel_launch: unexpected shapes n_in %d out %d ws %zu\n", n_in, out_size, ws_size); grid = -1; return; }
        int dev = 0, cus = 0;
        if (hipGetDevice(&dev) != hipSuccess || hipDeviceGetAttribute(&cus, hipDeviceAttributeMultiprocessorCount, dev) != hipSuccess) { grid = -1; return; }
        if (hipFuncSetAttribute((const void*)mega_fwd, hipFuncAttributeMaxDynamicSharedMemorySize, LDS_BYTES) != hipSuccess) { fprintf(stderr, "kernel_launch: hipFuncSetAttribute failed\n"); grid = -1; return; }
        int per_cu = 0;
        if (hipOccupancyMaxActiveBlocksPerMultiprocessor(&per_cu, (const void*)mega_fwd, NTHREADS, LDS_BYTES) != hipSuccess || per_cu < 1) fprintf(stderr, "kernel_launch: occupancy query says %d\n", per_cu);
        (void)hipGetLastError();
        grid = cus;
    }
    if (grid < 0) return;
    (void)hipMemsetAsync((char*)d_ws + WS_CTL, 0, CTL_ZERO_BYTES, stream);
    Args a{};
    for (int i = 0; i < 23; ++i) a.in[i] = (const float*)d_in[i];
    a.out = (float*)d_out; a.ws = (unsigned char*)d_ws;
#if MK_MULTI
    for (int p = 0; p < NPHASE; ++p) { a.ph_lo = p; a.ph_hi = p + 1; hipLaunchKernelGGL(mega_fwd, dim3(grid), dim3(NTHREADS), LDS_BYTES, stream, a); }
#else
    a.ph_lo = 0; a.ph_hi = NPHASE;
    hipLaunchKernelGGL(mega_fwd, dim3(grid), dim3(NTHREADS), LDS_BYTES, stream, a);
#endif
}
```

```cpp
#include <hip/hip_runtime.h>
#include <cstdio>
#include <cstdint>

constexpr int NB = 4, SEQ = 4096, DM = 1024, T = NB * SEQ, MEML = 256, NIN = 3072, NE = 32, TOPK = 4;
constexpr int TK = T * TOPK, MAXBLK = TK / 256 + NE, MAXROWS = MAXBLK * 256;
constexpr float LOG2E = 1.4426950408889634f, C2 = 0.125f * LOG2E, ALPHA = 1.189207115002721f, EPS = 1e-5f;
constexpr int U_DQ = 0, U_DK = 512, U_DV = 1024, U_HQ = 1536, U_HF = 1792, U_HI = 2304, U_HG = 2560, U_MQ = 2816;

constexpr size_t MiB = 1u << 20;
constexpr size_t WS_CTL = 0, CTL_ZERO_BYTES = 1 * MiB;
constexpr size_t WS_WIN = 2 * MiB, WS_WKV = 8 * MiB, WS_WO = 10 * MiB, WS_MEMB = 12 * MiB, WS_MKV = 14 * MiB;
constexpr size_t WS_XB = 16 * MiB, WS_U = 48 * MiB, WS_OD = 144 * MiB, WS_CAT = 176 * MiB, WS_Z1 = 208 * MiB;
constexpr size_t WS_ROUTE = 272 * MiB;
constexpr size_t WS_RWT = WS_ROUTE + 1 * MiB;
constexpr size_t WS_HU = 280 * MiB;
constexpr size_t WS_WGU = 336 * MiB, WS_WDN = 464 * MiB, WS_XS = 528 * MiB, WS_ACT = 672 * MiB, WS_Y = 816 * MiB;
constexpr size_t WS_ROWS = 944 * MiB;
constexpr size_t WS_SS = WS_XS;
constexpr size_t WS_OH = WS_ACT;
constexpr size_t WS_END = 948 * MiB;
constexpr int CW_TMO = 0, CW_CODE = 1, CW_CNT = 64  , CW_KN = 128  , CW_QUEUE = 192  , CW_MKV = 256  , CW_CONVQ = 257  , CW_RDONE = 258  , CW_BAR = 4096;

constexpr int RING_BYTES = 131072, LDSCTL_OFF = RING_BYTES, MISC_OFF = LDSCTL_OFF + 320, LDS_BYTES = 147456;
constexpr int NWAVES = 8, NTHREADS = 512;

#define GAS __attribute__((address_space(1)))
#define LAS __attribute__((address_space(3)))
typedef unsigned short bf16;
typedef unsigned v4u __attribute__((ext_vector_type(4)));
typedef unsigned v2u __attribute__((ext_vector_type(2)));
typedef float f32x4 __attribute__((ext_vector_type(4)));
typedef GAS unsigned gu32;
#define RLX_AGENT __ATOMIC_RELAXED, __HIP_MEMORY_SCOPE_AGENT
__device__ __forceinline__ unsigned f2bf(float f) { unsigned u = __builtin_bit_cast(unsigned, f); return (u + 0x7fffu + ((u >> 16) & 1u)) >> 16; }
__device__ __forceinline__ unsigned pk2(float lo, float hi) { return f2bf(lo) | (f2bf(hi) << 16); }
__device__ __forceinline__ float bf2f(unsigned v) { return __uint_as_float(v << 16); }
__device__ __forceinline__ unsigned pk4_fp8(float a, float b, float c, float d) { int w = 0; w = __builtin_amdgcn_cvt_pk_fp8_f32(a, b, w, false); w = __builtin_amdgcn_cvt_pk_fp8_f32(c, d, w, true); return (unsigned)w; }
constexpr float WDN_SCALE = 64.f;
constexpr float WGU_SCALE = 32.f;
__device__ __forceinline__ float bflo(unsigned w) { return __uint_as_float(w << 16); }
__device__ __forceinline__ float bfhi(unsigned w) { return __uint_as_float(w & 0xffff0000u); }
__device__ __forceinline__ float wave_sum(float v) {
#pragma unroll
    for (int o = 1; o < 64; o <<= 1) v += __shfl_xor(v, o);
    return v;
}
__device__ __forceinline__ float wave_max(float v) {
#pragma unroll
    for (int o = 1; o < 64; o <<= 1) v = fmaxf(v, __shfl_xor(v, o));
    return v;
}
__device__ __forceinline__ float sigmoidf_(float x) { return 1.f / (1.f + __expf(-x)); }

#define XB_TMO      128
#define XB_XCNT(j)  (256  + 64 * (j))
#define XB_XSUB(j)  (1280 + 64 * (j))
#define XB_XGEN(j)  (2304 + 64 * (j))
#define XB_TOP      3328
#define XB_TOPGEN   3392
#define XCD_BAR_WORDS 3456
#define XB_SPIN_CAP (1u << 20)
__device__ __forceinline__ unsigned xb_ld(unsigned* p)              { return __hip_atomic_load(p, __ATOMIC_RELAXED, __HIP_MEMORY_SCOPE_AGENT); }
__device__ __forceinline__ unsigned xb_add(unsigned* p, unsigned v) { return __hip_atomic_fetch_add(p, v, __ATOMIC_RELAXED, __HIP_MEMORY_SCOPE_AGENT); }
__device__ __forceinline__ unsigned xb_xcc_id() { return (unsigned)__builtin_amdgcn_s_getreg((3 << 11) | 20) & 0xFu; }
#define XB_SPIN(cond, bar) do { unsigned _sp = 0; while (cond) { __builtin_amdgcn_s_sleep(1); \
    if ((++_sp & 255u) == 0u) { if (xb_ld(&(bar)[XB_TMO])) break; if (_sp > XB_SPIN_CAP) { atomicAdd(&(bar)[XB_TMO], 1u); break; } } } } while (0)
struct XcdBarrier { unsigned* bar; unsigned x; volatile LAS unsigned* st; };
__device__ __forceinline__ XcdBarrier xcd_barrier_post(unsigned* bar, volatile LAS unsigned* st) {
    XcdBarrier b; b.bar = bar; b.x = xb_xcc_id(); b.st = st;
    if (threadIdx.x == 0) (void)xb_add(&bar[XB_XCNT(b.x)], 1u);
    return b;
}
__device__ __forceinline__ void xcd_barrier_complete(unsigned* bar, unsigned x, unsigned& nloc, unsigned& nx) {
    const unsigned G = gridDim.x * gridDim.y * gridDim.z;
    unsigned sum, cnt, mine, sp = 0u;
    for (;;) {
        sum = 0u; cnt = 0u; mine = 0u;
#pragma unroll
        for (unsigned j = 0; j < 16; ++j) { const unsigned c = xb_ld(&bar[XB_XCNT(j)]); sum += c; cnt += (c > 0u) ? 1u : 0u; mine = (j == x) ? c : mine; }
        if (sum == G) break;
        __builtin_amdgcn_s_sleep(1);
        if ((++sp & 255u) == 0u) { if (xb_ld(&bar[XB_TMO])) break; if (sp > XB_SPIN_CAP) { atomicAdd(&bar[XB_TMO], 1u); break; } }
    }
    nloc = mine > 0u ? mine : 1u; nx = cnt > 0u ? cnt : 1u;
}
__device__ __forceinline__ void xcd_barrier(const XcdBarrier& b) {
    asm volatile("s_waitcnt vmcnt(0)" ::: "memory");
    __syncthreads();
    if (threadIdx.x == 0) {
        unsigned* bar = b.bar;
        __builtin_amdgcn_s_waitcnt(0);
        unsigned nloc = b.st[0], nx = b.st[1];
        if (nloc == 0u) { xcd_barrier_complete(bar, b.x, nloc, nx); b.st[0] = nloc; b.st[1] = nx; }
        const unsigned old = xb_add(&bar[XB_XSUB(b.x)], 1u);
        const unsigned gen = old / nloc;
        if (old + 1u == (gen + 1u) * nloc) {
            __builtin_amdgcn_fence(__ATOMIC_RELEASE, "agent");
            asm volatile("s_waitcnt vmcnt(0)" ::: "memory");
            const unsigned og = xb_add(&bar[XB_TOP], 1u);
            const unsigned tg = og / nx;
            if (og + 1u == (tg + 1u) * nx) xb_add(&bar[XB_TOPGEN], 1u);
            else XB_SPIN(xb_ld(&bar[XB_TOPGEN]) == tg, bar);
            __builtin_amdgcn_fence(__ATOMIC_ACQUIRE, "agent");
            xb_add(&bar[XB_XGEN(b.x)], 1u);
            asm volatile("s_waitcnt vmcnt(0)" ::: "memory");
        } else {
            XB_SPIN(xb_ld(&bar[XB_XGEN(b.x)]) == gen, bar);
            __builtin_amdgcn_fence(__ATOMIC_ACQUIRE, "agent");
            asm volatile("s_waitcnt vmcnt(0)" ::: "memory");
        }
    }
    __syncthreads();
}

namespace pg8 {
#define PG8_LAS __attribute__((address_space(3)))
typedef unsigned short bf16_t;
typedef short bf16x8 __attribute__((ext_vector_type(8)));
typedef float f32x4 __attribute__((ext_vector_type(4)));
typedef unsigned u32x4 __attribute__((ext_vector_type(4)));
typedef int i32x4 __attribute__((ext_vector_type(4)));
typedef int i32x8 __attribute__((ext_vector_type(8)));
constexpr int BM = 256, BK = 64, HALF = 128, HTB = HALF * BK * 2  , STAGE_BYTES = 8 * HTB, NXCD = 8, WGM = 8;

__host__ __device__ __forceinline__ int lds_byte(int r, int c) { const int st = (r >> 4) * 2 + (c >> 5), rr = r & 15, cc = c & 31, ob = rr * 64 + cc * 2; return st * 1024 + (ob ^ (((ob >> 9) & 1) << 5)); }
__host__ __device__ __forceinline__ void stage_rc(int b, int& R, int& C) { const int st = b / 1024, sb = b % 1024, swz = sb ^ (((sb >> 9) & 1) << 5); R = (st >> 1) * 16 + swz / 64; C = (st & 1) * 32 + (swz % 64) / 2; }
__host__ __device__ __forceinline__ int perm32(int rho) { const int n = rho >> 4, i = rho & 15; return 8 * (i >> 2) + 4 * n + (i & 3); }

struct Unit { int pm, pn, pb, e; };
struct Gemm { const bf16_t* A; const bf16_t* Bt; int M, N, K; };

struct StaticOrder {
    int nM, nN, nwg, G, c;
    __host__ __device__ void init(int M, int N, int G_, int c_) { nM = M / BM; nN = N / BM; nwg = nM * nN; G = G_; c = c_; }
    __host__ __device__ bool next(int i, Unit& u) const {
        const long L = (long)i * G + c; if (L >= nwg) return false;
        int wgid = (int)L; { const int q = nwg / NXCD, r = nwg % NXCD, xcd = wgid % NXCD, off = wgid / NXCD; wgid = (xcd < r ? xcd * (q + 1) : r * (q + 1) + (xcd - r) * q) + off; }
        const int nig = WGM * nN, gid = wgid / nig, fm = gid * WGM, gsz = (nM - fm) < WGM ? (nM - fm) : WGM;
        u.pm = fm + ((wgid % nig) % gsz); u.pn = (wgid % nig) / gsz; u.pb = u.pn; u.e = 0; return true;
    }
    __device__ __forceinline__ void a_ready(const Unit&) const {}
    __device__ __forceinline__ void done(const Unit&) const {}
};

__device__ __forceinline__ void mfma8_inplace(f32x4& acc, const i32x8& b, const i32x8& a, int sc) {
    asm volatile("v_mfma_scale_f32_16x16x128_f8f6f4 %0, %1, %2, %0, %3, %3 op_sel_hi:[0,0,0]" : "+v"(acc) : "v"(b), "v"(a), "v"(sc)); }
__device__ __forceinline__ void glds16_s(const char* sbase, unsigned voff, unsigned lds_dst) { unsigned keep;
    asm volatile("s_mov_b32 %0, m0\n\ts_mov_b32 m0, %3\n\ts_nop 0\n\tglobal_load_lds_dwordx4 %1, %2\n\ts_mov_b32 m0, %0" : "=&s"(keep) : "v"(voff), "s"(sbase), "s"(lds_dst) : "memory"); }
template <class Epi, class Sched, bool ALIGN_EPI = false, bool SP2 = false, bool FP8 = false>
__device__ __forceinline__ void gemm_phase(PG8_LAS unsigned char* lds, const Gemm g, const Sched& S, const Epi& E) {
    int tid = threadIdx.x; asm volatile("" : "+v"(tid));
    const int wid = __builtin_amdgcn_readfirstlane(tid >> 6), lane = tid & 63, wr = wid >> 2, wc = wid & 3, fr = lane & 15, fq = lane >> 4;
    const int K = g.K, nt = K / BK;
    unsigned voffA[2], voffB[2];
#pragma unroll
    for (int i = 0; i < 2; ++i) { int R, C; stage_rc(tid * 16 + i * 8192, R, C); const int Rb = Epi::PERM ? ((R & ~31) + perm32(R & 31)) : R;
        voffA[i] = (unsigned)(R * K + C) * 2u; voffB[i] = (unsigned)(Rb * K + C) * 2u; }
    const size_t kstep = (size_t)(BK * 2);
    const size_t hstep = (size_t)HALF * K * 2;
    const size_t tstep = 2 * hstep;
    const unsigned ldsbase = (unsigned)(uintptr_t)lds;
    const unsigned ldsw = (unsigned)wid * 1024u;
    const int aoff = lds_byte(wr * 64 + fr, fq * 8), boff = lds_byte(wc * 32 + fr, fq * 8);
    const PG8_LAS unsigned char* lbaseA = lds + aoff; const PG8_LAS unsigned char* lbaseB = lds + 65536 + boff; asm volatile("" : "+v"(lbaseA), "+v"(lbaseB));
#define PG8_SA(b, h) (((b) * 2 + (h)) * HTB)
#define PG8_SB(b, h) ((4 + (b) * 2 + (h)) * HTB)
#define PG8_STAGE(bufoff, gbase, voff) do { _Pragma("unroll") for (int _i = 0; _i < 2; ++_i) { \
        if constexpr (FP8) glds16_s((const char*)(gbase), (voff)[_i], (unsigned)__builtin_amdgcn_readfirstlane(ldsbase + (unsigned)(bufoff) + ldsw + _i * 8192u)); \
        else __builtin_amdgcn_global_load_lds((const unsigned*)((const char*)(gbase) + (voff)[_i]), (PG8_LAS unsigned*)(lds + (bufoff) + ldsw + _i * 8192), 16, 0, 0); } } while (0)
#define PG8_LDFA(off) (*(const PG8_LAS bf16x8*)(lbaseA + (off)))
#define PG8_LDFB(off) (*(const PG8_LAS bf16x8*)(lbaseB + ((off) - 65536)))
#define PG8_LDA(dst, b, h) do { _Pragma("unroll") for (int m = 0; m < 4; ++m) { if constexpr (FP8) dst##8[m] = PG8_CAT8(PG8_LDFA(PG8_SA(b, h) + m * 2048), PG8_LDFA(PG8_SA(b, h) + m * 2048 + 1024)); \
        else { _Pragma("unroll") for (int k = 0; k < 2; ++k) dst[m][k] = PG8_LDFA(PG8_SA(b, h) + m * 2048 + k * 1024); } } } while (0)
#define PG8_LDB(dst, b, h) do { _Pragma("unroll") for (int n = 0; n < 2; ++n) { if constexpr (FP8) dst##8[n] = PG8_CAT8(PG8_LDFB(PG8_SB(b, h) + n * 2048), PG8_LDFB(PG8_SB(b, h) + n * 2048 + 1024)); \
        else { _Pragma("unroll") for (int k = 0; k < 2; ++k) dst[n][k] = PG8_LDFB(PG8_SB(b, h) + n * 2048 + k * 1024); } } } while (0)
#define PG8_CAT8(x0, x1) __builtin_shufflevector(__builtin_bit_cast(i32x4, x0), __builtin_bit_cast(i32x4, x1), 0, 1, 2, 3, 4, 5, 6, 7)
#define PG8_MMA(ai, bj, At, Bt) do { __builtin_amdgcn_s_setprio(1); _Pragma("unroll") for (int m = 0; m < 4; ++m) _Pragma("unroll") for (int n = 0; n < 2; ++n) { \
        if constexpr (FP8) mfma8_inplace(acc[ai][bj][m][n], Bt##8[n], At##8[m], sc8); \
        else { _Pragma("unroll") for (int k = 0; k < 2; ++k) acc[ai][bj][m][n] = __builtin_amdgcn_mfma_f32_16x16x32_bf16(Bt[n][k], At[m][k], acc[ai][bj][m][n], 0, 0, 0); } } \
        __builtin_amdgcn_s_setprio(0); } while (0)
#define PG8_WAIT_V(n) asm volatile("s_waitcnt vmcnt(" #n ")" ::: "memory")
#define PG8_WAIT_L(n) asm volatile("s_waitcnt lgkmcnt(" #n ")" ::: "memory")
#define PG8_BAR __builtin_amdgcn_s_barrier()
#define PG8_SCHED __builtin_amdgcn_sched_barrier(0)
    Unit cur, nxt; int ui = 0;
    if (!S.next(0, cur)) return;
    f32x4 acc[2][2][4][2];
#pragma unroll
    for (int a = 0; a < 2; ++a)
#pragma unroll
        for (int b = 0; b < 2; ++b)
#pragma unroll
            for (int m = 0; m < 4; ++m)
#pragma unroll
                for (int n = 0; n < 2; ++n) acc[a][b][m][n] = (f32x4){0.f, 0.f, 0.f, 0.f};
    int sc8 = 0x7f7f7f7f; asm volatile("" : "+v"(sc8));
    bf16x8 At[4][2], B0[2][2], B1[2][2]; i32x8 At8[4], B08[2], B18[2];
    const char* cA = (const char*)g.A + (size_t)cur.pm * tstep; const char* cB = (const char*)g.Bt + (size_t)cur.pb * tstep;
    S.a_ready(cur);
    if constexpr (SP2) {
        PG8_STAGE(PG8_SB(0, 0), cB, voffB); PG8_STAGE(PG8_SB(0, 1), cB + hstep, voffB); PG8_STAGE(PG8_SA(0, 0), cA, voffA); PG8_STAGE(PG8_SA(0, 1), cA + hstep, voffA);
        if (wr == 1) PG8_BAR;
        PG8_WAIT_V(2); PG8_BAR;
        PG8_STAGE(PG8_SB(1, 0), cB + kstep, voffB); PG8_STAGE(PG8_SA(1, 0), cA + kstep, voffA); PG8_STAGE(PG8_SB(1, 1), cB + hstep + kstep, voffB);
        PG8_WAIT_V(6); PG8_BAR;
    } else {
        PG8_STAGE(PG8_SB(0, 0), cB, voffB); PG8_STAGE(PG8_SA(0, 0), cA, voffA); PG8_STAGE(PG8_SB(0, 1), cB + hstep, voffB); PG8_STAGE(PG8_SA(0, 1), cA + hstep, voffA);
        if (wr == 1) PG8_BAR;
        PG8_WAIT_V(4); PG8_BAR;
        PG8_STAGE(PG8_SB(1, 0), cB + kstep, voffB); PG8_STAGE(PG8_SA(1, 0), cA + kstep, voffA); PG8_STAGE(PG8_SB(1, 1), cB + hstep + kstep, voffB);
        PG8_WAIT_V(6); PG8_BAR;
    }
    for (;;) {
        const bool has_next = S.next(ui + 1, nxt);
        const char* nA = has_next ? (const char*)g.A + (size_t)nxt.pm * tstep : cA; const char* nB = has_next ? (const char*)g.Bt + (size_t)nxt.pb * tstep : cB;
        for (int t = 0; t < nt; t += 2) {
            const bool last = (t == nt - 2);
            const char* a1 = cA + (size_t)(t + 1) * kstep;
            const char* a2 = last ? nA : cA + (size_t)(t + 2) * kstep; const char* b2 = last ? nB : cB + (size_t)(t + 2) * kstep;
            const char* a3 = a2 + kstep; const char* b3 = b2 + kstep;
            if (last && has_next) S.a_ready(nxt);
            if constexpr (SP2) {
            PG8_LDB(B0, 0, 0); PG8_LDB(B1, 0, 1); PG8_SCHED; PG8_LDA(At, 0, 0); PG8_STAGE(PG8_SA(1, 1), a1 + hstep, voffA);
            PG8_WAIT_V(8); PG8_WAIT_L(0); PG8_BAR; PG8_MMA(0, 0, At, B0); PG8_MMA(0, 1, At, B1); PG8_BAR; PG8_SCHED;
            PG8_LDA(At, 0, 1); PG8_STAGE(PG8_SB(0, 0), b2, voffB); PG8_STAGE(PG8_SB(0, 1), b2 + hstep, voffB); PG8_STAGE(PG8_SA(0, 0), a2, voffA);
            PG8_WAIT_V(8); PG8_WAIT_L(0); PG8_BAR; PG8_MMA(1, 0, At, B0); PG8_MMA(1, 1, At, B1); PG8_BAR; PG8_SCHED;
            PG8_LDB(B0, 1, 0); PG8_LDB(B1, 1, 1); PG8_SCHED; PG8_LDA(At, 1, 0); PG8_STAGE(PG8_SA(0, 1), a2 + hstep, voffA);
            PG8_WAIT_V(8); PG8_WAIT_L(0); PG8_BAR; PG8_MMA(0, 0, At, B0); PG8_MMA(0, 1, At, B1); PG8_BAR; PG8_SCHED;
            PG8_LDA(At, 1, 1); PG8_STAGE(PG8_SB(1, 0), b3, voffB); PG8_STAGE(PG8_SB(1, 1), b3 + hstep, voffB); PG8_STAGE(PG8_SA(1, 0), a3, voffA);
            PG8_WAIT_V(8); PG8_WAIT_L(0); PG8_BAR; PG8_MMA(1, 0, At, B0); PG8_MMA(1, 1, At, B1); PG8_BAR; PG8_SCHED;
            } else {
            PG8_LDB(B0, 0, 0); PG8_SCHED; PG8_LDA(At, 0, 0); PG8_STAGE(PG8_SA(1, 1), a1 + hstep, voffA);
            PG8_WAIT_L(8); PG8_BAR; PG8_WAIT_L(0); PG8_MMA(0, 0, At, B0); PG8_BAR; PG8_SCHED;
            PG8_LDB(B1, 0, 1); PG8_STAGE(PG8_SB(0, 0), b2, voffB);
            PG8_BAR; PG8_WAIT_L(0); PG8_MMA(0, 1, At, B1); PG8_BAR;
            PG8_LDA(At, 0, 1); PG8_STAGE(PG8_SA(0, 0), a2, voffA);
            PG8_BAR; PG8_WAIT_L(0); PG8_MMA(1, 0, At, B0); PG8_BAR; PG8_SCHED;
            PG8_STAGE(PG8_SB(0, 1), b2 + hstep, voffB);
            PG8_WAIT_V(6); PG8_BAR; PG8_MMA(1, 1, At, B1); PG8_BAR;
            PG8_LDB(B0, 1, 0); PG8_SCHED; PG8_LDA(At, 1, 0); PG8_STAGE(PG8_SA(0, 1), a2 + hstep, voffA);
            PG8_WAIT_L(8); PG8_BAR; PG8_WAIT_L(0); PG8_MMA(0, 0, At, B0); PG8_BAR; PG8_SCHED;
            PG8_LDB(B1, 1, 1); PG8_STAGE(PG8_SB(1, 0), b3, voffB);
            PG8_BAR; PG8_WAIT_L(0); PG8_MMA(0, 1, At, B1); PG8_BAR;
            PG8_LDA(At, 1, 1); PG8_STAGE(PG8_SA(1, 0), a3, voffA);
            PG8_BAR; PG8_WAIT_L(0); PG8_MMA(1, 0, At, B0); PG8_BAR; PG8_SCHED;
            PG8_STAGE(PG8_SB(1, 1), b3 + hstep, voffB);
            PG8_WAIT_V(6); PG8_BAR; PG8_MMA(1, 1, At, B1); PG8_BAR;
            }
        }
        if constexpr (ALIGN_EPI) { if (wr == 0) PG8_BAR; }
        if constexpr (FP8) { asm volatile("s_nop 15\n\ts_nop 3" ::: "memory"); __builtin_amdgcn_sched_barrier(0); }
        if constexpr (!Epi::AFTER_DRAIN) { int l2_ = threadIdx.x & 63; asm volatile("" : "+v"(l2_)); E(acc, cur, wr, wc, l2_ & 15, l2_ >> 4); S.done(cur); }
        if (!has_next) break;
#pragma unroll
        for (int a = 0; a < 2; ++a)
#pragma unroll
            for (int b = 0; b < 2; ++b)
#pragma unroll
                for (int m = 0; m < 4; ++m)
#pragma unroll
                    for (int n = 0; n < 2; ++n) acc[a][b][m][n] = (f32x4){0.f, 0.f, 0.f, 0.f};
        cur = nxt; cA = nA; cB = nB; ++ui;
        if constexpr (ALIGN_EPI) { if (wr == 1) PG8_BAR; }
    }
    PG8_WAIT_V(0);
    if constexpr (!ALIGN_EPI) { if (wr == 0) PG8_BAR; }
    PG8_BAR;
    if constexpr (Epi::AFTER_DRAIN) { E.fused(acc, cur, wr, wc, fr, fq, lds, wid, lane); S.done(cur); }
#undef PG8_SA
#undef PG8_SB
#undef PG8_STAGE
#undef PG8_LDA
#undef PG8_LDFA
#undef PG8_LDFB
#undef PG8_LDB
#undef PG8_MMA
#undef PG8_CAT8
#undef PG8_WAIT_V
#undef PG8_WAIT_L
#undef PG8_BAR
#undef PG8_SCHED
}

__device__ __forceinline__ unsigned cvt_pk_bf16(float lo, float hi) { unsigned r; asm volatile("v_cvt_pk_bf16_f32 %0, %1, %2" : "=v"(r) : "v"(lo), "v"(hi)); return r; }
struct EpiBf16 {
    static constexpr bool PERM = true, AFTER_DRAIN = false;
    bf16_t* O; int ldc; unsigned smask; float s;
    __device__ __forceinline__ void operator()(const f32x4 (&acc)[2][2][4][2], const Unit& u, int wr, int wc, int fr, int fq) const {
        const int row0 = u.pm * BM + wr * 64 + fr, col0 = u.pn * BM + wc * 32 + 8 * fq; const float sc = ((smask >> u.pn) & 1u) ? s : 1.f;
#pragma unroll
        for (int ai = 0; ai < 2; ++ai)
#pragma unroll
            for (int m = 0; m < 4; ++m) { bf16_t* rowp = O + (size_t)(row0 + ai * HALF + m * 16) * ldc + col0;
#pragma unroll
                for (int bj = 0; bj < 2; ++bj) { const f32x4 v0 = acc[ai][bj][m][0] * sc, v1 = acc[ai][bj][m][1] * sc;
                    u32x4 w; w.x = cvt_pk_bf16(v0[0], v0[1]); w.y = cvt_pk_bf16(v0[2], v0[3]); w.z = cvt_pk_bf16(v1[0], v1[1]); w.w = cvt_pk_bf16(v1[2], v1[3]);
                    *(u32x4*)(rowp + bj * HALF) = w; } }
    }
};
struct EpiResF32 {
    static constexpr bool PERM = false, AFTER_DRAIN = false;
    const float* base; float* out; int ldc; float alpha;
    __device__ __forceinline__ void operator()(const f32x4 (&acc)[2][2][4][2], const Unit& u, int wr, int wc, int fr, int fq) const {
        const int col0 = u.pn * BM + wc * 32 + 4 * fq;
#pragma unroll
        for (int ai = 0; ai < 2; ++ai)
#pragma unroll
            for (int m = 0; m < 4; ++m) { const size_t off = (size_t)(u.pm * BM + ai * HALF + wr * 64 + m * 16 + fr) * ldc + col0;
#pragma unroll
                for (int bj = 0; bj < 2; ++bj)
#pragma unroll
                    for (int n = 0; n < 2; ++n) { const f32x4 bs = *(const f32x4*)(base + off + bj * HALF + n * 16); *(f32x4*)(out + off + bj * HALF + n * 16) = bs * alpha + acc[ai][bj][m][n]; }
                if (m & 1) asm volatile("" ::: "memory"); }
    }
};
struct EpiGateUp {
    static constexpr bool PERM = true, AFTER_DRAIN = false;
    bf16_t* O; const float* bias; float ascale;
    __device__ __forceinline__ void operator()(const f32x4 (&acc)[2][2][4][2], const Unit& u, int wr, int wc, int fr, int fq) const {
        const int row0 = u.pm * BM + wr * 64 + fr, f0 = u.pn * 128 + wc * 32 + 8 * fq;
        bf16_t* Oo = this->O; const float* bo = this->bias; asm volatile("" : "+s"(Oo), "+s"(bo));
        __attribute__((address_space(1))) bf16_t* O = (__attribute__((address_space(1))) bf16_t*)Oo; const __attribute__((address_space(1))) float* bias = (const __attribute__((address_space(1))) float*)bo;
        const __attribute__((address_space(1))) float* bp = bias + (size_t)u.e * 2048 + 2 * f0;
        typedef __attribute__((address_space(1))) f32x4 gf4; typedef __attribute__((address_space(1))) u32x4 gu4;
        const f32x4 b0 = *(const gf4*)(bp), b1 = *(const gf4*)(bp + 4), b2 = *(const gf4*)(bp + 8), b3 = *(const gf4*)(bp + 12);
        const float bg[8] = {b0[0], b0[2], b1[0], b1[2], b2[0], b2[2], b3[0], b3[2]}, bl[8] = {b0[1], b0[3], b1[1], b1[3], b2[1], b2[3], b3[1], b3[3]};
#pragma unroll
        for (int ai = 0; ai < 2; ++ai)
#pragma unroll
            for (int m = 0; m < 4; ++m) { float a[8];
#pragma unroll
                for (int n = 0; n < 2; ++n)
#pragma unroll
                    for (int q = 0; q < 4; ++q) { const float g = fminf(acc[ai][0][m][n][q] * ascale + bg[4 * n + q], 7.f), l = fminf(fmaxf(acc[ai][1][m][n][q] * ascale + bl[4 * n + q], -7.f), 7.f);
                        a[4 * n + q] = g * __builtin_amdgcn_rcpf(1.f + __builtin_amdgcn_exp2f(-1.702f * 1.4426950408889634f * g)) * (l + 1.f); }
                typedef unsigned u32x2g __attribute__((ext_vector_type(2))); u32x2g w; w.x = pk4_fp8(a[0], a[1], a[2], a[3]); w.y = pk4_fp8(a[4], a[5], a[6], a[7]);
                *(__attribute__((address_space(1))) u32x2g*)((__attribute__((address_space(1))) unsigned char*)O + (size_t)(row0 + ai * HALF + m * 16) * 1024 + f0) = w; }
    }
};
struct EpiDown {
    static constexpr bool PERM = true, AFTER_DRAIN = false;
    bf16_t* Y; const float* bias; const int* rowslot; const float* rowgate; const int* blkv; float ascale;
    __device__ __forceinline__ void operator()(const f32x4 (&acc)[2][2][4][2], const Unit& u, int wr, int wc, int fr, int fq) const {
        const int col0 = u.pn * BM + wc * 32 + 8 * fq, nv = blkv[u.pm];
        const float* bp = bias + (size_t)u.e * 1024 + col0;
        f32x4 bv[2][2];
#pragma unroll
        for (int bj = 0; bj < 2; ++bj)
#pragma unroll
            for (int n = 0; n < 2; ++n) bv[bj][n] = *(const f32x4*)(bp + bj * HALF + 4 * n);
        int slot[2][4]; float gt[2][4];
#pragma unroll
        for (int ai = 0; ai < 2; ++ai)
#pragma unroll
            for (int m = 0; m < 4; ++m) { const int r = ai * HALF + wr * 64 + m * 16 + fr; slot[ai][m] = rowslot[u.pm * BM + r]; gt[ai][m] = rowgate[u.pm * BM + r]; }
#pragma unroll
        for (int ai = 0; ai < 2; ++ai)
#pragma unroll
            for (int m = 0; m < 4; ++m) { const int r = ai * HALF + wr * 64 + m * 16 + fr;
                if (r < nv) { const float g = gt[ai][m]; bf16_t* rowp = Y + (size_t)slot[ai][m] * 1024 + col0;
#pragma unroll
                    for (int bj = 0; bj < 2; ++bj) { const f32x4 v0 = (acc[ai][bj][m][0] * ascale + bv[bj][0]) * g, v1 = (acc[ai][bj][m][1] * ascale + bv[bj][1]) * g;
                        u32x4 w; w.x = cvt_pk_bf16(v0[0], v0[1]); w.y = cvt_pk_bf16(v0[2], v0[3]); w.z = cvt_pk_bf16(v1[0], v1[1]); w.w = cvt_pk_bf16(v1[2], v1[3]);
                        *(u32x4*)(rowp + bj * HALF) = w; } } }
    }
};
struct MoeOrder {
    const int* blke; int nunits, npn, gpx, c;
    __device__ __forceinline__ bool next(int i, Unit& u) const {
        const int L = (i * 8 + (c & 7)) * gpx + (c >> 3); if (L >= nunits) return false;
        const int blk = L / npn; u.pm = blk; u.pn = L - blk * npn; u.e = __builtin_amdgcn_readfirstlane(blke[blk]); u.pb = u.e * npn + u.pn; return true;
    }
    __device__ __forceinline__ void a_ready(const Unit&) const {}
    __device__ __forceinline__ void done(const Unit&) const {}
};
struct OneUnit { int pm, pn; __device__ __forceinline__ bool next(int i, Unit& u) const { if (i) return false; u.pm = pm; u.pn = pn; u.pb = pn; u.e = 0; return true; }
    __device__ __forceinline__ void a_ready(const Unit&) const {} __device__ __forceinline__ void done(const Unit&) const {} };
}

namespace attn_body {
typedef unsigned short abf;
using bf16x8=__attribute__((ext_vector_type(8)))short;
using s16x4=__attribute__((ext_vector_type(4)))short;
using f32x16=__attribute__((ext_vector_type(16)))float;
using u32x4=__attribute__((ext_vector_type(4)))unsigned;
constexpr int NW=8,QBLK=32,QB=QBLK*NW,KVBLK=64;
__device__ __forceinline__ int crow(int r,int hi){return (r&3)+8*(r>>2)+4*hi;}
#define SBAR() __builtin_amdgcn_sched_barrier(0)
constexpr int NSLOT=3, SLOTB=8192;
constexpr int LDS_K=0, LDS_V=NSLOT*SLOTB, LDS_WS=2*NSLOT*SLOTB, LDS_OST=LDS_WS+NW*64*4, LDS_BYTES=LDS_OST+NW*4096;
__device__ __forceinline__ void glds16(const void*gsrc,unsigned lds_dst){unsigned keep;
  asm volatile("s_mov_b32 %0, m0\n\ts_mov_b32 m0, %2\n\ts_nop 0\n\tglobal_load_lds_dwordx4 %1, off\n\ts_mov_b32 m0, %0":"=&s"(keep):"v"(gsrc),"s"(lds_dst):"memory");}
__device__ __forceinline__ float max3f(float a,float b,float c){float r;asm("v_max3_f32 %0, %1, %2, %3":"=v"(r):"v"(a),"v"(b),"v"(c));return r;}
__device__ __forceinline__ float max2f(float a,float b){float r;asm("v_max_f32_e32 %0, %1, %2":"=v"(r):"v"(a),"v"(b));return r;}
__device__ __forceinline__ float fadd_s(float a,float b){float r;asm("v_add_f32_e32 %0, %1, %2":"=v"(r):"v"(a),"v"(b));return r;}
__device__ __forceinline__ float fsub_s(float a,float b){float r;asm("v_sub_f32_e32 %0, %1, %2":"=v"(r):"v"(a),"v"(b));return r;}
typedef float f32x2_t __attribute__((ext_vector_type(2))); typedef __bf16 bf16x2_t __attribute__((ext_vector_type(2)));
__device__ __forceinline__ unsigned cvtpk_s(float lo,float hi){f32x2_t v={lo,hi};bf16x2_t b=__builtin_convertvector(v,bf16x2_t);return __builtin_bit_cast(unsigned,b);}
#define WAIT_BAR(N) asm volatile("s_waitcnt vmcnt(" #N ") lgkmcnt(0)\n\ts_barrier":::"memory")
__device__ __forceinline__ void qkt(f32x16&p0,f32x16&p1,const char*Kslot,const bf16x8*qr,const f32x16&c0,const f32x16&c1,int r32,int hi){
  const char*kb=Kslot+hi*1024+r32*16;
  #pragma unroll
  for(int d0=0;d0<4;++d0){
    const bf16x8 b0=*reinterpret_cast<const bf16x8*>(kb+d0*2048);
    const bf16x8 b1=*reinterpret_cast<const bf16x8*>(kb+d0*2048+512);
    if(d0==0){p0=__builtin_amdgcn_mfma_f32_32x32x16_bf16(b0,qr[0],c0,0,0,0);p1=__builtin_amdgcn_mfma_f32_32x32x16_bf16(b1,qr[0],c1,0,0,0);}
    else{p0=__builtin_amdgcn_mfma_f32_32x32x16_bf16(b0,qr[d0],p0,0,0,0);p1=__builtin_amdgcn_mfma_f32_32x32x16_bf16(b1,qr[d0],p1,0,0,0);}}
}
typedef __attribute__((address_space(3))) const char* lds_cptr;
typedef short v4i16_t __attribute__((ext_vector_type(4)));
__device__ __forceinline__ void kload8(bf16x8*kf,lds_cptr kp){
  kf[0]=*(const __attribute__((address_space(3))) bf16x8*)(kp);      kf[1]=*(const __attribute__((address_space(3))) bf16x8*)(kp+512);
  kf[2]=*(const __attribute__((address_space(3))) bf16x8*)(kp+2048); kf[3]=*(const __attribute__((address_space(3))) bf16x8*)(kp+2560);
  kf[4]=*(const __attribute__((address_space(3))) bf16x8*)(kp+4096); kf[5]=*(const __attribute__((address_space(3))) bf16x8*)(kp+4608);
  kf[6]=*(const __attribute__((address_space(3))) bf16x8*)(kp+6144); kf[7]=*(const __attribute__((address_space(3))) bf16x8*)(kp+6656);
}
__device__ __forceinline__ void kload2(bf16x8*kf,lds_cptr kp,int j){ kf[2*j]=*(const __attribute__((address_space(3))) bf16x8*)(kp+j*2048); kf[2*j+1]=*(const __attribute__((address_space(3))) bf16x8*)(kp+j*2048+512); }
__device__ __forceinline__ s16x4 vtr(lds_cptr p){ return __builtin_bit_cast(s16x4,__builtin_amdgcn_ds_read_tr16_b64_v4i16((__attribute__((address_space(3))) v4i16_t*)p)); }
__device__ __forceinline__ float rowmax(const f32x16&p0,const f32x16&p1){
  float a=max3f(p0[0],p0[1],p1[0]),b=max3f(p0[2],p0[3],p1[1]);a=max3f(a,p1[2],p1[3]);
  #pragma unroll
  for(int r=4;r<16;r+=4){a=max3f(a,p0[r],p0[r+1]);b=max3f(b,p0[r+2],p0[r+3]);a=max3f(a,p1[r],p1[r+1]);b=max3f(b,p1[r+2],p1[r+3]);}
  const float m=max2f(a,b);
  auto rr=__builtin_amdgcn_permlane32_swap(__float_as_uint(m),__float_as_uint(m),false,false);
  return max2f(__uint_as_float(rr[0]),__uint_as_float(rr[1]));
}
__device__ __forceinline__ void pv(f32x16*o,int vb,bf16x8 pa0,bf16x8 pa1,bf16x8 pa2,bf16x8 pa3){
  #pragma unroll
  for(int d0=0;d0<2;++d0){s16x4 lo[4],hi[4];
    #pragma unroll
    for(int ks=0;ks<4;++ks){
      asm volatile("ds_read_b64_tr_b16 %0,%1 offset:%c2":"=&v"(lo[ks]):"v"(vb),"i"(d0*4096+ks*1024):"memory");
      asm volatile("ds_read_b64_tr_b16 %0,%1 offset:%c2":"=&v"(hi[ks]):"v"(vb),"i"(d0*4096+ks*1024+512):"memory");}
    asm volatile("s_waitcnt lgkmcnt(0)":::"memory");SBAR();
    #define PK(k) (bf16x8){lo[k][0],lo[k][1],lo[k][2],lo[k][3],hi[k][0],hi[k][1],hi[k][2],hi[k][3]}
    o[d0]=__builtin_amdgcn_mfma_f32_32x32x16_bf16(pa0,PK(0),o[d0],0,0,0);
    o[d0]=__builtin_amdgcn_mfma_f32_32x32x16_bf16(pa1,PK(1),o[d0],0,0,0);
    o[d0]=__builtin_amdgcn_mfma_f32_32x32x16_bf16(pa2,PK(2),o[d0],0,0,0);
    o[d0]=__builtin_amdgcn_mfma_f32_32x32x16_bf16(pa3,PK(3),o[d0],0,0,0);
    #undef PK
  }
}
#ifndef ATTN_STORE16
#define ATTN_STORE16(p,v) (*(u32x4*)(p)=(v))
#endif
template<int THRL> __device__ __forceinline__ void attn_unit(const abf*Qw0,int QP,const abf*Kh,int KP,const abf*Vh,int VP,abf*Ow0,int OP,int NT,float c2,int q0,char*shm){
  int tid=threadIdx.x; asm volatile("":"+v"(tid)); const int lane=tid&63,r32=lane&31,hi=lane>>5; const int wid=__builtin_amdgcn_readfirstlane(tid>>6);
  const abf*Qw=Qw0+(long)(wid*QBLK)*QP;
  const unsigned lds0=(unsigned)(uintptr_t)shm;
  float*wsf=(float*)(shm+LDS_WS)+wid*64;
  const abf*ksrc=Kh+(long)lane*KP+wid*8;
  const abf*vsrc=Vh+(long)(16*(wid&3)+(lane>>2))*VP+(wid>>2)*32+(lane&3)*8;
  const unsigned kdst=lds0+LDS_K+wid*1024, vdst=lds0+LDS_V+wid*1024;
  #define DMA_K(t,slot) glds16(ksrc+(long)(t)*KVBLK*KP,(unsigned)__builtin_amdgcn_readfirstlane(kdst+(slot)))
  #define DMA_V(t,slot) glds16(vsrc+(long)(t)*KVBLK*VP,(unsigned)__builtin_amdgcn_readfirstlane(vdst+(slot)))
  const int vb0=(int)(lds0+LDS_V)+((lane>>4)&1)*32+(lane&3)*8+(4*hi+((lane&15)>>2))*64;
  const char*Kbase=shm+LDS_K; bf16x8 kf[8];
  const lds_cptr shm3=(lds_cptr)shm; const lds_cptr kp0=shm3+LDS_K+hi*1024+r32*16; const lds_cptr vp0=shm3+LDS_V+((lane>>4)&1)*32+(lane&3)*8+(4*hi+((lane&15)>>2))*64;
  DMA_K(0,0);DMA_V(0,0);DMA_K(1,SLOTB);
  bf16x8 qr[4];
  #pragma unroll
  for(int d0=0;d0<4;++d0)qr[d0]=*reinterpret_cast<const bf16x8*>(&Qw[(long)r32*QP+d0*16+hi*8]);
  float mhat=0.f,l_reg=0.f;f32x16 o[2];o[0]=f32x16{};o[1]=f32x16{};
  const int tdiag=__builtin_amdgcn_readfirstlane((q0+wid*QBLK)>>6);
  const float qrel4=(float)(q0+wid*QBLK+r32-4*hi);
  #define CINIT(C0,C1,t) do{ const int tt_=(t); const float dq_=qrel4-64.f*(float)tt_; \
    if(tt_!=tdiag){ float sc_=tt_<tdiag?c2:-c2; asm volatile("":"+v"(sc_)); const float sc8_=8.f*sc_, sc32_=32.f*sc_; \
      C0[0]=-mhat-sc_*dq_; C0[1]=C0[0]+sc_; C0[2]=C0[1]+sc_; C0[3]=C0[2]+sc_; \
      _Pragma("unroll") for(int r=4;r<16;++r) C0[r]=C0[r-4]+sc8_;          \
      _Pragma("unroll") for(int r=0;r<16;++r) C1[r]=C0[r]+sc32_; } \
    else { _Pragma("unroll") for(int r=0;r<16;++r){ const float cr_=(float)((r&3)+8*(r>>2)); C0[r]=-mhat-c2*__builtin_fabsf(dq_-cr_); C1[r]=-mhat-c2*__builtin_fabsf(dq_-cr_-32.f); } } }while(0)
  bool resc=false;
  #define START(P0,P1) do{ const float rm=rowmax(P0,P1); resc=false; \
    { const float dl=rm; mhat=fadd_s(mhat,dl); \
      _Pragma("unroll") for(int r=0;r<16;++r){P0[r]=fsub_s(P0[r],dl);P1[r]=fsub_s(P1[r],dl);} } \
    _Pragma("unroll") for(int r=0;r<16;++r)P0[r]=__builtin_amdgcn_exp2f(P0[r]); }while(0)
  #define RESC() do{ if(resc){ asm volatile("s_waitcnt lgkmcnt(0)":::"memory"); \
      _Pragma("unroll") for(int d_=0;d_<2;++d_) _Pragma("unroll") for(int r=0;r<16;++r)o[d_][r]*=wsf[crow(r,hi)]; } }while(0)
  f32x16 pA0,pA1,pB0,pB1;
  int sl_prev=0,sl_cur=0,sl_next=SLOTB;
  #define ROT() do{sl_prev=sl_cur;sl_cur=sl_next;sl_next=(sl_next==(NSLOT-1)*SLOTB)?0:sl_next+SLOTB;}while(0)
  DMA_K(2,2*SLOTB);
  WAIT_BAR(3);
  CINIT(pA0,pA1,0);
  qkt(pA0,pA1,Kbase,qr,pA0,pA1,r32,hi);asm volatile("s_nop 15\n\ts_nop 7":"+v"(pA0),"+v"(pA1));
  START(pA0,pA1);
  _Pragma("unroll") for(int r=0;r<16;++r)pA1[r]=__builtin_amdgcn_exp2f(pA1[r]);
  WAIT_BAR(0);
  DMA_K(3,0);DMA_V(1,SLOTB);
  ROT();
  kload8(kf,kp0+sl_cur);
  WAIT_BAR(2);
  s16x4 vlo[8],vhi[8]; u32x4 pw0,pw1,pw2,pw3;
  #define PKW(P,B) cvtpk_s(P[B],P[B+1])
  #define PAF(k) __builtin_bit_cast(bf16x8,pw##k)
  #define VFR(i) (bf16x8){vlo[i][0],vlo[i][1],vlo[i][2],vlo[i][3],vhi[i][0],vhi[i][1],vhi[i][2],vhi[i][3]}
  #define PIN(x) asm volatile("":"+v"(x))
  #define MX3(a,b,c) __builtin_fmaxf(__builtin_fmaxf((a),(b)),(c))
  #define GAPA(MF,A0,A1,A2,A3,W0,W1,PW) do{ MF; sacc+=A0; sacc+=A1; sacc+=A2; sacc+=A3; PIN(sacc); W0; W1; PIN(PW); SBAR(); }while(0)
  #define EX(v) __builtin_amdgcn_exp2f(v)
  #define GAPB(MF,X,B) do{ MF; X[B]=EX(X[B]); X[B+1]=EX(X[B+1]); X[B+2]=EX(X[B+2]); X[B+3]=EX(X[B+3]); PIN(X); SBAR(); }while(0)
  #define VRD(i) do{ vlo[i]=vtr(vp_+(((i)>>2)*4096+((i)&3)*1024)); vhi[i]=vtr(vp_+(((i)>>2)*4096+((i)&3)*1024+512)); }while(0)
  #define KRD(G,j) do{ if(G){ kload2(kf,kp0+sl_next,j); SBAR(); } }while(0)
  #define STEP(C0,C1,P0,P1,t,GK,GV,GL) do{ SBAR(); \
    CINIT(C0,C1,t); SBAR(); \
    const lds_cptr vp_=vp0+sl_prev; \
    VRD(0); SBAR(); float sacc=(P0[0]+P0[1]); \
    GAPA(C0=__builtin_amdgcn_mfma_f32_32x32x16_bf16(kf[0],qr[0],C0,0,0,0), P0[2],P0[3],P0[4],P0[5],     pw0[0]=PKW(P0,0), pw0[1]=PKW(P0,2), pw0); \
    VRD(4); SBAR(); GAPA(C1=__builtin_amdgcn_mfma_f32_32x32x16_bf16(kf[1],qr[0],C1,0,0,0), P0[6],P0[7],P0[8],P0[9],     pw0[2]=PKW(P0,4), pw0[3]=PKW(P0,6), pw0); \
    VRD(1); SBAR(); GAPA(C0=__builtin_amdgcn_mfma_f32_32x32x16_bf16(kf[2],qr[1],C0,0,0,0),   P0[10],P0[11],P0[12],P0[13], pw1[0]=PKW(P0,8), pw1[1]=PKW(P0,10), pw1); \
    VRD(5); SBAR(); GAPA(C1=__builtin_amdgcn_mfma_f32_32x32x16_bf16(kf[3],qr[1],C1,0,0,0),   P0[14],P0[15],P1[0],P1[1],   pw1[2]=PKW(P0,12),pw1[3]=PKW(P0,14), pw1); \
    VRD(2); SBAR(); GAPA(C0=__builtin_amdgcn_mfma_f32_32x32x16_bf16(kf[4],qr[2],C0,0,0,0),   P1[2],P1[3],P1[4],P1[5],     pw2[0]=PKW(P1,0), pw2[1]=PKW(P1,2), pw2); \
    VRD(6); SBAR(); GAPA(C1=__builtin_amdgcn_mfma_f32_32x32x16_bf16(kf[5],qr[2],C1,0,0,0),   P1[6],P1[7],P1[8],P1[9],     pw2[2]=PKW(P1,4), pw2[3]=PKW(P1,6), pw2); \
    VRD(3); SBAR(); GAPA(C0=__builtin_amdgcn_mfma_f32_32x32x16_bf16(kf[6],qr[3],C0,0,0,0),   P1[10],P1[11],P1[12],P1[13], pw3[0]=PKW(P1,8), pw3[1]=PKW(P1,10), pw3); \
    VRD(7); SBAR(); GAPA(C1=__builtin_amdgcn_mfma_f32_32x32x16_bf16(kf[7],qr[3],C1,0,0,0),   P1[14],P1[15],0.f,0.f,       pw3[2]=PKW(P1,12),pw3[3]=PKW(P1,14), pw3); \
    l_reg+=sacc; \
    if(GK){DMA_K((t)+3,sl_cur);} if(GV){DMA_V((t)+1,sl_next);} \
    { float a=MX3(C0[0],C0[1],C1[0]),b=MX3(C0[2],C0[3],C1[1]); a=MX3(a,C1[2],C1[3]); \
      _Pragma("unroll") for(int r=4;r<16;r+=4){a=MX3(a,C0[r],C0[r+1]);b=MX3(b,C0[r+2],C0[r+3]);a=MX3(a,C1[r],C1[r+1]);b=MX3(b,C1[r+2],C1[r+3]);} \
      float rm=__builtin_fmaxf(a,b); { auto rr=__builtin_amdgcn_permlane32_swap(__float_as_uint(rm),__float_as_uint(rm),false,false); rm=__builtin_fmaxf(__uint_as_float(rr[0]),__uint_as_float(rr[1])); } \
      resc=false; \
      if(__builtin_expect(__any(rm>(float)THRL),0)){ const float dl=__builtin_fmaxf(rm,0.f); mhat+=dl; \
        _Pragma("unroll") for(int r=0;r<16;++r){C0[r]-=dl;C1[r]-=dl;} \
        const float f=__builtin_amdgcn_exp2f(-dl); l_reg*=f; if(hi==0)wsf[r32]=f; resc=true; } } \
    SBAR(); \
    GAPB(o[0]=__builtin_amdgcn_mfma_f32_32x32x16_bf16(PAF(0),VFR(0),o[0],0,0,0), C0,0); \
    GAPB(o[1]=__builtin_amdgcn_mfma_f32_32x32x16_bf16(PAF(0),VFR(4),o[1],0,0,0), C0,4); \
    KRD(GL,0); GAPB(o[0]=__builtin_amdgcn_mfma_f32_32x32x16_bf16(PAF(1),VFR(1),o[0],0,0,0), C0,8); \
    KRD(GL,1); GAPB(o[1]=__builtin_amdgcn_mfma_f32_32x32x16_bf16(PAF(1),VFR(5),o[1],0,0,0), C0,12); \
    KRD(GL,2); GAPB(o[0]=__builtin_amdgcn_mfma_f32_32x32x16_bf16(PAF(2),VFR(2),o[0],0,0,0), C1,0); \
    KRD(GL,3); GAPB(o[1]=__builtin_amdgcn_mfma_f32_32x32x16_bf16(PAF(2),VFR(6),o[1],0,0,0), C1,4); \
    GAPB(o[0]=__builtin_amdgcn_mfma_f32_32x32x16_bf16(PAF(3),VFR(3),o[0],0,0,0), C1,8); \
    GAPB(o[1]=__builtin_amdgcn_mfma_f32_32x32x16_bf16(PAF(3),VFR(7),o[1],0,0,0), C1,12); \
    }while(0)
  int t=1;
  for(;t+5<NT;t+=2){
    STEP(pB0,pB1,pA0,pA1,t,true,true,true);     WAIT_BAR(2); RESC(); ROT();
    STEP(pA0,pA1,pB0,pB1,t+1,true,true,true);   WAIT_BAR(2); RESC(); ROT();
  }
  #define ENDW(tt) do{ if((tt)+3<NT){WAIT_BAR(2);} else if((tt)+2<NT){WAIT_BAR(1);} else {WAIT_BAR(0);} }while(0)
  for(;t+1<NT;t+=2){
    STEP(pB0,pB1,pA0,pA1,t,(t+3<NT),(t+1<NT),(t+1<NT));       ENDW(t);   RESC(); ROT();
    STEP(pA0,pA1,pB0,pB1,t+1,(t+4<NT),(t+2<NT),(t+2<NT));     ENDW(t+1); RESC(); ROT();
  }
  STEP(pB0,pB1,pA0,pA1,NT-1,false,false,false); RESC();
  { float sacc=pB0[0]+pB0[1]; _Pragma("unroll") for(int r=2;r<16;++r)sacc+=pB0[r]; _Pragma("unroll") for(int r=0;r<16;++r)sacc+=pB1[r]; l_reg+=sacc;
    pw0=(u32x4){PKW(pB0,0),PKW(pB0,2),PKW(pB0,4),PKW(pB0,6)};pw1=(u32x4){PKW(pB0,8),PKW(pB0,10),PKW(pB0,12),PKW(pB0,14)};pw2=(u32x4){PKW(pB1,0),PKW(pB1,2),PKW(pB1,4),PKW(pB1,6)};pw3=(u32x4){PKW(pB1,8),PKW(pB1,10),PKW(pB1,12),PKW(pB1,14)};
    SBAR(); pv(o,vb0+sl_cur,PAF(0),PAF(1),PAF(2),PAF(3)); }
  #undef PKW
  #undef PAF
  #undef VFR
  #undef PIN
  #undef MX3
  #undef GAPA
  #undef GAPB
  #undef EX
  #undef VRD
  #undef KRD
  #undef STEP
  #undef ENDW
  {auto rr=__builtin_amdgcn_permlane32_swap(__float_as_uint(l_reg),__float_as_uint(l_reg),false,false);l_reg=__uint_as_float(rr[0])+__uint_as_float(rr[1]);}
  if(hi==0)wsf[32+r32]=l_reg;asm volatile("s_waitcnt lgkmcnt(0)":::"memory");
  float rli[16];
  #pragma unroll
  for(int r=0;r<16;++r)rli[r]=__builtin_amdgcn_rcpf(wsf[32+crow(r,hi)]);
  abf*Ow=Ow0+(long)(wid*QBLK)*OP;
  { abf*stg=(abf*)(shm+LDS_OST)+wid*2048;
    #pragma unroll
    for(int r=0;r<16;++r){const int orow=crow(r,hi);
      #pragma unroll
      for(int d0=0;d0<2;++d0)stg[orow*64+d0*32+r32]=(abf)f2bf(o[d0][r]*rli[r]);}
    asm volatile("s_waitcnt lgkmcnt(0)":::"memory");
    #pragma unroll
    for(int i=0;i<4;++i){const int row=i*8+(lane>>3),ch=lane&7; const u32x4 v=*(const u32x4*)(stg+row*64+ch*8); ATTN_STORE16(Ow+(long)row*OP+ch*8,v);} }
  asm volatile("s_waitcnt lgkmcnt(0)\n\ts_barrier":::"memory");
  #undef DMA_K
  #undef DMA_V
  #undef CINIT
  #undef START
  #undef RESC
  #undef ROT
}
template<int THRL> __device__ __forceinline__ void attn_unit128(const abf*Qw0,int QP,const abf*Kh,int KP,const abf*Vh,int VP,abf*Ow0,int OP,int NT,float c2,int q0,char*shm){
  int tid=threadIdx.x; asm volatile("":"+v"(tid)); const int lane=tid&63,r32=lane&31,hi=lane>>5; const int wid=__builtin_amdgcn_readfirstlane(tid>>6);
  const abf*Qw=Qw0+(long)(wid*QBLK)*QP;
  const unsigned lds0=(unsigned)(uintptr_t)shm;
  constexpr int LDS_V2=NSLOT*SLOTB, LDS_WS2=LDS_V2+NSLOT*2*SLOTB;
  float*wsf=(float*)(shm+LDS_WS2)+wid*64;
  const abf*ksrc=Kh+(long)lane*KP+wid*8;
  const abf*vsrc=Vh+(long)(16*(wid&3)+(lane>>2))*VP+(wid>>2)*32+(lane&3)*8;
  const unsigned kdst=lds0+LDS_K+wid*1024, vdst=lds0+LDS_V2+wid*1024;
  #define DMA_K(t,slot) glds16(ksrc+(long)(t)*KVBLK*KP,(unsigned)__builtin_amdgcn_readfirstlane(kdst+(slot)))
  #define DMA_V(t,slot) do{ glds16(vsrc+(long)(t)*KVBLK*VP,(unsigned)__builtin_amdgcn_readfirstlane(vdst+2*(slot))); glds16(vsrc+(long)(t)*KVBLK*VP+64,(unsigned)__builtin_amdgcn_readfirstlane(vdst+2*(slot)+8192)); }while(0)
  const int vb0=(int)(lds0+LDS_V2)+((lane>>4)&1)*32+(lane&3)*8+(4*hi+((lane&15)>>2))*64;
  const char*Kbase=shm+LDS_K; bf16x8 kf[8];
  const lds_cptr shm3=(lds_cptr)shm; const lds_cptr kp0=shm3+LDS_K+hi*1024+r32*16; const lds_cptr vp0=shm3+LDS_V2+((lane>>4)&1)*32+(lane&3)*8+(4*hi+((lane&15)>>2))*64;
  DMA_K(0,0);DMA_V(0,0);DMA_K(1,SLOTB);
  bf16x8 qr[4];
  #pragma unroll
  for(int d0=0;d0<4;++d0)qr[d0]=*reinterpret_cast<const bf16x8*>(&Qw[(long)r32*QP+d0*16+hi*8]);
  float mhat=0.f,l_reg=0.f;f32x16 o[4];o[0]=f32x16{};o[1]=f32x16{};o[2]=f32x16{};o[3]=f32x16{};
  const int tdiag=__builtin_amdgcn_readfirstlane((q0+wid*QBLK)>>6);
  const float qrel4=(float)(q0+wid*QBLK+r32-4*hi);
  #define CINIT(C0,C1,t) do{ const int tt_=(t); const float dq_=qrel4-64.f*(float)tt_; \
    if(tt_!=tdiag){ float sc_=tt_<tdiag?c2:-c2; asm volatile("":"+v"(sc_)); const float sc8_=8.f*sc_, sc32_=32.f*sc_; \
      C0[0]=-mhat-sc_*dq_; C0[1]=C0[0]+sc_; C0[2]=C0[1]+sc_; C0[3]=C0[2]+sc_; \
      _Pragma("unroll") for(int r=4;r<16;++r) C0[r]=C0[r-4]+sc8_;          \
      _Pragma("unroll") for(int r=0;r<16;++r) C1[r]=C0[r]+sc32_; } \
    else { _Pragma("unroll") for(int r=0;r<16;++r){ const float cr_=(float)((r&3)+8*(r>>2)); C0[r]=-mhat-c2*__builtin_fabsf(dq_-cr_); C1[r]=-mhat-c2*__builtin_fabsf(dq_-cr_-32.f); } } }while(0)
  bool resc=false;
  #define START(P0,P1) do{ const float rm=rowmax(P0,P1); resc=false; \
    { const float dl=rm; mhat=fadd_s(mhat,dl); \
      _Pragma("unroll") for(int r=0;r<16;++r){P0[r]=fsub_s(P0[r],dl);P1[r]=fsub_s(P1[r],dl);} } \
    _Pragma("unroll") for(int r=0;r<16;++r)P0[r]=__builtin_amdgcn_exp2f(P0[r]); }while(0)
  #define RESC() do{ if(resc){ asm volatile("s_waitcnt lgkmcnt(0)":::"memory"); \
      _Pragma("unroll") for(int d_=0;d_<4;++d_) _Pragma("unroll") for(int r=0;r<16;++r)o[d_][r]*=wsf[crow(r,hi)]; } }while(0)
  f32x16 pA0,pA1,pB0,pB1;
  int sl_prev=0,sl_cur=0,sl_next=SLOTB;
  #define ROT() do{sl_prev=sl_cur;sl_cur=sl_next;sl_next=(sl_next==(NSLOT-1)*SLOTB)?0:sl_next+SLOTB;}while(0)
  DMA_K(2,2*SLOTB);
  WAIT_BAR(4);
  CINIT(pA0,pA1,0);
  qkt(pA0,pA1,Kbase,qr,pA0,pA1,r32,hi);asm volatile("s_nop 15\n\ts_nop 7":"+v"(pA0),"+v"(pA1));
  START(pA0,pA1);
  _Pragma("unroll") for(int r=0;r<16;++r)pA1[r]=__builtin_amdgcn_exp2f(pA1[r]);
  WAIT_BAR(0);
  DMA_K(3,0);DMA_V(1,SLOTB);
  ROT();
  kload8(kf,kp0+sl_cur);
  WAIT_BAR(3);
  s16x4 vlo[8],vhi[8]; u32x4 pw0,pw1,pw2,pw3;
  #define PKW(P,B) cvtpk_s(P[B],P[B+1])
  #define PAF(k) __builtin_bit_cast(bf16x8,pw##k)
  #define VFR(i) (bf16x8){vlo[i][0],vlo[i][1],vlo[i][2],vlo[i][3],vhi[i][0],vhi[i][1],vhi[i][2],vhi[i][3]}
  #define PIN(x) asm volatile("":"+v"(x))
  #define MX3(a,b,c) __builtin_fmaxf(__builtin_fmaxf((a),(b)),(c))
  #define GAPA(MF,A0,A1,A2,A3,W0,W1,PW) do{ MF; sacc+=A0; sacc+=A1; sacc+=A2; sacc+=A3; PIN(sacc); W0; W1; PIN(PW); SBAR(); }while(0)
  #define EX(v) __builtin_amdgcn_exp2f(v)
  #define GAPB(MF,X,B) do{ MF; X[B]=EX(X[B]); X[B+1]=EX(X[B+1]); PIN(X); SBAR(); }while(0)
  #define VRD2(i,f) do{ vlo[i]=vtr(vp_+(((f)>>2)*4096+((f)&3)*1024)); vhi[i]=vtr(vp_+(((f)>>2)*4096+((f)&3)*1024+512)); SBAR(); }while(0)
  #define VRD(i) do{ vlo[i]=vtr(vp_+(((i)>>2)*4096+((i)&3)*1024)); vhi[i]=vtr(vp_+(((i)>>2)*4096+((i)&3)*1024+512)); }while(0)
  #define KRD(G,j) do{ if(G){ kload2(kf,kp0+sl_next,j); SBAR(); } }while(0)
  #define STEP(C0,C1,P0,P1,t,GK,GV,GL) do{ SBAR(); \
    CINIT(C0,C1,t); SBAR(); \
    const lds_cptr vp_=vp0+2*sl_prev; \
    VRD(0); SBAR(); float sacc=(P0[0]+P0[1]); \
    GAPA(C0=__builtin_amdgcn_mfma_f32_32x32x16_bf16(kf[0],qr[0],C0,0,0,0), P0[2],P0[3],P0[4],P0[5],     pw0[0]=PKW(P0,0), pw0[1]=PKW(P0,2), pw0); \
    GAPA(C1=__builtin_amdgcn_mfma_f32_32x32x16_bf16(kf[1],qr[0],C1,0,0,0), P0[6],P0[7],P0[8],P0[9],     pw0[2]=PKW(P0,4), pw0[3]=PKW(P0,6), pw0); \
    VRD(1); SBAR(); GAPA(C0=__builtin_amdgcn_mfma_f32_32x32x16_bf16(kf[2],qr[1],C0,0,0,0),   P0[10],P0[11],P0[12],P0[13], pw1[0]=PKW(P0,8), pw1[1]=PKW(P0,10), pw1); \
    GAPA(C1=__builtin_amdgcn_mfma_f32_32x32x16_bf16(kf[3],qr[1],C1,0,0,0),   P0[14],P0[15],P1[0],P1[1],   pw1[2]=PKW(P0,12),pw1[3]=PKW(P0,14), pw1); \
    VRD(2); SBAR(); GAPA(C0=__builtin_amdgcn_mfma_f32_32x32x16_bf16(kf[4],qr[2],C0,0,0,0),   P1[2],P1[3],P1[4],P1[5],     pw2[0]=PKW(P1,0), pw2[1]=PKW(P1,2), pw2); \
    GAPA(C1=__builtin_amdgcn_mfma_f32_32x32x16_bf16(kf[5],qr[2],C1,0,0,0),   P1[6],P1[7],P1[8],P1[9],     pw2[2]=PKW(P1,4), pw2[3]=PKW(P1,6), pw2); \
    VRD(3); SBAR(); GAPA(C0=__builtin_amdgcn_mfma_f32_32x32x16_bf16(kf[6],qr[3],C0,0,0,0),   P1[10],P1[11],P1[12],P1[13], pw3[0]=PKW(P1,8), pw3[1]=PKW(P1,10), pw3); \
    GAPA(C1=__builtin_amdgcn_mfma_f32_32x32x16_bf16(kf[7],qr[3],C1,0,0,0),   P1[14],P1[15],0.f,0.f,       pw3[2]=PKW(P1,12),pw3[3]=PKW(P1,14), pw3); \
    l_reg+=sacc; \
    if(GK){DMA_K((t)+3,sl_cur);} if(GV){DMA_V((t)+1,sl_next);} \
    { float a=MX3(C0[0],C0[1],C1[0]),b=MX3(C0[2],C0[3],C1[1]); a=MX3(a,C1[2],C1[3]); \
      _Pragma("unroll") for(int r=4;r<16;r+=4){a=MX3(a,C0[r],C0[r+1]);b=MX3(b,C0[r+2],C0[r+3]);a=MX3(a,C1[r],C1[r+1]);b=MX3(b,C1[r+2],C1[r+3]);} \
      float rm=__builtin_fmaxf(a,b); { auto rr=__builtin_amdgcn_permlane32_swap(__float_as_uint(rm),__float_as_uint(rm),false,false); rm=__builtin_fmaxf(__uint_as_float(rr[0]),__uint_as_float(rr[1])); } \
      resc=false; \
      if(__builtin_expect(__any(rm>(float)THRL),0)){ const float dl=__builtin_fmaxf(rm,0.f); mhat+=dl; \
        _Pragma("unroll") for(int r=0;r<16;++r){C0[r]-=dl;C1[r]-=dl;} \
        const float f=__builtin_amdgcn_exp2f(-dl); l_reg*=f; if(hi==0)wsf[r32]=f; resc=true; } } \
    SBAR(); \
    GAPB(o[0]=__builtin_amdgcn_mfma_f32_32x32x16_bf16(PAF(0),VFR(0),o[0],0,0,0), C0,0);  VRD2(4,4); \
    GAPB(o[0]=__builtin_amdgcn_mfma_f32_32x32x16_bf16(PAF(1),VFR(1),o[0],0,0,0), C0,2);  VRD2(5,5); \
    KRD(GL,0); GAPB(o[0]=__builtin_amdgcn_mfma_f32_32x32x16_bf16(PAF(2),VFR(2),o[0],0,0,0), C0,4);  VRD2(6,6); \
    KRD(GL,1); GAPB(o[0]=__builtin_amdgcn_mfma_f32_32x32x16_bf16(PAF(3),VFR(3),o[0],0,0,0), C0,6);  VRD2(7,7); \
    KRD(GL,2); GAPB(o[1]=__builtin_amdgcn_mfma_f32_32x32x16_bf16(PAF(0),VFR(4),o[1],0,0,0), C0,8);  VRD2(0,8); \
    KRD(GL,3); GAPB(o[1]=__builtin_amdgcn_mfma_f32_32x32x16_bf16(PAF(1),VFR(5),o[1],0,0,0), C0,10); VRD2(1,9); \
    GAPB(o[1]=__builtin_amdgcn_mfma_f32_32x32x16_bf16(PAF(2),VFR(6),o[1],0,0,0), C0,12); VRD2(2,10); \
    GAPB(o[1]=__builtin_amdgcn_mfma_f32_32x32x16_bf16(PAF(3),VFR(7),o[1],0,0,0), C0,14); VRD2(3,11); \
    GAPB(o[2]=__builtin_amdgcn_mfma_f32_32x32x16_bf16(PAF(0),VFR(0),o[2],0,0,0), C1,0);  VRD2(4,12); \
    GAPB(o[2]=__builtin_amdgcn_mfma_f32_32x32x16_bf16(PAF(1),VFR(1),o[2],0,0,0), C1,2);  VRD2(5,13); \
    GAPB(o[2]=__builtin_amdgcn_mfma_f32_32x32x16_bf16(PAF(2),VFR(2),o[2],0,0,0), C1,4);  VRD2(6,14); \
    GAPB(o[2]=__builtin_amdgcn_mfma_f32_32x32x16_bf16(PAF(3),VFR(3),o[2],0,0,0), C1,6);  VRD2(7,15); \
    GAPB(o[3]=__builtin_amdgcn_mfma_f32_32x32x16_bf16(PAF(0),VFR(4),o[3],0,0,0), C1,8); \
    GAPB(o[3]=__builtin_amdgcn_mfma_f32_32x32x16_bf16(PAF(1),VFR(5),o[3],0,0,0), C1,10); \
    GAPB(o[3]=__builtin_amdgcn_mfma_f32_32x32x16_bf16(PAF(2),VFR(6),o[3],0,0,0), C1,12); \
    GAPB(o[3]=__builtin_amdgcn_mfma_f32_32x32x16_bf16(PAF(3),VFR(7),o[3],0,0,0), C1,14); \
    }while(0)
  int t=1;
  for(;t+5<NT;t+=2){
    STEP(pB0,pB1,pA0,pA1,t,true,true,true);     WAIT_BAR(3); RESC(); ROT();
    STEP(pA0,pA1,pB0,pB1,t+1,true,true,true);   WAIT_BAR(3); RESC(); ROT();
  }
  #define ENDW(tt) do{ if((tt)+3<NT){WAIT_BAR(3);} else if((tt)+2<NT){WAIT_BAR(2);} else {WAIT_BAR(0);} }while(0)
  for(;t+1<NT;t+=2){
    STEP(pB0,pB1,pA0,pA1,t,(t+3<NT),(t+1<NT),(t+1<NT));       ENDW(t);   RESC(); ROT();
    STEP(pA0,pA1,pB0,pB1,t+1,(t+4<NT),(t+2<NT),(t+2<NT));     ENDW(t+1); RESC(); ROT();
  }
  STEP(pB0,pB1,pA0,pA1,NT-1,false,false,false); RESC();
  { float sacc=pB0[0]+pB0[1]; _Pragma("unroll") for(int r=2;r<16;++r)sacc+=pB0[r]; _Pragma("unroll") for(int r=0;r<16;++r)sacc+=pB1[r]; l_reg+=sacc;
    pw0=(u32x4){PKW(pB0,0),PKW(pB0,2),PKW(pB0,4),PKW(pB0,6)};pw1=(u32x4){PKW(pB0,8),PKW(pB0,10),PKW(pB0,12),PKW(pB0,14)};pw2=(u32x4){PKW(pB1,0),PKW(pB1,2),PKW(pB1,4),PKW(pB1,6)};pw3=(u32x4){PKW(pB1,8),PKW(pB1,10),PKW(pB1,12),PKW(pB1,14)};
    SBAR(); pv(o,vb0+2*sl_cur,PAF(0),PAF(1),PAF(2),PAF(3)); pv(o+2,vb0+2*sl_cur+8192,PAF(0),PAF(1),PAF(2),PAF(3)); }
  #undef PKW
  #undef PAF
  #undef VFR
  #undef PIN
  #undef MX3
  #undef GAPA
  #undef GAPB
  #undef EX
  #undef VRD
  #undef KRD
  #undef VRD2
  #undef STEP
  #undef ENDW
  {auto rr=__builtin_amdgcn_permlane32_swap(__float_as_uint(l_reg),__float_as_uint(l_reg),false,false);l_reg=__uint_as_float(rr[0])+__uint_as_float(rr[1]);}
  if(hi==0)wsf[32+r32]=l_reg;asm volatile("s_waitcnt lgkmcnt(0)":::"memory");
  float rli[16];
  #pragma unroll
  for(int r=0;r<16;++r)rli[r]=__builtin_amdgcn_rcpf(wsf[32+crow(r,hi)]);
  abf*Ow=Ow0+(long)(wid*QBLK)*OP;
  asm volatile("s_waitcnt lgkmcnt(0)\n\ts_barrier":::"memory");
  { abf*stg=(abf*)(shm)+wid*4096;
    #pragma unroll
    for(int r=0;r<16;++r){const int orow=crow(r,hi);
      #pragma unroll
      for(int d0=0;d0<4;++d0)stg[orow*128+d0*32+r32]=(abf)f2bf(o[d0][r]*rli[r]);}
    asm volatile("s_waitcnt lgkmcnt(0)":::"memory");
    #pragma unroll
    for(int i=0;i<8;++i){const int row=i*4+(lane>>4),ch=lane&15; const u32x4 v=*(const u32x4*)(stg+row*128+ch*8); ATTN_STORE16(Ow+(long)row*OP+ch*8,v);} }
  asm volatile("s_waitcnt lgkmcnt(0)\n\ts_barrier":::"memory");
  #undef DMA_K
  #undef DMA_V
  #undef CINIT
  #undef START
  #undef RESC
  #undef ROT
}
constexpr int ATTN_LDS_BYTES=LDS_BYTES;
#undef SBAR
#undef WAIT_BAR
}

struct Args { const float* in[23]; float* out; unsigned char* ws; int ph_lo, ph_hi; };
struct Frame {
    LAS unsigned char* lds; char* ldsg;
    volatile LAS unsigned* MISC;
    gu32* ctl;
    int tid, lane, wave, vcu, G;
    float* out; unsigned char* ws;
};
constexpr int INTAB_OFF = LDSCTL_OFF + 8192;
__device__ __forceinline__ const float* fin(const Frame& F, int i) {
    const LAS unsigned* t = (const LAS unsigned*)(F.lds + INTAB_OFF) + 2 * i;
    const unsigned lo = __builtin_amdgcn_readfirstlane(t[0]), hi = __builtin_amdgcn_readfirstlane(t[1]);
    return (const float*)(const GAS float*)(((unsigned long long)hi << 32) | lo);
}
#define WSP(T_, off) ((T_*)(F.ws + (off)))
__device__ __forceinline__ int fresh_tid() { int t = threadIdx.x; asm volatile("" : "+v"(t)); return t; }

template <int MODE>
__device__ __forceinline__ void p0_transpose_item(const float* W, int K, int N, bf16* WT, LAS float* scr, int item, int lane) {
    const int nblk = N / 32, kb = item / nblk, nb = item % nblk, k0 = 64 * kb, n0 = 32 * nb;
    { f32x4 ld[8];
#pragma unroll
      for (int i = 0; i < 8; ++i) ld[i] = *(const GAS f32x4*)(W + (size_t)(k0 + 8 * i + (lane >> 3)) * N + n0 + (lane & 7) * 4);
#pragma unroll
      for (int i = 0; i < 8; ++i) { LAS float* d = scr + (8 * i + (lane >> 3)) * 33 + (lane & 7) * 4; d[0] = ld[i].x; d[1] = ld[i].y; d[2] = ld[i].z; d[3] = ld[i].w; } }
    asm volatile("s_waitcnt lgkmcnt(0)" ::: "memory");
    const int c = lane & 7;
#pragma unroll
    for (int j = 0; j < 4; ++j) { const int n = (lane >> 3) + 8 * j; const LAS float* s = scr + (8 * c) * 33 + n;
        v4u o; o.x = pk2(s[0 * 33], s[1 * 33]); o.y = pk2(s[2 * 33], s[3 * 33]); o.z = pk2(s[4 * 33], s[5 * 33]); o.w = pk2(s[6 * 33], s[7 * 33]);
        int col = n0 + n, drow = col;
        *(GAS v4u*)(WT + (size_t)drow * K + k0 + 8 * c) = o; }
    asm volatile("s_waitcnt lgkmcnt(0)" ::: "memory");
}
__device__ __forceinline__ void row_to_bf16(const float* xrow, bf16* orow, int lane) {
    const GAS f32x4* xr = (const GAS f32x4*)xrow + lane;
    GAS v2u* o8 = (GAS v2u*)orow + lane;
#pragma unroll
    for (int j = 0; j < 4; ++j) { const f32x4 v = xr[64 * j]; v2u w; w.x = pk2(v.x, v.y); w.y = pk2(v.z, v.w); o8[64 * j] = w; }
}
__device__ __forceinline__ void p0_transpose_fp8_item(bool PERM, const float* W, int K, int N, unsigned char* WT, float wscale, LAS float* scr, int item, int lane) {
    const int nblk = N / 32, kb = item / nblk, nb = item % nblk, k0 = 128 * kb, n0 = 32 * nb, c = lane & 7;
    v2u o8[2][4];
#pragma unroll
    for (int p = 0; p < 2; ++p) {
        { f32x4 ld[8];
#pragma unroll
          for (int i = 0; i < 8; ++i) ld[i] = __builtin_nontemporal_load((const GAS f32x4*)(W + (size_t)(k0 + 64 * p + 8 * i + (lane >> 3)) * N + n0 + (lane & 7) * 4));
#pragma unroll
          for (int i = 0; i < 8; ++i) { LAS float* d = scr + (8 * i + (lane >> 3)) * 33 + (lane & 7) * 4; d[0] = ld[i].x; d[1] = ld[i].y; d[2] = ld[i].z; d[3] = ld[i].w; } }
        asm volatile("s_waitcnt lgkmcnt(0)" ::: "memory");
#pragma unroll
        for (int j = 0; j < 4; ++j) { const int n = (lane >> 3) + 8 * j; const LAS float* sp = scr + (8 * c) * 33 + n;
            o8[p][j].x = pk4_fp8(sp[0 * 33] * wscale, sp[1 * 33] * wscale, sp[2 * 33] * wscale, sp[3 * 33] * wscale); o8[p][j].y = pk4_fp8(sp[4 * 33] * wscale, sp[5 * 33] * wscale, sp[6 * 33] * wscale, sp[7 * 33] * wscale); }
        asm volatile("s_waitcnt lgkmcnt(0)" ::: "memory");
    }
#pragma unroll
    for (int j = 0; j < 4; ++j) { const int col = n0 + (lane >> 3) + 8 * j, pn = col >> 8, w = col & 255, drow = PERM ? 256 * pn + 128 * (w & 1) + (w >> 1) : col;
        GAS v2u* dp = (GAS v2u*)(WT + (size_t)drow * K + k0 + 8 * c); __builtin_nontemporal_store(o8[0][j], dp); __builtin_nontemporal_store(o8[1][j], dp + 8); }
}
__device__ __forceinline__ void p0_prologue(Frame& F) {
    LAS float* scr = (LAS float*)(F.lds + F.wave * 16384);
    const int gw = F.vcu * NWAVES + F.wave, NGW = F.G * NWAVES;
    constexpr int I_IN = 16 * (NIN / 32), I_KV = 16 * (512 / 32), I_O = 16 * (1024 / 32);
    constexpr int NITEMS = I_IN + I_KV + I_O;
    for (int it = gw; it < NITEMS; it += NGW) {
        int r = it;
        if (r < I_IN) { p0_transpose_item<0>(fin(F, 2), DM, NIN, WSP(bf16, WS_WIN), scr, r, F.lane); continue; } r -= I_IN;
        if (r < I_KV) { p0_transpose_item<0>(fin(F, 11), DM, 512, WSP(bf16, WS_WKV), scr, r, F.lane); continue; } r -= I_KV;
        p0_transpose_item<0>(fin(F, 12), DM, DM, WSP(bf16, WS_WO), scr, r, F.lane);
    }
    for (int i = F.vcu * NTHREADS + F.tid; i < DM * NE; i += F.G * NTHREADS) { const int e = i >> 10, k = i & 1023; const float w = fin(F, 15)[(size_t)k * NE + e] * fin(F, 13)[k];
        const unsigned hi = f2bf(w); WSP(bf16, WS_RWT)[i] = (bf16)hi; WSP(bf16, WS_RWT)[DM * NE + i] = (bf16)f2bf(w - bf2f(hi)); }
    if (gw < NE) { float a = 0.f; for (int k = F.lane; k < DM; k += 64) a += fin(F, 14)[k] * fin(F, 15)[(size_t)k * NE + gw];
        a = wave_sum(a); if (F.lane == 0) WSP(float, WS_RWT + 2 * DM * NE * 2)[gw] = a + fin(F, 16)[gw]; }
    for (int m = gw; m < T; m += NGW) row_to_bf16(fin(F, 0) + (size_t)m * DM, WSP(bf16, WS_XB) + (size_t)m * DM, F.lane);
    for (int m = gw; m < NB * MEML; m += NGW) row_to_bf16(fin(F, 1) + (size_t)m * DM, WSP(bf16, WS_MEMB) + (size_t)m * DM, F.lane);
}

__device__ __forceinline__ void p1_inproj(Frame& F) {
    { pg8::Gemm g{WSP(bf16, WS_XB), WSP(bf16, WS_WIN), T, NIN, DM}; pg8::StaticOrder S; S.init(T, NIN, F.G, (int)blockIdx.x);
      pg8::EpiBf16 E{WSP(bf16, WS_U), NIN, (1u << 0) | (1u << 1) | (1u << 11), C2};
      pg8::gemm_phase<pg8::EpiBf16, pg8::StaticOrder, true, true>(F.lds, g, S, E); }
}

constexpr int HCH = 64, NCH = SEQ / HCH, HU_STRIDE = 64 * 64 + 64;
namespace hg {
typedef short bf16x8 __attribute__((ext_vector_type(8)));
typedef short s16x4 __attribute__((ext_vector_type(4)));
typedef float f32x4 __attribute__((ext_vector_type(4)));
typedef unsigned u32x2 __attribute__((ext_vector_type(2)));
typedef short v4i16_t __attribute__((ext_vector_type(4)));
template <int N> __device__ __forceinline__ float row_shr_or(float x, float fill) { return __int_as_float(__builtin_amdgcn_update_dpp(__float_as_int(fill), __float_as_int(x), 0x110 + N, 0xf, 0xf, false)); }
__device__ __forceinline__ float row_cumprod(float x) { x *= row_shr_or<1>(x, 1.f); x *= row_shr_or<2>(x, 1.f); x *= row_shr_or<4>(x, 1.f); x *= row_shr_or<8>(x, 1.f); return x; }
__device__ __forceinline__ float sigm(float x) { return __builtin_amdgcn_rcpf(1.f + __builtin_amdgcn_exp2f(-1.4426950408889634f * x)); }
__device__ __forceinline__ unsigned pkbf(float lo, float hi) { typedef float f2 __attribute__((ext_vector_type(2))); typedef __bf16 b2 __attribute__((ext_vector_type(2))); f2 v = {lo, hi}; b2 o = __builtin_convertvector(v, b2); return __builtin_bit_cast(unsigned, o); }
__device__ __forceinline__ bf16x8 frag8(float a0, float a1, float a2, float a3, float a4, float a5, float a6, float a7) { typedef unsigned u4 __attribute__((ext_vector_type(4))); u4 w = {pkbf(a0, a1), pkbf(a2, a3), pkbf(a4, a5), pkbf(a6, a7)}; return __builtin_bit_cast(bf16x8, w); }
__device__ __forceinline__ s16x4 frag4s(float a0, float a1, float a2, float a3) { u32x2 w = {pkbf(a0, a1), pkbf(a2, a3)}; return __builtin_bit_cast(s16x4, w); }
__device__ __forceinline__ s16x4 trd(const LAS unsigned char* p) { return __builtin_bit_cast(s16x4, __builtin_amdgcn_ds_read_tr16_b64_v4i16((LAS v4i16_t*)p)); }
__device__ __forceinline__ float b2f(short v) { return __uint_as_float(((unsigned)(unsigned short)v) << 16); }

template <bool OUT>
__device__ __forceinline__ void unit(const bf16* U, const float* lbsrc, int b, int h, int dir, int c, f32x4 (&S)[4][4], float (&aprod)[4], LAS unsigned char* wl, int lane) {
    const int r = lane & 15, g = lane >> 4;
    LAS unsigned char* tHQ = wl + 8192; LAS unsigned char* tHF = wl + 10240; LAS unsigned char* tHI = wl + 12288; LAS float* aL = (LAS float*)(wl + 14336);
    LAS float* lbL = aL + 64;
    lbL[lane] = __builtin_amdgcn_rcpf(1.f + __expf(lbsrc[256 + h * 64 + lane] - lbsrc[h * 64 + lane]));
    float lbD[4];
#pragma unroll
    for (int cc = 0; cc < 4; ++cc) lbD[cc] = lbL[16 * cc + r];
#pragma unroll
    for (int mb = 0; mb < 4; ++mb) aprod[mb] = 1.f;
    const int lrow = lane >> 3, piece = lane & 7;
    const bf16* ubase = U + (size_t)b * SEQ * NIN + h * 64 + piece * 8;
    v4u stg[3][2];
#define HG_LOAD(sc) do { _Pragma("unroll") for (int hh = 0; hh < 2; ++hh) { const int i_ = 16 * (sc) + lrow + 8 * hh; const int t_ = dir ? HCH * c + HCH - 1 - i_ : HCH * c + i_; const bf16* p_ = ubase + (size_t)t_ * NIN; \
        stg[1][hh] = *(const GAS v4u*)(p_ + U_HF + dir * 256); stg[2][hh] = *(const GAS v4u*)(p_ + U_HI); } } while (0)
#define HG_LOADQ(sc) do { _Pragma("unroll") for (int hh = 0; hh < 2; ++hh) { const int i_ = 16 * (sc) + lrow + 8 * hh; const int t_ = dir ? HCH * c + HCH - 1 - i_ : HCH * c + i_; \
        stg[0][hh] = *(const GAS v4u*)(ubase + (size_t)t_ * NIN + U_HQ); } } while (0)
    HG_LOAD(0);
#pragma unroll 1
    for (int sc = 0; sc < 4; ++sc) {
        if (OUT) HG_LOADQ(sc);
#pragma unroll
        for (int hh = 0; hh < 2; ++hh) { const int off = (lrow + 8 * hh) * 128 + piece * 16;
            *(LAS v4u*)(tHF + off) = stg[1][hh]; *(LAS v4u*)(tHI + off) = stg[2][hh]; }
        if (sc < 3) HG_LOAD(sc + 1);
        s16x4 kteF[4], vF[4];
        const int q4 = r >> 2, p4 = r & 3;
#pragma unroll
        for (int mb = 0; mb < 4; ++mb) {
            const int toff = (4 * g + q4) * 128 + (16 * mb + 4 * p4) * 2;
            const s16x4 hfv = trd(tHF + toff); vF[mb] = trd(tHI + toff);
            float f[4], lp[4];
#pragma unroll
            for (int j = 0; j < 4; ++j) f[j] = lbD[mb] + (1.f - lbD[mb]) * sigm(b2f(hfv[j]));
            lp[0] = f[0]; lp[1] = lp[0] * f[1]; lp[2] = lp[1] * f[2]; lp[3] = lp[2] * f[3];
            float inc = lp[3];
            { const float u1 = __shfl_up(inc, 16); inc *= (g >= 1 ? u1 : 1.f); const float u2 = __shfl_up(inc, 32); inc *= (g >= 2 ? u2 : 1.f); }
            const float ex0 = __shfl_up(inc, 16), excl = g >= 1 ? ex0 : 1.f, plast = __shfl(inc, 48 + r);
            aprod[mb] *= plast;
            float kt[4];
#pragma unroll
            for (int j = 0; j < 4; ++j) kt[j] = (1.f - f[j]) * plast * __builtin_amdgcn_rcpf(excl * lp[j]);
            kteF[mb] = frag4s(kt[0], kt[1], kt[2], kt[3]);
            aL[16 * mb + r] = plast;
        }
        if (OUT) {
#pragma unroll
            for (int hh = 0; hh < 2; ++hh) *(LAS v4u*)(tHQ + (lrow + 8 * hh) * 128 + piece * 16) = stg[0][hh];
            float qe[4][4], ke[4][4];
#pragma unroll
            for (int cc = 0; cc < 4; ++cc) {
                const u32x2 wq = *(const LAS u32x2*)(tHQ + r * 128 + (16 * cc + 4 * g) * 2), wf = *(const LAS u32x2*)(tHF + r * 128 + (16 * cc + 4 * g) * 2);
                const float hq4[4] = {bflo(wq.x), bfhi(wq.x), bflo(wq.y), bfhi(wq.y)}, hf4[4] = {bflo(wf.x), bfhi(wf.x), bflo(wf.y), bfhi(wf.y)};
                const f32x4 lbv = *(const LAS f32x4*)&lbL[16 * cc + 4 * g];
#pragma unroll
                for (int e = 0; e < 4; ++e) { const float f = lbv[e] + (1.f - lbv[e]) * sigm(hf4[e]); const float P = row_cumprod(f);
                    qe[cc][e] = hq4[e] * sigm(hq4[e]) * P; ke[cc][e] = (1.f - f) * __builtin_amdgcn_rcpf(P); }
            }
            bf16x8 qeF[2], keF[2];
#pragma unroll
            for (int ks = 0; ks < 2; ++ks) { qeF[ks] = frag8(qe[2 * ks][0], qe[2 * ks][1], qe[2 * ks][2], qe[2 * ks][3], qe[2 * ks + 1][0], qe[2 * ks + 1][1], qe[2 * ks + 1][2], qe[2 * ks + 1][3]);
                keF[ks] = frag8(ke[2 * ks][0], ke[2 * ks][1], ke[2 * ks][2], ke[2 * ks][3], ke[2 * ks + 1][0], ke[2 * ks + 1][1], ke[2 * ks + 1][2], ke[2 * ks + 1][3]); }
            f32x4 cp = {0.f, 0.f, 0.f, 0.f};
            cp = __builtin_amdgcn_mfma_f32_16x16x32_bf16(keF[0], qeF[0], cp, 0, 0, 0); cp = __builtin_amdgcn_mfma_f32_16x16x32_bf16(keF[1], qeF[1], cp, 0, 0, 0);
            const s16x4 amF = frag4s(4 * g + 0 <= r ? cp[0] : 0.f, 4 * g + 1 <= r ? cp[1] : 0.f, 4 * g + 2 <= r ? cp[2] : 0.f, 4 * g + 3 <= r ? cp[3] : 0.f);
#pragma unroll
            for (int mb = 0; mb < 4; ++mb) {
                f32x4 ot = {0.f, 0.f, 0.f, 0.f}, oi = {0.f, 0.f, 0.f, 0.f};
                oi = __builtin_amdgcn_mfma_f32_16x16x16bf16_1k(vF[mb], amF, oi, 0, 0, 0);
#pragma unroll
                for (int ks = 0; ks < 2; ++ks) { const f32x4 s0 = S[2 * ks][mb], s1 = S[2 * ks + 1][mb];
                    ot = __builtin_amdgcn_mfma_f32_16x16x32_bf16(frag8(s0[0], s0[1], s0[2], s0[3], s1[0], s1[1], s1[2], s1[3]), qeF[ks], ot, 0, 0, 0); }
                ot = ot + oi;
                u32x2 w; w.x = pkbf(ot[0], ot[1]); w.y = pkbf(ot[2], ot[3]);
                *(LAS u32x2*)(wl + ((16 * sc + r) * 64 + 16 * mb + 4 * g) * 2) = w;
            }
        }
#pragma unroll
        for (int db = 0; db < 4; ++db) { const f32x4 ar = *(const LAS f32x4*)&aL[16 * db + 4 * g];
#pragma unroll
            for (int vb = 0; vb < 4; ++vb) S[db][vb] = __builtin_amdgcn_mfma_f32_16x16x16bf16_1k(kteF[db], vF[vb], S[db][vb] * ar, 0, 0, 0); }
    }
#undef HG_LOAD
#undef HG_LOADQ
}
}

__device__ __forceinline__ void p2_hgrn_local(Frame& F) {
    const int gw = F.vcu * NWAVES + F.wave, NGW = F.G * NWAVES, lane = F.lane;
    for (int u = gw; u < 32 * NCH; u += NGW) {
        const int seq = u / NCH, cp = u % NCH, b = seq >> 3, h = (seq >> 1) & 3, dir = seq & 1, c = dir ? NCH - 1 - cp : cp;
        hg::f32x4 S[4][4]; float aprod[4];
#pragma unroll
        for (int db = 0; db < 4; ++db)
#pragma unroll
            for (int vb = 0; vb < 4; ++vb) S[db][vb] = (hg::f32x4){0.f, 0.f, 0.f, 0.f};
        hg::unit<false>(WSP(bf16, WS_U), dir ? fin(F, 9) : fin(F, 8), b, h, dir, c, S, aprod, F.lds + F.wave * 16384, lane);
        float* hu = WSP(float, WS_HU) + (size_t)u * HU_STRIDE; const int r = lane & 15, g = lane >> 4;
#pragma unroll
        for (int db = 0; db < 4; ++db)
#pragma unroll
            for (int vb = 0; vb < 4; ++vb)
#pragma unroll
                for (int q = 0; q < 4; ++q) hu[(16 * db + 4 * g + q) * 64 + 16 * vb + r] = S[db][vb][q];
#pragma unroll
        for (int mb = 0; mb < 4; ++mb) hu[4096 + 16 * mb + r] = aprod[mb];
    }
    {
        LAS float* red = (LAS float*)(F.lds + LDSCTL_OFF + 1024);
        for (int r0 = F.vcu * 64; r0 < T; r0 += F.G * 64) {
            float mx = 0.f;
            for (int i = 0; i < 8; ++i) { const v4u w = *(const GAS v4u*)(WSP(bf16, WS_U) + (size_t)(r0 + F.wave * 8 + i) * NIN + U_DK + lane * 8);
                float ss = bflo(w.x) * bflo(w.x) + bfhi(w.x) * bfhi(w.x) + bflo(w.y) * bflo(w.y) + bfhi(w.y) * bfhi(w.y) + bflo(w.z) * bflo(w.z) + bfhi(w.z) * bfhi(w.z) + bflo(w.w) * bflo(w.w) + bfhi(w.w) * bfhi(w.w);
                ss += __shfl_xor(ss, 1); ss += __shfl_xor(ss, 2); ss += __shfl_xor(ss, 4); mx = fmaxf(mx, ss); }
            __syncthreads();
            if ((lane & 7) == 0) red[F.wave * 8 + (lane >> 3)] = mx;
            __syncthreads();
            if (F.tid < 8) { float m = red[F.tid]; for (int w = 1; w < 8; ++w) m = fmaxf(m, red[w * 8 + F.tid]);
                __hip_atomic_fetch_max((unsigned*)(F.ctl + CW_KN + (r0 / SEQ) * 8 + F.tid), __float_as_uint(m), RLX_AGENT); }
        }
    }
}
__device__ __forceinline__ void hgrn_scan(Frame& F) {
    for (int idx = F.vcu * NTHREADS + F.tid; idx < 32 * 4096; idx += F.G * NTHREADS) {
        const int seq = idx >> 12, dv = idx & 4095, d = dv >> 6;
        const float* hu = WSP(float, WS_HU) + (size_t)seq * NCH * HU_STRIDE; float* ss = WSP(float, WS_SS) + (size_t)seq * NCH * 4096 + dv;
        float st = 0.f;
#pragma unroll 8
        for (int cp = 0; cp < NCH; ++cp) { ss[(size_t)cp * 4096] = st; st = hu[(size_t)cp * HU_STRIDE + 4096 + d] * st + hu[(size_t)cp * HU_STRIDE + dv]; }
    }
}
constexpr int CV_IGU = 8 * (2048 / 32), CV_IDN = 8 * (1024 / 32), CV_NWAVEITEMS = NE * CV_IGU + NE * CV_IDN, CV_NGROUPS = CV_NWAVEITEMS / NWAVES;
__device__ __forceinline__ bool conv_items(Frame& F, LAS int* qs) {
    if (F.tid == 0) qs[1] = (int)__hip_atomic_fetch_add((unsigned*)(F.ctl + CW_CONVQ), 8u, RLX_AGENT);
    __syncthreads();
    const int g0 = __builtin_amdgcn_readfirstlane(qs[1]);
    __syncthreads();
    if (g0 >= CV_NGROUPS) return false;
    LAS float* scr = (LAS float*)(F.lds + F.wave * 16384);
#pragma unroll 1
    for (int gi = g0; gi < min(g0 + 8, CV_NGROUPS); ++gi) {
        int r = gi * NWAVES + F.wave; const bool gu = r < NE * CV_IGU; if (!gu) r -= NE * CV_IGU;
        const int per = gu ? CV_IGU : CV_IDN, e = r / per, n = gu ? 2048 : 1024;
        p0_transpose_fp8_item(gu, (gu ? fin(F, 17) : fin(F, 19)) + (size_t)e * DM * n, DM, n, (gu ? WSP(unsigned char, WS_WGU) : WSP(unsigned char, WS_WDN)) + (size_t)e * n * DM, gu ? WGU_SCALE : WDN_SCALE, scr, r - e * per, F.lane);
    }
    __syncthreads();
    return true;
}
__device__ __forceinline__ void p3_attn(Frame& F) {
    hgrn_scan(F);
    if (F.vcu < 8) {
        pg8::Gemm g{WSP(bf16, WS_MEMB), WSP(bf16, WS_WKV), NB * MEML, 512, DM}; pg8::OneUnit S{F.vcu >> 1, F.vcu & 1};
        pg8::EpiBf16 E{WSP(bf16, WS_MKV), 512, 0u, 1.f};
        pg8::gemm_phase<pg8::EpiBf16, pg8::OneUnit, false, true>(F.lds, g, S, E);
        asm volatile("s_waitcnt vmcnt(0)" ::: "memory"); __syncthreads();
        if (F.tid == 0) { __builtin_amdgcn_fence(__ATOMIC_RELEASE, "agent"); asm volatile("s_waitcnt vmcnt(0)" ::: "memory"); __hip_atomic_fetch_add((unsigned*)(F.ctl + CW_MKV), 1u, RLX_AGENT); }
    }
    const bf16* U = WSP(bf16, WS_U);
    const bf16* MKV = WSP(bf16, WS_MKV);
    LAS float* red = (LAS float*)(F.lds + LDSCTL_OFF + 1024);
    LAS int* qs = (LAS int*)(red + 16);
    bool conv_more = true, first_it = true;
    for (;;) {
        if (F.tid == 0) qs[0] = (int)__hip_atomic_fetch_add((unsigned*)(F.ctl + CW_QUEUE), 1u, RLX_AGENT);
        __syncthreads();
        const int it = __builtin_amdgcn_readfirstlane(qs[0]);
        __syncthreads();
        if (it >= 512 + 256) break;
        if (conv_more && !(first_it && (F.vcu & 1))) conv_more = conv_items(F, qs);
        first_it = false;
        if (it >= 512) {
            if (F.tid == 0) { unsigned sp = 0; while (__hip_atomic_load((unsigned*)(F.ctl + CW_MKV), RLX_AGENT) < 8u && ++sp < (1u << 22)) __builtin_amdgcn_s_sleep(2);
                __builtin_amdgcn_fence(__ATOMIC_ACQUIRE, "agent"); asm volatile("s_waitcnt vmcnt(0)" ::: "memory"); }
            __syncthreads();
            const int u = it - 512, b = u >> 6, h = (u >> 4) & 3, qb = u & 15; const size_t row0 = (size_t)b * SEQ + qb * 256;
            const bf16* Kp = MKV + (size_t)b * MEML * 512 + h * 64;
            attn_body::attn_unit<8>(U + row0 * NIN + U_MQ + h * 64, NIN, Kp, 512, Kp + 256, 512, WSP(bf16, WS_CAT) + row0 * DM + 768 + h * 64, DM, MEML / 64, 0.f, 0, F.ldsg);
            continue;
        }
        const int h = 3 - (it >> 7), b = (it >> 5) & 3, m = (it >> 4) & 1, qb = it & 15; const size_t row0 = (size_t)b * SEQ + qb * 256;
        const bf16* Qp = U + row0 * NIN + U_DQ + h * 128 + m * 64; const bf16* Kp = U + (size_t)b * SEQ * NIN + U_DK + h * 128 + m * 64; const bf16* Vp = U + (size_t)b * SEQ * NIN + U_DV + h * 128;
        bf16* Op = WSP(bf16, WS_OD) + row0 * DM + h * 256 + m * 128; const float c2 = __builtin_ldexpf(LOG2E, -2 * (h + 1)); int q0 = qb * 256, tlo, thi;
        {
            const int r = F.tid >> 1, hf = F.tid & 1; const bf16* qp = Qp + (size_t)r * NIN + hf * 32; const bf16* kp = Kp + (size_t)(q0 + r) * NIN + hf * 32;
            float qq = 0.f, qk = 0.f;
#pragma unroll
            for (int i = 0; i < 4; ++i) { const v4u a = *(const GAS v4u*)(qp + 8 * i), k4 = *(const GAS v4u*)(kp + 8 * i);
                qq += bflo(a.x) * bflo(a.x) + bfhi(a.x) * bfhi(a.x) + bflo(a.y) * bflo(a.y) + bfhi(a.y) * bfhi(a.y) + bflo(a.z) * bflo(a.z) + bfhi(a.z) * bfhi(a.z) + bflo(a.w) * bflo(a.w) + bfhi(a.w) * bfhi(a.w);
                qk += bflo(a.x) * bflo(k4.x) + bfhi(a.x) * bfhi(k4.x) + bflo(a.y) * bflo(k4.y) + bfhi(a.y) * bfhi(k4.y) + bflo(a.z) * bflo(k4.z) + bfhi(a.z) * bfhi(k4.z) + bflo(a.w) * bflo(k4.w) + bfhi(a.w) * bfhi(k4.w); }
            qq += __shfl_xor(qq, 1); qk += __shfl_xor(qk, 1);
            const float kn = sqrtf(__uint_as_float(__hip_atomic_load((unsigned*)(F.ctl + CW_KN + b * 8 + h * 2 + m), RLX_AGENT))) * 1.0001f;
            float need = wave_max(sqrtf(qq) * 1.0001f * kn - qk + 36.5f);
            if (F.lane == 0) red[F.wave] = need;
            __syncthreads();
            need = red[0];
#pragma unroll
            for (int w = 1; w < 8; ++w) need = fmaxf(need, red[w]);
            const float dist = need / c2;
            const float flo = floorf(((float)(q0 - 63) - dist) * (1.f / 64.f)) + 1.f, fhi = ceilf(((float)(q0 + 255) + dist) * (1.f / 64.f)) - 1.f;
            tlo = flo < 0.f ? 0 : (int)flo; if (tlo > 4 * qb) tlo = 4 * qb;
            thi = fhi > (float)(SEQ / 64 - 1) ? SEQ / 64 - 1 : (int)fhi; if (thi < 4 * qb + 3) thi = 4 * qb + 3;
            if (((thi - tlo + 1) & 1) != 0) { if (tlo > 0) --tlo; else ++thi; }
            tlo = __builtin_amdgcn_readfirstlane(tlo); thi = __builtin_amdgcn_readfirstlane(thi);
            __syncthreads();
        }
        const int NT = thi - tlo + 1; Kp += (size_t)tlo * 64 * NIN; Vp += (size_t)tlo * 64 * NIN; q0 -= tlo * 64;
        attn_body::attn_unit128<8>(Qp, NIN, Kp, NIN, Vp, NIN, Op, DM, NT, c2, q0, F.ldsg);
    }
    while (conv_more) conv_more = conv_items(F, qs);
}

__device__ __forceinline__ void hgrn_out(Frame& F) {
    const int lane = F.lane, wave = F.wave, r = lane & 15, g = lane >> 4;
    for (int u0 = F.vcu * NWAVES; u0 < 32 * NCH; u0 += F.G * NWAVES) {
        const int u = u0 + wave, bhc = u >> 1, dir = u & 1, b = bhc / (4 * NCH), h = (bhc / NCH) & 3, c = bhc % NCH, cp = dir ? NCH - 1 - c : c, seq = b * 8 + h * 2 + dir;
        const float* ss = WSP(float, WS_SS) + ((size_t)seq * NCH + cp) * 4096;
        hg::f32x4 S[4][4]; float aprod[4];
#pragma unroll
        for (int db = 0; db < 4; ++db)
#pragma unroll
            for (int vb = 0; vb < 4; ++vb)
#pragma unroll
                for (int q = 0; q < 4; ++q) S[db][vb][q] = ss[(16 * db + 4 * g + q) * 64 + 16 * vb + r];
        hg::unit<true>(WSP(bf16, WS_U), dir ? fin(F, 9) : fin(F, 8), b, h, dir, c, S, aprod, F.lds + wave * 16384, lane);
        __syncthreads();
        const LAS unsigned char* Of = F.lds + (wave & ~1) * 16384; const LAS unsigned char* Ob = F.lds + (wave | 1) * 16384;
        const int i16 = lane & 15, k4 = lane >> 4; const f32x4 nw = *(const GAS f32x4*)(fin(F, 10) + h * 64 + 4 * i16);
#pragma unroll 2
        for (int k0 = 0; k0 < 32; k0 += 4) { const int tl = dir * 32 + k0 + k4; const size_t row = (size_t)b * SEQ + c * HCH + tl;
            const v2u gq = *(const GAS v2u*)(WSP(bf16, WS_U) + row * NIN + U_HG + h * 64 + 4 * i16);
            const v2u a = *(const LAS v2u*)(Of + tl * 128 + 8 * i16), bb = *(const LAS v2u*)(Ob + (HCH - 1 - tl) * 128 + 8 * i16);
            const float o0 = bflo(a.x) + bflo(bb.x), o1 = bfhi(a.x) + bfhi(bb.x), o2 = bflo(a.y) + bflo(bb.y), o3 = bfhi(a.y) + bfhi(bb.y);
            float ss2 = (o0 * o0 + o1 * o1) + (o2 * o2 + o3 * o3);
            ss2 += __shfl_xor(ss2, 1); ss2 += __shfl_xor(ss2, 2); ss2 += __shfl_xor(ss2, 4); ss2 += __shfl_xor(ss2, 8);
            const float rr = rsqrtf(ss2 * (1.f / 64.f) + EPS);
            v2u w; w.x = pk2(o0 * rr * nw.x * sigmoidf_(bflo(gq.x)), o1 * rr * nw.y * sigmoidf_(bfhi(gq.x))); w.y = pk2(o2 * rr * nw.z * sigmoidf_(bflo(gq.y)), o3 * rr * nw.w * sigmoidf_(bfhi(gq.y)));
            *(GAS v2u*)(WSP(bf16, WS_CAT) + row * DM + 512 + h * 64 + 4 * i16) = w; }
        __syncthreads();
    }
}

__device__ __forceinline__ void p4_combine(Frame& F) {
    hgrn_out(F);
    const int gw = F.vcu * NWAVES + F.wave, NGW = F.G * NWAVES, lane = F.lane;
    const float sa = wave_sum(fin(F, 3)[lane] * fin(F, 4)[lane]), sb = wave_sum(fin(F, 5)[lane] * fin(F, 6)[lane]);
    const float lam = __expf(sa) - __expf(sb) + 0.2f;
    const bf16* OD = WSP(bf16, WS_OD); bf16* CAT = WSP(bf16, WS_CAT);
    const int i16 = lane & 15, mm = (lane >> 4) & 1, hh = lane >> 5;
    const f32x4 dw0 = *(const GAS f32x4*)(fin(F, 7) + 8 * i16), dw1 = *(const GAS f32x4*)(fin(F, 7) + 8 * i16 + 4);
    v4u nx[2];
#pragma unroll
    for (int x = 0; x < 2; ++x) nx[x] = *(const GAS v4u*)(OD + (size_t)gw * DM + 512 * x + 8 * lane);
    for (int row = gw; row < T; row += NGW) {
        v4u cur[2] = {nx[0], nx[1]};
        if (row + NGW < T) {
#pragma unroll
            for (int x = 0; x < 2; ++x) nx[x] = *(const GAS v4u*)(OD + (size_t)(row + NGW) * DM + 512 * x + 8 * lane); }
#pragma unroll
        for (int x = 0; x < 2; ++x) {
            const v4u a = cur[x]; v4u b; b.x = __shfl_xor(a.x, 16); b.y = __shfl_xor(a.y, 16); b.z = __shfl_xor(a.z, 16); b.w = __shfl_xor(a.w, 16);
            float o[8] = {bflo(a.x) - lam * bflo(b.x), bfhi(a.x) - lam * bfhi(b.x), bflo(a.y) - lam * bflo(b.y), bfhi(a.y) - lam * bfhi(b.y),
                          bflo(a.z) - lam * bflo(b.z), bfhi(a.z) - lam * bfhi(b.z), bflo(a.w) - lam * bflo(b.w), bfhi(a.w) - lam * bfhi(b.w)};
            float ss = 0.f;
#pragma unroll
            for (int k = 0; k < 8; ++k) ss += o[k] * o[k];
            ss += __shfl_xor(ss, 1); ss += __shfl_xor(ss, 2); ss += __shfl_xor(ss, 4); ss += __shfl_xor(ss, 8);
            const float r = rsqrtf(ss * (1.f / 128.f) + EPS) * 0.8f;
            if (mm == 0) { v4u w; w.x = pk2(o[0] * r * dw0.x, o[1] * r * dw0.y); w.y = pk2(o[2] * r * dw0.z, o[3] * r * dw0.w); w.z = pk2(o[4] * r * dw1.x, o[5] * r * dw1.y); w.w = pk2(o[6] * r * dw1.z, o[7] * r * dw1.w);
                *(GAS v4u*)(CAT + (size_t)row * DM + (2 * x + hh) * 128 + 8 * i16) = w; }
        }
    }
}

__device__ __forceinline__ void p4_wo(Frame& F) {
    pg8::Gemm g{WSP(bf16, WS_CAT), WSP(bf16, WS_WO), T, DM, DM}; pg8::StaticOrder S; S.init(T, DM, F.G, (int)blockIdx.x);
    pg8::EpiResF32 E{fin(F, 0), WSP(float, WS_Z1), DM, ALPHA};
    pg8::gemm_phase<pg8::EpiResF32, pg8::StaticOrder, true, true>(F.lds, g, S, E);
}

__device__ __forceinline__ void ln_row(f32x4 (&v)[4], const float* g, const float* bb, int lane, float& mean, float& rstd) {
    float s = 0.f;
#pragma unroll
    for (int j = 0; j < 4; ++j) s += (v[j].x + v[j].y) + (v[j].z + v[j].w);
    mean = wave_sum(s) * (1.f / DM); float s2 = 0.f;
#pragma unroll
    for (int j = 0; j < 4; ++j) { v[j] = v[j] - mean; s2 += (v[j].x * v[j].x + v[j].y * v[j].y) + (v[j].z * v[j].z + v[j].w * v[j].w); }
    rstd = rsqrtf(wave_sum(s2) * (1.f / DM) + EPS);
#pragma unroll
    for (int j = 0; j < 4; ++j) { const f32x4 gv = *(const GAS f32x4*)(g + 4 * lane + 256 * j), bv = *(const GAS f32x4*)(bb + 4 * lane + 256 * j); v[j] = v[j] * rstd * gv + bv; }
}

__device__ __forceinline__ void ln_row_pre(f32x4 (&v)[4], const f32x4 (&gv)[4], const f32x4 (&bv)[4], float& mean, float& rstd) {
    float s = 0.f;
#pragma unroll
    for (int j = 0; j < 4; ++j) s += (v[j].x + v[j].y) + (v[j].z + v[j].w);
    mean = wave_sum(s) * (1.f / DM); float s2 = 0.f;
#pragma unroll
    for (int j = 0; j < 4; ++j) { v[j] = v[j] - mean; s2 += (v[j].x * v[j].x + v[j].y * v[j].y) + (v[j].z * v[j].z + v[j].w * v[j].w); }
    rstd = rsqrtf(wave_sum(s2) * (1.f / DM) + EPS);
#pragma unroll
    for (int j = 0; j < 4; ++j) v[j] = v[j] * rstd * gv[j] + bv[j];
}
__device__ __forceinline__ void p5_router(Frame& F) {
    typedef short bf16x8r __attribute__((ext_vector_type(8)));
    LAS float* LG = (LAS float*)F.lds;
    LAS float* PX = LG + 64 * 33;
    LAS int* SEL = (LAS int*)(F.lds + LDSCTL_OFF + 1024);
    LAS int* LRK = SEL + 512;
    LAS unsigned* LCNT = (LAS unsigned*)(SEL + 1024);
    LAS unsigned* LBASE = LCNT + 32;
    LAS float* GTL = (LAS float*)(F.lds + LDSCTL_OFF + 6656);
    LAS unsigned char* XT = F.lds + 17920;
    LAS float* GB = (LAS float*)(F.lds + 17920 + 65536);
    if (F.tid < 32) LCNT[F.tid] = 0u;
    { const f32x4 gq = *(const GAS f32x4*)(fin(F, 13) + 4 * (F.tid & 255)), bq = *(const GAS f32x4*)(fin(F, 14) + 4 * (F.tid & 255)); if (F.tid < 256) *(LAS f32x4*)&GB[4 * F.tid] = gq; else *(LAS f32x4*)&GB[1024 + 4 * (F.tid - 256)] = bq; }
    const int lane = F.lane, r = lane & 15, g = lane >> 4, tg = F.wave & 3, kh = F.wave >> 2;
    const int rpb = T / F.G;
    const int row = F.vcu * rpb + tg * 16 + r;
    const float* zr = WSP(float, WS_Z1) + (size_t)row * DM + 8 * g + 512 * kh;
    f32x4 z[16][2];
#pragma unroll
    for (int ks = 0; ks < 16; ++ks) { z[ks][0] = *(const GAS f32x4*)(zr + 32 * ks); z[ks][1] = *(const GAS f32x4*)(zr + 32 * ks + 4); }
    const bf16* wh = WSP(bf16, WS_RWT) + (size_t)r * DM + 8 * g + 512 * kh; const bf16* wl = wh + DM * NE;
    bf16x8r Bc[2][2], Bn[2][2];
#pragma unroll
    for (int nb = 0; nb < 2; ++nb) { Bc[nb][0] = *(const GAS bf16x8r*)(wh + (size_t)nb * 16 * DM); Bc[nb][1] = *(const GAS bf16x8r*)(wl + (size_t)nb * 16 * DM); }
    float s1 = 0.f, s2 = 0.f;
#pragma unroll
    for (int ks = 0; ks < 16; ++ks) { const f32x4 a = z[ks][0], b = z[ks][1];
        s1 += (a.x + a.y) + (a.z + a.w) + (b.x + b.y) + (b.z + b.w); s2 += (a.x * a.x + a.y * a.y) + (a.z * a.z + a.w * a.w) + (b.x * b.x + b.y * b.y) + (b.z * b.z + b.w * b.w); }
    s1 += __shfl_xor(s1, 16); s1 += __shfl_xor(s1, 32); s2 += __shfl_xor(s2, 16); s2 += __shfl_xor(s2, 32);
    LAS float* PS = PX + 4 * 2 * 64 * 4;
    if (g == 0) { PS[(F.wave * 16 + r) * 2] = s1; PS[(F.wave * 16 + r) * 2 + 1] = s2; }
    __syncthreads();
    { const int pw = F.wave ^ 4; s1 += PS[(pw * 16 + r) * 2]; s2 += PS[(pw * 16 + r) * 2 + 1]; }
    const float mean = s1 * (1.f / DM), rstd = rsqrtf(fmaxf(s2 * (1.f / DM) - mean * mean, 0.f) + EPS);
    f32x4 acc[2] = {{0.f, 0.f, 0.f, 0.f}, {0.f, 0.f, 0.f, 0.f}};
#pragma unroll
    for (int ks = 0; ks < 16; ++ks) {
        if (ks + 1 < 16) {
#pragma unroll
            for (int nb = 0; nb < 2; ++nb) { Bn[nb][0] = *(const GAS bf16x8r*)(wh + (size_t)nb * 16 * DM + 32 * (ks + 1)); Bn[nb][1] = *(const GAS bf16x8r*)(wl + (size_t)nb * 16 * DM + 32 * (ks + 1)); } }
        const f32x4 ha = (z[ks][0] - mean) * rstd, hb = (z[ks][1] - mean) * rstd;
        const float h[8] = {ha.x, ha.y, ha.z, ha.w, hb.x, hb.y, hb.z, hb.w}; unsigned hi[8]; float lo[8];
#pragma unroll
        for (int j = 0; j < 8; ++j) { hi[j] = f2bf(h[j]); lo[j] = h[j] - bf2f(hi[j]); }
        v4u Ah, Al; Ah.x = hi[0] | (hi[1] << 16); Ah.y = hi[2] | (hi[3] << 16); Ah.z = hi[4] | (hi[5] << 16); Ah.w = hi[6] | (hi[7] << 16);
        Al.x = pk2(lo[0], lo[1]); Al.y = pk2(lo[2], lo[3]); Al.z = pk2(lo[4], lo[5]); Al.w = pk2(lo[6], lo[7]);
        const bf16x8r ah = __builtin_bit_cast(bf16x8r, Ah), al = __builtin_bit_cast(bf16x8r, Al);
#pragma unroll
        for (int nb = 0; nb < 2; ++nb) { acc[nb] = __builtin_amdgcn_mfma_f32_16x16x32_bf16(ah, Bc[nb][0], acc[nb], 0, 0, 0); acc[nb] = __builtin_amdgcn_mfma_f32_16x16x32_bf16(ah, Bc[nb][1], acc[nb], 0, 0, 0);
            acc[nb] = __builtin_amdgcn_mfma_f32_16x16x32_bf16(al, Bc[nb][0], acc[nb], 0, 0, 0); }
#pragma unroll
        for (int nb = 0; nb < 2; ++nb) { Bc[nb][0] = Bn[nb][0]; Bc[nb][1] = Bn[nb][1]; }
    }
#pragma unroll
    for (int ks = 0; ks < 16; ++ks) { const int col = 512 * kh + 32 * ks + 8 * g;
        const f32x4 g0 = *(const LAS f32x4*)&GB[col], g1 = *(const LAS f32x4*)&GB[col + 4], b0 = *(const LAS f32x4*)&GB[1024 + col], b1 = *(const LAS f32x4*)&GB[1024 + col + 4];
        const f32x4 ha = (z[ks][0] - mean) * rstd * g0 + b0, hb = (z[ks][1] - mean) * rstd * g1 + b1;
        v2u w; w.x = pk4_fp8(ha.x, ha.y, ha.z, ha.w); w.y = pk4_fp8(hb.x, hb.y, hb.z, hb.w);
        *(LAS v2u*)(XT + (tg * 16 + r) * 1024 + col) = w; }
    if (kh == 1) { *(LAS f32x4*)&PX[((tg * 2 + 0) * 64 + lane) * 4] = acc[0]; *(LAS f32x4*)&PX[((tg * 2 + 1) * 64 + lane) * 4] = acc[1]; }
    __syncthreads();
    if (kh == 0) {
#pragma unroll
        for (int nb = 0; nb < 2; ++nb) { const f32x4 o = acc[nb] + *(const LAS f32x4*)&PX[((tg * 2 + nb) * 64 + lane) * 4]; const float bias = WSP(float, WS_RWT + 2 * DM * NE * 2)[16 * nb + r];
#pragma unroll
            for (int q = 0; q < 4; ++q) LG[(tg * 16 + 4 * g + q) * 33 + 16 * nb + r] = o[q] + bias; }
    }
    __syncthreads();
    LAS float* selv = (LAS float*)(F.lds + LDSCTL_OFF + 6144 + F.wave * 32); LAS int* seli = (LAS int*)(selv + 4);
    for (int rl = F.wave; rl < rpb; rl += NWAVES) {
        const float logit = LG[rl * 33 + (lane >> 1)];
        const int myi = lane >> 1; int rank = 0;
#pragma unroll
        for (int e2 = 0; e2 < 32; ++e2) { const float o = __int_as_float(__builtin_amdgcn_readlane(__float_as_int(logit), 2 * e2)); rank += (o > logit || (o == logit && e2 < myi)) ? 1 : 0; }
        if ((lane & 1) == 0 && rank < 4) { selv[rank] = logit; seli[rank] = myi; }
        float tv[4]; int ti[4];
#pragma unroll
        for (int k = 0; k < 4; ++k) { tv[k] = selv[k]; ti[k] = seli[k]; }
        const float e1 = __expf(tv[1] - tv[0]), e2 = __expf(tv[2] - tv[0]), e3 = __expf(tv[3] - tv[0]); const float inv = 1.f / (1.f + e1 + e2 + e3);
        if (lane < 4) { const int e = lane == 0 ? ti[0] : lane == 1 ? ti[1] : lane == 2 ? ti[2] : ti[3]; const float gt = (lane == 0 ? 1.f : lane == 1 ? e1 : lane == 2 ? e2 : e3) * inv;
            SEL[rl * 4 + lane] = e; GTL[rl * 4 + lane] = gt;
            LRK[rl * 4 + lane] = (int)__hip_atomic_fetch_add((LAS unsigned*)&LCNT[e], 1u, __ATOMIC_RELAXED, __HIP_MEMORY_SCOPE_WORKGROUP); }
    }
    __syncthreads();
    if (F.tid < 32) LBASE[F.tid] = __hip_atomic_fetch_add((unsigned*)(F.ctl + CW_CNT + F.tid), LCNT[F.tid], RLX_AGENT);
    __syncthreads();
    if (F.tid == 0) { __hip_atomic_fetch_add((unsigned*)(F.ctl + CW_RDONE), 1u, RLX_AGENT); unsigned sp = 0;
        while (__hip_atomic_load((unsigned*)(F.ctl + CW_RDONE), RLX_AGENT) < (unsigned)F.G && ++sp < (1u << 24)) __builtin_amdgcn_s_sleep(1); }
    __syncthreads();
    LAS int* pst = (LAS int*)(F.lds + LDSCTL_OFF + 7680);
    if (F.tid == 0) { int a = 0; for (int e = 0; e < NE; ++e) { pst[e] = a; const int c = (int)__hip_atomic_load((unsigned*)(F.ctl + CW_CNT + e), RLX_AGENT); a += (c + 255) / 256 * 256; } pst[NE] = a; }
    __syncthreads();
    int* ROWSLOT = WSP(int, WS_ROWS); float* ROWGATE = WSP(float, WS_ROWS + MAXROWS * 4); int* BLKE = WSP(int, WS_ROWS + 2 * MAXROWS * 4); int* BLKV = BLKE + 512; int* NBLK = BLKE + 1024;
    if (blockIdx.x == 0 && F.tid < NE) { const int e = F.tid, c = (int)__hip_atomic_load((unsigned*)(F.ctl + CW_CNT + e), RLX_AGENT); const int b0 = pst[e] / 256, nb = (pst[e + 1] - pst[e]) / 256;
        for (int i = 0; i < nb; ++i) { BLKE[b0 + i] = e; BLKV[b0 + i] = min(256, c - 256 * i); }
        if (e == 0) NBLK[0] = pst[NE] / 256; }
    for (int rl = F.wave; rl < rpb; rl += NWAVES) {
        const v4u rowv = *(const LAS v4u*)(XT + rl * 1024 + 16 * lane);
#pragma unroll
        for (int k = 0; k < 4; ++k) { const int e = SEL[rl * 4 + k], dest = pst[e] + (int)LBASE[e] + LRK[rl * 4 + k];
            *(GAS v4u*)(WSP(unsigned char, WS_XS) + (size_t)dest * DM + 16 * lane) = rowv;
            if (lane == 0) { ROWSLOT[dest] = (F.vcu * rpb + rl) * 4 + k; ROWGATE[dest] = GTL[rl * 4 + k]; } }
    }
    __syncthreads();
}

__device__ __forceinline__ void p7_gateup(Frame& F) {
    const int* BLKE = WSP(int, WS_ROWS + 2 * MAXROWS * 4); const int nblk = __builtin_amdgcn_readfirstlane(BLKE[1024]);
    int kk = DM / 2; asm volatile("" : "+s"(kk));
    pg8::Gemm g{WSP(bf16, WS_XS), WSP(bf16, WS_WGU), MAXROWS, 2048, kk}; pg8::MoeOrder S{BLKE, nblk * 8, 8, F.G / 8, (int)blockIdx.x};
    pg8::EpiGateUp E{WSP(bf16, WS_ACT), fin(F, 18), 1.f / WGU_SCALE};
    pg8::gemm_phase<pg8::EpiGateUp, pg8::MoeOrder, true, true, true>(F.lds, g, S, E);
}

__device__ __forceinline__ void p8_down(Frame& F) {
    const int* BLKE = WSP(int, WS_ROWS + 2 * MAXROWS * 4); const int nblk = __builtin_amdgcn_readfirstlane(BLKE[1024]);
    int kk = DM / 2; asm volatile("" : "+s"(kk));
    pg8::Gemm g{WSP(bf16, WS_ACT), WSP(bf16, WS_WDN), MAXROWS, 1024, kk}; pg8::MoeOrder S{BLKE, nblk * 4, 4, F.G / 8, (int)blockIdx.x};
    pg8::EpiDown E{WSP(bf16, WS_Y), fin(F, 20), WSP(int, WS_ROWS), WSP(float, WS_ROWS + MAXROWS * 4), BLKE + 512, 1.f / WDN_SCALE};
    pg8::gemm_phase<pg8::EpiDown, pg8::MoeOrder, true, true, true>(F.lds, g, S, E);
}

__device__ __forceinline__ void p9_final(Frame& F) {
    const int gw = F.vcu * NWAVES + F.wave, NGW = F.G * NWAVES, lane = F.lane;
    f32x4 g1[4], b1[4], g2[4], b2[4], vn[4]; v2u yn[4][4];
#pragma unroll
    for (int j = 0; j < 4; ++j) { g1[j] = *(const GAS f32x4*)(fin(F, 13) + 4 * lane + 256 * j); b1[j] = *(const GAS f32x4*)(fin(F, 14) + 4 * lane + 256 * j);
        g2[j] = *(const GAS f32x4*)(fin(F, 21) + 4 * lane + 256 * j); b2[j] = *(const GAS f32x4*)(fin(F, 22) + 4 * lane + 256 * j); }
#define P9_LOAD(r_) do { _Pragma("unroll") for (int j = 0; j < 4; ++j) vn[j] = *(const GAS f32x4*)(WSP(float, WS_Z1) + (size_t)(r_) * DM + 4 * lane + 256 * j); \
        _Pragma("unroll") for (int k = 0; k < 4; ++k) _Pragma("unroll") for (int j = 0; j < 4; ++j) yn[k][j] = ((const GAS v2u*)(WSP(bf16, WS_Y) + (size_t)((r_) * 4 + k) * DM) + lane)[64 * j]; } while (0)
    P9_LOAD(gw);
    for (int row = gw; row < T; row += NGW) {
        f32x4 v[4]; v2u y[4][4];
#pragma unroll
        for (int j = 0; j < 4; ++j) { v[j] = vn[j];
#pragma unroll
            for (int k = 0; k < 4; ++k) y[k][j] = yn[k][j]; }
        if (row + NGW < T) P9_LOAD(row + NGW);
        float mean, rstd; ln_row_pre(v, g1, b1, mean, rstd);
#pragma unroll
        for (int j = 0; j < 4; ++j) { v[j] = v[j] * ALPHA;
#pragma unroll
            for (int k = 0; k < 4; ++k) { const v2u w = y[k][j]; v[j].x += bflo(w.x); v[j].y += bfhi(w.x); v[j].z += bflo(w.y); v[j].w += bfhi(w.y); } }
        ln_row_pre(v, g2, b2, mean, rstd);
#pragma unroll
        for (int j = 0; j < 4; ++j) *(GAS f32x4*)(F.out + (size_t)row * DM + 4 * lane + 256 * j) = v[j];
    }
#undef P9_LOAD
}

constexpr int NPHASE = 10;
#ifndef PROBE_A
#define PROBE_A -1
#define PROBE_B -1
#endif
__global__ void __launch_bounds__(NTHREADS, 2) mega_fwd(Args args) {
    extern __shared__ __attribute__((aligned(16))) unsigned char lds[];
    Frame F;
    F.lds = (LAS unsigned char*)lds; F.ldsg = (char*)lds; F.MISC = (volatile LAS unsigned*)(F.lds + MISC_OFF);
    F.tid = threadIdx.x; F.lane = F.tid & 63; F.wave = __builtin_amdgcn_readfirstlane(F.tid >> 6);
    F.G = gridDim.x; { const int bx = blockIdx.x; F.vcu = (F.G % 8 == 0) ? (bx % 8) * (F.G / 8) + bx / 8 : bx; }
    F.ws = args.ws; F.ctl = (gu32*)(args.ws + WS_CTL); F.out = args.out;
    for (int u = F.tid; u < (LDS_BYTES - LDSCTL_OFF) / 4; u += NTHREADS) ((LAS unsigned*)(F.lds + LDSCTL_OFF))[u] = 0u;
    __syncthreads();
    if (F.tid < 23) ((LAS unsigned long long*)(F.lds + INTAB_OFF))[F.tid] = (unsigned long long)args.in[F.tid];
    __syncthreads();
    const bool single = (args.ph_lo == 0 && args.ph_hi == NPHASE);
    XcdBarrier bar; bar.bar = (unsigned*)(F.ctl + CW_BAR); bar.x = 0; bar.st = nullptr;
    if (single) bar = xcd_barrier_post((unsigned*)(F.ctl + CW_BAR), F.MISC + 8);
    const int lo = args.ph_lo, hi = args.ph_hi;
#ifndef PH_MASK
#define PH_MASK 0x3ff
#endif
#define IN(k) (((PH_MASK >> (k)) & 1) && lo <= (k) && (k) < hi)
#define SEAM(k) do { if (IN(k) && IN((k) + 1)) xcd_barrier(bar); F.tid = fresh_tid(); F.lane = F.tid & 63; if (PROBE_A >= 0 && blockIdx.x == 0 && F.tid == 0) pts[(k) + 1] = __builtin_amdgcn_s_memrealtime(); } while (0)
    unsigned long long* pts = (unsigned long long*)(args.ws + WS_CTL + 512 * 1024);
    if (PROBE_A >= 0 && blockIdx.x == 0 && F.tid == 0) pts[0] = __builtin_amdgcn_s_memrealtime();
    if (IN(0)) { p0_prologue(F); } SEAM(0);
    if (IN(1)) { p1_inproj(F); } SEAM(1);
    if (IN(2)) { p2_hgrn_local(F); } SEAM(2);
    if (IN(3)) { p3_attn(F); } SEAM(3);
    if (IN(4)) { p4_combine(F); } SEAM(4);
    if (IN(5)) { p4_wo(F); } SEAM(5);
    if (IN(6)) { p5_router(F); } SEAM(6);
    if (IN(7)) { p7_gateup(F); } SEAM(7);
    if (IN(8)) { p8_down(F); } SEAM(8);
    if (IN(9)) { p9_final(F); }
    if (PROBE_A >= 0 && blockIdx.x == 0 && F.tid == 0) {
        const unsigned long long tend = __builtin_amdgcn_s_memrealtime(); pts[NPHASE] = tend;
        const int pa = PROBE_A >= 0 ? PROBE_A : 0, pb = PROBE_B >= 0 ? PROBE_B : 0;
        unsigned long long qa = (pts[pa + 1] - pts[pa] + 400) / 800, qb = PROBE_B >= 0 ? (pts[pb + 1] - pts[pb] + 400) / 800 : 0; if (qa > 63) qa = 63; if (qb > 63) qb = 63;
        const unsigned long long dly = (qa + 64 * qb) * 1600;
        while (__builtin_amdgcn_s_memrealtime() - tend < dly) __builtin_amdgcn_s_sleep(8);
    }
#undef IN
#undef SEAM
}

#ifndef MK_MULTI
#define MK_MULTI 0
#endif
extern "C" void kernel_launch(void* const* d_in, const int* in_sizes, int n_in, void* d_out, int out_size, void* d_ws, size_t ws_size, hipStream_t stream) {
    static int grid = 0;
    if (grid == 0) {
        if (n_in != 23 || out_size != T * DM || ws_size < WS_END) { fprintf(stderr, "kernel_launch: unexpected shapes n_in %d out %d ws %zu\n", n_in, out_size, ws_size); grid = -1; return; }
        int dev = 0, cus = 0;
        if (hipGetDevice(&dev) != hipSuccess || hipDeviceGetAttribute(&cus, hipDeviceAttributeMultiprocessorCount, dev) != hipSuccess) { grid = -1; return; }
        if (hipFuncSetAttribute((const void*)mega_fwd, hipFuncAttributeMaxDynamicSharedMemorySize, LDS_BYTES) != hipSuccess) { fprintf(stderr, "kernel_launch: hipFuncSetAttribute failed\n"); grid = -1; return; }
        int per_cu = 0;
        if (hipOccupancyMaxActiveBlocksPerMultiprocessor(&per_cu, (const void*)mega_fwd, NTHREADS, LDS_BYTES) != hipSuccess || per_cu < 1) fprintf(stderr, "kernel_launch: occupancy query says %d\n", per_cu);
        (void)hipGetLastError();
        grid = cus;
    }
    if (grid < 0) return;
    (void)hipMemsetAsync((char*)d_ws + WS_CTL, 0, CTL_ZERO_BYTES, stream);
    Args a{};
    for (int i = 0; i < 23; ++i) a.in[i] = (const float*)d_in[i];
    a.out = (float*)d_out; a.ws = (unsigned char*)d_ws;
#if MK_MULTI
    for (int p = 0; p < NPHASE; ++p) { a.ph_lo = p; a.ph_hi = p + 1; hipLaunchKernelGGL(mega_fwd, dim3(grid), dim3(NTHREADS), LDS_BYTES, stream, a); }
#else
    a.ph_lo = 0; a.ph_hi = NPHASE;
    hipLaunchKernelGGL(mega_fwd, dim3(grid), dim3(NTHREADS), LDS_BYTES, stream, a);
#endif
}
```
